# Optimizing an MI355X kernel written in HIP

```python
import math, functools
import jax, jax.numpy as jnp
from jax import lax
import numpy as np

D_MODEL = 1024
BATCH = 4
SEQ = 4096
DEPTH = 2

GRID_W = 64
CTX_LEN = 256
N_MOD = 6
NORM_EPS = 1e-6
D_FF = -(-8 * D_MODEL // (3 * 256)) * 256

D_MIX = D_MODEL
GLA_HEADS = 4
GLA_DV = D_MIX // 2 // GLA_HEADS
GLA_DK = GLA_DV // 2
GLA_LR = 16
GLA_TAU = 16.0
GLA_CHUNK = 64
GLA_HK = GLA_HEADS * GLA_DK
GLA_HV = GLA_HEADS * GLA_DV
GMLP_GROUPS = 4
GMLP_WIDTH = D_MIX // 2
GMLP_GC = GMLP_WIDTH // GMLP_GROUPS
GMLP_CHUNK = 128
AB_STATE_SPLITS = (GLA_HK, GLA_HV, GLA_LR, GLA_LR)
AB_OUT_SPLITS = (GLA_HK, GLA_HV, GMLP_WIDTH, GMLP_WIDTH)
AB_IN = sum(AB_STATE_SPLITS + AB_OUT_SPLITS)

SSD_INNER = 2 * D_MODEL
SSD_HEADDIM = 64
SSD_HEADS = SSD_INNER // SSD_HEADDIM
SSD_GROUPS = 4
SSD_HPG = SSD_HEADS // SSD_GROUPS
SSD_STATE = 128
SSD_CHUNK = 128
SSD_CONV = 5
SSD_GS = SSD_GROUPS * SSD_STATE
SSD_CONV_DIM = SSD_INNER + 2 * SSD_GS
SSD_IN = SSD_CONV_DIM + 2 * SSD_HEADS + SSD_INNER

kernel_name = 'hybrid_gla_gmlp_ssd_prefix_dit'


def rms_norm(x, g):
    xf = x.astype(jnp.float32)
    y = xf * lax.rsqrt(jnp.mean(xf * xf, axis=-1, keepdims=True) + NORM_EPS)
    return y.astype(x.dtype) * g


def group_rms_norm(x, g, groups):
    shp = x.shape
    xf = x.astype(jnp.float32).reshape(shp[:-1] + (groups, shp[-1] // groups))
    y = xf * lax.rsqrt(jnp.mean(xf * xf, axis=-1, keepdims=True) + NORM_EPS)
    return y.reshape(shp).astype(x.dtype) * g


def layer_norm(x, g):
    xf = x.astype(jnp.float32)
    mu = jnp.mean(xf, axis=-1, keepdims=True)
    var = jnp.mean(jnp.square(xf - mu), axis=-1, keepdims=True)
    return ((xf - mu) * lax.rsqrt(var + NORM_EPS)).astype(x.dtype) * g


def modulate(h, shift, scale):
    return h * (1 + scale) + shift


def split_cols(a, sizes):
    idx = [int(i) for i in np.cumsum(sizes)[:-1]]
    return jnp.split(a, idx, axis=-1)


def swiglu(h, w_in, w_out):
    g, u = jnp.split(h @ w_in, 2, axis=-1)
    return (jax.nn.silu(g) * u) @ w_out


def to_col_major(x):
    bsz, t, d = x.shape
    rows = t // GRID_W
    return x.reshape(bsz, rows, GRID_W, d).transpose(0, 2, 1, 3).reshape(bsz, t, d)


def to_row_major(x):
    bsz, t, d = x.shape
    rows = t // GRID_W
    return x.reshape(bsz, GRID_W, rows, d).transpose(0, 2, 1, 3).reshape(bsz, t, d)


def dwconv_centred(x, w, b):
    pad = (w.shape[0] - 1) // 2
    y = lax.conv_general_dilated(x, w.astype(x.dtype)[:, None, :], window_strides=(1,),
                                 padding=[(pad, pad)], dimension_numbers=('NWC', 'WIO', 'NWC'),
                                 feature_group_count=x.shape[-1])
    return y + b


def bidir_prefix_scan(scan_f, scan_b, ctx_f, ctx_b, lat_f, lat_b, s0, ctx_out):
    flip = lambda a: None if a is None else jnp.flip(a, axis=1)
    y_cf, s_cf = scan_f(*ctx_f, s0, ctx_out)
    y_xf, _ = scan_f(*lat_f, s_cf, True)
    y_cb, s_cb = scan_b(*[flip(a) for a in ctx_b], s0, ctx_out)
    y_xb, _ = scan_b(*[flip(a) for a in lat_b], s_cb, True)
    y_x = y_xf + flip(y_xb)
    y_c = y_cf + flip(y_cb) if ctx_out else None
    return y_x, y_c


def gla_chunked(k, v, log_a, q, s0, with_output):
    bsz, t, h, dk = k.shape
    dv = v.shape[-1]
    n = t // GLA_CHUNK
    chunks = lambda a: a.astype(jnp.float32).reshape(bsz, n, GLA_CHUNK, h, a.shape[-1])
    k, v, log_a = chunks(k), chunks(v), chunks(log_a)
    b = jnp.cumsum(log_a, axis=2)
    b_last = b[:, :, -1]
    d_state = jnp.einsum('bnlhk,bnlhv->bnhkv', k * jnp.exp(b_last[:, :, None] - b), v)

    def step(s, inp):
        decay, ds = inp
        return decay[..., None] * s + ds, s

    s_final, s_prev = lax.scan(step, s0, (jnp.moveaxis(jnp.exp(b_last), 1, 0), jnp.moveaxis(d_state, 1, 0)))
    if not with_output:
        return None, s_final
    q = chunks(q)
    s_prev = jnp.moveaxis(s_prev, 0, 1)
    q_dec = q * jnp.exp(b)
    o_inter = jnp.einsum('bnlhk,bnhkv->bnlhv', q_dec, s_prev)
    scores = jnp.einsum('bnlhk,bnshk->bnhls', q_dec, k * jnp.exp(-b))
    tri = jnp.tril(jnp.ones((GLA_CHUNK, GLA_CHUNK), dtype=bool))
    scores = jnp.where(tri, scores, 0.0)
    o_intra = jnp.einsum('bnhls,bnshv->bnlhv', scores, v)
    return (o_inter + o_intra).reshape(bsz, t, h, dv), s_final


def ssd_chunked(x, bm, dt, cm, s0, with_output, a_coef):
    bsz, t = x.shape[:2]
    n = t // SSD_CHUNK
    f = lambda z: z.astype(jnp.float32).reshape((bsz, n, SSD_CHUNK) + z.shape[2:])
    x, bm, dt = f(x), f(bm), f(dt)
    acum = jnp.cumsum(dt * a_coef, axis=2)
    a_last = acum[:, :, -1]
    xdt = x * dt[..., None]
    states = jnp.einsum('bclgn,bclgh,bclghp->bcghpn', bm, jnp.exp(a_last[:, :, None] - acum), xdt)

    def step(s, inp):
        decay, st = inp
        return decay[..., None, None] * s + st, s

    s_final, s_prev = lax.scan(step, s0, (jnp.moveaxis(jnp.exp(a_last), 1, 0), jnp.moveaxis(states, 1, 0)))
    if not with_output:
        return None, s_final
    cm = f(cm)
    s_prev = jnp.moveaxis(s_prev, 0, 1)
    y_off = jnp.einsum('bclgn,bcghpn->bclghp', cm, s_prev) * jnp.exp(acum)[..., None]
    at = jnp.moveaxis(acum, 2, -1)
    seg = at[..., :, None] - at[..., None, :]
    tri = jnp.tril(jnp.ones((SSD_CHUNK, SSD_CHUNK), dtype=bool))
    decay = jnp.exp(jnp.where(tri, seg, -jnp.inf))
    cb = jnp.einsum('bclgn,bcsgn->bcgls', cm, bm)
    y_diag = jnp.einsum('bcgls,bcghls,bcsghp->bclghp', cb, decay, xdt)
    return (y_diag + y_off).reshape((bsz, t) + x.shape[3:]), s_final


def ab_project(h, w_in, gate_w, gate_b, full):
    bsz, t, _ = h.shape
    sizes = AB_STATE_SPLITS + AB_OUT_SPLITS if full else AB_STATE_SPLITS
    parts = split_cols(h @ w_in[:, :sum(sizes)], sizes)
    heads = lambda a: a.reshape(bsz, t, GLA_HEADS, -1)
    k, v, lr_f, lr_b = parts[:4]
    la_f = jax.nn.log_sigmoid((lr_f @ gate_w[0] + gate_b[0]).astype(jnp.float32)) / GLA_TAU
    la_b = jax.nn.log_sigmoid((lr_b @ gate_w[1] + gate_b[1]).astype(jnp.float32)) / GLA_TAU
    state = (heads(k), heads(v), heads(la_f), heads(la_b))
    if not full:
        return state, None
    q, r, u, g = parts[4:]
    return state, (heads(q) * GLA_DK ** -0.5, r, u, g)


def gmlp_chunk_mix(u, v, vnorm_g, spatial_w, spatial_b):
    bsz, t, _ = u.shape
    n = t // GMLP_CHUNK
    u = jax.nn.gelu(u)
    v = layer_norm(jax.nn.gelu(v), vnorm_g).reshape(bsz, n, GMLP_CHUNK, GMLP_GROUPS, GMLP_GC)
    s = jnp.einsum('gts,bnsgc->bntgc', spatial_w, v) + spatial_b.T[:, :, None]
    return u * s.reshape(bsz, t, GMLP_WIDTH)


def mixer_gla_gmlp(hx, hc, w_in, gate_w, gate_b, gla_norm_g, vnorm_g, spatial_w, spatial_b, w_out, ctx_out):
    (kx, vx, lfx, lbx), (qx, rx, ux, gx) = ab_project(hx, w_in, gate_w, gate_b, True)
    (kc, vc, lfc, lbc), rest_c = ab_project(hc, w_in, gate_w, gate_b, ctx_out)
    qc = rest_c[0] if ctx_out else None
    s0 = jnp.zeros((hx.shape[0], GLA_HEADS, GLA_DK, GLA_DV), jnp.float32)
    ox, oc = bidir_prefix_scan(gla_chunked, gla_chunked,
                               [kc, vc, lfc, qc], [kc, vc, lbc, qc],
                               [kx, vx, lfx, qx], [kx, vx, lbx, qx], s0, ctx_out)

    def merge(o, r, u, g):
        bsz, t = o.shape[:2]
        a = group_rms_norm(o.reshape(bsz, t, GLA_HV), gla_norm_g, GLA_HEADS) * jax.nn.silu(r)
        b = gmlp_chunk_mix(u, g, vnorm_g, spatial_w, spatial_b)
        return jnp.concatenate([a.astype(b.dtype), b], axis=-1) @ w_out

    yx = merge(ox, rx, ux, gx)
    yc = merge(oc, rest_c[1], rest_c[2], rest_c[3]) if ctx_out else None
    return yx, yc


def ssd_project(h, w_in, conv_w, conv_b, dt_bias, full):
    bsz, t, _ = h.shape
    if full:
        p = h @ w_in
        xbc = jax.nn.silu(dwconv_centred(p[..., :SSD_CONV_DIM], conv_w, conv_b))
        xs, bm, cm = split_cols(xbc, (SSD_INNER, SSD_GS, SSD_GS))
        dt_raw = p[..., SSD_CONV_DIM:SSD_CONV_DIM + 2 * SSD_HEADS]
        z = p[..., SSD_CONV_DIM + 2 * SSD_HEADS:]
        cm = cm.reshape(bsz, t, SSD_GROUPS, SSD_STATE)
    else:
        nxb = SSD_INNER + SSD_GS
        xb = jax.nn.silu(dwconv_centred(h @ w_in[:, :nxb], conv_w[:, :nxb], conv_b[:nxb]))
        xs, bm = split_cols(xb, (SSD_INNER, SSD_GS))
        dt_raw = h @ w_in[:, SSD_CONV_DIM:SSD_CONV_DIM + 2 * SSD_HEADS]
        cm = None
        z = None
    dt = jax.nn.softplus(dt_raw.astype(jnp.float32).reshape(bsz, t, 2, SSD_HEADS) + dt_bias)
    dt = dt.reshape(bsz, t, 2, SSD_GROUPS, SSD_HPG)
    xs = xs.reshape(bsz, t, SSD_GROUPS, SSD_HPG, SSD_HEADDIM)
    bm = bm.reshape(bsz, t, SSD_GROUPS, SSD_STATE)
    return xs, bm, cm, dt[:, :, 0], dt[:, :, 1], z


def mixer_ssd(hx, hc, w_in, conv_w, conv_b, dt_bias, a_log, d_skip, norm_g, w_out, ctx_out):
    xx, bx, cx, dfx, dbx, zx = ssd_project(hx, w_in, conv_w, conv_b, dt_bias, True)
    xc, bc, cc, dfc, dbc, zc = ssd_project(hc, w_in, conv_w, conv_b, dt_bias, ctx_out)
    a = -jnp.exp(a_log.astype(jnp.float32)).reshape(2, SSD_GROUPS, SSD_HPG)
    s0 = jnp.zeros((hx.shape[0], SSD_GROUPS, SSD_HPG, SSD_HEADDIM, SSD_STATE), jnp.float32)
    yx, yc = bidir_prefix_scan(functools.partial(ssd_chunked, a_coef=a[0]),
                               functools.partial(ssd_chunked, a_coef=a[1]),
                               [xc, bc, dfc, cc], [xc, bc, dbc, cc],
                               [xx, bx, dfx, cx], [xx, bx, dbx, cx], s0, ctx_out)
    d_h = d_skip.reshape(SSD_GROUPS, SSD_HPG)[..., None]

    def finish(y, xs, z):
        bsz, t = y.shape[:2]
        y = (y + d_h * xs).reshape(bsz, t, SSD_INNER)
        y = group_rms_norm(y * jax.nn.silu(z), norm_g, SSD_GROUPS)
        return y.astype(z.dtype) @ w_out

    out_x = finish(yx, xx, zx)
    out_c = finish(yc, xc, zc) if ctx_out else None
    return out_x, out_c


def setup_inputs(seed: int = 0) -> dict:
    key = jax.random.key(seed)
    ks = iter(jax.random.split(key, 40))

    def nrm(shape, scale):
        return jax.random.normal(next(ks), shape, jnp.float32) * scale

    ne, no = (DEPTH + 1) // 2, DEPTH // 2
    dt0 = jnp.exp(jax.random.uniform(next(ks), (no, 2, SSD_HEADS), jnp.float32, math.log(1e-3), math.log(1e-1)))
    return {
        'x': nrm((BATCH, SEQ, D_MODEL), 1.0),
        'c': nrm((BATCH, D_MODEL), 1.0),
        'ctx': nrm((BATCH, CTX_LEN, D_MODEL), 1.0),
        'c_ctx': nrm((D_MODEL,), 1.0),
        'mod_w': nrm((DEPTH, D_MODEL, N_MOD * D_MODEL), D_MODEL ** -0.5),
        'mod_b': nrm((DEPTH, N_MOD * D_MODEL), 0.02),
        'norm_g': 1.0 + nrm((DEPTH, 2, D_MODEL), 0.02),
        'ffn_w_in': nrm((DEPTH, D_MODEL, 2 * D_FF), D_MODEL ** -0.5),
        'ffn_w_out': nrm((DEPTH, D_FF, D_MODEL), D_FF ** -0.5),
        'ab_w_in': nrm((ne, D_MODEL, AB_IN), D_MODEL ** -0.5),
        'ab_gate_w': nrm((ne, 2, GLA_LR, GLA_HK), GLA_LR ** -0.5),
        'ab_gate_b': nrm((ne, 2, GLA_HK), 0.1),
        'ab_gla_norm_g': 1.0 + nrm((ne, GLA_HV), 0.02),
        'ab_vnorm_g': 1.0 + nrm((ne, GMLP_WIDTH), 0.02),
        'ab_spatial_w': nrm((ne, GMLP_GROUPS, GMLP_CHUNK, GMLP_CHUNK), GMLP_CHUNK ** -0.5),
        'ab_spatial_b': 1.0 + nrm((ne, GMLP_GROUPS, GMLP_CHUNK), 0.02),
        'ab_w_out': nrm((ne, D_MIX, D_MODEL), D_MIX ** -0.5),
        'ssd_w_in': nrm((no, D_MODEL, SSD_IN), D_MODEL ** -0.5),
        'ssd_conv_w': nrm((no, SSD_CONV, SSD_CONV_DIM), SSD_CONV ** -0.5),
        'ssd_conv_b': nrm((no, SSD_CONV_DIM), 0.02),
        'ssd_dt_bias': dt0 + jnp.log(-jnp.expm1(-dt0)),
        'ssd_a_log': jnp.log(jax.random.uniform(next(ks), (no, 2, SSD_HEADS), jnp.float32, 1.0, 16.0)),
        'ssd_d': 1.0 + nrm((no, SSD_HEADS), 0.02),
        'ssd_norm_g': 1.0 + nrm((no, SSD_INNER), 0.02),
        'ssd_w_out': nrm((no, SSD_INNER, D_MODEL), SSD_INNER ** -0.5),
        'final_norm_g': 1.0 + nrm((D_MODEL,), 0.02),
    }


def reference(x, c, ctx, c_ctx, mod_w, mod_b, norm_g, ffn_w_in, ffn_w_out,
              ab_w_in, ab_gate_w, ab_gate_b, ab_gla_norm_g, ab_vnorm_g, ab_spatial_w, ab_spatial_b, ab_w_out,
              ssd_w_in, ssd_conv_w, ssd_conv_b, ssd_dt_bias, ssd_a_log, ssd_d, ssd_norm_g, ssd_w_out,
              final_norm_g):
    sc = jax.nn.silu(c)
    sc_ctx = jax.nn.silu(c_ctx)
    for i in range(DEPTH):
        ctx_out = i < DEPTH - 1
        j = i // 2
        mx = jnp.split((sc @ mod_w[i] + mod_b[i])[:, None, :], N_MOD, axis=-1)
        mc = jnp.split(sc_ctx @ mod_w[i] + mod_b[i], N_MOD, axis=-1)
        hx = modulate(rms_norm(x, norm_g[i, 0]), mx[0], mx[1])
        hc = modulate(rms_norm(ctx, norm_g[i, 0]), mc[0], mc[1])
        if i % 2 == 0:
            yx, yc = mixer_gla_gmlp(hx, hc, ab_w_in[j], ab_gate_w[j], ab_gate_b[j], ab_gla_norm_g[j],
                                    ab_vnorm_g[j], ab_spatial_w[j], ab_spatial_b[j], ab_w_out[j], ctx_out)
        else:
            yx_cm, yc = mixer_ssd(to_col_major(hx), hc, ssd_w_in[j], ssd_conv_w[j], ssd_conv_b[j],
                                  ssd_dt_bias[j], ssd_a_log[j], ssd_d[j], ssd_norm_g[j], ssd_w_out[j], ctx_out)
            yx = to_row_major(yx_cm)
        x = x + mx[2] * yx
        x = x + mx[5] * swiglu(modulate(rms_norm(x, norm_g[i, 1]), mx[3], mx[4]), ffn_w_in[i], ffn_w_out[i])
        if ctx_out:
            ctx = ctx + mc[2] * yc
            ctx = ctx + mc[5] * swiglu(modulate(rms_norm(ctx, norm_g[i, 1]), mc[3], mc[4]), ffn_w_in[i], ffn_w_out[i])
    return rms_norm(x, final_norm_g)
```

```cpp
#include <hip/hip_runtime.h>
#include <hip/hip_cooperative_groups.h>
#include <cstdio>
namespace cg = cooperative_groups;
namespace pg8 {
#define PG8_LAS __attribute__((address_space(3)))
typedef unsigned short bf16_t;
typedef short bf16x8 __attribute__((ext_vector_type(8)));
typedef float f32x4 __attribute__((ext_vector_type(4)));
typedef unsigned u32x4 __attribute__((ext_vector_type(4)));
constexpr int BM = 256, BK = 64, HALF = 128, HTB = HALF * BK * 2  , STAGE_BYTES = 8 * HTB, NXCD = 8, WGM = 8;

__host__ __device__ __forceinline__ int lds_byte(int r, int c) { const int st = (r >> 4) * 2 + (c >> 5), rr = r & 15, cc = c & 31, ob = rr * 64 + cc * 2; return st * 1024 + (ob ^ (((ob >> 9) & 1) << 5)); }
__host__ __device__ __forceinline__ void stage_rc(int b, int& R, int& C) { const int st = b / 1024, sb = b % 1024, swz = sb ^ (((sb >> 9) & 1) << 5); R = (st >> 1) * 16 + swz / 64; C = (st & 1) * 32 + (swz % 64) / 2; }
__host__ __device__ __forceinline__ int perm32(int rho) { const int n = rho >> 4, i = rho & 15; return 8 * (i >> 2) + 4 * n + (i & 3); }

struct Unit { int pm, pn; };
struct Gemm { const bf16_t* A; const bf16_t* Bt; int M, N, K; };

struct StaticOrder {
    int nM, nN, nwg, G, c;
    __host__ __device__ void init(int M, int N, int G_, int c_) { nM = M / BM; nN = N / BM; nwg = nM * nN; G = G_; c = c_; }
    __host__ __device__ bool next(int i, Unit& u) const {
        const long L = (long)i * G + c; if (L >= nwg) return false;
        int wgid = (int)L; { const int q = nwg / NXCD, r = nwg % NXCD, xcd = wgid % NXCD, off = wgid / NXCD; wgid = (xcd < r ? xcd * (q + 1) : r * (q + 1) + (xcd - r) * q) + off; }
        const int nig = WGM * nN, gid = wgid / nig, fm = gid * WGM, gsz = (nM - fm) < WGM ? (nM - fm) : WGM;
        u.pm = fm + ((wgid % nig) % gsz); u.pn = (wgid % nig) / gsz; return true;
    }
    __device__ __forceinline__ void a_ready(const Unit&) const {}
    __device__ __forceinline__ void done(const Unit&) const {}
};
__device__ __forceinline__ unsigned cvt_pk_bf16(float lo, float hi) { unsigned r; asm volatile("v_cvt_pk_bf16_f32 %0, %1, %2" : "=v"(r) : "v"(lo), "v"(hi)); return r; }
template <class Epi, class Sched, bool STAMP = false>
__device__ __forceinline__ void gemm_phase(PG8_LAS unsigned char* lds, const Gemm g, const Sched& S, const Epi& E, unsigned long long* stamps) {
    int tid_ = threadIdx.x; asm volatile("" : "+v"(tid_)); const int tid = tid_, wid = __builtin_amdgcn_readfirstlane(tid >> 6), lane = tid & 63, wr = wid >> 2, wc = wid & 3, fr = lane & 15, fq = lane >> 4;
    const int K = g.K, nt = K / BK;
    int ts_lo = 0, ts_hi = 0, nts = 0; const unsigned long long rt_entry = STAMP ? (unsigned long long)wall_clock64() : 0ull;
#define PG8_STAMP() do { if (STAMP && wid == 0 && nts < 64) { const unsigned long long _c = (unsigned long long)clock64(); \
        ts_lo = (lane == nts) ? (int)(unsigned)_c : ts_lo; ts_hi = (lane == nts) ? (int)(unsigned)(_c >> 32) : ts_hi; ++nts; } } while (0)
    PG8_STAMP();
    unsigned voffA[2], voffB[2];
#pragma unroll
    for (int i = 0; i < 2; ++i) { int R, C; stage_rc(tid * 16 + i * 8192, R, C); const int Rb = Epi::PERM ? ((R & ~31) + perm32(R & 31)) : R;
        voffA[i] = (unsigned)(R * K + C) * 2u; voffB[i] = (unsigned)(Rb * K + C) * 2u; }
    const size_t kstep = (size_t)(BK * 2);
    const size_t hstep = (size_t)HALF * K * 2;
    const size_t tstep = 2 * hstep;
    const unsigned ldsw = (unsigned)wid * 1024u;
    const int aoff = lds_byte(wr * 64 + fr, fq * 8), boff = lds_byte(wc * 32 + fr, fq * 8);
#define PG8_SA(b, h) (((b) * 2 + (h)) * HTB)
#define PG8_SB(b, h) ((4 + (b) * 2 + (h)) * HTB)
#define PG8_STAGE(bufoff, gbase, voff) do { _Pragma("unroll") for (int _i = 0; _i < 2; ++_i) \
        __builtin_amdgcn_global_load_lds((const unsigned*)((const char*)(gbase) + (voff)[_i]), (PG8_LAS unsigned*)(lds + (bufoff) + ldsw + _i * 8192), 16, 0, 0); } while (0)
#define PG8_LDA(dst, b, h) do { _Pragma("unroll") for (int m = 0; m < 4; ++m) _Pragma("unroll") for (int k = 0; k < 2; ++k) dst[m][k] = *(const PG8_LAS bf16x8*)(lds + PG8_SA(b, h) + aoff + m * 2048 + k * 1024); } while (0)
#define PG8_LDB(dst, b, h) do { _Pragma("unroll") for (int n = 0; n < 2; ++n) _Pragma("unroll") for (int k = 0; k < 2; ++k) dst[n][k] = *(const PG8_LAS bf16x8*)(lds + PG8_SB(b, h) + boff + n * 2048 + k * 1024); } while (0)
#define PG8_MMA(ai, bj, At, Bt) do { __builtin_amdgcn_s_setprio(1); _Pragma("unroll") for (int m = 0; m < 4; ++m) _Pragma("unroll") for (int n = 0; n < 2; ++n) _Pragma("unroll") for (int k = 0; k < 2; ++k) \
        acc[ai][bj][m][n] = __builtin_amdgcn_mfma_f32_16x16x32_bf16(Bt[n][k], At[m][k], acc[ai][bj][m][n], 0, 0, 0); __builtin_amdgcn_s_setprio(0); } while (0)
#define PG8_WAIT_V(n) asm volatile("s_waitcnt vmcnt(" #n ")" ::: "memory")
#define PG8_WAIT_L(n) asm volatile("s_waitcnt lgkmcnt(" #n ")" ::: "memory")
#define PG8_BAR __builtin_amdgcn_s_barrier()
#define PG8_SCHED __builtin_amdgcn_sched_barrier(0)
    Unit cur, nxt; int ui = 0;
    if (!S.next(0, cur)) return;
    f32x4 acc[2][2][4][2];
#pragma unroll
    for (int a = 0; a < 2; ++a)
#pragma unroll
        for (int b = 0; b < 2; ++b)
#pragma unroll
            for (int m = 0; m < 4; ++m)
#pragma unroll
                for (int n = 0; n < 2; ++n) acc[a][b][m][n] = (f32x4){0.f, 0.f, 0.f, 0.f};
    bf16x8 At[4][2], B0[2][2], B1[2][2];
    const char* cA = (const char*)g.A + (size_t)cur.pm * tstep; const char* cB = (const char*)g.Bt + (size_t)cur.pn * tstep;
    S.a_ready(cur);
    PG8_STAGE(PG8_SB(0, 0), cB, voffB); PG8_STAGE(PG8_SA(0, 0), cA, voffA); PG8_STAGE(PG8_SB(0, 1), cB + hstep, voffB); PG8_STAGE(PG8_SA(0, 1), cA + hstep, voffA);
    if (wr == 1) PG8_BAR;
    PG8_WAIT_V(4); PG8_BAR;
    PG8_STAGE(PG8_SB(1, 0), cB + kstep, voffB); PG8_STAGE(PG8_SA(1, 0), cA + kstep, voffA); PG8_STAGE(PG8_SB(1, 1), cB + hstep + kstep, voffB);
    PG8_WAIT_V(6); PG8_BAR;
    PG8_STAMP();
    for (;;) {
        const bool has_next = S.next(ui + 1, nxt);
        const char* nA = has_next ? (const char*)g.A + (size_t)nxt.pm * tstep : cA; const char* nB = has_next ? (const char*)g.Bt + (size_t)nxt.pn * tstep : cB;
        for (int t = 0; t < nt; t += 2) {
            const bool last = (t == nt - 2);
            const char* a1 = cA + (size_t)(t + 1) * kstep;
            const char* a2 = last ? nA : cA + (size_t)(t + 2) * kstep; const char* b2 = last ? nB : cB + (size_t)(t + 2) * kstep;
            const char* a3 = a2 + kstep; const char* b3 = b2 + kstep;
            if (last && has_next) S.a_ready(nxt);
            PG8_LDB(B0, 0, 0); PG8_SCHED; PG8_LDA(At, 0, 0); PG8_STAGE(PG8_SA(1, 1), a1 + hstep, voffA);
            PG8_WAIT_L(8); PG8_BAR; PG8_WAIT_L(0); PG8_MMA(0, 0, At, B0); PG8_BAR; PG8_SCHED;
            PG8_LDB(B1, 0, 1); PG8_STAGE(PG8_SB(0, 0), b2, voffB);
            PG8_BAR; PG8_WAIT_L(0); PG8_MMA(0, 1, At, B1); PG8_BAR;
            PG8_LDA(At, 0, 1); PG8_STAGE(PG8_SA(0, 0), a2, voffA);
            PG8_BAR; PG8_WAIT_L(0); PG8_MMA(1, 0, At, B0); PG8_BAR; PG8_SCHED;
            PG8_STAGE(PG8_SB(0, 1), b2 + hstep, voffB);
            PG8_WAIT_V(6); PG8_BAR; PG8_MMA(1, 1, At, B1); PG8_BAR;
            PG8_LDB(B0, 1, 0); PG8_SCHED; PG8_LDA(At, 1, 0); PG8_STAGE(PG8_SA(0, 1), a2 + hstep, voffA);
            PG8_WAIT_L(8); PG8_BAR; PG8_WAIT_L(0); PG8_MMA(0, 0, At, B0); PG8_BAR; PG8_SCHED;
            PG8_LDB(B1, 1, 1); PG8_STAGE(PG8_SB(1, 0), b3, voffB);
            PG8_BAR; PG8_WAIT_L(0); PG8_MMA(0, 1, At, B1); PG8_BAR;
            PG8_LDA(At, 1, 1); PG8_STAGE(PG8_SA(1, 0), a3, voffA);
            PG8_BAR; PG8_WAIT_L(0); PG8_MMA(1, 0, At, B0); PG8_BAR; PG8_SCHED;
            PG8_STAGE(PG8_SB(1, 1), b3 + hstep, voffB);
            PG8_WAIT_V(6); PG8_BAR; PG8_MMA(1, 1, At, B1); PG8_BAR;
        }
        PG8_STAMP();
        if constexpr (!Epi::AFTER_DRAIN) { E(acc, cur, wr, wc, fr, fq); S.done(cur); }
        PG8_STAMP();
        if (!has_next) break;
#pragma unroll
        for (int a = 0; a < 2; ++a)
#pragma unroll
            for (int b = 0; b < 2; ++b)
#pragma unroll
                for (int m = 0; m < 4; ++m)
#pragma unroll
                    for (int n = 0; n < 2; ++n) acc[a][b][m][n] = (f32x4){0.f, 0.f, 0.f, 0.f};
        cur = nxt; cA = nA; cB = nB; ++ui;
    }
    PG8_WAIT_V(0);
    if (wr == 0) PG8_BAR;
    PG8_BAR;
    if constexpr (Epi::AFTER_DRAIN) { E.fused(acc, cur, wr, wc, fr, fq, lds, wid, lane); S.done(cur); }
    PG8_STAMP();
    if (STAMP && wid == 0) { stamps[lane] = lane < nts ? (((unsigned long long)(unsigned)ts_hi << 32) | (unsigned)ts_lo) : 0ull;
        if (lane == 62) stamps[62] = rt_entry; if (lane == 63) stamps[63] = (unsigned long long)wall_clock64(); }
#undef PG8_STAMP
#undef PG8_SA
#undef PG8_SB
#undef PG8_STAGE
#undef PG8_LDA
#undef PG8_LDB
#undef PG8_MMA
#undef PG8_WAIT_V
#undef PG8_WAIT_L
#undef PG8_BAR
#undef PG8_SCHED
}
}

typedef unsigned short u16;
using pg8::bf16x8; using pg8::f32x4;
typedef unsigned u32x2 __attribute__((ext_vector_type(2)));
typedef unsigned u32x4v __attribute__((ext_vector_type(4)));

constexpr int DM = 1024, NB = 4, SEQ = 4096, CTXL = 256, RL = NB * SEQ, RC = NB * CTXL, RT = RL + RC;
constexpr int DFF = 2816, NMOD = 6;
constexpr int P0_LD = 2592;
constexpr int P0_K = 0, P0_V = 256, P0_LR = 768, P0_Q = 800, P0_R = 1056, P0_U = 1568, P0_G = 2080;
constexpr int XBC_LD = 3072;
constexpr float EPS = 1e-6f;

constexpr size_t OFF_MOD = 0;
constexpr size_t OFF_A = 262144;
constexpr size_t A_AB_IN = OFF_A, A_AB_OUT = A_AB_IN + (size_t)2816 * 1024 * 2, A_FF_IN0 = A_AB_OUT + (size_t)1024 * 1024 * 2, A_FF_OUT0 = A_FF_IN0 + (size_t)5632 * 1024 * 2;
constexpr size_t A_END = A_FF_OUT0 + (size_t)1024 * 2816 * 2;
constexpr size_t A_DTRAW = OFF_A, A_DT = A_DTRAW + (size_t)RT * 64 * 4, A_ACUM = A_DT + (size_t)RT * 64 * 4, A_HALO = A_ACUM + (size_t)RT * 64 * 4;
constexpr size_t A_SSD_OUT = OFF_A, A_FF_IN1 = A_SSD_OUT + (size_t)1024 * 2048 * 2, A_FF_OUT1 = A_FF_IN1 + (size_t)5632 * 1024 * 2;
constexpr size_t OFF_B = A_END;
constexpr size_t B_SSD_INA = OFF_B, B_WZ = B_SSD_INA + (size_t)3328 * 1024 * 2, B_END = B_WZ + (size_t)2048 * 1024 * 2;
constexpr size_t OFF_XC = B_END;
constexpr size_t OFF_H = OFF_XC + (size_t)RC * DM * 4;
constexpr size_t OFF_DSC = OFF_H + (size_t)RT * DM * 2;
constexpr size_t OFF_DEC = OFF_DSC + (size_t)4 * 2 * 4 * 4 * 8192 * 4;
constexpr size_t OFF_E = OFF_DEC + (size_t)4 * 2 * 4 * 68 * 64 * 4;
constexpr size_t E_P0 = OFF_E, E_ACT = OFF_E, E_XBC = OFF_E, E_Z = OFF_E;
constexpr size_t E_Y = OFF_E + (size_t)RT * XBC_LD * 2;
constexpr size_t WS_END = E_Y + (size_t)RL * 2048 * 2;
static_assert(A_HALO + (size_t)272 * 4 * 3072 * 2 <= A_END && A_FF_OUT1 + (size_t)1024 * 2816 * 2 <= A_END, "region A overflow");
static_assert(WS_END <= (size_t)256 * 1024 * 1024, "workspace over 256 MiB");

constexpr int LDS_BYTES = 144 * 1024;

struct Params { const float* in[26]; float* out; unsigned char* ws; };
enum { I_X = 0, I_C, I_CTX, I_CCTX, I_MODW, I_MODB, I_NORMG, I_FFWIN, I_FFWOUT, I_ABWIN, I_ABGW, I_ABGB, I_ABGNG, I_ABVNG, I_ABSW, I_ABSB, I_ABWOUT,
       I_SSDWIN, I_SSDCW, I_SSDCB, I_SSDDTB, I_SSDALOG, I_SSDD, I_SSDNG, I_SSDWOUT, I_FNG };

__device__ __forceinline__ u16 f2bf(float f) { unsigned u = __float_as_uint(f); u += 0x7FFFu + ((u >> 16) & 1u); return (u16)(u >> 16); }
__device__ __forceinline__ float bf2f(unsigned b) { return __uint_as_float(b << 16); }
__device__ __forceinline__ unsigned pk2(float lo, float hi) { return (unsigned)f2bf(lo) | ((unsigned)f2bf(hi) << 16); }
__device__ __forceinline__ float bflo(unsigned w) { return __uint_as_float(w << 16); }
__device__ __forceinline__ float bfhi(unsigned w) { return __uint_as_float(w & 0xFFFF0000u); }
__device__ __forceinline__ float siluf(float x) { return x / (1.0f + __expf(-x)); }
__device__ __forceinline__ float geluf(float x) { const float y = 0.7978845608028654f * (x + 0.044715f * x * x * x); const float th = 1.0f - 2.0f / (1.0f + __expf(2.0f * y)); return 0.5f * x * (1.0f + th); }
__device__ __forceinline__ float softplusf(float x) { return fmaxf(x, 0.f) + log1pf(__expf(-fabsf(x))); }
__device__ __forceinline__ float logsigmoidf(float x) { return fminf(x, 0.f) - log1pf(__expf(-fabsf(x))); }
__device__ __forceinline__ float wave_sum(float v) {
#pragma unroll
    for (int o = 32; o > 0; o >>= 1) v += __shfl_xor(v, o, 64);
    return v;
}

template <int MT, int NT>
__device__ __forceinline__ void wave_mma(f32x4 (&acc)[MT][NT], const u16* A, int lda, const u16* B, int ldb, int ksteps) {
    const int lane = threadIdx.x & 63, fr = lane & 15, fq = lane >> 4;
    const u16* ap = A + fr * lda + fq * 8; const u16* bp = B + fr * ldb + fq * 8;
    for (int k = 0; k < ksteps; ++k) {
        bf16x8 a[MT], b[NT];
#pragma unroll
        for (int i = 0; i < MT; ++i) a[i] = *(const bf16x8*)(ap + i * 16 * lda + k * 32);
#pragma unroll
        for (int i = 0; i < NT; ++i) b[i] = *(const bf16x8*)(bp + i * 16 * ldb + k * 32);
#pragma unroll
        for (int i = 0; i < MT; ++i)
#pragma unroll
            for (int j = 0; j < NT; ++j) acc[i][j] = __builtin_amdgcn_mfma_f32_16x16x32_bf16(a[i], b[j], acc[i][j], 0, 0, 0);
    }
}
template <int MT, int NT> __device__ __forceinline__ void zero_acc(f32x4 (&acc)[MT][NT]) {
#pragma unroll
    for (int i = 0; i < MT; ++i)
#pragma unroll
        for (int j = 0; j < NT; ++j) acc[i][j] = (f32x4){0.f, 0.f, 0.f, 0.f};
}

__device__ __forceinline__ u32x4v pack8(const f32x4& a, const f32x4& b) { u32x4v r; r[0] = pk2(a[0], a[1]); r[1] = pk2(a[2], a[3]); r[2] = pk2(b[0], b[1]); r[3] = pk2(b[2], b[3]); return r; }

struct EpiBf16Plain {
    static constexpr bool PERM = true, AFTER_DRAIN = false;
    u16* O; int ld; int ncols;
    __device__ __forceinline__ void operator()(const f32x4 (&acc)[2][2][4][2], const pg8::Unit& u, int wr, int wc, int fr, int fq) const {
        const int row0 = u.pm * 256 + wr * 64 + fr, col0 = u.pn * 256 + wc * 32 + 8 * fq;
#pragma unroll
        for (int ai = 0; ai < 2; ++ai)
#pragma unroll
            for (int m = 0; m < 4; ++m) { const int row = row0 + ai * 128 + m * 16;
#pragma unroll
                for (int bj = 0; bj < 2; ++bj) { const int c = col0 + bj * 128; if (c < ncols) *(u32x4v*)(O + (size_t)row * ld + c) = pack8(acc[ai][bj][m][0], acc[ai][bj][m][1]); } }
    }
};
struct EpiSwiglu {
    static constexpr bool PERM = true, AFTER_DRAIN = false;
    u16* O;
    __device__ __forceinline__ void operator()(const f32x4 (&acc)[2][2][4][2], const pg8::Unit& u, int wr, int wc, int fr, int fq) const {
        const int row0 = u.pm * 256 + wr * 64 + fr, j0 = u.pn * 128 + wc * 32 + 8 * fq;
#pragma unroll
        for (int ai = 0; ai < 2; ++ai)
#pragma unroll
            for (int m = 0; m < 4; ++m) { const int row = row0 + ai * 128 + m * 16; f32x4 o0, o1;
#pragma unroll
                for (int i = 0; i < 4; ++i) { o0[i] = siluf(acc[ai][0][m][0][i]) * acc[ai][1][m][0][i]; o1[i] = siluf(acc[ai][0][m][1][i]) * acc[ai][1][m][1][i]; }
                *(u32x4v*)(O + (size_t)row * DFF + j0) = pack8(o0, o1); }
    }
};
struct EpiSsdIn {
    static constexpr bool PERM = true, AFTER_DRAIN = false;
    u16* XBC; u16* HALO; float* DTRAW;
    __device__ __forceinline__ void operator()(const f32x4 (&acc)[2][2][4][2], const pg8::Unit& u, int wr, int wc, int fr, int fq) const {
        const int row0 = u.pm * 256 + wr * 64 + fr, col0 = u.pn * 256 + wc * 32 + 8 * fq;
#pragma unroll
        for (int ai = 0; ai < 2; ++ai)
#pragma unroll
            for (int m = 0; m < 4; ++m) { const int row = row0 + ai * 128 + m * 16; const int rr = row & 63; const int slot = rr < 2 ? rr : (rr >= 62 ? rr - 60 : -1);
#pragma unroll
                for (int bj = 0; bj < 2; ++bj) { const int c = col0 + bj * 128;
                    if (c < 3072) { const u32x4v v = pack8(acc[ai][bj][m][0], acc[ai][bj][m][1]); *(u32x4v*)(XBC + (size_t)row * XBC_LD + c) = v;
                        if (slot >= 0) *(u32x4v*)(HALO + ((size_t)(row >> 6) * 4 + slot) * XBC_LD + c) = v; }
                    else if (c < 3136) { float* d = DTRAW + (size_t)row * 64 + (c - 3072); *(f32x4*)d = acc[ai][bj][m][0]; *(f32x4*)(d + 4) = acc[ai][bj][m][1]; } } }
    }
};
struct EpiRes {
    static constexpr bool PERM = false, AFTER_DRAIN = false;
    const float* src_lat; const float* src_ctx; float* dst_lat; float* dst_ctx; const float* gate; int cm;
    __device__ __forceinline__ void operator()(const f32x4 (&acc)[2][2][4][2], const pg8::Unit& u, int wr, int wc, int fr, int fq) const {
        const int row0 = u.pm * 256 + wr * 64 + fr, col0 = u.pn * 256 + wc * 32 + 4 * fq;
#pragma unroll
        for (int ai = 0; ai < 2; ++ai)
#pragma unroll
            for (int m = 0; m < 4; ++m) { const int row = row0 + ai * 128 + m * 16; const float* s; float* d; int mi;
                if (row < RL) { const int xr = cm ? ((row & ~4095) | ((row & 63) << 6) | ((row >> 6) & 63)) : row; s = src_lat + (size_t)xr * DM; d = dst_lat + (size_t)xr * DM; mi = row >> 12; }
                else { s = src_ctx + (size_t)(row - RL) * DM; d = dst_ctx + (size_t)(row - RL) * DM; mi = 4; }
                const float* gt = gate + mi * (NMOD * DM);
#pragma unroll
                for (int bj = 0; bj < 2; ++bj)
#pragma unroll
                    for (int n = 0; n < 2; ++n) { const int c = col0 + bj * 128 + n * 16; const f32x4 g4 = *(const f32x4*)(gt + c), x4 = *(const f32x4*)(s + c);
                        *(f32x4*)(d + c) = x4 + g4 * acc[ai][bj][m][n]; } }
    }
};

template <class Epi> __device__ __forceinline__ void run_gemm(unsigned char* shm, const u16* A, const u16* Bt, int M, int N, int K, const Epi& E) {
    pg8::Gemm g; g.A = A; g.Bt = Bt; g.M = M; g.N = N; g.K = K;
    pg8::StaticOrder S; S.init(M, N, (int)gridDim.x, (int)blockIdx.x);
    pg8::gemm_phase<Epi, pg8::StaticOrder, false>((PG8_LAS unsigned char*)shm, g, S, E, nullptr);
}

__device__ __forceinline__ int wcol(int r, int N, int mode) {
    if (mode == 0) return r < N ? r : -1;
    if (mode == 1) { const int q = r >> 8, s = (r >> 7) & 1, i = r & 127; return s * DFF + 128 * q + i; }
    if (mode == 2) return r + 3136;
    return r < 3136 ? r : -1;
}
__device__ void convert_weight(unsigned char* shm, const float* src, int K, int N, u16* dst, int NR, int mode) {
    u16* tile = (u16*)shm;
    const int t = threadIdx.x, rl = t & 63, k0 = t >> 6, r2 = t >> 3, kk = (t & 7) * 8;
    const int nkt = K >> 6, ntiles = (NR >> 6) * nkt;
    for (int ti = blockIdx.x; ti < ntiles; ti += gridDim.x) {
        const int rb = (ti / nkt) << 6, kb = (ti % nkt) << 6;
        const int col = wcol(rb + rl, N, mode);
#pragma unroll
        for (int i = 0; i < 8; ++i) { const int k = k0 + 8 * i; const float v = col >= 0 ? src[(size_t)(kb + k) * N + col] : 0.f; tile[rl * 72 + k] = f2bf(v); }
        __syncthreads();
        *(u32x4v*)(dst + (size_t)(rb + r2) * K + kb + kk) = *(const u32x4v*)(tile + r2 * 72 + kk);
        __syncthreads();
    }
}
__device__ void mod_gemv(unsigned char* shm, const Params& p) {
    float* sc = (float*)shm;
    float* red = sc + 5 * 1024;
    const int t = threadIdx.x;
    for (int i = t; i < 5 * 1024; i += 512) { const float v = i < 4096 ? p.in[I_C][i] : p.in[I_CCTX][i - 4096]; sc[i] = siluf(v); }
    __syncthreads();
    float* MOD = (float*)(p.ws + OFF_MOD);
    const int n = t & 31, kc = t >> 5;
    for (int job = blockIdx.x; job < 2 * 192; job += gridDim.x) {
        const int l = job / 192, nb = (job % 192) * 32;
        const float* W = p.in[I_MODW] + (size_t)l * DM * (NMOD * DM) + nb + n;
        float a[5] = {0.f, 0.f, 0.f, 0.f, 0.f};
#pragma unroll 8
        for (int i = 0; i < 64; ++i) { const int k = kc + 16 * i; const float w = W[(size_t)k * (NMOD * DM)];
#pragma unroll
            for (int m = 0; m < 5; ++m) a[m] += sc[m * 1024 + k] * w; }
#pragma unroll
        for (int m = 0; m < 5; ++m) red[(kc * 5 + m) * 32 + n] = a[m];
        __syncthreads();
        if (t < 160) { const int m = t >> 5; float s = 0.f;
#pragma unroll
            for (int q = 0; q < 16; ++q) s += red[(q * 5 + m) * 32 + n];
            MOD[((size_t)l * 5 + m) * (NMOD * DM) + nb + n] = s + p.in[I_MODB][(size_t)l * (NMOD * DM) + nb + n]; }
        __syncthreads();
    }
}

__device__ void norm_mod_phase(const float* lat, const float* ctx, const float* ng, const float* modl  , int ishift, int iscale, int nrows, int cm, u16* H) {
    const int lane = threadIdx.x & 63, wid = threadIdx.x >> 6;
    for (int row = blockIdx.x * 8 + wid; row < nrows; row += gridDim.x * 8) {
        const float* s = row < RL ? lat + (size_t)row * DM : ctx + (size_t)(row - RL) * DM;
        const int mi = row < RL ? (row >> 12) : 4;
        f32x4 v[4]; float ss = 0.f;
#pragma unroll
        for (int i = 0; i < 4; ++i) { v[i] = *(const f32x4*)(s + i * 256 + lane * 4); ss += v[i][0] * v[i][0] + v[i][1] * v[i][1] + v[i][2] * v[i][2] + v[i][3] * v[i][3]; }
        ss = wave_sum(ss);
        const float rs = rsqrtf(ss * (1.0f / DM) + EPS);
        const int dr = (cm && row < RL) ? ((row & ~4095) | ((row & 63) << 6) | ((row >> 6) & 63)) : row;
        const float* sh = modl + mi * (NMOD * DM) + ishift * DM; const float* scp = modl + mi * (NMOD * DM) + iscale * DM;
#pragma unroll
        for (int i = 0; i < 4; ++i) { const int c = i * 256 + lane * 4; const f32x4 g4 = *(const f32x4*)(ng + c), sh4 = *(const f32x4*)(sh + c), sc4 = *(const f32x4*)(scp + c);
            float o[4];
#pragma unroll
            for (int e = 0; e < 4; ++e) o[e] = (v[i][e] * rs * g4[e]) * (1.0f + sc4[e]) + sh4[e];
            u32x2 w; w[0] = pk2(o[0], o[1]); w[1] = pk2(o[2], o[3]); *(u32x2*)(H + (size_t)dr * DM + c) = w; }
    }
}
__device__ void final_norm_phase(float* X, const float* g) {
    const int lane = threadIdx.x & 63, wid = threadIdx.x >> 6;
    for (int row = blockIdx.x * 8 + wid; row < RL; row += gridDim.x * 8) {
        float* s = X + (size_t)row * DM; f32x4 v[4]; float ss = 0.f;
#pragma unroll
        for (int i = 0; i < 4; ++i) { v[i] = *(const f32x4*)(s + i * 256 + lane * 4); ss += v[i][0] * v[i][0] + v[i][1] * v[i][1] + v[i][2] * v[i][2] + v[i][3] * v[i][3]; }
        ss = wave_sum(ss);
        const float rs = rsqrtf(ss * (1.0f / DM) + EPS);
#pragma unroll
        for (int i = 0; i < 4; ++i) { const int c = i * 256 + lane * 4; const f32x4 g4 = *(const f32x4*)(g + c); f32x4 o;
#pragma unroll
            for (int e = 0; e < 4; ++e) o[e] = (v[i][e] * rs) * g4[e];
            *(f32x4*)(s + c) = o; }
    }
}

__device__ __forceinline__ int gla_rowbase(int b, int c) { return c < 4 ? RL + b * CTXL + c * 64 : b * SEQ + (c - 4) * 64; }
__device__ __forceinline__ float* gla_ds_ptr(const Params& p, int b, int d, int h, int c) {
    return c < 4 ? (float*)(p.ws + OFF_DSC) + ((size_t)((b * 2 + d) * 4 + h) * 4 + c) * 8192 : p.out + ((size_t)((b * 2 + d) * 4 + h) * 64 + (c - 4)) * 8192;
}
constexpr int GL_BC = 0;
constexpr int GL_LR = GL_BC + 2 * 64 * 65 * 4;
constexpr int GL_GW = GL_LR + 64 * 32 * 4;
constexpr int GL_X0 = GL_GW + 2 * 16 * 64 * 4;
constexpr int GL_LD = 72;

__device__ void gla_gates(unsigned char* shm, const Params& p, int rowbase, int h) {
    const u16* P0 = (const u16*)(p.ws + E_P0);
    float* BC = (float*)(shm + GL_BC); float* LR = (float*)(shm + GL_LR); float* GW = (float*)(shm + GL_GW);
    const int t = threadIdx.x;
    if (t < 256) { const int row = t >> 2, part = t & 3; const u32x4v w = *(const u32x4v*)(P0 + (size_t)(rowbase + row) * P0_LD + P0_LR + part * 8);
#pragma unroll
        for (int e = 0; e < 4; ++e) { LR[row * 32 + part * 8 + 2 * e] = bflo(w[e]); LR[row * 32 + part * 8 + 2 * e + 1] = bfhi(w[e]); } }
    { const int idx = t * 4, d = idx >> 10, j = (idx & 1023) >> 6, kk = idx & 63;
      *(f32x4*)(GW + idx) = *(const f32x4*)(p.in[I_ABGW] + (size_t)(d * 16 + j) * 256 + h * 64 + kk); }
    __syncthreads();
    { const int d = t >> 8, rem = t & 255, l = rem >> 2, kq = (rem & 3) * 16;
      float lr[16];
#pragma unroll
      for (int j = 0; j < 16; ++j) lr[j] = LR[l * 32 + d * 16 + j];
#pragma unroll
      for (int e = 0; e < 16; ++e) { const int kk = kq + e; float pre = p.in[I_ABGB][d * 256 + h * 64 + kk];
#pragma unroll
          for (int j = 0; j < 16; ++j) pre += lr[j] * GW[(d * 16 + j) * 64 + kk];
          BC[(d * 64 + l) * 65 + kk] = logsigmoidf(pre) * (1.0f / 16.0f); } }
    __syncthreads();
    if (t < 128) { const int d = t >> 6, kk = t & 63; float run = 0.f;
        if (d == 0) { for (int l = 0; l < 64; ++l) { run += BC[l * 65 + kk]; BC[l * 65 + kk] = run; } }
        else { for (int l = 63; l >= 0; --l) { run += BC[(64 + l) * 65 + kk]; BC[(64 + l) * 65 + kk] = run; } } }
    __syncthreads();
}
__device__ __forceinline__ void gla_stage_vT(u16* vT, const u16* P0, int rowbase, int h) {
    const int t = threadIdx.x, l = t & 63, vg = t >> 6;
    const u16* src = P0 + (size_t)(rowbase + l) * P0_LD + P0_V + h * 128 + vg * 16;
    const u32x4v w0 = *(const u32x4v*)src, w1 = *(const u32x4v*)(src + 8);
#pragma unroll
    for (int e = 0; e < 4; ++e) { vT[(vg * 16 + 2 * e) * GL_LD + l] = (u16)(w0[e] & 0xFFFF); vT[(vg * 16 + 2 * e + 1) * GL_LD + l] = (u16)(w0[e] >> 16);
        vT[(vg * 16 + 8 + 2 * e) * GL_LD + l] = (u16)(w1[e] & 0xFFFF); vT[(vg * 16 + 8 + 2 * e + 1) * GL_LD + l] = (u16)(w1[e] >> 16); }
}

__device__ void gla_a_item(unsigned char* shm, const Params& p, int b, int c, int h) {
    const u16* P0 = (const u16*)(p.ws + E_P0);
    const int rowbase = gla_rowbase(b, c), t = threadIdx.x, lane = t & 63, w = t >> 6;
    gla_gates(shm, p, rowbase, h);
    const float* BC = (const float*)(shm + GL_BC);
    u16* kwT = (u16*)(shm + GL_X0);
    u16* vT = kwT + 2 * 64 * GL_LD;
    { const int l = t & 63, kg = t >> 6; const u32x4v kw = *(const u32x4v*)(P0 + (size_t)(rowbase + l) * P0_LD + P0_K + h * 64 + kg * 8);
#pragma unroll
      for (int e = 0; e < 8; ++e) { const int k = kg * 8 + e; const float kv = (e & 1) ? bfhi(kw[e >> 1]) : bflo(kw[e >> 1]);
          const float w0 = __expf(BC[63 * 65 + k] - BC[l * 65 + k]), w1 = __expf(BC[(64 + 0) * 65 + k] - BC[(64 + l) * 65 + k]);
          kwT[k * GL_LD + l] = f2bf(kv * w0); kwT[(64 + k) * GL_LD + l] = f2bf(kv * w1); } }
    gla_stage_vT(vT, P0, rowbase, h);
    __syncthreads();
    { const int d = w >> 2, kb = w & 3; f32x4 acc[1][8]; zero_acc(acc);
      wave_mma<1, 8>(acc, kwT + (d * 64 + kb * 16) * GL_LD, GL_LD, vT, GL_LD, 2);
      float* DS = gla_ds_ptr(p, b, d, h, c);
#pragma unroll
      for (int nt = 0; nt < 8; ++nt) { const int v = nt * 16 + (lane & 15), k0 = kb * 16 + (lane >> 4) * 4; *(f32x4*)(DS + v * 64 + k0) = acc[0][nt]; } }
    if (t < 128) { const int d = t >> 6, kk = t & 63; const float bl = d == 0 ? BC[63 * 65 + kk] : BC[64 * 65 + kk];
        ((float*)(p.ws + OFF_DEC))[((size_t)((b * 2 + d) * 4 + h) * 68 + c) * 64 + kk] = __expf(bl); }
    __syncthreads();
}

__device__ void gmlp_item(unsigned char* shm, const Params& p, int b, int cc, int gi) {
    const u16* P0 = (const u16*)(p.ws + E_P0); u16* MG = (u16*)(p.ws + OFF_H);
    const int rowbase = cc < 2 ? RL + b * CTXL + cc * 128 : b * SEQ + (cc - 2) * 128;
    const int t = threadIdx.x, lane = t & 63, w = t >> 6;
    float* st = (float*)shm;
    u16* vnT = (u16*)(shm + 1024);
    u16* Ws = vnT + 128 * 136;
    { const int row = t >> 2, part = t & 3; const u16* src = P0 + (size_t)(rowbase + row) * P0_LD + P0_G + part * 128; float s = 0.f, ss = 0.f;
#pragma unroll 4
      for (int i = 0; i < 16; ++i) { const u32x4v wv = *(const u32x4v*)(src + i * 8);
#pragma unroll
          for (int e = 0; e < 4; ++e) { const float a = geluf(bflo(wv[e])), c2 = geluf(bfhi(wv[e])); s += a + c2; ss += a * a + c2 * c2; } }
      s += __shfl_xor(s, 1, 64); ss += __shfl_xor(ss, 1, 64); s += __shfl_xor(s, 2, 64); ss += __shfl_xor(ss, 2, 64);
      if (part == 0) { const float mu = s * (1.0f / 512.0f); const float var = fmaxf(ss * (1.0f / 512.0f) - mu * mu, 0.f); st[row * 2] = mu; st[row * 2 + 1] = rsqrtf(var + EPS); } }
    { const float* SW = p.in[I_ABSW] + (size_t)gi * 128 * 128;
#pragma unroll
      for (int ps = 0; ps < 8; ++ps) { const int idx = ps * 2048 + t * 4, tt = idx >> 7, s0 = idx & 127; const f32x4 v = *(const f32x4*)(SW + idx);
          u32x2 o; o[0] = pk2(v[0], v[1]); o[1] = pk2(v[2], v[3]); *(u32x2*)(Ws + tt * 136 + s0) = o; } }
    __syncthreads();
    { const int s = t & 127, cg4 = t >> 7; const u16* src = P0 + (size_t)(rowbase + s) * P0_LD + P0_G + gi * 128 + cg4 * 32; const float mu = st[s * 2], rstd = st[s * 2 + 1];
      const float* vg = p.in[I_ABVNG] + gi * 128 + cg4 * 32;
#pragma unroll
      for (int i = 0; i < 4; ++i) { const u32x4v wv = *(const u32x4v*)(src + i * 8);
#pragma unroll
          for (int e = 0; e < 8; ++e) { const float x = (e & 1) ? bfhi(wv[e >> 1]) : bflo(wv[e >> 1]); const int cl = i * 8 + e;
              vnT[(cg4 * 32 + cl) * 136 + s] = f2bf((geluf(x) - mu) * rstd * vg[cl]); } } }
    __syncthreads();
    { f32x4 acc[1][8]; zero_acc(acc);
      wave_mma<1, 8>(acc, vnT + (w * 16) * 136, 136, Ws, 136, 4);
      const int c0 = w * 16 + (lane >> 4) * 4;
#pragma unroll
      for (int nt = 0; nt < 8; ++nt) { const int tt = nt * 16 + (lane & 15); const float sb = p.in[I_ABSB][gi * 128 + tt];
          const u32x2 uw = *(const u32x2*)(P0 + (size_t)(rowbase + tt) * P0_LD + P0_U + gi * 128 + c0);
          const float o0 = geluf(bflo(uw[0])) * (acc[0][nt][0] + sb), o1 = geluf(bfhi(uw[0])) * (acc[0][nt][1] + sb), o2 = geluf(bflo(uw[1])) * (acc[0][nt][2] + sb), o3 = geluf(bfhi(uw[1])) * (acc[0][nt][3] + sb);
          u32x2 o; o[0] = pk2(o0, o1); o[1] = pk2(o2, o3); *(u32x2*)(MG + (size_t)(rowbase + tt) * DM + 512 + gi * 128 + c0) = o; } }
    __syncthreads();
}

__device__ void gla_scan_phase(const Params& p) {
    const float* DEC = (const float*)(p.ws + OFF_DEC);
    for (int gidx = blockIdx.x * 512 + threadIdx.x; gidx < 4 * 2 * 4 * 8192; gidx += gridDim.x * 512) {
        const int e = gidx & 8191, bdh = gidx >> 13, h = bdh & 3, d = (bdh >> 2) & 1, b = bdh >> 3, kk = e & 63;
        const float* dec = DEC + (size_t)bdh * 68 * 64 + kk;
        float s = 0.f;
        for (int i0 = 0; i0 < 68; i0 += 4) {
            float* ptr[4]; float ds[4], dc[4];
#pragma unroll
            for (int u = 0; u < 4; ++u) { const int i = i0 + u; const int c = d == 0 ? i : (i < 4 ? 3 - i : 71 - i); ptr[u] = gla_ds_ptr(p, b, d, h, c) + e; ds[u] = *ptr[u]; dc[u] = dec[c * 64]; }
#pragma unroll
            for (int u = 0; u < 4; ++u) { *ptr[u] = s; s = dc[u] * s + ds[u]; }
        }
    }
}

__device__ void gla_c_item(unsigned char* shm, const Params& p, int b, int c, int h) {
    const u16* P0 = (const u16*)(p.ws + E_P0); u16* MG = (u16*)(p.ws + OFF_H);
    const int rowbase = gla_rowbase(b, c), t = threadIdx.x, lane = t & 63, w = t >> 6;
    gla_gates(shm, p, rowbase, h);
    const float* BC = (const float*)(shm + GL_BC);
    u16* qd = (u16*)(shm + GL_X0);
    u16* kd = qd + 2 * 64 * GL_LD;
    u16* vT = kd + 2 * 64 * GL_LD;
    u16* SpT = vT + 128 * GL_LD;
    u16* SC = (u16*)(shm + GL_BC);
    float* O = (float*)SpT;
    { const int l = t & 63, kg = t >> 6; const u16* rp = P0 + (size_t)(rowbase + l) * P0_LD + h * 64 + kg * 8;
      const u32x4v qw = *(const u32x4v*)(rp + P0_Q), kw = *(const u32x4v*)(rp + P0_K);
#pragma unroll
      for (int d = 0; d < 2; ++d) { u32x4v qo, ko;
#pragma unroll
          for (int e2 = 0; e2 < 4; ++e2) { const float e0 = BC[(d * 64 + l) * 65 + kg * 8 + 2 * e2], e1 = BC[(d * 64 + l) * 65 + kg * 8 + 2 * e2 + 1];
              qo[e2] = pk2(bflo(qw[e2]) * 0.125f * __expf(e0), bfhi(qw[e2]) * 0.125f * __expf(e1));
              ko[e2] = pk2(bflo(kw[e2]) * __expf(-e0), bfhi(kw[e2]) * __expf(-e1)); }
          *(u32x4v*)(qd + (d * 64 + l) * GL_LD + kg * 8) = qo; *(u32x4v*)(kd + (d * 64 + l) * GL_LD + kg * 8) = ko; } }
    gla_stage_vT(vT, P0, rowbase, h);
#pragma unroll
    for (int ps = 0; ps < 4; ++ps) { const int idx = ps * 4096 + t * 8, d = idx >> 13, rem = idx & 8191, v = rem >> 6, k0 = rem & 63;
        const float* src = gla_ds_ptr(p, b, d, h, c) + rem; const f32x4 a = *(const f32x4*)src, bq = *(const f32x4*)(src + 4);
        *(u32x4v*)(SpT + (d * 128 + v) * GL_LD + k0) = pack8(a, bq); }
    __syncthreads();
    { const int d = w >> 2, lb = w & 3; f32x4 acc[1][4]; zero_acc(acc);
      wave_mma<1, 4>(acc, qd + (d * 64 + lb * 16) * GL_LD, GL_LD, kd + d * 64 * GL_LD, GL_LD, 2);
      __syncthreads();
#pragma unroll
      for (int nt = 0; nt < 4; ++nt)
#pragma unroll
          for (int j = 0; j < 4; ++j) { const int l = lb * 16 + (lane >> 4) * 4 + j, s = nt * 16 + (lane & 15); const bool keep = d == 0 ? (s <= l) : (s >= l);
              SC[(d * 64 + l) * GL_LD + s] = f2bf(keep ? acc[0][nt][j] : 0.f); } }
    __syncthreads();
    f32x4 oacc[1][4]; zero_acc(oacc);
    const int lb = w & 3, vh = w >> 2;
#pragma unroll
    for (int d = 0; d < 2; ++d) {
        wave_mma<1, 4>(oacc, qd + (d * 64 + lb * 16) * GL_LD, GL_LD, SpT + (d * 128 + vh * 64) * GL_LD, GL_LD, 2);
        wave_mma<1, 4>(oacc, SC + (d * 64 + lb * 16) * GL_LD, GL_LD, vT + (vh * 64) * GL_LD, GL_LD, 2);
    }
    __syncthreads();
#pragma unroll
    for (int nt = 0; nt < 4; ++nt)
#pragma unroll
        for (int j = 0; j < 4; ++j) { const int l = lb * 16 + (lane >> 4) * 4 + j, v = vh * 64 + nt * 16 + (lane & 15); O[l * 132 + v] = oacc[0][nt][j]; }
    __syncthreads();
    { const int l = t >> 3, part = t & 7; float o[16]; float ss = 0.f;
#pragma unroll
      for (int i = 0; i < 4; ++i) { const f32x4 v4 = *(const f32x4*)(O + l * 132 + part * 16 + i * 4);
#pragma unroll
          for (int e = 0; e < 4; ++e) { o[i * 4 + e] = v4[e]; ss += v4[e] * v4[e]; } }
      ss += __shfl_xor(ss, 1, 64); ss += __shfl_xor(ss, 2, 64); ss += __shfl_xor(ss, 4, 64);
      const float rs = rsqrtf(ss * (1.0f / 128.0f) + EPS);
      const u16* rp = P0 + (size_t)(rowbase + l) * P0_LD + P0_R + h * 128 + part * 16; const float* gg = p.in[I_ABGNG] + h * 128 + part * 16;
      const u32x4v r0 = *(const u32x4v*)rp, r1 = *(const u32x4v*)(rp + 8); u32x4v o0, o1;
#pragma unroll
      for (int e2 = 0; e2 < 4; ++e2) {
          o0[e2] = pk2(o[2 * e2] * rs * gg[2 * e2] * siluf(bflo(r0[e2])), o[2 * e2 + 1] * rs * gg[2 * e2 + 1] * siluf(bfhi(r0[e2])));
          o1[e2] = pk2(o[8 + 2 * e2] * rs * gg[8 + 2 * e2] * siluf(bflo(r1[e2])), o[8 + 2 * e2 + 1] * rs * gg[8 + 2 * e2 + 1] * siluf(bfhi(r1[e2]))); }
      u16* dst = MG + (size_t)(rowbase + l) * DM + h * 128 + part * 16; *(u32x4v*)dst = o0; *(u32x4v*)(dst + 8) = o1; }
    __syncthreads();
}

__device__ void conv_phase(const Params& p) {
    u16* XBC = (u16*)(p.ws + E_XBC); const u16* HALO = (const u16*)(p.ws + A_HALO);
    const int t = threadIdx.x;
    if (t >= 384) return;
    const int c0 = t * 8;
    float wt[5][8], bias[8];
#pragma unroll
    for (int j = 0; j < 5; ++j) { const f32x4 a = *(const f32x4*)(p.in[I_SSDCW] + j * 3072 + c0), b2 = *(const f32x4*)(p.in[I_SSDCW] + j * 3072 + c0 + 4);
#pragma unroll
        for (int e = 0; e < 4; ++e) { wt[j][e] = a[e]; wt[j][4 + e] = b2[e]; } }
    { const f32x4 a = *(const f32x4*)(p.in[I_SSDCB] + c0), b2 = *(const f32x4*)(p.in[I_SSDCB] + c0 + 4);
#pragma unroll
      for (int e = 0; e < 4; ++e) { bias[e] = a[e]; bias[4 + e] = b2[e]; } }
    for (int rb = blockIdx.x; rb < RT / 64; rb += gridDim.x) {
        const bool first = rb < 256 ? ((rb & 63) == 0) : (((rb - 256) & 3) == 0);
        const bool last = rb < 256 ? ((rb & 63) == 63) : (((rb - 256) & 3) == 3);
        const u32x4v zero = {0u, 0u, 0u, 0u};
        u32x4v win[5];
        win[0] = first ? zero : *(const u32x4v*)(HALO + ((size_t)(rb - 1) * 4 + 2) * XBC_LD + c0);
        win[1] = first ? zero : *(const u32x4v*)(HALO + ((size_t)(rb - 1) * 4 + 3) * XBC_LD + c0);
        u16* base = XBC + (size_t)rb * 64 * XBC_LD + c0;
        win[2] = *(const u32x4v*)(base); win[3] = *(const u32x4v*)(base + XBC_LD);
        for (int r = 0; r < 64; ++r) {
            if (r + 2 < 64) win[4] = *(const u32x4v*)(base + (size_t)(r + 2) * XBC_LD);
            else win[4] = last ? zero : *(const u32x4v*)(HALO + ((size_t)(rb + 1) * 4 + (r + 2 - 64)) * XBC_LD + c0);
            float o[8];
#pragma unroll
            for (int e = 0; e < 8; ++e) o[e] = bias[e];
#pragma unroll
            for (int j = 0; j < 5; ++j)
#pragma unroll
                for (int e2 = 0; e2 < 4; ++e2) { o[2 * e2] += wt[j][2 * e2] * bflo(win[j][e2]); o[2 * e2 + 1] += wt[j][2 * e2 + 1] * bfhi(win[j][e2]); }
            u32x4v ov;
#pragma unroll
            for (int e2 = 0; e2 < 4; ++e2) ov[e2] = pk2(siluf(o[2 * e2]), siluf(o[2 * e2 + 1]));
            *(u32x4v*)(base + (size_t)r * XBC_LD) = ov;
            win[0] = win[1]; win[1] = win[2]; win[2] = win[3]; win[3] = win[4];
        }
    }
}
__device__ void dt_phase(const Params& p) {
    const float* DTRAW = (const float*)(p.ws + A_DTRAW); float* DT = (float*)(p.ws + A_DT); float* ACUM = (float*)(p.ws + A_ACUM);
    const int lane = threadIdx.x & 63, wid = threadIdx.x >> 6;
    const float bias = p.in[I_SSDDTB][lane], a = -__expf(p.in[I_SSDALOG][lane]);
    for (int ch = blockIdx.x * 8 + wid; ch < RT / 128; ch += gridDim.x * 8) {
        const size_t r0 = (size_t)ch * 128;
        if (lane < 32) { float run = 0.f;
            for (int m = 0; m < 128; ++m) { const float d = softplusf(DTRAW[(r0 + m) * 64 + lane] + bias); DT[(r0 + m) * 64 + lane] = d; run += d * a; ACUM[(r0 + m) * 64 + lane] = run; } }
        else { float run = 0.f;
            for (int m = 127; m >= 0; --m) { const float d = softplusf(DTRAW[(r0 + m) * 64 + lane] + bias); DT[(r0 + m) * 64 + lane] = d; run += d * a; ACUM[(r0 + m) * 64 + lane] = run; } }
    }
}

constexpr int SS_LD = 136;
constexpr int SS_C = 0;
constexpr int SS_B = SS_C + 128 * SS_LD * 2;
constexpr int SS_BT = SS_B + 128 * SS_LD * 2;
constexpr int SS_XT = SS_BT + 128 * SS_LD * 2;
constexpr int SS_XW = SS_XT + 32 * SS_LD * 2;
constexpr int SS_S = SS_XW + 32 * SS_LD * 2;
constexpr int SS_AC = SS_S + 32 * SS_LD * 2;
constexpr int SS_END = SS_AC + 512;
static_assert(SS_END <= LDS_BYTES, "SSD LDS");

__device__ void ssd_item(unsigned char* shm, const Params& p, int b, int h, int ph) {
    const u16* XBC = (const u16*)(p.ws + E_XBC); u16* Y = (u16*)(p.ws + E_Y);
    const float* DT = (const float*)(p.ws + A_DT); const float* ACUM = (const float*)(p.ws + A_ACUM);
    u16* Cs = (u16*)(shm + SS_C); u16* Bs = (u16*)(shm + SS_B); u16* BT = (u16*)(shm + SS_BT); u16* xT = (u16*)(shm + SS_XT); u16* xwT = (u16*)(shm + SS_XW); u16* Sb = (u16*)(shm + SS_S);
    float* acs = (float*)(shm + SS_AC);
    const int t = threadIdx.x, lane = t & 63, w = t >> 6, g = h >> 3;
    const int xcol = h * 64 + ph * 32, bcol = 2048 + g * 128, ccol = 2560 + g * 128;
    const float dsk = p.in[I_SSDD][h];
    for (int dir = 0; dir < 2; ++dir) {
        const int dcol = dir * 32 + h;
        f32x4 accS[1][2]; zero_acc(accS);
        for (int step = 0; step < 34; ++step) {
            const bool isctx = step < 2;
            const int base = isctx ? RL + b * CTXL + (dir == 0 ? step : 1 - step) * 128 : b * SEQ + (dir == 0 ? step - 2 : 33 - step) * 128;
            const float a_last = ACUM[(size_t)(base + (dir == 0 ? 127 : 0)) * 64 + dcol];
            if (t < 128) acs[t] = ACUM[(size_t)(base + t) * 64 + dcol];
#pragma unroll
            for (int i = 0; i < 4; ++i) { const int idx = i * 512 + t, m = idx >> 4, seg = idx & 15; const u16* rp = XBC + (size_t)(base + m) * XBC_LD + seg * 8;
                const u32x4v bw = *(const u32x4v*)(rp + bcol);
                if (!isctx) { *(u32x4v*)(Cs + m * SS_LD + seg * 8) = *(const u32x4v*)(rp + ccol); *(u32x4v*)(Bs + m * SS_LD + seg * 8) = bw; }
#pragma unroll
                for (int e2 = 0; e2 < 4; ++e2) { BT[(seg * 8 + 2 * e2) * SS_LD + m] = (u16)(bw[e2] & 0xFFFF); BT[(seg * 8 + 2 * e2 + 1) * SS_LD + m] = (u16)(bw[e2] >> 16); } }
            { const int m = t >> 2, seg = t & 3; const u32x4v xw = *(const u32x4v*)(XBC + (size_t)(base + m) * XBC_LD + xcol + seg * 8);
              const float dtm = DT[(size_t)(base + m) * 64 + dcol], wgt = __expf(a_last - ACUM[(size_t)(base + m) * 64 + dcol]);
#pragma unroll
              for (int e = 0; e < 8; ++e) { const float x = ((e & 1) ? bfhi(xw[e >> 1]) : bflo(xw[e >> 1])) * dtm; xT[(seg * 8 + e) * SS_LD + m] = f2bf(x); xwT[(seg * 8 + e) * SS_LD + m] = f2bf(x * wgt); } }
            if (!isctx) {
#pragma unroll
                for (int nt = 0; nt < 2; ++nt) { const int pp = nt * 16 + (lane & 15), n0 = w * 16 + (lane >> 4) * 4; u32x2 o; o[0] = pk2(accS[0][nt][0], accS[0][nt][1]); o[1] = pk2(accS[0][nt][2], accS[0][nt][3]);
                    *(u32x2*)(Sb + pp * SS_LD + n0) = o; } }
            __syncthreads();
            if (!isctx) {
                const int mrow0 = w * 16;
                f32x4 cb[1][8]; zero_acc(cb);
                wave_mma<1, 8>(cb, Cs + mrow0 * SS_LD, SS_LD, Bs, SS_LD, 4);
                f32x4 yT[2][1]; zero_acc(yT);
                wave_mma<2, 1>(yT, Sb, SS_LD, Cs + mrow0 * SS_LD, SS_LD, 4);
                { const float sc = __expf(acs[mrow0 + (lane & 15)]);
#pragma unroll
                  for (int mt = 0; mt < 2; ++mt)
#pragma unroll
                      for (int j = 0; j < 4; ++j) yT[mt][0][j] *= sc; }
#pragma unroll
                for (int j = 0; j < 4; ++j) { const int m = mrow0 + (lane >> 4) * 4 + j; const float am = acs[m];
#pragma unroll
                    for (int nt = 0; nt < 8; ++nt) { const int s = nt * 16 + (lane & 15); const bool keep = dir == 0 ? (s <= m) : (s >= m);
                        const float v = keep ? cb[0][nt][j] * __expf(am - acs[s]) : 0.f; Cs[m * SS_LD + s] = f2bf(v); } }
                wave_mma<2, 1>(yT, xT, SS_LD, Cs + mrow0 * SS_LD, SS_LD, 4);
                { const int m = mrow0 + (lane & 15); const size_t row = (size_t)(base + m);
#pragma unroll
                  for (int mt = 0; mt < 2; ++mt) { const int p0 = mt * 16 + (lane >> 4) * 4; u16* yp = Y + row * 2048 + xcol + p0; float o0 = yT[mt][0][0], o1 = yT[mt][0][1], o2 = yT[mt][0][2], o3 = yT[mt][0][3];
                      if (dir == 1) { const u32x2 pv = *(const u32x2*)yp; const u32x2 xs = *(const u32x2*)(XBC + row * XBC_LD + xcol + p0);
                          o0 += bflo(pv[0]) + dsk * bflo(xs[0]); o1 += bfhi(pv[0]) + dsk * bfhi(xs[0]); o2 += bflo(pv[1]) + dsk * bflo(xs[1]); o3 += bfhi(pv[1]) + dsk * bfhi(xs[1]); }
                      u32x2 o; o[0] = pk2(o0, o1); o[1] = pk2(o2, o3); *(u32x2*)yp = o; } }
            }
            { const float dl = __expf(a_last);
#pragma unroll
              for (int nt = 0; nt < 2; ++nt)
#pragma unroll
                  for (int j = 0; j < 4; ++j) accS[0][nt][j] *= dl; }
            wave_mma<1, 2>(accS, BT + (w * 16) * SS_LD, SS_LD, xwT, SS_LD, 4);
            __syncthreads();
        }
    }
}

__device__ void ssd_finish_phase(const Params& p) {
    u16* Y = (u16*)(p.ws + E_Y); const u16* Z = (const u16*)(p.ws + E_Z);
    const int lane = threadIdx.x & 63, wid = threadIdx.x >> 6;
    for (int it = blockIdx.x * 8 + wid; it < RL * 4; it += gridDim.x * 8) {
        const size_t off = (size_t)(it >> 2) * 2048 + (it & 3) * 512 + lane * 8;
        const u32x4v yw = *(const u32x4v*)(Y + off), zw = *(const u32x4v*)(Z + off);
        float v[8]; float ss = 0.f;
#pragma unroll
        for (int e2 = 0; e2 < 4; ++e2) { v[2 * e2] = bflo(yw[e2]) * siluf(bflo(zw[e2])); v[2 * e2 + 1] = bfhi(yw[e2]) * siluf(bfhi(zw[e2])); ss += v[2 * e2] * v[2 * e2] + v[2 * e2 + 1] * v[2 * e2 + 1]; }
        ss = wave_sum(ss);
        const float rs = rsqrtf(ss * (1.0f / 512.0f) + EPS);
        const float* gg = p.in[I_SSDNG] + (it & 3) * 512 + lane * 8; u32x4v o;
#pragma unroll
        for (int e2 = 0; e2 < 4; ++e2) o[e2] = pk2(v[2 * e2] * rs * gg[2 * e2], v[2 * e2 + 1] * rs * gg[2 * e2 + 1]);
        *(u32x4v*)(Y + off) = o;
    }
}

__global__ __launch_bounds__(512, 2) void mega(Params p) {
    extern __shared__ __attribute__((aligned(16))) unsigned char shm[];
    cg::grid_group grid = cg::this_grid();
    unsigned char* ws = p.ws;
    float* MOD = (float*)(ws + OFF_MOD); const float* MOD1 = MOD + 5 * NMOD * DM;
    u16* H = (u16*)(ws + OFF_H); float* XC = (float*)(ws + OFF_XC);
    const int bid = blockIdx.x, nb = gridDim.x;
    mod_gemv(shm, p);
    convert_weight(shm, p.in[I_ABWIN], 1024, 2592, (u16*)(ws + A_AB_IN), 2816, 0);
    convert_weight(shm, p.in[I_ABWOUT], 1024, 1024, (u16*)(ws + A_AB_OUT), 1024, 0);
    convert_weight(shm, p.in[I_FFWIN], 1024, 5632, (u16*)(ws + A_FF_IN0), 5632, 1);
    convert_weight(shm, p.in[I_FFWOUT], 2816, 1024, (u16*)(ws + A_FF_OUT0), 1024, 0);
    convert_weight(shm, p.in[I_SSDWIN], 1024, 5184, (u16*)(ws + B_SSD_INA), 3328, 3);
    convert_weight(shm, p.in[I_SSDWIN], 1024, 5184, (u16*)(ws + B_WZ), 2048, 2);
    grid.sync();
    norm_mod_phase(p.in[I_X], p.in[I_CTX], p.in[I_NORMG], MOD, 0, 1, RT, 0, H);
    grid.sync();
    { EpiBf16Plain E; E.O = (u16*)(ws + E_P0); E.ld = P0_LD; E.ncols = P0_LD; run_gemm(shm, H, (const u16*)(ws + A_AB_IN), RT, 2816, 1024, E); }
    grid.sync();
    for (int it = bid; it < 4 * 68 * 4 + 4 * 34 * 4; it += nb) {
        if (it < 4 * 68 * 4) { const int h = it & 3, bc = it >> 2; gla_a_item(shm, p, bc / 68, bc % 68, h); }
        else { const int j = it - 4 * 68 * 4; const int gi = j & 3, bc = j >> 2; gmlp_item(shm, p, bc / 34, bc % 34, gi); }
    }
    grid.sync();
    gla_scan_phase(p);
    grid.sync();
    for (int it = bid; it < 4 * 68 * 4; it += nb) { const int h = it & 3, bc = it >> 2; gla_c_item(shm, p, bc / 68, bc % 68, h); }
    grid.sync();
    { EpiRes E; E.src_lat = p.in[I_X]; E.src_ctx = p.in[I_CTX]; E.dst_lat = p.out; E.dst_ctx = XC; E.gate = MOD + 2 * DM; E.cm = 0;
      run_gemm(shm, H, (const u16*)(ws + A_AB_OUT), RT, 1024, 1024, E); }
    grid.sync();
    norm_mod_phase(p.out, XC, p.in[I_NORMG] + DM, MOD, 3, 4, RT, 0, H);
    grid.sync();
    { EpiSwiglu E; E.O = (u16*)(ws + E_ACT); run_gemm(shm, H, (const u16*)(ws + A_FF_IN0), RT, 5632, 1024, E); }
    grid.sync();
    { EpiRes E; E.src_lat = p.out; E.src_ctx = XC; E.dst_lat = p.out; E.dst_ctx = XC; E.gate = MOD + 5 * DM; E.cm = 0;
      run_gemm(shm, (const u16*)(ws + E_ACT), (const u16*)(ws + A_FF_OUT0), RT, 1024, 2816, E); }
    grid.sync();
    norm_mod_phase(p.out, XC, p.in[I_NORMG] + 2 * DM, MOD1, 0, 1, RT, 1, H);
    grid.sync();
    { EpiSsdIn E; E.XBC = (u16*)(ws + E_XBC); E.HALO = (u16*)(ws + A_HALO); E.DTRAW = (float*)(ws + A_DTRAW); run_gemm(shm, H, (const u16*)(ws + B_SSD_INA), RT, 3328, 1024, E); }
    grid.sync();
    dt_phase(p);
    conv_phase(p);
    grid.sync();
    for (int it = bid; it < 4 * 32 * 2; it += nb) { ssd_item(shm, p, it >> 6, (it >> 1) & 31, it & 1); }
    grid.sync();
    { EpiBf16Plain E; E.O = (u16*)(ws + E_Z); E.ld = 2048; E.ncols = 2048; run_gemm(shm, H, (const u16*)(ws + B_WZ), RL, 2048, 1024, E); }
    convert_weight(shm, p.in[I_SSDWOUT], 2048, 1024, (u16*)(ws + A_SSD_OUT), 1024, 0);
    convert_weight(shm, p.in[I_FFWIN] + (size_t)1024 * 5632, 1024, 5632, (u16*)(ws + A_FF_IN1), 5632, 1);
    convert_weight(shm, p.in[I_FFWOUT] + (size_t)2816 * 1024, 2816, 1024, (u16*)(ws + A_FF_OUT1), 1024, 0);
    grid.sync();
    ssd_finish_phase(p);
    grid.sync();
    { EpiRes E; E.src_lat = p.out; E.src_ctx = XC; E.dst_lat = p.out; E.dst_ctx = XC; E.gate = MOD1 + 2 * DM; E.cm = 1;
      run_gemm(shm, (const u16*)(ws + E_Y), (const u16*)(ws + A_SSD_OUT), RL, 1024, 2048, E); }
    grid.sync();
    norm_mod_phase(p.out, XC, p.in[I_NORMG] + 3 * DM, MOD1, 3, 4, RL, 0, H);
    grid.sync();
    { EpiSwiglu E; E.O = (u16*)(ws + E_ACT); run_gemm(shm, H, (const u16*)(ws + A_FF_IN1), RL, 5632, 1024, E); }
    grid.sync();
    { EpiRes E; E.src_lat = p.out; E.src_ctx = XC; E.dst_lat = p.out; E.dst_ctx = XC; E.gate = MOD1 + 5 * DM; E.cm = 0;
      run_gemm(shm, (const u16*)(ws + E_ACT), (const u16*)(ws + A_FF_OUT1), RL, 1024, 2816, E); }
    grid.sync();
    final_norm_phase(p.out, p.in[I_FNG]);
}

extern "C" void kernel_launch(void* const* d_in, const int* in_sizes, int n_in, void* d_out, int out_size, void* d_ws, size_t ws_size, hipStream_t stream) {
    static int grid_blocks = 0;
    if (!grid_blocks) {
        int dev = 0, cus = 0, per_cu = 0;
        (void)hipGetDevice(&dev);
        (void)hipDeviceGetAttribute(&cus, hipDeviceAttributeMultiprocessorCount, dev);
        (void)hipFuncSetAttribute((const void*)mega, hipFuncAttributeMaxDynamicSharedMemorySize, LDS_BYTES);
        (void)hipOccupancyMaxActiveBlocksPerMultiprocessor(&per_cu, (const void*)mega, 512, LDS_BYTES);
        if (per_cu < 1) { fprintf(stderr, "occupancy query says %d blocks/CU\n", per_cu); per_cu = 1; }
        if (per_cu > 1) per_cu = 1;
        grid_blocks = cus * per_cu;
        if (ws_size < WS_END) fprintf(stderr, "workspace too small: %zu < %zu\n", ws_size, (size_t)WS_END);
    }
    Params p{};
    for (int i = 0; i < 26; ++i) p.in[i] = (const float*)d_in[i];
    p.out = (float*)d_out; p.ws = (unsigned char*)d_ws;
    void* args[] = {&p};
    hipError_t e = hipLaunchCooperativeKernel((const void*)mega, dim3(grid_blocks), dim3(512), args, LDS_BYTES, stream);
    if (e != hipSuccess) fprintf(stderr, "cooperative launch failed: %s (grid %d)\n", hipGetErrorString(e), grid_blocks);
}
```

```cpp
#include <hip/hip_runtime.h>
#include <hip/hip_cooperative_groups.h>
#include <cstdio>
namespace cg = cooperative_groups;
namespace pg8 {
#define PG8_LAS __attribute__((address_space(3)))
typedef unsigned short bf16_t;
typedef short bf16x8 __attribute__((ext_vector_type(8)));
typedef float f32x4 __attribute__((ext_vector_type(4)));
typedef unsigned u32x4 __attribute__((ext_vector_type(4)));
constexpr int BM = 256, BK = 64, HALF = 128, HTB = HALF * BK * 2  , STAGE_BYTES = 8 * HTB, NXCD = 8, WGM = 8;

__host__ __device__ __forceinline__ int lds_byte(int r, int c) { const int st = (r >> 4) * 2 + (c >> 5), rr = r & 15, cc = c & 31, ob = rr * 64 + cc * 2; return st * 1024 + (ob ^ (((ob >> 9) & 1) << 5)); }
__host__ __device__ __forceinline__ void stage_rc(int b, int& R, int& C) { const int st = b / 1024, sb = b % 1024, swz = sb ^ (((sb >> 9) & 1) << 5); R = (st >> 1) * 16 + swz / 64; C = (st & 1) * 32 + (swz % 64) / 2; }
__host__ __device__ __forceinline__ int perm32(int rho) { const int n = rho >> 4, i = rho & 15; return 8 * (i >> 2) + 4 * n + (i & 3); }

struct Unit { int pm, pn; };
struct Gemm { const bf16_t* A; const bf16_t* Bt; int M, N, K; };

struct StaticOrder {
    int nM, nN, nwg, G, c;
    __host__ __device__ void init(int M, int N, int G_, int c_) { nM = M / BM; nN = N / BM; nwg = nM * nN; G = G_; c = c_; }
    __host__ __device__ bool next(int i, Unit& u) const {
        const long L = (long)i * G + c; if (L >= nwg) return false;
        int wgid = (int)L; { const int q = nwg / NXCD, r = nwg % NXCD, xcd = wgid % NXCD, off = wgid / NXCD; wgid = (xcd < r ? xcd * (q + 1) : r * (q + 1) + (xcd - r) * q) + off; }
        const int nig = WGM * nN, gid = wgid / nig, fm = gid * WGM, gsz = (nM - fm) < WGM ? (nM - fm) : WGM;
        u.pm = fm + ((wgid % nig) % gsz); u.pn = (wgid % nig) / gsz; return true;
    }
    __device__ __forceinline__ void a_ready(const Unit&) const {}
    __device__ __forceinline__ void done(const Unit&) const {}
};
__device__ __forceinline__ unsigned cvt_pk_bf16(float lo, float hi) { unsigned r; asm volatile("v_cvt_pk_bf16_f32 %0, %1, %2" : "=v"(r) : "v"(lo), "v"(hi)); return r; }
template <class Epi, class Sched, bool STAMP = false>
__device__ __forceinline__ void gemm_phase(PG8_LAS unsigned char* lds, const Gemm g, const Sched& S, const Epi& E, unsigned long long* stamps) {
    int tid_ = threadIdx.x; asm volatile("" : "+v"(tid_)); const int tid = tid_, wid = __builtin_amdgcn_readfirstlane(tid >> 6), lane = tid & 63, wr = wid >> 2, wc = wid & 3, fr = lane & 15, fq = lane >> 4;
    const int K = g.K, nt = K / BK;
    int ts_lo = 0, ts_hi = 0, nts = 0; const unsigned long long rt_entry = STAMP ? (unsigned long long)wall_clock64() : 0ull;
#define PG8_STAMP() do { if (STAMP && wid == 0 && nts < 64) { const unsigned long long _c = (unsigned long long)clock64(); \
        ts_lo = (lane == nts) ? (int)(unsigned)_c : ts_lo; ts_hi = (lane == nts) ? (int)(unsigned)(_c >> 32) : ts_hi; ++nts; } } while (0)
    PG8_STAMP();
    unsigned voffA[2], voffB[2];
#pragma unroll
    for (int i = 0; i < 2; ++i) { int R, C; stage_rc(tid * 16 + i * 8192, R, C); const int Rb = Epi::PERM ? ((R & ~31) + perm32(R & 31)) : R;
        voffA[i] = (unsigned)(R * K + C) * 2u; voffB[i] = (unsigned)(Rb * K + C) * 2u; }
    const size_t kstep = (size_t)(BK * 2);
    const size_t hstep = (size_t)HALF * K * 2;
    const size_t tstep = 2 * hstep;
    const unsigned ldsw = (unsigned)wid * 1024u;
    const int aoff = lds_byte(wr * 64 + fr, fq * 8), boff = lds_byte(wc * 32 + fr, fq * 8);
#define PG8_SA(b, h) (((b) * 2 + (h)) * HTB)
#define PG8_SB(b, h) ((4 + (b) * 2 + (h)) * HTB)
#define PG8_STAGE(bufoff, gbase, voff) do { _Pragma("unroll") for (int _i = 0; _i < 2; ++_i) \
        __builtin_amdgcn_global_load_lds((const unsigned*)((const char*)(gbase) + (voff)[_i]), (PG8_LAS unsigned*)(lds + (bufoff) + ldsw + _i * 8192), 16, 0, 0); } while (0)
#define PG8_LDA(dst, b, h) do { _Pragma("unroll") for (int m = 0; m < 4; ++m) _Pragma("unroll") for (int k = 0; k < 2; ++k) dst[m][k] = *(const PG8_LAS bf16x8*)(lds + PG8_SA(b, h) + aoff + m * 2048 + k * 1024); } while (0)
#define PG8_LDB(dst, b, h) do { _Pragma("unroll") for (int n = 0; n < 2; ++n) _Pragma("unroll") for (int k = 0; k < 2; ++k) dst[n][k] = *(const PG8_LAS bf16x8*)(lds + PG8_SB(b, h) + boff + n * 2048 + k * 1024); } while (0)
#define PG8_MMA(ai, bj, At, Bt) do { __builtin_amdgcn_s_setprio(1); _Pragma("unroll") for (int m = 0; m < 4; ++m) _Pragma("unroll") for (int n = 0; n < 2; ++n) _Pragma("unroll") for (int k = 0; k < 2; ++k) \
        acc[ai][bj][m][n] = __builtin_amdgcn_mfma_f32_16x16x32_bf16(Bt[n][k], At[m][k], acc[ai][bj][m][n], 0, 0, 0); __builtin_amdgcn_s_setprio(0); } while (0)
#define PG8_WAIT_V(n) asm volatile("s_waitcnt vmcnt(" #n ")" ::: "memory")
#define PG8_WAIT_L(n) asm volatile("s_waitcnt lgkmcnt(" #n ")" ::: "memory")
#define PG8_BAR __builtin_amdgcn_s_barrier()
#define PG8_SCHED __builtin_amdgcn_sched_barrier(0)
    Unit cur, nxt; int ui = 0;
    if (!S.next(0, cur)) return;
    f32x4 acc[2][2][4][2];
#pragma unroll
    for (int a = 0; a < 2; ++a)
#pragma unroll
        for (int b = 0; b < 2; ++b)
#pragma unroll
            for (int m = 0; m < 4; ++m)
#pragma unroll
                for (int n = 0; n < 2; ++n) acc[a][b][m][n] = (f32x4){0.f, 0.f, 0.f, 0.f};
    bf16x8 At[4][2], B0[2][2], B1[2][2];
    const char* cA = (const char*)g.A + (size_t)cur.pm * tstep; const char* cB = (const char*)g.Bt + (size_t)cur.pn * tstep;
    S.a_ready(cur);
    PG8_STAGE(PG8_SB(0, 0), cB, voffB); PG8_STAGE(PG8_SA(0, 0), cA, voffA); PG8_STAGE(PG8_SB(0, 1), cB + hstep, voffB); PG8_STAGE(PG8_SA(0, 1), cA + hstep, voffA);
    if (wr == 1) PG8_BAR;
    PG8_WAIT_V(4); PG8_BAR;
    PG8_STAGE(PG8_SB(1, 0), cB + kstep, voffB); PG8_STAGE(PG8_SA(1, 0), cA + kstep, voffA); PG8_STAGE(PG8_SB(1, 1), cB + hstep + kstep, voffB);
    PG8_WAIT_V(6); PG8_BAR;
    PG8_STAMP();
    for (;;) {
        const bool has_next = S.next(ui + 1, nxt);
        const char* nA = has_next ? (const char*)g.A + (size_t)nxt.pm * tstep : cA; const char* nB = has_next ? (const char*)g.Bt + (size_t)nxt.pn * tstep : cB;
        for (int t = 0; t < nt; t += 2) {
            const bool last = (t == nt - 2);
            const char* a1 = cA + (size_t)(t + 1) * kstep;
            const char* a2 = last ? nA : cA + (size_t)(t + 2) * kstep; const char* b2 = last ? nB : cB + (size_t)(t + 2) * kstep;
            const char* a3 = a2 + kstep; const char* b3 = b2 + kstep;
            if (last && has_next) S.a_ready(nxt);
            PG8_LDB(B0, 0, 0); PG8_SCHED; PG8_LDA(At, 0, 0); PG8_STAGE(PG8_SA(1, 1), a1 + hstep, voffA);
            PG8_WAIT_L(8); PG8_BAR; PG8_WAIT_L(0); PG8_MMA(0, 0, At, B0); PG8_BAR; PG8_SCHED;
            PG8_LDB(B1, 0, 1); PG8_STAGE(PG8_SB(0, 0), b2, voffB);
            PG8_BAR; PG8_WAIT_L(0); PG8_MMA(0, 1, At, B1); PG8_BAR;
            PG8_LDA(At, 0, 1); PG8_STAGE(PG8_SA(0, 0), a2, voffA);
            PG8_BAR; PG8_WAIT_L(0); PG8_MMA(1, 0, At, B0); PG8_BAR; PG8_SCHED;
            PG8_STAGE(PG8_SB(0, 1), b2 + hstep, voffB);
            PG8_WAIT_V(6); PG8_BAR; PG8_MMA(1, 1, At, B1); PG8_BAR;
            PG8_LDB(B0, 1, 0); PG8_SCHED; PG8_LDA(At, 1, 0); PG8_STAGE(PG8_SA(0, 1), a2 + hstep, voffA);
            PG8_WAIT_L(8); PG8_BAR; PG8_WAIT_L(0); PG8_MMA(0, 0, At, B0); PG8_BAR; PG8_SCHED;
            PG8_LDB(B1, 1, 1); PG8_STAGE(PG8_SB(1, 0), b3, voffB);
            PG8_BAR; PG8_WAIT_L(0); PG8_MMA(0, 1, At, B1); PG8_BAR;
            PG8_LDA(At, 1, 1); PG8_STAGE(PG8_SA(1, 0), a3, voffA);
            PG8_BAR; PG8_WAIT_L(0); PG8_MMA(1, 0, At, B0); PG8_BAR; PG8_SCHED;
            PG8_STAGE(PG8_SB(1, 1), b3 + hstep, voffB);
            PG8_WAIT_V(6); PG8_BAR; PG8_MMA(1, 1, At, B1); PG8_BAR;
        }
        PG8_STAMP();
        if constexpr (!Epi::AFTER_DRAIN) { E(acc, cur, wr, wc, fr, fq); S.done(cur); }
        PG8_STAMP();
        if (!has_next) break;
#pragma unroll
        for (int a = 0; a < 2; ++a)
#pragma unroll
            for (int b = 0; b < 2; ++b)
#pragma unroll
                for (int m = 0; m < 4; ++m)
#pragma unroll
                    for (int n = 0; n < 2; ++n) acc[a][b][m][n] = (f32x4){0.f, 0.f, 0.f, 0.f};
        cur = nxt; cA = nA; cB = nB; ++ui;
    }
    PG8_WAIT_V(0);
    if (wr == 0) PG8_BAR;
    PG8_BAR;
    if constexpr (Epi::AFTER_DRAIN) { E.fused(acc, cur, wr, wc, fr, fq, lds, wid, lane); S.done(cur); }
    PG8_STAMP();
    if (STAMP && wid == 0) { stamps[lane] = lane < nts ? (((unsigned long long)(unsigned)ts_hi << 32) | (unsigned)ts_lo) : 0ull;
        if (lane == 62) stamps[62] = rt_entry; if (lane == 63) stamps[63] = (unsigned long long)wall_clock64(); }
#undef PG8_STAMP
#undef PG8_SA
#undef PG8_SB
#undef PG8_STAGE
#undef PG8_LDA
#undef PG8_LDB
#undef PG8_MMA
#undef PG8_WAIT_V
#undef PG8_WAIT_L
#undef PG8_BAR
#undef PG8_SCHED
}
}

#define XB_TMO      128
#define XB_XCNT(j)  (256  + 64 * (j))
#define XB_XSUB(j)  (1280 + 64 * (j))
#define XB_XGEN(j)  (2304 + 64 * (j))
#define XB_TOP      3328
#define XB_TOPGEN   3392
#define XCD_BAR_WORDS 3456
#define XB_SPIN_CAP (1u << 18)
#define LAS __attribute__((address_space(3)))

__device__ __forceinline__ unsigned xb_ld(unsigned* p)              { return __hip_atomic_load(p, __ATOMIC_RELAXED, __HIP_MEMORY_SCOPE_AGENT); }
__device__ __forceinline__ unsigned xb_add(unsigned* p, unsigned v) { return __hip_atomic_fetch_add(p, v, __ATOMIC_RELAXED, __HIP_MEMORY_SCOPE_AGENT); }
__device__ __forceinline__ unsigned xb_xcc_id() { return (unsigned)__builtin_amdgcn_s_getreg((3 << 11) | 20) & 0xFu; }
#define XB_SPIN(cond, bar) do { unsigned _sp = 0; while (cond) { __builtin_amdgcn_s_sleep(1); \
    if ((++_sp & 255u) == 0u) { if (xb_ld(&(bar)[XB_TMO])) break; if (_sp > XB_SPIN_CAP) { atomicAdd(&(bar)[XB_TMO], 1u); break; } } } } while (0)

struct XcdBarrier {
    unsigned* bar; unsigned x;
    volatile LAS unsigned* st;
};

__device__ __forceinline__ XcdBarrier xcd_barrier_post(unsigned* bar, volatile LAS unsigned* st) {
    XcdBarrier b; b.bar = bar; b.x = xb_xcc_id(); b.st = st;
    if (threadIdx.x == 0) (void)xb_add(&bar[XB_XCNT(b.x)], 1u);
    return b;
}
__device__ __forceinline__ void xcd_barrier_complete(unsigned* bar, unsigned x, unsigned& nloc, unsigned& nx) {
    const unsigned G = gridDim.x * gridDim.y * gridDim.z;
    unsigned sum, cnt, mine, sp = 0u;
    for (;;) {
        sum = 0u; cnt = 0u; mine = 0u;
#pragma unroll
        for (unsigned j = 0; j < 16; ++j) { const unsigned c = xb_ld(&bar[XB_XCNT(j)]); sum += c; cnt += (c > 0u) ? 1u : 0u; mine = (j == x) ? c : mine; }
        if (sum == G) break;
        __builtin_amdgcn_s_sleep(1);
        if ((++sp & 255u) == 0u) { if (xb_ld(&bar[XB_TMO])) break; if (sp > XB_SPIN_CAP) { atomicAdd(&bar[XB_TMO], 1u); break; } }
    }
    nloc = mine > 0u ? mine : 1u; nx = cnt > 0u ? cnt : 1u;
}

__device__ __attribute__((noinline)) void xcd_barrier_impl(unsigned* bar_, unsigned x_, volatile LAS unsigned* st_) {
    XcdBarrier b; b.bar = bar_; b.x = x_; b.st = st_;
    asm volatile("s_waitcnt vmcnt(0)" ::: "memory");
    __syncthreads();
    if (threadIdx.x == 0) {
        unsigned* bar = b.bar;
        __builtin_amdgcn_s_waitcnt(0);
        unsigned nloc = b.st[0], nx = b.st[1];
        if (nloc == 0u) { xcd_barrier_complete(bar, b.x, nloc, nx); b.st[0] = nloc; b.st[1] = nx; }
        const unsigned old = xb_add(&bar[XB_XSUB(b.x)], 1u);
        const unsigned gen = old / nloc;
        if (old + 1u == (gen + 1u) * nloc) {
            __builtin_amdgcn_fence(__ATOMIC_RELEASE, "agent");
            asm volatile("s_waitcnt vmcnt(0)" ::: "memory");
            const unsigned og = xb_add(&bar[XB_TOP], 1u);
            const unsigned tg = og / nx;
            if (og + 1u == (tg + 1u) * nx) xb_add(&bar[XB_TOPGEN], 1u);
            else XB_SPIN(xb_ld(&bar[XB_TOPGEN]) == tg, bar);
            __builtin_amdgcn_fence(__ATOMIC_ACQUIRE, "agent");
            xb_add(&bar[XB_XGEN(b.x)], 1u);
            asm volatile("s_waitcnt vmcnt(0)" ::: "memory");
        } else {
            XB_SPIN(xb_ld(&bar[XB_XGEN(b.x)]) == gen, bar);
            __builtin_amdgcn_fence(__ATOMIC_ACQUIRE, "agent");
            asm volatile("s_waitcnt vmcnt(0)" ::: "memory");
        }
    }
    __syncthreads();
}

__device__ __forceinline__ void xcd_barrier(const XcdBarrier& b) { xcd_barrier_impl(b.bar, b.x, b.st); }

typedef unsigned short u16;
using pg8::bf16x8; using pg8::f32x4;
typedef unsigned u32x2 __attribute__((ext_vector_type(2)));
typedef unsigned u32x4v __attribute__((ext_vector_type(4)));

constexpr int DM = 1024, NB = 4, SEQ = 4096, CTXL = 256, RL = NB * SEQ, RC = NB * CTXL, RT = RL + RC;
constexpr int DFF = 2816, NMOD = 6;
constexpr int P0_LD = 2592;
constexpr int P0_K = 0, P0_V = 256, P0_LR = 768, P0_Q = 800, P0_R = 1056, P0_U = 1568, P0_G = 2080;
constexpr int XBC_LD = 3072;
constexpr float EPS = 1e-6f;

constexpr size_t OFF_MOD = 0;
constexpr size_t OFF_A = 262144;
constexpr size_t A_AB_IN = OFF_A, A_AB_OUT = A_AB_IN + (size_t)2816 * 1024 * 2, A_FF_IN0 = A_AB_OUT + (size_t)1024 * 1024 * 2, A_FF_OUT0 = A_FF_IN0 + (size_t)5632 * 1024 * 2;
constexpr size_t A_END = A_FF_OUT0 + (size_t)1024 * 2816 * 2;
constexpr size_t A_DTRAW = OFF_A, A_HALO = A_DTRAW + (size_t)RT * 64 * 4;
constexpr size_t A_SSD_OUT = OFF_A, A_FF_IN1 = A_SSD_OUT + (size_t)1024 * 2048 * 2, A_FF_OUT1 = A_FF_IN1 + (size_t)5632 * 1024 * 2;
constexpr size_t OFF_B = A_END;
constexpr size_t B_SSD_INA = OFF_B, B_WZ = B_SSD_INA + (size_t)3328 * 1024 * 2, B_END = B_WZ + (size_t)2048 * 1024 * 2;
constexpr size_t OFF_XC = B_END;
constexpr size_t OFF_H = OFF_XC + (size_t)RC * DM * 4;
constexpr size_t OFF_DSC = OFF_H + (size_t)RT * DM * 2;
constexpr size_t OFF_DEC = OFF_DSC + (size_t)4 * 2 * 4 * 4 * 8192 * 4;
constexpr size_t OFF_E = OFF_DEC + (size_t)4 * 2 * 4 * 68 * 64 * 4;
constexpr size_t E_P0 = OFF_E, E_ACT = OFF_E, E_XBC = OFF_E, E_Z = OFF_E;
constexpr size_t E_Y = OFF_E + (size_t)RT * XBC_LD * 2;
constexpr size_t T_DT = E_Y + (size_t)RL * 2048 * 2, T_ACUM = T_DT + (size_t)RT * 64 * 4;
constexpr size_t WS_END = T_ACUM + (size_t)RT * 64 * 4;
constexpr size_t A_CB = OFF_A;
static_assert(A_HALO + (size_t)272 * 4 * 3072 * 2 <= A_END && A_FF_OUT1 + (size_t)1024 * 2816 * 2 <= A_END && A_CB + (size_t)512 * 16384 * 2 <= A_END, "region A overflow");
static_assert(WS_END <= (size_t)256 * 1024 * 1024, "workspace over 256 MiB");

constexpr int LDS_BYTES = 144 * 1024;
constexpr int LDS_XB = LDS_BYTES - 16;
constexpr size_t OFF_BAR = 245760;

struct Params { const float* in[26]; float* out; unsigned char* ws; };
enum { I_X = 0, I_C, I_CTX, I_CCTX, I_MODW, I_MODB, I_NORMG, I_FFWIN, I_FFWOUT, I_ABWIN, I_ABGW, I_ABGB, I_ABGNG, I_ABVNG, I_ABSW, I_ABSB, I_ABWOUT,
       I_SSDWIN, I_SSDCW, I_SSDCB, I_SSDDTB, I_SSDALOG, I_SSDD, I_SSDNG, I_SSDWOUT, I_FNG };

__device__ __forceinline__ u16 f2bf(float f) { return __builtin_bit_cast(u16, (__bf16)f); }
__device__ __forceinline__ float bf2f(unsigned b) { return __uint_as_float(b << 16); }
typedef float f32x2v __attribute__((ext_vector_type(2)));
typedef __bf16 bf16x2v __attribute__((ext_vector_type(2)));
__device__ __forceinline__ unsigned pk2(float lo, float hi) { const f32x2v v = {lo, hi}; return __builtin_bit_cast(unsigned, __builtin_convertvector(v, bf16x2v)); }
__device__ __forceinline__ float bflo(unsigned w) { return __uint_as_float(w << 16); }
__device__ __forceinline__ float bfhi(unsigned w) { return __uint_as_float(w & 0xFFFF0000u); }
__device__ __forceinline__ float siluf(float x) { return x / (1.0f + __expf(-x)); }
__device__ __forceinline__ float geluf(float x) { const float y = 0.7978845608028654f * (x + 0.044715f * x * x * x); const float th = 1.0f - 2.0f / (1.0f + __expf(2.0f * y)); return 0.5f * x * (1.0f + th); }
__device__ __forceinline__ float softplusf(float x) { return fmaxf(x, 0.f) + log1pf(__expf(-fabsf(x))); }
__device__ __forceinline__ float logsigmoidf(float x) { return fminf(x, 0.f) - log1pf(__expf(-fabsf(x))); }
__device__ __forceinline__ float wave_sum(float v) {
#pragma unroll
    for (int o = 32; o > 0; o >>= 1) v += __shfl_xor(v, o, 64);
    return v;
}

template <int MT, int NT>
__device__ __forceinline__ void wave_mma(f32x4 (&acc)[MT][NT], const u16* A, int lda, const u16* B, int ldb, int ksteps) {
    const int lane = threadIdx.x & 63, fr = lane & 15, fq = lane >> 4;
    const u16* ap = A + fr * lda + fq * 8; const u16* bp = B + fr * ldb + fq * 8;
    for (int k = 0; k < ksteps; ++k) {
        bf16x8 a[MT], b[NT];
#pragma unroll
        for (int i = 0; i < MT; ++i) a[i] = *(const bf16x8*)(ap + i * 16 * lda + k * 32);
#pragma unroll
        for (int i = 0; i < NT; ++i) b[i] = *(const bf16x8*)(bp + i * 16 * ldb + k * 32);
#pragma unroll
        for (int i = 0; i < MT; ++i)
#pragma unroll
            for (int j = 0; j < NT; ++j) acc[i][j] = __builtin_amdgcn_mfma_f32_16x16x32_bf16(a[i], b[j], acc[i][j], 0, 0, 0);
    }
}
template <int MT, int NT> __device__ __forceinline__ void zero_acc(f32x4 (&acc)[MT][NT]) {
#pragma unroll
    for (int i = 0; i < MT; ++i)
#pragma unroll
        for (int j = 0; j < NT; ++j) acc[i][j] = (f32x4){0.f, 0.f, 0.f, 0.f};
}

__device__ __forceinline__ u32x4v pack8(const f32x4& a, const f32x4& b) { u32x4v r; r[0] = pk2(a[0], a[1]); r[1] = pk2(a[2], a[3]); r[2] = pk2(b[0], b[1]); r[3] = pk2(b[2], b[3]); return r; }

struct EpiBf16Plain {
    static constexpr bool PERM = true, AFTER_DRAIN = false;
    u16* O; int ld; int ncols;
    __device__ __forceinline__ void operator()(const f32x4 (&acc)[2][2][4][2], const pg8::Unit& u, int wr, int wc, int fr, int fq) const {
        const int row0 = u.pm * 256 + wr * 64 + fr, col0 = u.pn * 256 + wc * 32 + 8 * fq;
#pragma unroll
        for (int ai = 0; ai < 2; ++ai)
#pragma unroll
            for (int m = 0; m < 4; ++m) { const int row = row0 + ai * 128 + m * 16;
#pragma unroll
                for (int bj = 0; bj < 2; ++bj) { const int c = col0 + bj * 128; if (c < ncols) *(u32x4v*)(O + (size_t)row * ld + c) = pack8(acc[ai][bj][m][0], acc[ai][bj][m][1]); } }
    }
};
struct EpiSwiglu {
    static constexpr bool PERM = true, AFTER_DRAIN = false;
    u16* O;
    __device__ __forceinline__ void operator()(const f32x4 (&acc)[2][2][4][2], const pg8::Unit& u, int wr, int wc, int fr, int fq) const {
        const int row0 = u.pm * 256 + wr * 64 + fr, j0 = u.pn * 128 + wc * 32 + 8 * fq;
#pragma unroll
        for (int ai = 0; ai < 2; ++ai)
#pragma unroll
            for (int m = 0; m < 4; ++m) { const int row = row0 + ai * 128 + m * 16; f32x4 o0, o1;
#pragma unroll
                for (int i = 0; i < 4; ++i) { o0[i] = siluf(acc[ai][0][m][0][i]) * acc[ai][1][m][0][i]; o1[i] = siluf(acc[ai][0][m][1][i]) * acc[ai][1][m][1][i]; }
                *(u32x4v*)(O + (size_t)row * DFF + j0) = pack8(o0, o1); }
    }
};
struct EpiSsdIn {
    static constexpr bool PERM = true, AFTER_DRAIN = false;
    u16* XBC; u16* HALO; float* DTRAW;
    __device__ __forceinline__ void operator()(const f32x4 (&acc)[2][2][4][2], const pg8::Unit& u, int wr, int wc, int fr, int fq) const {
        const int row0 = u.pm * 256 + wr * 64 + fr, col0 = u.pn * 256 + wc * 32 + 8 * fq;
#pragma unroll
        for (int ai = 0; ai < 2; ++ai)
#pragma unroll
            for (int m = 0; m < 4; ++m) { const int row = row0 + ai * 128 + m * 16; const int rr = row & 63; const int slot = rr < 2 ? rr : (rr >= 62 ? rr - 60 : -1);
#pragma unroll
                for (int bj = 0; bj < 2; ++bj) { const int c = col0 + bj * 128;
                    if (c < 3072) { const u32x4v v = pack8(acc[ai][bj][m][0], acc[ai][bj][m][1]); *(u32x4v*)(XBC + (size_t)row * XBC_LD + c) = v;
                        if (slot >= 0) *(u32x4v*)(HALO + ((size_t)(row >> 6) * 4 + slot) * XBC_LD + c) = v; }
                    else if (c < 3136) { float* d = DTRAW + (size_t)row * 64 + (c - 3072); *(f32x4*)d = acc[ai][bj][m][0]; *(f32x4*)(d + 4) = acc[ai][bj][m][1]; } } }
    }
};
struct EpiRes {
    static constexpr bool PERM = false, AFTER_DRAIN = false;
    const float* src_lat; const float* src_ctx; float* dst_lat; float* dst_ctx; const float* gate; int cm;
    __device__ __forceinline__ void operator()(const f32x4 (&acc)[2][2][4][2], const pg8::Unit& u, int wr, int wc, int fr, int fq) const {
        const int row0 = u.pm * 256 + wr * 64 + fr, col0 = u.pn * 256 + wc * 32 + 4 * fq;
#pragma unroll
        for (int ai = 0; ai < 2; ++ai)
#pragma unroll
            for (int m = 0; m < 4; ++m) { const int row = row0 + ai * 128 + m * 16; const float* s; float* d; int mi;
                if (row < RL) { const int xr = cm ? ((row & ~4095) | ((row & 63) << 6) | ((row >> 6) & 63)) : row; s = src_lat + (size_t)xr * DM; d = dst_lat + (size_t)xr * DM; mi = row >> 12; }
                else { s = src_ctx + (size_t)(row - RL) * DM; d = dst_ctx + (size_t)(row - RL) * DM; mi = 4; }
                const float* gt = gate + mi * (NMOD * DM);
#pragma unroll
                for (int bj = 0; bj < 2; ++bj)
#pragma unroll
                    for (int n = 0; n < 2; ++n) { const int c = col0 + bj * 128 + n * 16; const f32x4 g4 = *(const f32x4*)(gt + c), x4 = *(const f32x4*)(s + c);
                        *(f32x4*)(d + c) = x4 + g4 * acc[ai][bj][m][n]; } }
    }
};

template <class Epi> __device__ __forceinline__ void run_gemm(unsigned char* shm, const u16* A, const u16* Bt, int M, int N, int K, const Epi& E) {
    pg8::Gemm g; g.A = A; g.Bt = Bt; g.M = M; g.N = N; g.K = K;
    pg8::StaticOrder S; S.init(M, N, (int)gridDim.x, (int)blockIdx.x);
    pg8::gemm_phase<Epi, pg8::StaticOrder, false>((PG8_LAS unsigned char*)shm, g, S, E, nullptr);
}

__device__ __forceinline__ int wcol(int r, int N, int mode) {
    if (mode == 0) return r < N ? r : -1;
    if (mode == 1) { const int q = r >> 8, s = (r >> 7) & 1, i = r & 127; return s * DFF + 128 * q + i; }
    if (mode == 2) return r + 3136;
    return r < 3136 ? r : -1;
}
__device__ void convert_weight(unsigned char* shm, const float* src, int K, int N, u16* dst, int NR, int mode) {
    u16* tile = (u16*)shm;
    const int t = threadIdx.x, rl = t & 63, k0 = t >> 6, r2 = t >> 3, kk = (t & 7) * 8;
    const int nkt = K >> 6, ntiles = (NR >> 6) * nkt;
    for (int ti = blockIdx.x; ti < ntiles; ti += gridDim.x) {
        const int rb = (ti / nkt) << 6, kb = (ti % nkt) << 6;
        const int col = wcol(rb + rl, N, mode);
#pragma unroll
        for (int i = 0; i < 8; ++i) { const int k = k0 + 8 * i; const float v = col >= 0 ? src[(size_t)(kb + k) * N + col] : 0.f; tile[rl * 72 + k] = f2bf(v); }
        __syncthreads();
        *(u32x4v*)(dst + (size_t)(rb + r2) * K + kb + kk) = *(const u32x4v*)(tile + r2 * 72 + kk);
        __syncthreads();
    }
}
__device__ void mod_gemv(unsigned char* shm, const Params& p) {
    float* sc = (float*)shm;
    float* red = sc + 5 * 1024;
    const int t = threadIdx.x;
    for (int i = t; i < 5 * 1024; i += 512) { const float v = i < 4096 ? p.in[I_C][i] : p.in[I_CCTX][i - 4096]; sc[i] = siluf(v); }
    __syncthreads();
    float* MOD = (float*)(p.ws + OFF_MOD);
    const int n = t & 31, kc = t >> 5;
    for (int job = blockIdx.x; job < 2 * 192; job += gridDim.x) {
        const int l = job / 192, nb = (job % 192) * 32;
        const float* W = p.in[I_MODW] + (size_t)l * DM * (NMOD * DM) + nb + n;
        float a[5] = {0.f, 0.f, 0.f, 0.f, 0.f};
#pragma unroll 8
        for (int i = 0; i < 64; ++i) { const int k = kc + 16 * i; const float w = W[(size_t)k * (NMOD * DM)];
#pragma unroll
            for (int m = 0; m < 5; ++m) a[m] += sc[m * 1024 + k] * w; }
#pragma unroll
        for (int m = 0; m < 5; ++m) red[(kc * 5 + m) * 32 + n] = a[m];
        __syncthreads();
        if (t < 160) { const int m = t >> 5; float s = 0.f;
#pragma unroll
            for (int q = 0; q < 16; ++q) s += red[(q * 5 + m) * 32 + n];
            MOD[((size_t)l * 5 + m) * (NMOD * DM) + nb + n] = s + p.in[I_MODB][(size_t)l * (NMOD * DM) + nb + n]; }
        __syncthreads();
    }
}

__device__ void norm_mod_phase(const float* lat, const float* ctx, const float* ng, const float* modl  , int ishift, int iscale, int nrows, int cm, u16* H) {
    const int lane = threadIdx.x & 63, wid = threadIdx.x >> 6;
    for (int row = blockIdx.x * 8 + wid; row < nrows; row += gridDim.x * 8) {
        const float* s = row < RL ? lat + (size_t)row * DM : ctx + (size_t)(row - RL) * DM;
        const int mi = row < RL ? (row >> 12) : 4;
        f32x4 v[4]; float ss = 0.f;
#pragma unroll
        for (int i = 0; i < 4; ++i) { v[i] = *(const f32x4*)(s + i * 256 + lane * 4); ss += v[i][0] * v[i][0] + v[i][1] * v[i][1] + v[i][2] * v[i][2] + v[i][3] * v[i][3]; }
        ss = wave_sum(ss);
        const float rs = rsqrtf(ss * (1.0f / DM) + EPS);
        const int dr = (cm && row < RL) ? ((row & ~4095) | ((row & 63) << 6) | ((row >> 6) & 63)) : row;
        const float* sh = modl + mi * (NMOD * DM) + ishift * DM; const float* scp = modl + mi * (NMOD * DM) + iscale * DM;
#pragma unroll
        for (int i = 0; i < 4; ++i) { const int c = i * 256 + lane * 4; const f32x4 g4 = *(const f32x4*)(ng + c), sh4 = *(const f32x4*)(sh + c), sc4 = *(const f32x4*)(scp + c);
            float o[4];
#pragma unroll
            for (int e = 0; e < 4; ++e) o[e] = (v[i][e] * rs * g4[e]) * (1.0f + sc4[e]) + sh4[e];
            u32x2 w; w[0] = pk2(o[0], o[1]); w[1] = pk2(o[2], o[3]); *(u32x2*)(H + (size_t)dr * DM + c) = w; }
    }
}
__device__ void final_norm_phase(float* X, const float* g) {
    const int lane = threadIdx.x & 63, wid = threadIdx.x >> 6;
    for (int row = blockIdx.x * 8 + wid; row < RL; row += gridDim.x * 8) {
        float* s = X + (size_t)row * DM; f32x4 v[4]; float ss = 0.f;
#pragma unroll
        for (int i = 0; i < 4; ++i) { v[i] = *(const f32x4*)(s + i * 256 + lane * 4); ss += v[i][0] * v[i][0] + v[i][1] * v[i][1] + v[i][2] * v[i][2] + v[i][3] * v[i][3]; }
        ss = wave_sum(ss);
        const float rs = rsqrtf(ss * (1.0f / DM) + EPS);
#pragma unroll
        for (int i = 0; i < 4; ++i) { const int c = i * 256 + lane * 4; const f32x4 g4 = *(const f32x4*)(g + c); f32x4 o;
#pragma unroll
            for (int e = 0; e < 4; ++e) o[e] = (v[i][e] * rs) * g4[e];
            *(f32x4*)(s + c) = o; }
    }
}

__device__ __forceinline__ int gla_rowbase(int b, int c) { return c < 4 ? RL + b * CTXL + c * 64 : b * SEQ + (c - 4) * 64; }
__device__ __forceinline__ float* gla_ds_ptr(const Params& p, int b, int d, int h, int c) {
    return c < 4 ? (float*)(p.ws + OFF_DSC) + ((size_t)((b * 2 + d) * 4 + h) * 4 + c) * 8192 : p.out + ((size_t)((b * 2 + d) * 4 + h) * 64 + (c - 4)) * 8192;
}
constexpr int GL_BC = 0;
constexpr int GL_LR = GL_BC + 2 * 64 * 65 * 4;
constexpr int GL_GW = GL_LR + 64 * 32 * 4;
constexpr int GL_X0 = GL_GW + 2 * 16 * 64 * 4;
constexpr int GL_LD = 72;

__device__ void gla_gates(unsigned char* shm, const Params& p, int rowbase, int h) {
    const u16* P0 = (const u16*)(p.ws + E_P0);
    float* BC = (float*)(shm + GL_BC); float* LR = (float*)(shm + GL_LR); float* GW = (float*)(shm + GL_GW);
    const int t = threadIdx.x;
    if (t < 256) { const int row = t >> 2, part = t & 3; const u32x4v w = *(const u32x4v*)(P0 + (size_t)(rowbase + row) * P0_LD + P0_LR + part * 8);
#pragma unroll
        for (int e = 0; e < 4; ++e) { LR[row * 32 + part * 8 + 2 * e] = bflo(w[e]); LR[row * 32 + part * 8 + 2 * e + 1] = bfhi(w[e]); } }
    { const int idx = t * 4, d = idx >> 10, j = (idx & 1023) >> 6, kk = idx & 63;
      *(f32x4*)(GW + idx) = *(const f32x4*)(p.in[I_ABGW] + (size_t)(d * 16 + j) * 256 + h * 64 + kk); }
    __syncthreads();
    { const int d = t >> 8, rem = t & 255, l = rem >> 2, kq = (rem & 3) * 16;
      float lr[16];
#pragma unroll
      for (int j = 0; j < 16; ++j) lr[j] = LR[l * 32 + d * 16 + j];
#pragma unroll
      for (int e = 0; e < 16; ++e) { const int kk = kq + e; float pre = p.in[I_ABGB][d * 256 + h * 64 + kk];
#pragma unroll
          for (int j = 0; j < 16; ++j) pre += lr[j] * GW[(d * 16 + j) * 64 + kk];
          BC[(d * 64 + l) * 65 + kk] = logsigmoidf(pre) * (1.0f / 16.0f); } }
    __syncthreads();
    if (t < 128) { const int d = t >> 6, kk = t & 63; float run = 0.f;
        if (d == 0) { for (int l = 0; l < 64; ++l) { run += BC[l * 65 + kk]; BC[l * 65 + kk] = run; } }
        else { for (int l = 63; l >= 0; --l) { run += BC[(64 + l) * 65 + kk]; BC[(64 + l) * 65 + kk] = run; } } }
    __syncthreads();
}
__device__ __forceinline__ void gla_stage_vT(u16* vT, const u16* P0, int rowbase, int h) {
    const int t = threadIdx.x, l = t & 63, vg = t >> 6;
    const u16* src = P0 + (size_t)(rowbase + l) * P0_LD + P0_V + h * 128 + vg * 16;
    const u32x4v w0 = *(const u32x4v*)src, w1 = *(const u32x4v*)(src + 8);
#pragma unroll
    for (int e = 0; e < 4; ++e) { vT[(vg * 16 + 2 * e) * GL_LD + l] = (u16)(w0[e] & 0xFFFF); vT[(vg * 16 + 2 * e + 1) * GL_LD + l] = (u16)(w0[e] >> 16);
        vT[(vg * 16 + 8 + 2 * e) * GL_LD + l] = (u16)(w1[e] & 0xFFFF); vT[(vg * 16 + 8 + 2 * e + 1) * GL_LD + l] = (u16)(w1[e] >> 16); }
}

__device__ void gla_a_item(unsigned char* shm, const Params& p, int b, int c, int h) {
    const u16* P0 = (const u16*)(p.ws + E_P0);
    const int rowbase = gla_rowbase(b, c), t = threadIdx.x, lane = t & 63, w = t >> 6;
    gla_gates(shm, p, rowbase, h);
    const float* BC = (const float*)(shm + GL_BC);
    u16* kwT = (u16*)(shm + GL_X0);
    u16* vT = kwT + 2 * 64 * GL_LD;
    { const int l = t & 63, kg = t >> 6; const u32x4v kw = *(const u32x4v*)(P0 + (size_t)(rowbase + l) * P0_LD + P0_K + h * 64 + kg * 8);
#pragma unroll
      for (int e = 0; e < 8; ++e) { const int k = kg * 8 + e; const float kv = (e & 1) ? bfhi(kw[e >> 1]) : bflo(kw[e >> 1]);
          const float w0 = __expf(BC[63 * 65 + k] - BC[l * 65 + k]), w1 = __expf(BC[(64 + 0) * 65 + k] - BC[(64 + l) * 65 + k]);
          kwT[k * GL_LD + l] = f2bf(kv * w0); kwT[(64 + k) * GL_LD + l] = f2bf(kv * w1); } }
    gla_stage_vT(vT, P0, rowbase, h);
    __syncthreads();
    { const int d = w >> 2, kb = w & 3; f32x4 acc[1][8]; zero_acc(acc);
      wave_mma<1, 8>(acc, kwT + (d * 64 + kb * 16) * GL_LD, GL_LD, vT, GL_LD, 2);
      float* DS = gla_ds_ptr(p, b, d, h, c);
#pragma unroll
      for (int nt = 0; nt < 8; ++nt) { const int v = nt * 16 + (lane & 15), k0 = kb * 16 + (lane >> 4) * 4; *(f32x4*)(DS + v * 64 + k0) = acc[0][nt]; } }
    if (t < 128) { const int d = t >> 6, kk = t & 63; const float bl = d == 0 ? BC[63 * 65 + kk] : BC[64 * 65 + kk];
        ((float*)(p.ws + OFF_DEC))[((size_t)((b * 2 + d) * 4 + h) * 68 + c) * 64 + kk] = __expf(bl); }
    __syncthreads();
}

__device__ void gmlp_item(unsigned char* shm, const Params& p, int b, int cc, int gi) {
    const u16* P0 = (const u16*)(p.ws + E_P0); u16* MG = (u16*)(p.ws + OFF_H);
    const int rowbase = cc < 2 ? RL + b * CTXL + cc * 128 : b * SEQ + (cc - 2) * 128;
    const int t = threadIdx.x, lane = t & 63, w = t >> 6;
    float* st = (float*)shm;
    u16* vnT = (u16*)(shm + 1024);
    u16* Ws = vnT + 128 * 136;
    { const int row = t >> 2, part = t & 3; const u16* src = P0 + (size_t)(rowbase + row) * P0_LD + P0_G + part * 128; float s = 0.f, ss = 0.f;
#pragma unroll 4
      for (int i = 0; i < 16; ++i) { const u32x4v wv = *(const u32x4v*)(src + i * 8);
#pragma unroll
          for (int e = 0; e < 4; ++e) { const float a = geluf(bflo(wv[e])), c2 = geluf(bfhi(wv[e])); s += a + c2; ss += a * a + c2 * c2; } }
      s += __shfl_xor(s, 1, 64); ss += __shfl_xor(ss, 1, 64); s += __shfl_xor(s, 2, 64); ss += __shfl_xor(ss, 2, 64);
      if (part == 0) { const float mu = s * (1.0f / 512.0f); const float var = fmaxf(ss * (1.0f / 512.0f) - mu * mu, 0.f); st[row * 2] = mu; st[row * 2 + 1] = rsqrtf(var + EPS); } }
    { const float* SW = p.in[I_ABSW] + (size_t)gi * 128 * 128;
#pragma unroll
      for (int ps = 0; ps < 8; ++ps) { const int idx = ps * 2048 + t * 4, tt = idx >> 7, s0 = idx & 127; const f32x4 v = *(const f32x4*)(SW + idx);
          u32x2 o; o[0] = pk2(v[0], v[1]); o[1] = pk2(v[2], v[3]); *(u32x2*)(Ws + tt * 136 + s0) = o; } }
    __syncthreads();
    { const int s = t & 127, cg4 = t >> 7; const u16* src = P0 + (size_t)(rowbase + s) * P0_LD + P0_G + gi * 128 + cg4 * 32; const float mu = st[s * 2], rstd = st[s * 2 + 1];
      const float* vg = p.in[I_ABVNG] + gi * 128 + cg4 * 32;
#pragma unroll
      for (int i = 0; i < 4; ++i) { const u32x4v wv = *(const u32x4v*)(src + i * 8);
#pragma unroll
          for (int e = 0; e < 8; ++e) { const float x = (e & 1) ? bfhi(wv[e >> 1]) : bflo(wv[e >> 1]); const int cl = i * 8 + e;
              vnT[(cg4 * 32 + cl) * 136 + s] = f2bf((geluf(x) - mu) * rstd * vg[cl]); } } }
    __syncthreads();
    { f32x4 acc[1][8]; zero_acc(acc);
      wave_mma<1, 8>(acc, vnT + (w * 16) * 136, 136, Ws, 136, 4);
      const int c0 = w * 16 + (lane >> 4) * 4;
#pragma unroll
      for (int nt = 0; nt < 8; ++nt) { const int tt = nt * 16 + (lane & 15); const float sb = p.in[I_ABSB][gi * 128 + tt];
          const u32x2 uw = *(const u32x2*)(P0 + (size_t)(rowbase + tt) * P0_LD + P0_U + gi * 128 + c0);
          const float o0 = geluf(bflo(uw[0])) * (acc[0][nt][0] + sb), o1 = geluf(bfhi(uw[0])) * (acc[0][nt][1] + sb), o2 = geluf(bflo(uw[1])) * (acc[0][nt][2] + sb), o3 = geluf(bfhi(uw[1])) * (acc[0][nt][3] + sb);
          u32x2 o; o[0] = pk2(o0, o1); o[1] = pk2(o2, o3); *(u32x2*)(MG + (size_t)(rowbase + tt) * DM + 512 + gi * 128 + c0) = o; } }
    __syncthreads();
}

__device__ void gla_scan_phase(const Params& p) {
    const float* DEC = (const float*)(p.ws + OFF_DEC);
    for (int g0 = blockIdx.x * 512 + threadIdx.x; g0 < 4 * 2 * 4 * 8192 / 2; g0 += gridDim.x * 512) {
        int e[2], bb[2], dd[2], hh[2]; const float* dec[2]; float s[2] = {0.f, 0.f};
#pragma unroll
        for (int q = 0; q < 2; ++q) { const int gidx = g0 + q * (4 * 2 * 4 * 8192 / 2); e[q] = gidx & 8191; const int bdh = gidx >> 13; hh[q] = bdh & 3; dd[q] = (bdh >> 2) & 1; bb[q] = bdh >> 3; dec[q] = DEC + (size_t)bdh * 68 * 64 + (e[q] & 63); }
        for (int i0 = 0; i0 < 68; i0 += 17) {
            float* ptr[2][17]; float ds[2][17], dc[2][17];
#pragma unroll
            for (int u = 0; u < 17; ++u)
#pragma unroll
                for (int q = 0; q < 2; ++q) { const int i = i0 + u; const int c = dd[q] == 0 ? i : (i < 4 ? 3 - i : 71 - i); ptr[q][u] = gla_ds_ptr(p, bb[q], dd[q], hh[q], c) + e[q]; ds[q][u] = *ptr[q][u]; dc[q][u] = dec[q][c * 64]; }
#pragma unroll
            for (int u = 0; u < 17; ++u)
#pragma unroll
                for (int q = 0; q < 2; ++q) { *ptr[q][u] = s[q]; s[q] = dc[q][u] * s[q] + ds[q][u]; }
        }
    }
}

__device__ void gla_c_item(unsigned char* shm, const Params& p, int b, int c, int h) {
    const u16* P0 = (const u16*)(p.ws + E_P0); u16* MG = (u16*)(p.ws + OFF_H);
    const int rowbase = gla_rowbase(b, c), t = threadIdx.x, lane = t & 63, w = t >> 6;
    gla_gates(shm, p, rowbase, h);
    const float* BC = (const float*)(shm + GL_BC);
    u16* qd = (u16*)(shm + GL_X0);
    u16* kd = qd + 2 * 64 * GL_LD;
    u16* vT = kd + 2 * 64 * GL_LD;
    u16* SpT = vT + 128 * GL_LD;
    u16* SC = (u16*)(shm + GL_BC);
    float* O = (float*)SpT;
    { const int l = t & 63, kg = t >> 6; const u16* rp = P0 + (size_t)(rowbase + l) * P0_LD + h * 64 + kg * 8;
      const u32x4v qw = *(const u32x4v*)(rp + P0_Q), kw = *(const u32x4v*)(rp + P0_K);
#pragma unroll
      for (int d = 0; d < 2; ++d) { u32x4v qo, ko;
#pragma unroll
          for (int e2 = 0; e2 < 4; ++e2) { const float e0 = BC[(d * 64 + l) * 65 + kg * 8 + 2 * e2], e1 = BC[(d * 64 + l) * 65 + kg * 8 + 2 * e2 + 1];
              qo[e2] = pk2(bflo(qw[e2]) * 0.125f * __expf(e0), bfhi(qw[e2]) * 0.125f * __expf(e1));
              ko[e2] = pk2(bflo(kw[e2]) * __expf(-e0), bfhi(kw[e2]) * __expf(-e1)); }
          *(u32x4v*)(qd + (d * 64 + l) * GL_LD + kg * 8) = qo; *(u32x4v*)(kd + (d * 64 + l) * GL_LD + kg * 8) = ko; } }
    gla_stage_vT(vT, P0, rowbase, h);
#pragma unroll
    for (int ps = 0; ps < 4; ++ps) { const int idx = ps * 4096 + t * 8, d = idx >> 13, rem = idx & 8191, v = rem >> 6, k0 = rem & 63;
        const float* src = gla_ds_ptr(p, b, d, h, c) + rem; const f32x4 a = *(const f32x4*)src, bq = *(const f32x4*)(src + 4);
        *(u32x4v*)(SpT + (d * 128 + v) * GL_LD + k0) = pack8(a, bq); }
    __syncthreads();
    { const int d = w >> 2, lb = w & 3; f32x4 acc[1][4]; zero_acc(acc);
      wave_mma<1, 4>(acc, qd + (d * 64 + lb * 16) * GL_LD, GL_LD, kd + d * 64 * GL_LD, GL_LD, 2);
      __syncthreads();
#pragma unroll
      for (int nt = 0; nt < 4; ++nt)
#pragma unroll
          for (int j = 0; j < 4; ++j) { const int l = lb * 16 + (lane >> 4) * 4 + j, s = nt * 16 + (lane & 15); const bool keep = d == 0 ? (s <= l) : (s >= l);
              SC[(d * 64 + l) * GL_LD + s] = f2bf(keep ? acc[0][nt][j] : 0.f); } }
    __syncthreads();
    f32x4 oacc[1][4]; zero_acc(oacc);
    const int lb = w & 3, vh = w >> 2;
#pragma unroll
    for (int d = 0; d < 2; ++d) {
        wave_mma<1, 4>(oacc, qd + (d * 64 + lb * 16) * GL_LD, GL_LD, SpT + (d * 128 + vh * 64) * GL_LD, GL_LD, 2);
        wave_mma<1, 4>(oacc, SC + (d * 64 + lb * 16) * GL_LD, GL_LD, vT + (vh * 64) * GL_LD, GL_LD, 2);
    }
    __syncthreads();
#pragma unroll
    for (int nt = 0; nt < 4; ++nt)
#pragma unroll
        for (int j = 0; j < 4; ++j) { const int l = lb * 16 + (lane >> 4) * 4 + j, v = vh * 64 + nt * 16 + (lane & 15); O[l * 132 + v] = oacc[0][nt][j]; }
    __syncthreads();
    { const int l = t >> 3, part = t & 7; float o[16]; float ss = 0.f;
#pragma unroll
      for (int i = 0; i < 4; ++i) { const f32x4 v4 = *(const f32x4*)(O + l * 132 + part * 16 + i * 4);
#pragma unroll
          for (int e = 0; e < 4; ++e) { o[i * 4 + e] = v4[e]; ss += v4[e] * v4[e]; } }
      ss += __shfl_xor(ss, 1, 64); ss += __shfl_xor(ss, 2, 64); ss += __shfl_xor(ss, 4, 64);
      const float rs = rsqrtf(ss * (1.0f / 128.0f) + EPS);
      const u16* rp = P0 + (size_t)(rowbase + l) * P0_LD + P0_R + h * 128 + part * 16; const float* gg = p.in[I_ABGNG] + h * 128 + part * 16;
      const u32x4v r0 = *(const u32x4v*)rp, r1 = *(const u32x4v*)(rp + 8); u32x4v o0, o1;
#pragma unroll
      for (int e2 = 0; e2 < 4; ++e2) {
          o0[e2] = pk2(o[2 * e2] * rs * gg[2 * e2] * siluf(bflo(r0[e2])), o[2 * e2 + 1] * rs * gg[2 * e2 + 1] * siluf(bfhi(r0[e2])));
          o1[e2] = pk2(o[8 + 2 * e2] * rs * gg[8 + 2 * e2] * siluf(bflo(r1[e2])), o[8 + 2 * e2 + 1] * rs * gg[8 + 2 * e2 + 1] * siluf(bfhi(r1[e2]))); }
      u16* dst = MG + (size_t)(rowbase + l) * DM + h * 128 + part * 16; *(u32x4v*)dst = o0; *(u32x4v*)(dst + 8) = o1; }
    __syncthreads();
}

__device__ void conv_phase(const Params& p) {
    u16* XBC = (u16*)(p.ws + E_XBC); const u16* HALO = (const u16*)(p.ws + A_HALO);
    const int t = threadIdx.x, cg = t & 127, q = __builtin_amdgcn_readfirstlane(t >> 7);
    for (int it = blockIdx.x; it < (RT / 64) * 3; it += gridDim.x) {
        const int rb = it / 3, cp = (it % 3) * 1024, c0 = cp + cg * 8;
        const bool first = rb < 256 ? ((rb & 63) == 0) : (((rb - 256) & 3) == 0);
        const bool last = rb < 256 ? ((rb & 63) == 63) : (((rb - 256) & 3) == 3);
        const bool z0 = (q == 0) && first, z1 = (q == 3) && last;
        u16* rowq = XBC + ((size_t)rb * 64 + 16 * q) * XBC_LD + cp;
        const u16* pre = (q == 0) ? (z0 ? rowq : HALO + ((size_t)(rb - 1) * 4 + 2) * XBC_LD + cp) : rowq - 2 * XBC_LD;
        const u16* post = (q == 3) ? (z1 ? rowq : HALO + ((size_t)(rb + 1) * 4) * XBC_LD + cp) : rowq + 16 * XBC_LD;
        u32x4v win[20];
        win[0] = *(const u32x4v*)(pre + cg * 8); win[1] = *(const u32x4v*)(pre + XBC_LD + cg * 8);
#pragma unroll
        for (int i = 0; i < 16; ++i) win[2 + i] = *(const u32x4v*)(rowq + (size_t)i * XBC_LD + cg * 8);
        win[18] = *(const u32x4v*)(post + cg * 8); win[19] = *(const u32x4v*)(post + XBC_LD + cg * 8);
        const u32x4v zero = {0u, 0u, 0u, 0u};
        if (z0) { win[0] = zero; win[1] = zero; }
        if (z1) { win[18] = zero; win[19] = zero; }
        float wt[5][8], bias[8];
#pragma unroll
        for (int j = 0; j < 5; ++j) { const f32x4 a = *(const f32x4*)(p.in[I_SSDCW] + j * 3072 + c0), b2 = *(const f32x4*)(p.in[I_SSDCW] + j * 3072 + c0 + 4);
#pragma unroll
            for (int e = 0; e < 4; ++e) { wt[j][e] = a[e]; wt[j][4 + e] = b2[e]; } }
        { const f32x4 a = *(const f32x4*)(p.in[I_SSDCB] + c0), b2 = *(const f32x4*)(p.in[I_SSDCB] + c0 + 4);
#pragma unroll
          for (int e = 0; e < 4; ++e) { bias[e] = a[e]; bias[4 + e] = b2[e]; } }
        __syncthreads();
#pragma unroll
        for (int r = 0; r < 16; ++r) {
            float o[8];
#pragma unroll
            for (int e = 0; e < 8; ++e) o[e] = bias[e];
#pragma unroll
            for (int j = 0; j < 5; ++j)
#pragma unroll
                for (int e2 = 0; e2 < 4; ++e2) { o[2 * e2] += wt[j][2 * e2] * bflo(win[r + j][e2]); o[2 * e2 + 1] += wt[j][2 * e2 + 1] * bfhi(win[r + j][e2]); }
            u32x4v ov;
#pragma unroll
            for (int e2 = 0; e2 < 4; ++e2) ov[e2] = pk2(siluf(o[2 * e2]), siluf(o[2 * e2 + 1]));
            *(u32x4v*)(rowq + (size_t)r * XBC_LD + cg * 8) = ov;
        }
    }
}
__device__ void dt_phase(unsigned char* shm, const Params& p) {
    const float* DTRAW = (const float*)(p.ws + A_DTRAW); float* DT = (float*)(p.ws + T_DT); float* ACUM = (float*)(p.ws + T_ACUM);
    float* tile = (float*)shm;
    float* tdt = tile + 128 * 65;
    const int t = threadIdx.x, col = t & 63;
    const float bias = p.in[I_SSDDTB][col], a = -__expf(p.in[I_SSDALOG][col]);
    for (int ch = blockIdx.x; ch < RT / 128; ch += gridDim.x) {
        const size_t r0 = (size_t)ch * 128;
#pragma unroll
        for (int i = 0; i < 16; ++i) { const int m = i * 8 + (t >> 6); const float d = softplusf(DTRAW[(r0 + m) * 64 + col] + bias); tdt[m * 65 + col] = d; tile[m * 65 + col] = d * a; }
        __syncthreads();
        if (t < 64) { float run = 0.f;
            if (t < 32) { for (int m = 0; m < 128; ++m) { run += tile[m * 65 + t]; tile[m * 65 + t] = run; } }
            else { for (int m = 127; m >= 0; --m) { run += tile[m * 65 + t]; tile[m * 65 + t] = run; } } }
        __syncthreads();
        { const int m = t & 127, cq = t >> 7;
#pragma unroll
          for (int i = 0; i < 16; ++i) { const int c = cq * 16 + i; ACUM[(size_t)c * RT + r0 + m] = tile[m * 65 + c]; DT[(size_t)c * RT + r0 + m] = tdt[m * 65 + c]; } }
        __syncthreads();
    }
}
__device__ void ssd_cb_item(unsigned char* shm, const Params& p, int item) {
    const u16* XBC = (const u16*)(p.ws + E_XBC); u16* CB = (u16*)(p.ws + A_CB) + (size_t)item * 16384;
    const int g = item & 3, base = (item >> 2) * 128;
    u16* Cs = (u16*)shm; u16* Bs = Cs + 128 * 136;
    const int t = threadIdx.x, lane = t & 63, w = t >> 6;
#pragma unroll
    for (int i = 0; i < 4; ++i) { const int idx = i * 512 + t, m = idx >> 4, seg = idx & 15; const u16* rp = XBC + (size_t)(base + m) * XBC_LD + g * 128 + seg * 8;
        *(u32x4v*)(Cs + m * 136 + seg * 8) = *(const u32x4v*)(rp + 2560); *(u32x4v*)(Bs + m * 136 + seg * 8) = *(const u32x4v*)(rp + 2048); }
    __syncthreads();
    f32x4 acc[1][8]; zero_acc(acc);
    wave_mma<1, 8>(acc, Bs + (w * 16) * 136, 136, Cs, 136, 4);
#pragma unroll
    for (int nt = 0; nt < 8; ++nt) { const int m = nt * 16 + (lane & 15), s0 = w * 16 + (lane >> 4) * 4; u32x2 o; o[0] = pk2(acc[0][nt][0], acc[0][nt][1]); o[1] = pk2(acc[0][nt][2], acc[0][nt][3]);
        *(u32x2*)(CB + m * 128 + s0) = o; }
    __syncthreads();
}

constexpr int SS_LD = 136, SS_LB = 130;
constexpr int SS_C = 0;
constexpr int SS_M = SS_C + 128 * SS_LD * 2;
constexpr int SS_B = SS_M + 128 * SS_LD * 2;
constexpr int SS_XT = SS_B + 128 * SS_LB * 2;
constexpr int SS_XW = SS_XT + 32 * SS_LD * 2;
constexpr int SS_S = SS_XW + 32 * SS_LD * 2;
constexpr int SS_AC = SS_S + 32 * SS_LD * 2;
constexpr int SS_END = SS_AC + 512;
static_assert(SS_END <= LDS_BYTES, "SSD LDS");

__device__ void ssd_item(unsigned char* shm, const Params& p, int b, int h, int ph) {
    const u16* XBC = (const u16*)(p.ws + E_XBC); u16* Y = (u16*)(p.ws + E_Y); const u16* CB = (const u16*)(p.ws + A_CB);
    const float* DT = (const float*)(p.ws + T_DT); const float* ACUM = (const float*)(p.ws + T_ACUM);
    u16* Cs = (u16*)(shm + SS_C); u16* Ms = (u16*)(shm + SS_M); u16* Bs = (u16*)(shm + SS_B); u16* xT = (u16*)(shm + SS_XT); u16* xwT = (u16*)(shm + SS_XW); u16* Sb = (u16*)(shm + SS_S);
    float* acs = (float*)(shm + SS_AC);
    const int t = threadIdx.x, lane = t & 63, w = t >> 6, g = h >> 3, fr = lane & 15, fq = lane >> 4;
    const int xcol = h * 64 + ph * 32, bcol = 2048 + g * 128, ccol = 2560 + g * 128;
    const int seg = t & 15, mq = t >> 4, xm = t & 127, xseg = t >> 7, mrow0 = w * 16;
    const float dsk = p.in[I_SSDD][h];
    for (int dir = 0; dir < 2; ++dir) {
        const float* dtc = DT + (size_t)(dir * 32 + h) * RT; const float* acc_ = ACUM + (size_t)(dir * 32 + h) * RT;
        f32x4 accS[1][2]; zero_acc(accS);
        u32x4v rC[4], rCB[4], rB[4], rX; f32x4 rAs0, rAs1; float rAm[4], rDt, rAcX, rAlast; u32x2 rY[2], rXs[2];
        { const u32x4v z4 = {0u, 0u, 0u, 0u}; const u32x2 z2 = {0u, 0u};
#pragma unroll
          for (int i = 0; i < 4; ++i) { rC[i] = z4; rCB[i] = z4; rAm[i] = 0.f; }
          rAs0 = (f32x4){0.f, 0.f, 0.f, 0.f}; rAs1 = rAs0; rY[0] = z2; rY[1] = z2; rXs[0] = z2; rXs[1] = z2; }
#define SSD_BASE(st) ((st) < 2 ? RL + b * CTXL + (dir == 0 ? (st) : 1 - (st)) * 128 : b * SEQ + (dir == 0 ? (st) - 2 : 33 - (st)) * 128)
#define SSD_PREFETCH(st) do { const int base_ = SSD_BASE(st); const bool ctx_ = (st) < 2; \
            _Pragma("unroll") for (int i = 0; i < 4; ++i) { const int m = mq + 32 * i; const u16* rp = XBC + (size_t)(base_ + m) * XBC_LD + seg * 8; rB[i] = *(const u32x4v*)(rp + bcol); \
                if (!ctx_) { rC[i] = *(const u32x4v*)(rp + ccol); rCB[i] = *(const u32x4v*)(CB + ((size_t)(base_ >> 7) * 4 + g) * 16384 + m * 128 + seg * 8); rAm[i] = acc_[base_ + m]; } } \
            rX = *(const u32x4v*)(XBC + (size_t)(base_ + xm) * XBC_LD + xcol + xseg * 8); rDt = dtc[base_ + xm]; rAcX = acc_[base_ + xm]; rAlast = acc_[base_ + (dir == 0 ? 127 : 0)]; \
            if (!ctx_) { rAs0 = *(const f32x4*)(acc_ + base_ + seg * 8); rAs1 = *(const f32x4*)(acc_ + base_ + seg * 8 + 4); \
                if (dir == 1) { _Pragma("unroll") for (int mt = 0; mt < 2; ++mt) { const size_t row = (size_t)(base_ + mrow0 + fr); const int p0 = mt * 16 + fq * 4; \
                    rY[mt] = *(const u32x2*)(Y + row * 2048 + xcol + p0); rXs[mt] = *(const u32x2*)(XBC + row * XBC_LD + xcol + p0); } } } } while (0)
        SSD_PREFETCH(0);
        for (int step = 0; step < 34; ++step) {
            const bool isctx = step < 2;
            const int base = SSD_BASE(step);
            const float a_last = rAlast;
            if (xseg == 0) acs[xm] = rAcX;
#pragma unroll
            for (int i = 0; i < 4; ++i) { const int m = mq + 32 * i;
                unsigned* bd = (unsigned*)(Bs + m * SS_LB + seg * 8); bd[0] = rB[i][0]; bd[1] = rB[i][1]; bd[2] = rB[i][2]; bd[3] = rB[i][3];
                if (!isctx) { *(u32x4v*)(Cs + m * SS_LD + seg * 8) = rC[i];
                    u32x4v mv = {0u, 0u, 0u, 0u};
                    const bool any = dir == 0 ? (seg * 8 <= m) : (seg * 8 + 7 >= m);
                    if (any) { float v[8];
#pragma unroll
                        for (int e = 0; e < 8; ++e) { const int s = seg * 8 + e; const bool keep = dir == 0 ? (s <= m) : (s >= m); const float as = e < 4 ? rAs0[e & 3] : rAs1[e & 3];
                            const float cbv = (e & 1) ? bfhi(rCB[i][e >> 1]) : bflo(rCB[i][e >> 1]); v[e] = keep ? cbv * __expf(rAm[i] - as) : 0.f; }
                        mv[0] = pk2(v[0], v[1]); mv[1] = pk2(v[2], v[3]); mv[2] = pk2(v[4], v[5]); mv[3] = pk2(v[6], v[7]); }
                    *(u32x4v*)(Ms + m * SS_LD + seg * 8) = mv; } }
            { const float wgt = __expf(a_last - rAcX);
#pragma unroll
              for (int e = 0; e < 8; ++e) { const float x = ((e & 1) ? bfhi(rX[e >> 1]) : bflo(rX[e >> 1])) * rDt; xT[(xseg * 8 + e) * SS_LD + xm] = f2bf(x); xwT[(xseg * 8 + e) * SS_LD + xm] = f2bf(x * wgt); } }
            if (!isctx) {
#pragma unroll
                for (int nt = 0; nt < 2; ++nt) { u32x2 o; o[0] = pk2(accS[0][nt][0], accS[0][nt][1]); o[1] = pk2(accS[0][nt][2], accS[0][nt][3]); *(u32x2*)(Sb + (nt * 16 + fr) * SS_LD + mrow0 + fq * 4) = o; } }
            u32x2 cY[2], cXs[2];
#pragma unroll
            for (int mt = 0; mt < 2; ++mt) { cY[mt] = rY[mt]; cXs[mt] = rXs[mt]; }
            __syncthreads();
            if (step + 1 < 34) SSD_PREFETCH(step + 1);
            if (!isctx) {
                f32x4 yT[2][1]; zero_acc(yT);
                wave_mma<2, 1>(yT, Sb, SS_LD, Cs + mrow0 * SS_LD, SS_LD, 4);
                { const float sc = __expf(acs[mrow0 + fr]);
#pragma unroll
                  for (int mt = 0; mt < 2; ++mt)
#pragma unroll
                      for (int j = 0; j < 4; ++j) yT[mt][0][j] *= sc; }
                wave_mma<2, 1>(yT, xT, SS_LD, Ms + mrow0 * SS_LD, SS_LD, 4);
                { const size_t row = (size_t)(base + mrow0 + fr);
#pragma unroll
                  for (int mt = 0; mt < 2; ++mt) { const int p0 = mt * 16 + fq * 4; u16* yp = Y + row * 2048 + xcol + p0; float o0 = yT[mt][0][0], o1 = yT[mt][0][1], o2 = yT[mt][0][2], o3 = yT[mt][0][3];
                      if (dir == 1) { const u32x2 pv = cY[mt], xs = cXs[mt];
                          o0 += bflo(pv[0]) + dsk * bflo(xs[0]); o1 += bfhi(pv[0]) + dsk * bfhi(xs[0]); o2 += bflo(pv[1]) + dsk * bflo(xs[1]); o3 += bfhi(pv[1]) + dsk * bfhi(xs[1]); }
                      u32x2 o; o[0] = pk2(o0, o1); o[1] = pk2(o2, o3); *(u32x2*)yp = o; } }
            }
            { const float dl = __expf(a_last);
#pragma unroll
              for (int nt = 0; nt < 2; ++nt)
#pragma unroll
                  for (int j = 0; j < 4; ++j) accS[0][nt][j] *= dl; }
#pragma unroll
            for (int k = 0; k < 4; ++k) {
                bf16x8 a;
#pragma unroll
                for (int e = 0; e < 8; ++e) a[e] = (short)Bs[(k * 32 + fq * 8 + e) * SS_LB + mrow0 + fr];
#pragma unroll
                for (int nt = 0; nt < 2; ++nt) { const bf16x8 bb = *(const bf16x8*)(xwT + (nt * 16 + fr) * SS_LD + k * 32 + fq * 8); accS[0][nt] = __builtin_amdgcn_mfma_f32_16x16x32_bf16(a, bb, accS[0][nt], 0, 0, 0); } }
            __syncthreads();
        }
#undef SSD_PREFETCH
#undef SSD_BASE
    }
}

__device__ void ssd_finish_phase(const Params& p) {
    u16* Y = (u16*)(p.ws + E_Y); const u16* Z = (const u16*)(p.ws + E_Z);
    const int lane = threadIdx.x & 63, wid = threadIdx.x >> 6;
    for (int it = blockIdx.x * 8 + wid; it < RL * 4; it += gridDim.x * 8) {
        const size_t off = (size_t)(it >> 2) * 2048 + (it & 3) * 512 + lane * 8;
        const u32x4v yw = *(const u32x4v*)(Y + off), zw = *(const u32x4v*)(Z + off);
        float v[8]; float ss = 0.f;
#pragma unroll
        for (int e2 = 0; e2 < 4; ++e2) { v[2 * e2] = bflo(yw[e2]) * siluf(bflo(zw[e2])); v[2 * e2 + 1] = bfhi(yw[e2]) * siluf(bfhi(zw[e2])); ss += v[2 * e2] * v[2 * e2] + v[2 * e2 + 1] * v[2 * e2 + 1]; }
        ss = wave_sum(ss);
        const float rs = rsqrtf(ss * (1.0f / 512.0f) + EPS);
        const float* gg = p.in[I_SSDNG] + (it & 3) * 512 + lane * 8; u32x4v o;
#pragma unroll
        for (int e2 = 0; e2 < 4; ++e2) o[e2] = pk2(v[2 * e2] * rs * gg[2 * e2], v[2 * e2 + 1] * rs * gg[2 * e2 + 1]);
        *(u32x4v*)(Y + off) = o;
    }
}

__global__ __launch_bounds__(512, 2) void mega(Params p) {
    extern __shared__ __attribute__((aligned(16))) unsigned char shm[];
    cg::grid_group grid = cg::this_grid();
    unsigned char* ws = p.ws;
    float* MOD = (float*)(ws + OFF_MOD); const float* MOD1 = MOD + 5 * NMOD * DM;
    u16* H = (u16*)(ws + OFF_H); float* XC = (float*)(ws + OFF_XC);
    const int bid = blockIdx.x, nb = gridDim.x;
    volatile LAS unsigned* xst = (volatile LAS unsigned*)(shm + LDS_XB);
    if (threadIdx.x < 2) xst[threadIdx.x] = 0u;
    __syncthreads();
    const XcdBarrier xb = xcd_barrier_post((unsigned*)(ws + OFF_BAR), xst);
    mod_gemv(shm, p);
    convert_weight(shm, p.in[I_ABWIN], 1024, 2592, (u16*)(ws + A_AB_IN), 2816, 0);
    convert_weight(shm, p.in[I_ABWOUT], 1024, 1024, (u16*)(ws + A_AB_OUT), 1024, 0);
    convert_weight(shm, p.in[I_FFWIN], 1024, 5632, (u16*)(ws + A_FF_IN0), 5632, 1);
    convert_weight(shm, p.in[I_FFWOUT], 2816, 1024, (u16*)(ws + A_FF_OUT0), 1024, 0);
    convert_weight(shm, p.in[I_SSDWIN], 1024, 5184, (u16*)(ws + B_SSD_INA), 3328, 3);
    convert_weight(shm, p.in[I_SSDWIN], 1024, 5184, (u16*)(ws + B_WZ), 2048, 2);
    grid.sync();
    norm_mod_phase(p.in[I_X], p.in[I_CTX], p.in[I_NORMG], MOD, 0, 1, RT, 0, H);
    xcd_barrier(xb);
    { EpiBf16Plain E; E.O = (u16*)(ws + E_P0); E.ld = P0_LD; E.ncols = P0_LD; run_gemm(shm, H, (const u16*)(ws + A_AB_IN), RT, 2816, 1024, E); }
    xcd_barrier(xb);
    for (int it = bid; it < 4 * 68 * 4 + 4 * 34 * 4; it += nb) {
        if (it < 4 * 68 * 4) { const int h = it & 3, bc = it >> 2; gla_a_item(shm, p, bc / 68, bc % 68, h); }
        else { const int j = it - 4 * 68 * 4; const int gi = j & 3, bc = j >> 2; gmlp_item(shm, p, bc / 34, bc % 34, gi); }
    }
    xcd_barrier(xb);
    gla_scan_phase(p);
    xcd_barrier(xb);
    for (int it = bid; it < 4 * 68 * 4; it += nb) { const int h = it & 3, bc = it >> 2; gla_c_item(shm, p, bc / 68, bc % 68, h); }
    xcd_barrier(xb);
    { EpiRes E; E.src_lat = p.in[I_X]; E.src_ctx = p.in[I_CTX]; E.dst_lat = p.out; E.dst_ctx = XC; E.gate = MOD + 2 * DM; E.cm = 0;
      run_gemm(shm, H, (const u16*)(ws + A_AB_OUT), RT, 1024, 1024, E); }
    xcd_barrier(xb);
    norm_mod_phase(p.out, XC, p.in[I_NORMG] + DM, MOD, 3, 4, RT, 0, H);
    xcd_barrier(xb);
    { EpiSwiglu E; E.O = (u16*)(ws + E_ACT); run_gemm(shm, H, (const u16*)(ws + A_FF_IN0), RT, 5632, 1024, E); }
    xcd_barrier(xb);
    { EpiRes E; E.src_lat = p.out; E.src_ctx = XC; E.dst_lat = p.out; E.dst_ctx = XC; E.gate = MOD + 5 * DM; E.cm = 0;
      run_gemm(shm, (const u16*)(ws + E_ACT), (const u16*)(ws + A_FF_OUT0), RT, 1024, 2816, E); }
    xcd_barrier(xb);
    norm_mod_phase(p.out, XC, p.in[I_NORMG] + 2 * DM, MOD1, 0, 1, RT, 1, H);
    xcd_barrier(xb);
    { EpiSsdIn E; E.XBC = (u16*)(ws + E_XBC); E.HALO = (u16*)(ws + A_HALO); E.DTRAW = (float*)(ws + A_DTRAW); run_gemm(shm, H, (const u16*)(ws + B_SSD_INA), RT, 3328, 1024, E); }
    xcd_barrier(xb);
    dt_phase(shm, p);
    conv_phase(p);
    xcd_barrier(xb);
    for (int it = bid; it < 4 * 32 * 4; it += nb) ssd_cb_item(shm, p, it);
    xcd_barrier(xb);
    for (int it = bid; it < 4 * 32 * 2; it += nb) {
        const int xcd = it & 7, slot = it >> 3, grp = xcd * 2 + (slot >> 4), idx = slot & 15;
        ssd_item(shm, p, grp >> 2, (grp & 3) * 8 + (idx >> 1), idx & 1); }
    xcd_barrier(xb);
    { EpiBf16Plain E; E.O = (u16*)(ws + E_Z); E.ld = 2048; E.ncols = 2048; run_gemm(shm, H, (const u16*)(ws + B_WZ), RL, 2048, 1024, E); }
    convert_weight(shm, p.in[I_SSDWOUT], 2048, 1024, (u16*)(ws + A_SSD_OUT), 1024, 0);
    convert_weight(shm, p.in[I_FFWIN] + (size_t)1024 * 5632, 1024, 5632, (u16*)(ws + A_FF_IN1), 5632, 1);
    convert_weight(shm, p.in[I_FFWOUT] + (size_t)2816 * 1024, 2816, 1024, (u16*)(ws + A_FF_OUT1), 1024, 0);
    xcd_barrier(xb);
    ssd_finish_phase(p);
    xcd_barrier(xb);
    { EpiRes E; E.src_lat = p.out; E.src_ctx = XC; E.dst_lat = p.out; E.dst_ctx = XC; E.gate = MOD1 + 2 * DM; E.cm = 1;
      run_gemm(shm, (const u16*)(ws + E_Y), (const u16*)(ws + A_SSD_OUT), RL, 1024, 2048, E); }
    xcd_barrier(xb);
    norm_mod_phase(p.out, XC, p.in[I_NORMG] + 3 * DM, MOD1, 3, 4, RL, 0, H);
    xcd_barrier(xb);
    { EpiSwiglu E; E.O = (u16*)(ws + E_ACT); run_gemm(shm, H, (const u16*)(ws + A_FF_IN1), RL, 5632, 1024, E); }
    xcd_barrier(xb);
    { EpiRes E; E.src_lat = p.out; E.src_ctx = XC; E.dst_lat = p.out; E.dst_ctx = XC; E.gate = MOD1 + 5 * DM; E.cm = 0;
      run_gemm(shm, (const u16*)(ws + E_ACT), (const u16*)(ws + A_FF_OUT1), RL, 1024, 2816, E); }
    xcd_barrier(xb);
    final_norm_phase(p.out, p.in[I_FNG]);
}

extern "C" void kernel_launch(void* const* d_in, const int* in_sizes, int n_in, void* d_out, int out_size, void* d_ws, size_t ws_size, hipStream_t stream) {
    static int grid_blocks = 0;
    if (!grid_blocks) {
        int dev = 0, cus = 0, per_cu = 0;
        (void)hipGetDevice(&dev);
        (void)hipDeviceGetAttribute(&cus, hipDeviceAttributeMultiprocessorCount, dev);
        (void)hipFuncSetAttribute((const void*)mega, hipFuncAttributeMaxDynamicSharedMemorySize, LDS_BYTES);
        (void)hipOccupancyMaxActiveBlocksPerMultiprocessor(&per_cu, (const void*)mega, 512, LDS_BYTES);
        if (per_cu < 1) { fprintf(stderr, "occupancy query says %d blocks/CU\n", per_cu); per_cu = 1; }
        if (per_cu > 1) per_cu = 1;
        grid_blocks = cus * per_cu;
        if (ws_size < WS_END) fprintf(stderr, "workspace too small: %zu < %zu\n", ws_size, (size_t)WS_END);
    }
    Params p{};
    for (int i = 0; i < 26; ++i) p.in[i] = (const float*)d_in[i];
    p.out = (float*)d_out; p.ws = (unsigned char*)d_ws;
    (void)hipMemsetAsync((unsigned char*)d_ws + OFF_BAR, 0, XCD_BAR_WORDS * sizeof(unsigned), stream);
    void* args[] = {&p};
    hipError_t e = hipLaunchCooperativeKernel((const void*)mega, dim3(grid_blocks), dim3(512), args, LDS_BYTES, stream);
    if (e != hipSuccess) fprintf(stderr, "cooperative launch failed: %s (grid %d)\n", hipGetErrorString(e), grid_blocks);
}
```

```cpp
#include <hip/hip_runtime.h>
#include <hip/hip_cooperative_groups.h>
#include <cstdio>
namespace cg = cooperative_groups;
namespace pg8 {
#define PG8_LAS __attribute__((address_space(3)))
typedef unsigned short bf16_t;
typedef short bf16x8 __attribute__((ext_vector_type(8)));
typedef float f32x4 __attribute__((ext_vector_type(4)));
typedef unsigned u32x4 __attribute__((ext_vector_type(4)));
constexpr int BM = 256, BK = 64, HALF = 128, HTB = HALF * BK * 2  , STAGE_BYTES = 8 * HTB, NXCD = 8, WGM = 8;

__host__ __device__ __forceinline__ int lds_byte(int r, int c) { const int st = (r >> 4) * 2 + (c >> 5), rr = r & 15, cc = c & 31, ob = rr * 64 + cc * 2; return st * 1024 + (ob ^ (((ob >> 9) & 1) << 5)); }
__host__ __device__ __forceinline__ void stage_rc(int b, int& R, int& C) { const int st = b / 1024, sb = b % 1024, swz = sb ^ (((sb >> 9) & 1) << 5); R = (st >> 1) * 16 + swz / 64; C = (st & 1) * 32 + (swz % 64) / 2; }
__host__ __device__ __forceinline__ int perm32(int rho) { const int n = rho >> 4, i = rho & 15; return 8 * (i >> 2) + 4 * n + (i & 3); }

struct Unit { int pm, pn, kt0, nkt; };
struct Gemm { const bf16_t* A; const bf16_t* Bt; int M, N, K; };

struct StaticOrder {
    int nM, nN, nwg, G, c, nkt_all;
    __host__ __device__ void init(int M, int N, int G_, int c_, int K_ = 0) { nM = M / BM; nN = N / BM; nwg = nM * nN; G = G_; c = c_; nkt_all = K_ / BK; }
    __host__ __device__ bool next(int i, Unit& u) const {
        const long L = (long)i * G + c; if (L >= nwg) return false;
        int wgid = (int)L; { const int q = nwg / NXCD, r = nwg % NXCD, xcd = wgid % NXCD, off = wgid / NXCD; wgid = (xcd < r ? xcd * (q + 1) : r * (q + 1) + (xcd - r) * q) + off; }
        const int nig = WGM * nN, gid = wgid / nig, fm = gid * WGM, gsz = (nM - fm) < WGM ? (nM - fm) : WGM;
        u.pm = fm + ((wgid % nig) % gsz); u.pn = (wgid % nig) / gsz; u.kt0 = 0; u.nkt = nkt_all; return true;
    }
    __device__ __forceinline__ void a_ready(const Unit&) const {}
    __device__ __forceinline__ void done(const Unit&) const {}
};
__device__ __forceinline__ unsigned cvt_pk_bf16(float lo, float hi) { unsigned r; asm volatile("v_cvt_pk_bf16_f32 %0, %1, %2" : "=v"(r) : "v"(lo), "v"(hi)); return r; }
template <class Epi, class Sched, bool STAMP = false>
__device__ __forceinline__ void gemm_phase(PG8_LAS unsigned char* lds, const Gemm g, const Sched& S, const Epi& E, unsigned long long* stamps) {
    int tid_ = threadIdx.x; asm volatile("" : "+v"(tid_)); const int tid = tid_, wid = __builtin_amdgcn_readfirstlane(tid >> 6), lane = tid & 63, wr = wid >> 2, wc = wid & 3, fr = lane & 15, fq = lane >> 4;
    const int K = g.K;
    int ts_lo = 0, ts_hi = 0, nts = 0; const unsigned long long rt_entry = STAMP ? (unsigned long long)wall_clock64() : 0ull;
#define PG8_STAMP() do { if (STAMP && wid == 0 && nts < 64) { const unsigned long long _c = (unsigned long long)clock64(); \
        ts_lo = (lane == nts) ? (int)(unsigned)_c : ts_lo; ts_hi = (lane == nts) ? (int)(unsigned)(_c >> 32) : ts_hi; ++nts; } } while (0)
    PG8_STAMP();
    unsigned voffA[2], voffB[2];
#pragma unroll
    for (int i = 0; i < 2; ++i) { int R, C; stage_rc(tid * 16 + i * 8192, R, C); const int Rb = Epi::PERM ? ((R & ~31) + perm32(R & 31)) : R;
        voffA[i] = (unsigned)(R * K + C) * 2u; voffB[i] = (unsigned)(Rb * K + C) * 2u; }
    const size_t kstep = (size_t)(BK * 2);
    const size_t hstep = (size_t)HALF * K * 2;
    const size_t tstep = 2 * hstep;
    const unsigned ldsw = (unsigned)wid * 1024u;
    const int aoff = lds_byte(wr * 64 + fr, fq * 8), boff = lds_byte(wc * 32 + fr, fq * 8);
#define PG8_SA(b, h) (((b) * 2 + (h)) * HTB)
#define PG8_SB(b, h) ((4 + (b) * 2 + (h)) * HTB)
#define PG8_STAGE(bufoff, gbase, voff) do { _Pragma("unroll") for (int _i = 0; _i < 2; ++_i) \
        __builtin_amdgcn_global_load_lds((const unsigned*)((const char*)(gbase) + (voff)[_i]), (PG8_LAS unsigned*)(lds + (bufoff) + ldsw + _i * 8192), 16, 0, 0); } while (0)
#define PG8_LDA(dst, b, h) do { _Pragma("unroll") for (int m = 0; m < 4; ++m) _Pragma("unroll") for (int k = 0; k < 2; ++k) dst[m][k] = *(const PG8_LAS bf16x8*)(lds + PG8_SA(b, h) + aoff + m * 2048 + k * 1024); } while (0)
#define PG8_LDB(dst, b, h) do { _Pragma("unroll") for (int n = 0; n < 2; ++n) _Pragma("unroll") for (int k = 0; k < 2; ++k) dst[n][k] = *(const PG8_LAS bf16x8*)(lds + PG8_SB(b, h) + boff + n * 2048 + k * 1024); } while (0)
#define PG8_MMA(ai, bj, At, Bt) do { __builtin_amdgcn_s_setprio(1); _Pragma("unroll") for (int m = 0; m < 4; ++m) _Pragma("unroll") for (int n = 0; n < 2; ++n) _Pragma("unroll") for (int k = 0; k < 2; ++k) \
        acc[ai][bj][m][n] = __builtin_amdgcn_mfma_f32_16x16x32_bf16(Bt[n][k], At[m][k], acc[ai][bj][m][n], 0, 0, 0); __builtin_amdgcn_s_setprio(0); } while (0)
#define PG8_WAIT_V(n) asm volatile("s_waitcnt vmcnt(" #n ")" ::: "memory")
#define PG8_WAIT_L(n) asm volatile("s_waitcnt lgkmcnt(" #n ")" ::: "memory")
#define PG8_BAR __builtin_amdgcn_s_barrier()
#define PG8_SCHED __builtin_amdgcn_sched_barrier(0)
    Unit cur, nxt; int ui = 0;
    if (!S.next(0, cur)) return;
    f32x4 acc[2][2][4][2];
#pragma unroll
    for (int a = 0; a < 2; ++a)
#pragma unroll
        for (int b = 0; b < 2; ++b)
#pragma unroll
            for (int m = 0; m < 4; ++m)
#pragma unroll
                for (int n = 0; n < 2; ++n) acc[a][b][m][n] = (f32x4){0.f, 0.f, 0.f, 0.f};
    bf16x8 At[4][2], B0[2][2], B1[2][2];
    const char* cA = (const char*)g.A + (size_t)cur.pm * tstep + (size_t)cur.kt0 * kstep; const char* cB = (const char*)g.Bt + (size_t)cur.pn * tstep + (size_t)cur.kt0 * kstep;
    S.a_ready(cur);
    PG8_STAGE(PG8_SB(0, 0), cB, voffB); PG8_STAGE(PG8_SA(0, 0), cA, voffA); PG8_STAGE(PG8_SB(0, 1), cB + hstep, voffB); PG8_STAGE(PG8_SA(0, 1), cA + hstep, voffA);
    if (wr == 1) PG8_BAR;
    PG8_WAIT_V(4); PG8_BAR;
    PG8_STAGE(PG8_SB(1, 0), cB + kstep, voffB); PG8_STAGE(PG8_SA(1, 0), cA + kstep, voffA); PG8_STAGE(PG8_SB(1, 1), cB + hstep + kstep, voffB);
    PG8_WAIT_V(6); PG8_BAR;
    PG8_STAMP();
    for (;;) {
        const bool has_next = S.next(ui + 1, nxt);
        const char* nA = has_next ? (const char*)g.A + (size_t)nxt.pm * tstep + (size_t)nxt.kt0 * kstep : cA; const char* nB = has_next ? (const char*)g.Bt + (size_t)nxt.pn * tstep + (size_t)nxt.kt0 * kstep : cB;
        const int nt = cur.nkt;
        for (int t = 0; t < nt; t += 2) {
            const bool last = (t == nt - 2);
            const char* a1 = cA + (size_t)(t + 1) * kstep;
            const char* a2 = last ? nA : cA + (size_t)(t + 2) * kstep; const char* b2 = last ? nB : cB + (size_t)(t + 2) * kstep;
            const char* a3 = a2 + kstep; const char* b3 = b2 + kstep;
            if (last && has_next) S.a_ready(nxt);
            PG8_LDB(B0, 0, 0); PG8_SCHED; PG8_LDA(At, 0, 0); PG8_STAGE(PG8_SA(1, 1), a1 + hstep, voffA);
            PG8_WAIT_L(8); PG8_BAR; PG8_WAIT_L(0); PG8_MMA(0, 0, At, B0); PG8_BAR; PG8_SCHED;
            PG8_LDB(B1, 0, 1); PG8_STAGE(PG8_SB(0, 0), b2, voffB);
            PG8_BAR; PG8_WAIT_L(0); PG8_MMA(0, 1, At, B1); PG8_BAR;
            PG8_LDA(At, 0, 1); PG8_STAGE(PG8_SA(0, 0), a2, voffA);
            PG8_BAR; PG8_WAIT_L(0); PG8_MMA(1, 0, At, B0); PG8_BAR; PG8_SCHED;
            PG8_STAGE(PG8_SB(0, 1), b2 + hstep, voffB);
            PG8_WAIT_V(6); PG8_BAR; PG8_MMA(1, 1, At, B1); PG8_BAR;
            PG8_LDB(B0, 1, 0); PG8_SCHED; PG8_LDA(At, 1, 0); PG8_STAGE(PG8_SA(0, 1), a2 + hstep, voffA);
            PG8_WAIT_L(8); PG8_BAR; PG8_WAIT_L(0); PG8_MMA(0, 0, At, B0); PG8_BAR; PG8_SCHED;
            PG8_LDB(B1, 1, 1); PG8_STAGE(PG8_SB(1, 0), b3, voffB);
            PG8_BAR; PG8_WAIT_L(0); PG8_MMA(0, 1, At, B1); PG8_BAR;
            PG8_LDA(At, 1, 1); PG8_STAGE(PG8_SA(1, 0), a3, voffA);
            PG8_BAR; PG8_WAIT_L(0); PG8_MMA(1, 0, At, B0); PG8_BAR; PG8_SCHED;
            PG8_STAGE(PG8_SB(1, 1), b3 + hstep, voffB);
            PG8_WAIT_V(6); PG8_BAR; PG8_MMA(1, 1, At, B1); PG8_BAR;
        }
        PG8_STAMP();
        if constexpr (!Epi::AFTER_DRAIN) { E(acc, cur, wr, wc, fr, fq); S.done(cur); }
        PG8_STAMP();
        if (!has_next) break;
#pragma unroll
        for (int a = 0; a < 2; ++a)
#pragma unroll
            for (int b = 0; b < 2; ++b)
#pragma unroll
                for (int m = 0; m < 4; ++m)
#pragma unroll
                    for (int n = 0; n < 2; ++n) acc[a][b][m][n] = (f32x4){0.f, 0.f, 0.f, 0.f};
        cur = nxt; cA = nA; cB = nB; ++ui;
    }
    PG8_WAIT_V(0);
    if (wr == 0) PG8_BAR;
    PG8_BAR;
    if constexpr (Epi::AFTER_DRAIN) { E.fused(acc, cur, wr, wc, fr, fq, lds, wid, lane); S.done(cur); }
    PG8_STAMP();
    if (STAMP && wid == 0) { stamps[lane] = lane < nts ? (((unsigned long long)(unsigned)ts_hi << 32) | (unsigned)ts_lo) : 0ull;
        if (lane == 62) stamps[62] = rt_entry; if (lane == 63) stamps[63] = (unsigned long long)wall_clock64(); }
#undef PG8_STAMP
#undef PG8_SA
#undef PG8_SB
#undef PG8_STAGE
#undef PG8_LDA
#undef PG8_LDB
#undef PG8_MMA
#undef PG8_WAIT_V
#undef PG8_WAIT_L
#undef PG8_BAR
#undef PG8_SCHED
}
}

#define XB_TMO      128
#define XB_XCNT(j)  (256  + 64 * (j))
#define XB_XSUB(j)  (1280 + 64 * (j))
#define XB_XGEN(j)  (2304 + 64 * (j))
#define XB_TOP      3328
#define XB_TOPGEN   3392
#define XCD_BAR_WORDS 3456
#define XB_SPIN_CAP (1u << 18)
#define LAS __attribute__((address_space(3)))

__device__ __forceinline__ unsigned xb_ld(unsigned* p)              { return __hip_atomic_load(p, __ATOMIC_RELAXED, __HIP_MEMORY_SCOPE_AGENT); }
__device__ __forceinline__ unsigned xb_add(unsigned* p, unsigned v) { return __hip_atomic_fetch_add(p, v, __ATOMIC_RELAXED, __HIP_MEMORY_SCOPE_AGENT); }
__device__ __forceinline__ unsigned xb_xcc_id() { return (unsigned)__builtin_amdgcn_s_getreg((3 << 11) | 20) & 0xFu; }
#define XB_SPIN(cond, bar) do { unsigned _sp = 0; while (cond) { __builtin_amdgcn_s_sleep(1); \
    if ((++_sp & 255u) == 0u) { if (xb_ld(&(bar)[XB_TMO])) break; if (_sp > XB_SPIN_CAP) { atomicAdd(&(bar)[XB_TMO], 1u); break; } } } } while (0)

struct XcdBarrier {
    unsigned* bar; unsigned x;
    volatile LAS unsigned* st;
};

__device__ __forceinline__ XcdBarrier xcd_barrier_post(unsigned* bar, volatile LAS unsigned* st) {
    XcdBarrier b; b.bar = bar; b.x = xb_xcc_id(); b.st = st;
    if (threadIdx.x == 0) (void)xb_add(&bar[XB_XCNT(b.x)], 1u);
    return b;
}
__device__ __forceinline__ void xcd_barrier_complete(unsigned* bar, unsigned x, unsigned& nloc, unsigned& nx) {
    const unsigned G = gridDim.x * gridDim.y * gridDim.z;
    unsigned sum, cnt, mine, sp = 0u;
    for (;;) {
        sum = 0u; cnt = 0u; mine = 0u;
#pragma unroll
        for (unsigned j = 0; j < 16; ++j) { const unsigned c = xb_ld(&bar[XB_XCNT(j)]); sum += c; cnt += (c > 0u) ? 1u : 0u; mine = (j == x) ? c : mine; }
        if (sum == G) break;
        __builtin_amdgcn_s_sleep(1);
        if ((++sp & 255u) == 0u) { if (xb_ld(&bar[XB_TMO])) break; if (sp > XB_SPIN_CAP) { atomicAdd(&bar[XB_TMO], 1u); break; } }
    }
    nloc = mine > 0u ? mine : 1u; nx = cnt > 0u ? cnt : 1u;
}

__device__ __attribute__((noinline)) void xcd_barrier_impl(unsigned* bar_, unsigned x_, volatile LAS unsigned* st_) {
    XcdBarrier b; b.bar = bar_; b.x = x_; b.st = st_;
    asm volatile("s_waitcnt vmcnt(0)" ::: "memory");
    __syncthreads();
    if (threadIdx.x == 0) {
        unsigned* bar = b.bar;
        __builtin_amdgcn_s_waitcnt(0);
        unsigned nloc = b.st[0], nx = b.st[1];
        if (nloc == 0u) { xcd_barrier_complete(bar, b.x, nloc, nx); b.st[0] = nloc; b.st[1] = nx; }
        const unsigned old = xb_add(&bar[XB_XSUB(b.x)], 1u);
        const unsigned gen = old / nloc;
        if (old + 1u == (gen + 1u) * nloc) {
            __builtin_amdgcn_fence(__ATOMIC_RELEASE, "agent");
            asm volatile("s_waitcnt vmcnt(0)" ::: "memory");
            const unsigned og = xb_add(&bar[XB_TOP], 1u);
            const unsigned tg = og / nx;
            if (og + 1u == (tg + 1u) * nx) xb_add(&bar[XB_TOPGEN], 1u);
            else XB_SPIN(xb_ld(&bar[XB_TOPGEN]) == tg, bar);
            __builtin_amdgcn_fence(__ATOMIC_ACQUIRE, "agent");
            xb_add(&bar[XB_XGEN(b.x)], 1u);
            asm volatile("s_waitcnt vmcnt(0)" ::: "memory");
        } else {
            XB_SPIN(xb_ld(&bar[XB_XGEN(b.x)]) == gen, bar);
            __builtin_amdgcn_fence(__ATOMIC_ACQUIRE, "agent");
            asm volatile("s_waitcnt vmcnt(0)" ::: "memory");
        }
    }
    __syncthreads();
}

__device__ __forceinline__ void xcd_barrier(const XcdBarrier& b) { xcd_barrier_impl(b.bar, b.x, b.st); }

typedef unsigned short u16;
using pg8::bf16x8; using pg8::f32x4;
typedef unsigned u32x2 __attribute__((ext_vector_type(2)));
typedef unsigned u32x4v __attribute__((ext_vector_type(4)));

constexpr int DM = 1024, NB = 4, SEQ = 4096, CTXL = 256, RL = NB * SEQ, RC = NB * CTXL, RT = RL + RC;
constexpr int DFF = 2816, NMOD = 6;
constexpr int P0_LD = 2592;
constexpr int P0_K = 0, P0_V = 256, P0_LR = 768, P0_Q = 800, P0_R = 1056, P0_U = 1568, P0_G = 2080;
constexpr int XBC_LD = 3072;
constexpr float EPS = 1e-6f;

constexpr size_t OFF_MOD = 0;
constexpr size_t OFF_A = 262144;
constexpr size_t A_AB_IN = OFF_A, A_AB_OUT = A_AB_IN + (size_t)2816 * 1024 * 2, A_FF_IN0 = A_AB_OUT + (size_t)1024 * 1024 * 2, A_FF_OUT0 = A_FF_IN0 + (size_t)5632 * 1024 * 2;
constexpr size_t A_END = A_FF_OUT0 + (size_t)1024 * 2816 * 2;
constexpr size_t A_DTRAW = OFF_A, A_HALO = A_DTRAW + (size_t)RT * 64 * 4;
constexpr size_t A_SSD_OUT = OFF_A, A_FF_IN1 = A_SSD_OUT + (size_t)1024 * 2048 * 2, A_FF_OUT1 = A_FF_IN1 + (size_t)5632 * 1024 * 2;
constexpr size_t OFF_B = A_END;
constexpr size_t B_SSD_INA = OFF_B, B_WZ = B_SSD_INA + (size_t)3328 * 1024 * 2, B_END = B_WZ + (size_t)2048 * 1024 * 2;
constexpr size_t OFF_XC = B_END;
constexpr size_t OFF_H = OFF_XC + (size_t)RC * DM * 4;
constexpr size_t OFF_DSC = OFF_H + (size_t)RT * DM * 2;
constexpr size_t OFF_DEC = OFF_DSC + (size_t)4 * 2 * 4 * 4 * 8192 * 4;
constexpr size_t OFF_E = OFF_DEC + (size_t)4 * 2 * 4 * 68 * 64 * 4;
constexpr size_t E_P0 = OFF_E, E_ACT = OFF_E, E_XBC = OFF_E, E_Z = OFF_E;
constexpr size_t E_Y = OFF_E + (size_t)RT * XBC_LD * 2;
constexpr size_t T_DT = E_Y + (size_t)RL * 2048 * 2, T_ACUM = T_DT + (size_t)RT * 64 * 4;
constexpr size_t WS_END = T_ACUM + (size_t)RT * 64 * 4;
constexpr size_t E_PART = OFF_E + (size_t)100 * 1024 * 1024;
constexpr size_t A_CB = OFF_A;
static_assert(A_HALO + (size_t)272 * 4 * 3072 * 2 <= A_END && A_FF_OUT1 + (size_t)1024 * 2816 * 2 <= A_END && A_CB + (size_t)512 * 16384 * 2 <= A_END, "region A overflow");
static_assert(WS_END <= (size_t)256 * 1024 * 1024, "workspace over 256 MiB");

constexpr int LDS_BYTES = 144 * 1024;
constexpr int LDS_XB = LDS_BYTES - 16;
constexpr size_t OFF_BAR = 245760;

struct Params { const float* in[26]; float* out; unsigned char* ws; };
enum { I_X = 0, I_C, I_CTX, I_CCTX, I_MODW, I_MODB, I_NORMG, I_FFWIN, I_FFWOUT, I_ABWIN, I_ABGW, I_ABGB, I_ABGNG, I_ABVNG, I_ABSW, I_ABSB, I_ABWOUT,
       I_SSDWIN, I_SSDCW, I_SSDCB, I_SSDDTB, I_SSDALOG, I_SSDD, I_SSDNG, I_SSDWOUT, I_FNG };

__device__ __forceinline__ u16 f2bf(float f) { return __builtin_bit_cast(u16, (__bf16)f); }
__device__ __forceinline__ float bf2f(unsigned b) { return __uint_as_float(b << 16); }
typedef float f32x2v __attribute__((ext_vector_type(2)));
typedef __bf16 bf16x2v __attribute__((ext_vector_type(2)));
__device__ __forceinline__ unsigned pk2(float lo, float hi) { const f32x2v v = {lo, hi}; return __builtin_bit_cast(unsigned, __builtin_convertvector(v, bf16x2v)); }
__device__ __forceinline__ float bflo(unsigned w) { return __uint_as_float(w << 16); }
__device__ __forceinline__ float bfhi(unsigned w) { return __uint_as_float(w & 0xFFFF0000u); }
__device__ __forceinline__ float siluf(float x) { return x / (1.0f + __expf(-x)); }
__device__ __forceinline__ float geluf(float x) { const float y = 0.7978845608028654f * (x + 0.044715f * x * x * x); const float th = 1.0f - 2.0f / (1.0f + __expf(2.0f * y)); return 0.5f * x * (1.0f + th); }
__device__ __forceinline__ float softplusf(float x) { return fmaxf(x, 0.f) + log1pf(__expf(-fabsf(x))); }
__device__ __forceinline__ float logsigmoidf(float x) { return fminf(x, 0.f) - log1pf(__expf(-fabsf(x))); }
__device__ __forceinline__ float wave_sum(float v) {
#pragma unroll
    for (int o = 32; o > 0; o >>= 1) v += __shfl_xor(v, o, 64);
    return v;
}

template <int MT, int NT>
__device__ __forceinline__ void wave_mma(f32x4 (&acc)[MT][NT], const u16* A, int lda, const u16* B, int ldb, int ksteps) {
    const int lane = threadIdx.x & 63, fr = lane & 15, fq = lane >> 4;
    const u16* ap = A + fr * lda + fq * 8; const u16* bp = B + fr * ldb + fq * 8;
    for (int k = 0; k < ksteps; ++k) {
        bf16x8 a[MT], b[NT];
#pragma unroll
        for (int i = 0; i < MT; ++i) a[i] = *(const bf16x8*)(ap + i * 16 * lda + k * 32);
#pragma unroll
        for (int i = 0; i < NT; ++i) b[i] = *(const bf16x8*)(bp + i * 16 * ldb + k * 32);
#pragma unroll
        for (int i = 0; i < MT; ++i)
#pragma unroll
            for (int j = 0; j < NT; ++j) acc[i][j] = __builtin_amdgcn_mfma_f32_16x16x32_bf16(a[i], b[j], acc[i][j], 0, 0, 0);
    }
}
template <int MT, int NT> __device__ __forceinline__ void zero_acc(f32x4 (&acc)[MT][NT]) {
#pragma unroll
    for (int i = 0; i < MT; ++i)
#pragma unroll
        for (int j = 0; j < NT; ++j) acc[i][j] = (f32x4){0.f, 0.f, 0.f, 0.f};
}

__device__ __forceinline__ u32x4v pack8(const f32x4& a, const f32x4& b) { u32x4v r; r[0] = pk2(a[0], a[1]); r[1] = pk2(a[2], a[3]); r[2] = pk2(b[0], b[1]); r[3] = pk2(b[2], b[3]); return r; }

struct EpiBf16Plain {
    static constexpr bool PERM = true, AFTER_DRAIN = false;
    u16* O; int ld; int ncols;
    __device__ __forceinline__ void operator()(const f32x4 (&acc)[2][2][4][2], const pg8::Unit& u, int wr, int wc, int fr, int fq) const {
        const int row0 = u.pm * 256 + wr * 64 + fr, col0 = u.pn * 256 + wc * 32 + 8 * fq;
#pragma unroll
        for (int ai = 0; ai < 2; ++ai)
#pragma unroll
            for (int m = 0; m < 4; ++m) { const int row = row0 + ai * 128 + m * 16;
#pragma unroll
                for (int bj = 0; bj < 2; ++bj) { const int c = col0 + bj * 128; if (c < ncols) *(u32x4v*)(O + (size_t)row * ld + c) = pack8(acc[ai][bj][m][0], acc[ai][bj][m][1]); } }
    }
};
struct EpiSwiglu {
    static constexpr bool PERM = true, AFTER_DRAIN = false;
    u16* O;
    __device__ __forceinline__ void operator()(const f32x4 (&acc)[2][2][4][2], const pg8::Unit& u, int wr, int wc, int fr, int fq) const {
        const int row0 = u.pm * 256 + wr * 64 + fr, j0 = u.pn * 128 + wc * 32 + 8 * fq;
#pragma unroll
        for (int ai = 0; ai < 2; ++ai)
#pragma unroll
            for (int m = 0; m < 4; ++m) { const int row = row0 + ai * 128 + m * 16; f32x4 o0, o1;
#pragma unroll
                for (int i = 0; i < 4; ++i) { o0[i] = siluf(acc[ai][0][m][0][i]) * acc[ai][1][m][0][i]; o1[i] = siluf(acc[ai][0][m][1][i]) * acc[ai][1][m][1][i]; }
                *(u32x4v*)(O + (size_t)row * DFF + j0) = pack8(o0, o1); }
    }
};
struct EpiSsdIn {
    static constexpr bool PERM = true, AFTER_DRAIN = false;
    u16* XBC; u16* HALO; float* DTRAW;
    __device__ __forceinline__ void operator()(const f32x4 (&acc)[2][2][4][2], const pg8::Unit& u, int wr, int wc, int fr, int fq) const {
        const int row0 = u.pm * 256 + wr * 64 + fr, col0 = u.pn * 256 + wc * 32 + 8 * fq;
#pragma unroll
        for (int ai = 0; ai < 2; ++ai)
#pragma unroll
            for (int m = 0; m < 4; ++m) { const int row = row0 + ai * 128 + m * 16; const int rr = row & 63; const int slot = rr < 2 ? rr : (rr >= 62 ? rr - 60 : -1);
#pragma unroll
                for (int bj = 0; bj < 2; ++bj) { const int c = col0 + bj * 128;
                    if (c < 3072) { const u32x4v v = pack8(acc[ai][bj][m][0], acc[ai][bj][m][1]); *(u32x4v*)(XBC + (size_t)row * XBC_LD + c) = v;
                        if (slot >= 0) *(u32x4v*)(HALO + ((size_t)(row >> 6) * 4 + slot) * XBC_LD + c) = v; }
                    else if (c < 3136) { float* d = DTRAW + (size_t)row * 64 + (c - 3072); *(f32x4*)d = acc[ai][bj][m][0]; *(f32x4*)(d + 4) = acc[ai][bj][m][1]; } } }
    }
};
struct EpiRes {
    static constexpr bool PERM = false, AFTER_DRAIN = false;
    const float* src_lat; const float* src_ctx; float* dst_lat; float* dst_ctx; const float* gate; int cm; float* part;
    __device__ __forceinline__ void operator()(const f32x4 (&acc)[2][2][4][2], const pg8::Unit& u, int wr, int wc, int fr, int fq) const {
        const int row0 = u.pm * 256 + wr * 64 + fr, col0 = u.pn * 256 + wc * 32 + 4 * fq;
#pragma unroll
        for (int ai = 0; ai < 2; ++ai)
#pragma unroll
            for (int m = 0; m < 4; ++m) { const int row = row0 + ai * 128 + m * 16; const float* s; float* d; int mi;
                if (row < RL) { const int xr = cm ? ((row & ~4095) | ((row & 63) << 6) | ((row >> 6) & 63)) : row; s = src_lat + (size_t)xr * DM; d = dst_lat + (size_t)xr * DM; mi = row >> 12; }
                else { s = src_ctx + (size_t)(row - RL) * DM; d = dst_ctx + (size_t)(row - RL) * DM; mi = 4; }
                const float* gt = gate + mi * (NMOD * DM);
                if (part != nullptr && row >= RL) { float* pd = part + ((size_t)(u.kt0 >> 2) * RC + (row - RL)) * DM;
#pragma unroll
                    for (int bj = 0; bj < 2; ++bj)
#pragma unroll
                        for (int n = 0; n < 2; ++n) { const int c = col0 + bj * 128 + n * 16; *(f32x4*)(pd + c) = acc[ai][bj][m][n]; }
                    continue; }
#pragma unroll
                for (int bj = 0; bj < 2; ++bj)
#pragma unroll
                    for (int n = 0; n < 2; ++n) { const int c = col0 + bj * 128 + n * 16; const f32x4 g4 = *(const f32x4*)(gt + c), x4 = *(const f32x4*)(s + c);
                        *(f32x4*)(d + c) = x4 + g4 * acc[ai][bj][m][n]; } }
    }
};

template <class Epi> __device__ __forceinline__ void run_gemm(unsigned char* shm, const u16* A, const u16* Bt, int M, int N, int K, const Epi& E) {
    pg8::Gemm g; g.A = A; g.Bt = Bt; g.M = M; g.N = N; g.K = K;
    pg8::StaticOrder S; S.init(M, N, (int)gridDim.x, (int)blockIdx.x, K);
    pg8::gemm_phase<Epi, pg8::StaticOrder, false>((PG8_LAS unsigned char*)shm, g, S, E, nullptr);
}

struct SplitOrder {
    pg8::StaticOrder lat; int nlat, nsl, nctx, G, c, nN;
    __device__ void init(int N, int K, int G_, int c_) { lat.init(RL, N, G_, c_, K); nlat = lat.nwg; nN = N / 256; nsl = (K / 64) / 4; nctx = (RC / 256) * nN * nsl; G = G_; c = c_; }
    __device__ bool next(int i, pg8::Unit& u) const {
        const long L = (long)i * G + c; if (L < nlat) return lat.next(i, u);
        const int j = (int)(L - nlat); if (j >= nctx) return false;
        const int sl = j % nsl, tile = j / nsl; u.pm = RL / 256 + tile / nN; u.pn = tile % nN; u.kt0 = sl * 4; u.nkt = 4; return true; }
    __device__ __forceinline__ void a_ready(const pg8::Unit&) const {}
    __device__ __forceinline__ void done(const pg8::Unit&) const {}
};
template <class Epi> __device__ __forceinline__ void run_gemm_split(unsigned char* shm, const u16* A, const u16* Bt, int N, int K, const Epi& E) {
    pg8::Gemm g; g.A = A; g.Bt = Bt; g.M = RT; g.N = N; g.K = K;
    SplitOrder S; S.init(N, K, (int)gridDim.x, (int)blockIdx.x);
    pg8::gemm_phase<Epi, SplitOrder, false>((PG8_LAS unsigned char*)shm, g, S, E, nullptr);
}

__device__ __forceinline__ int wcol(int r, int N, int mode) {
    if (mode == 0) return r < N ? r : -1;
    if (mode == 1) { const int q = r >> 8, s = (r >> 7) & 1, i = r & 127; return s * DFF + 128 * q + i; }
    if (mode == 2) return r + 3136;
    return r < 3136 ? r : -1;
}
__device__ __forceinline__ void convert_tile(unsigned char* shm, const float* src, u16* dst, int K, int N, int mode, int ti) {
    u16* tile = (u16*)shm;
    const int t = threadIdx.x, rl = t & 63, k0 = t >> 6, r2 = t >> 3, kk = (t & 7) * 8;
    const int nkt = K >> 7, rb = (ti / nkt) << 6, kb = (ti % nkt) << 7;
    const int col = wcol(rb + rl, N, mode);
    const float* sp = src + (size_t)(kb + k0) * N + (col >= 0 ? col : 0);
    float v[16];
#pragma unroll
    for (int i = 0; i < 16; ++i) v[i] = sp[(size_t)(8 * i) * N];
#pragma unroll
    for (int i = 0; i < 16; ++i) tile[rl * 136 + k0 + 8 * i] = f2bf(col >= 0 ? v[i] : 0.f);
    __syncthreads();
    *(u32x4v*)(dst + (size_t)(rb + r2) * K + kb + kk) = *(const u32x4v*)(tile + r2 * 136 + kk);
    *(u32x4v*)(dst + (size_t)(rb + r2) * K + kb + 64 + kk) = *(const u32x4v*)(tile + r2 * 136 + 64 + kk);
    __syncthreads();
}
constexpr int wtiles(int NR, int K) { return (NR / 64) * (K / 128); }
__device__ void convert_weights_early(unsigned char* shm, const Params& p) {
    unsigned char* ws = p.ws;
    constexpr int T0 = wtiles(5632, 1024), T1 = wtiles(1024, 2816), T2 = wtiles(3328, 1024), T3 = wtiles(2816, 1024), T4 = wtiles(2048, 1024), T5 = wtiles(1024, 1024);
    for (int gi = blockIdx.x; gi < T0 + T1 + T2 + T3 + T4 + T5; gi += gridDim.x) {
        int ti = gi;
        if (ti < T0) { convert_tile(shm, p.in[I_FFWIN], (u16*)(ws + A_FF_IN0), 1024, 5632, 1, ti); continue; } ti -= T0;
        if (ti < T1) { convert_tile(shm, p.in[I_FFWOUT], (u16*)(ws + A_FF_OUT0), 2816, 1024, 0, ti); continue; } ti -= T1;
        if (ti < T2) { convert_tile(shm, p.in[I_SSDWIN], (u16*)(ws + B_SSD_INA), 1024, 5184, 3, ti); continue; } ti -= T2;
        if (ti < T3) { convert_tile(shm, p.in[I_ABWIN], (u16*)(ws + A_AB_IN), 1024, 2592, 0, ti); continue; } ti -= T3;
        if (ti < T4) { convert_tile(shm, p.in[I_SSDWIN], (u16*)(ws + B_WZ), 1024, 5184, 2, ti); continue; } ti -= T4;
        convert_tile(shm, p.in[I_ABWOUT], (u16*)(ws + A_AB_OUT), 1024, 1024, 0, ti);
    }
}
__device__ void convert_weights_late(unsigned char* shm, const Params& p) {
    unsigned char* ws = p.ws;
    constexpr int T0 = wtiles(5632, 1024), T1 = wtiles(1024, 2816), T2 = wtiles(1024, 2048);
    for (int gi = blockIdx.x; gi < T0 + T1 + T2; gi += gridDim.x) {
        int ti = gi;
        if (ti < T0) { convert_tile(shm, p.in[I_FFWIN] + (size_t)1024 * 5632, (u16*)(ws + A_FF_IN1), 1024, 5632, 1, ti); continue; } ti -= T0;
        if (ti < T1) { convert_tile(shm, p.in[I_FFWOUT] + (size_t)2816 * 1024, (u16*)(ws + A_FF_OUT1), 2816, 1024, 0, ti); continue; } ti -= T1;
        convert_tile(shm, p.in[I_SSDWOUT], (u16*)(ws + A_SSD_OUT), 2048, 1024, 0, ti);
    }
}
__device__ void mod_gemv(unsigned char* shm, const Params& p) {
    float* sc = (float*)shm;
    float* red = sc + 5 * 1024;
    const int t = threadIdx.x;
    for (int i = t; i < 5 * 1024; i += 512) { const float v = i < 4096 ? p.in[I_C][i] : p.in[I_CCTX][i - 4096]; sc[i] = siluf(v); }
    __syncthreads();
    float* MOD = (float*)(p.ws + OFF_MOD);
    const int n = t & 31, kc = t >> 5;
    for (int job = blockIdx.x; job < 2 * 192; job += gridDim.x) {
        const int l = job / 192, nb = (job % 192) * 32;
        const float* W = p.in[I_MODW] + (size_t)l * DM * (NMOD * DM) + nb + n;
        float a[5] = {0.f, 0.f, 0.f, 0.f, 0.f};
#pragma unroll 16
        for (int i = 0; i < 64; ++i) { const int k = kc + 16 * i; const float w = W[(size_t)k * (NMOD * DM)];
#pragma unroll
            for (int m = 0; m < 5; ++m) a[m] += sc[m * 1024 + k] * w; }
#pragma unroll
        for (int m = 0; m < 5; ++m) red[(kc * 5 + m) * 32 + n] = a[m];
        __syncthreads();
        if (t < 160) { const int m = t >> 5; float s = 0.f;
#pragma unroll
            for (int q = 0; q < 16; ++q) s += red[(q * 5 + m) * 32 + n];
            MOD[((size_t)l * 5 + m) * (NMOD * DM) + nb + n] = s + p.in[I_MODB][(size_t)l * (NMOD * DM) + nb + n]; }
        __syncthreads();
    }
}

__device__ void norm_mod_phase(const float* lat, const float* ctx, const float* ng, const float* modl  , int ishift, int iscale, int nrows, int cm, u16* H, const float* part = nullptr, int nsl = 0, const float* pgate = nullptr, float* xc_out = nullptr) {
    const int lane = threadIdx.x & 63, wid = threadIdx.x >> 6;
    for (int row = blockIdx.x * 8 + wid; row < nrows; row += gridDim.x * 8) {
        const float* s = row < RL ? lat + (size_t)row * DM : ctx + (size_t)(row - RL) * DM;
        const int mi = row < RL ? (row >> 12) : 4;
        f32x4 v[4], pg[4], psh[4], psc[4]; float ss = 0.f;
        const float* sh = modl + mi * (NMOD * DM) + ishift * DM; const float* scp = modl + mi * (NMOD * DM) + iscale * DM;
#pragma unroll
        for (int i = 0; i < 4; ++i) v[i] = *(const f32x4*)(s + i * 256 + lane * 4);
#pragma unroll
        for (int i = 0; i < 4; ++i) { const int c = i * 256 + lane * 4; pg[i] = *(const f32x4*)(ng + c); psh[i] = *(const f32x4*)(sh + c); psc[i] = *(const f32x4*)(scp + c); }
#pragma unroll
        for (int i = 0; i < 4; ++i) ss += v[i][0] * v[i][0] + v[i][1] * v[i][1] + v[i][2] * v[i][2] + v[i][3] * v[i][3];
        if (part != nullptr && row >= RL) {
            ss = 0.f;
#pragma unroll
            for (int i = 0; i < 4; ++i) { const int c = i * 256 + lane * 4; f32x4 a = {0.f, 0.f, 0.f, 0.f};
                for (int sl = 0; sl < nsl; ++sl) a += *(const f32x4*)(part + ((size_t)sl * RC + (row - RL)) * DM + c);
                v[i] += *(const f32x4*)(pgate + c) * a; *(f32x4*)(xc_out + (size_t)(row - RL) * DM + c) = v[i];
                ss += v[i][0] * v[i][0] + v[i][1] * v[i][1] + v[i][2] * v[i][2] + v[i][3] * v[i][3]; } }
        ss = wave_sum(ss);
        const float rs = rsqrtf(ss * (1.0f / DM) + EPS);
        const int dr = (cm && row < RL) ? ((row & ~4095) | ((row & 63) << 6) | ((row >> 6) & 63)) : row;
#pragma unroll
        for (int i = 0; i < 4; ++i) { const int c = i * 256 + lane * 4; const f32x4 g4 = pg[i], sh4 = psh[i], sc4 = psc[i];
            float o[4];
#pragma unroll
            for (int e = 0; e < 4; ++e) o[e] = (v[i][e] * rs * g4[e]) * (1.0f + sc4[e]) + sh4[e];
            u32x2 w; w[0] = pk2(o[0], o[1]); w[1] = pk2(o[2], o[3]); *(u32x2*)(H + (size_t)dr * DM + c) = w; }
    }
}
__device__ void final_norm_phase(float* X, const float* g) {
    const int lane = threadIdx.x & 63, wid = threadIdx.x >> 6;
    for (int row = blockIdx.x * 8 + wid; row < RL; row += gridDim.x * 8) {
        float* s = X + (size_t)row * DM; f32x4 v[4]; float ss = 0.f;
#pragma unroll
        for (int i = 0; i < 4; ++i) { v[i] = *(const f32x4*)(s + i * 256 + lane * 4); ss += v[i][0] * v[i][0] + v[i][1] * v[i][1] + v[i][2] * v[i][2] + v[i][3] * v[i][3]; }
        ss = wave_sum(ss);
        const float rs = rsqrtf(ss * (1.0f / DM) + EPS);
#pragma unroll
        for (int i = 0; i < 4; ++i) { const int c = i * 256 + lane * 4; const f32x4 g4 = *(const f32x4*)(g + c); f32x4 o;
#pragma unroll
            for (int e = 0; e < 4; ++e) o[e] = (v[i][e] * rs) * g4[e];
            *(f32x4*)(s + c) = o; }
    }
}

__device__ __forceinline__ int gla_rowbase(int b, int c) { return c < 4 ? RL + b * CTXL + c * 64 : b * SEQ + (c - 4) * 64; }
__device__ __forceinline__ float* gla_ds_ptr(const Params& p, int b, int d, int h, int c) {
    return c < 4 ? (float*)(p.ws + OFF_DSC) + ((size_t)((b * 2 + d) * 4 + h) * 4 + c) * 8192 : p.out + ((size_t)((b * 2 + d) * 4 + h) * 64 + (c - 4)) * 8192;
}
constexpr int GL_BC = 0;
constexpr int GL_LR = GL_BC + 2 * 64 * 65 * 4;
constexpr int GL_GW = GL_LR + 64 * 32 * 4;
constexpr int GL_X0 = GL_GW + 2 * 16 * 64 * 4;
constexpr int GL_LD = 72;

__device__ void gla_gates(unsigned char* shm, const Params& p, int rowbase, int h) {
    const u16* P0 = (const u16*)(p.ws + E_P0);
    float* BC = (float*)(shm + GL_BC); float* LR = (float*)(shm + GL_LR); float* QS = (float*)(shm + GL_GW);
    const int t = threadIdx.x;
    const int kk = t & 63, lq = (t >> 6) & 3, d = t >> 8;
    float gw[16];
#pragma unroll
    for (int j = 0; j < 16; ++j) gw[j] = p.in[I_ABGW][(size_t)(d * 16 + j) * 256 + h * 64 + kk];
    const float gb = p.in[I_ABGB][d * 256 + h * 64 + kk];
    if (t < 256) { const int row = t >> 2, part = t & 3; const u32x4v w = *(const u32x4v*)(P0 + (size_t)(rowbase + row) * P0_LD + P0_LR + part * 8);
        f32x4 lo, hi; lo[0] = bflo(w[0]); lo[1] = bfhi(w[0]); lo[2] = bflo(w[1]); lo[3] = bfhi(w[1]); hi[0] = bflo(w[2]); hi[1] = bfhi(w[2]); hi[2] = bflo(w[3]); hi[3] = bfhi(w[3]);
        *(f32x4*)(LR + row * 32 + part * 8) = lo; *(f32x4*)(LR + row * 32 + part * 8 + 4) = hi; }
    __syncthreads();
    float la[16];
#pragma unroll
    for (int i = 0; i < 16; ++i) { const int l = lq * 16 + i; const float* lr = LR + l * 32 + d * 16; float pre = gb;
#pragma unroll
        for (int j4 = 0; j4 < 4; ++j4) { const f32x4 v = *(const f32x4*)(lr + j4 * 4); pre += v[0] * gw[j4 * 4] + v[1] * gw[j4 * 4 + 1] + v[2] * gw[j4 * 4 + 2] + v[3] * gw[j4 * 4 + 3]; }
        la[i] = logsigmoidf(pre) * (1.0f / 16.0f); }
    if (d == 0) {
#pragma unroll
        for (int i = 1; i < 16; ++i) la[i] += la[i - 1];
        QS[(d * 4 + lq) * 64 + kk] = la[15];
    } else {
#pragma unroll
        for (int i = 14; i >= 0; --i) la[i] += la[i + 1];
        QS[(d * 4 + lq) * 64 + kk] = la[0];
    }
    __syncthreads();
    float off = 0.f;
    if (d == 0) { for (int q = 0; q < lq; ++q) off += QS[(0 * 4 + q) * 64 + kk]; }
    else { for (int q = 3; q > lq; --q) off += QS[(1 * 4 + q) * 64 + kk]; }
#pragma unroll
    for (int i = 0; i < 16; ++i) BC[(d * 64 + lq * 16 + i) * 65 + kk] = la[i] + off;
    __syncthreads();
}
__device__ __forceinline__ void gla_stage_vT(u16* vT, const u16* P0, int rowbase, int h) {
    const int t = threadIdx.x, l = t & 63, vg = t >> 6;
    const u16* src = P0 + (size_t)(rowbase + l) * P0_LD + P0_V + h * 128 + vg * 16;
    const u32x4v w0 = *(const u32x4v*)src, w1 = *(const u32x4v*)(src + 8);
#pragma unroll
    for (int e = 0; e < 4; ++e) { vT[(vg * 16 + 2 * e) * GL_LD + l] = (u16)(w0[e] & 0xFFFF); vT[(vg * 16 + 2 * e + 1) * GL_LD + l] = (u16)(w0[e] >> 16);
        vT[(vg * 16 + 8 + 2 * e) * GL_LD + l] = (u16)(w1[e] & 0xFFFF); vT[(vg * 16 + 8 + 2 * e + 1) * GL_LD + l] = (u16)(w1[e] >> 16); }
}

__device__ void gla_a_item(unsigned char* shm, const Params& p, int b, int c, int h) {
    const u16* P0 = (const u16*)(p.ws + E_P0);
    const int rowbase = gla_rowbase(b, c), t = threadIdx.x, lane = t & 63, w = t >> 6;
    gla_gates(shm, p, rowbase, h);
    const float* BC = (const float*)(shm + GL_BC);
    u16* kwT = (u16*)(shm + GL_X0);
    u16* vT = kwT + 2 * 64 * GL_LD;
    { const int l = t & 63, kg = t >> 6; const u32x4v kw = *(const u32x4v*)(P0 + (size_t)(rowbase + l) * P0_LD + P0_K + h * 64 + kg * 8);
#pragma unroll
      for (int e = 0; e < 8; ++e) { const int k = kg * 8 + e; const float kv = (e & 1) ? bfhi(kw[e >> 1]) : bflo(kw[e >> 1]);
          const float w0 = __expf(BC[63 * 65 + k] - BC[l * 65 + k]), w1 = __expf(BC[(64 + 0) * 65 + k] - BC[(64 + l) * 65 + k]);
          kwT[k * GL_LD + l] = f2bf(kv * w0); kwT[(64 + k) * GL_LD + l] = f2bf(kv * w1); } }
    gla_stage_vT(vT, P0, rowbase, h);
    __syncthreads();
    { const int d = w >> 2, kb = w & 3; f32x4 acc[1][8]; zero_acc(acc);
      wave_mma<1, 8>(acc, kwT + (d * 64 + kb * 16) * GL_LD, GL_LD, vT, GL_LD, 2);
      float* DS = gla_ds_ptr(p, b, d, h, c);
#pragma unroll
      for (int nt = 0; nt < 8; ++nt) { const int v = nt * 16 + (lane & 15), k0 = kb * 16 + (lane >> 4) * 4; *(f32x4*)(DS + v * 64 + k0) = acc[0][nt]; } }
    if (t < 128) { const int d = t >> 6, kk = t & 63; const float bl = d == 0 ? BC[63 * 65 + kk] : BC[64 * 65 + kk];
        ((float*)(p.ws + OFF_DEC))[((size_t)((b * 2 + d) * 4 + h) * 68 + c) * 64 + kk] = __expf(bl); }
    __syncthreads();
}

__device__ void gmlp_item(unsigned char* shm, const Params& p, int b, int cc, int gi) {
    const u16* P0 = (const u16*)(p.ws + E_P0); u16* MG = (u16*)(p.ws + OFF_H);
    const int rowbase = cc < 2 ? RL + b * CTXL + cc * 128 : b * SEQ + (cc - 2) * 128;
    const int t = threadIdx.x, lane = t & 63, w = t >> 6;
    float* st = (float*)shm;
    u16* vnT = (u16*)(shm + 1024);
    u16* Ws = vnT + 128 * 136;
    { const int row = t >> 2, part = t & 3; const u16* src = P0 + (size_t)(rowbase + row) * P0_LD + P0_G + part * 128; float s = 0.f, ss = 0.f;
#pragma unroll 4
      for (int i = 0; i < 16; ++i) { const u32x4v wv = *(const u32x4v*)(src + i * 8);
#pragma unroll
          for (int e = 0; e < 4; ++e) { const float a = geluf(bflo(wv[e])), c2 = geluf(bfhi(wv[e])); s += a + c2; ss += a * a + c2 * c2; } }
      s += __shfl_xor(s, 1, 64); ss += __shfl_xor(ss, 1, 64); s += __shfl_xor(s, 2, 64); ss += __shfl_xor(ss, 2, 64);
      if (part == 0) { const float mu = s * (1.0f / 512.0f); const float var = fmaxf(ss * (1.0f / 512.0f) - mu * mu, 0.f); st[row * 2] = mu; st[row * 2 + 1] = rsqrtf(var + EPS); } }
    { const float* SW = p.in[I_ABSW] + (size_t)gi * 128 * 128;
#pragma unroll
      for (int ps = 0; ps < 8; ++ps) { const int idx = ps * 2048 + t * 4, tt = idx >> 7, s0 = idx & 127; const f32x4 v = *(const f32x4*)(SW + idx);
          u32x2 o; o[0] = pk2(v[0], v[1]); o[1] = pk2(v[2], v[3]); *(u32x2*)(Ws + tt * 136 + s0) = o; } }
    __syncthreads();
    { const int s = t & 127, cg4 = t >> 7; const u16* src = P0 + (size_t)(rowbase + s) * P0_LD + P0_G + gi * 128 + cg4 * 32; const float mu = st[s * 2], rstd = st[s * 2 + 1];
      const float* vg = p.in[I_ABVNG] + gi * 128 + cg4 * 32;
#pragma unroll
      for (int i = 0; i < 4; ++i) { const u32x4v wv = *(const u32x4v*)(src + i * 8);
#pragma unroll
          for (int e = 0; e < 8; ++e) { const float x = (e & 1) ? bfhi(wv[e >> 1]) : bflo(wv[e >> 1]); const int cl = i * 8 + e;
              vnT[(cg4 * 32 + cl) * 136 + s] = f2bf((geluf(x) - mu) * rstd * vg[cl]); } } }
    __syncthreads();
    { f32x4 acc[1][8]; zero_acc(acc);
      wave_mma<1, 8>(acc, vnT + (w * 16) * 136, 136, Ws, 136, 4);
      const int c0 = w * 16 + (lane >> 4) * 4;
#pragma unroll
      for (int nt = 0; nt < 8; ++nt) { const int tt = nt * 16 + (lane & 15); const float sb = p.in[I_ABSB][gi * 128 + tt];
          const u32x2 uw = *(const u32x2*)(P0 + (size_t)(rowbase + tt) * P0_LD + P0_U + gi * 128 + c0);
          const float o0 = geluf(bflo(uw[0])) * (acc[0][nt][0] + sb), o1 = geluf(bfhi(uw[0])) * (acc[0][nt][1] + sb), o2 = geluf(bflo(uw[1])) * (acc[0][nt][2] + sb), o3 = geluf(bfhi(uw[1])) * (acc[0][nt][3] + sb);
          u32x2 o; o[0] = pk2(o0, o1); o[1] = pk2(o2, o3); *(u32x2*)(MG + (size_t)(rowbase + tt) * DM + 512 + gi * 128 + c0) = o; } }
    __syncthreads();
}

__device__ void gla_scan_phase(const Params& p) {
    const float* DEC = (const float*)(p.ws + OFF_DEC);
    for (int g0 = blockIdx.x * 512 + threadIdx.x; g0 < 4 * 2 * 4 * 8192 / 2; g0 += gridDim.x * 512) {
        int e[2], bb[2], dd[2], hh[2]; const float* dec[2]; float s[2] = {0.f, 0.f};
#pragma unroll
        for (int q = 0; q < 2; ++q) { const int gidx = g0 + q * (4 * 2 * 4 * 8192 / 2); e[q] = gidx & 8191; const int bdh = gidx >> 13; hh[q] = bdh & 3; dd[q] = (bdh >> 2) & 1; bb[q] = bdh >> 3; dec[q] = DEC + (size_t)bdh * 68 * 64 + (e[q] & 63); }
        for (int i0 = 0; i0 < 68; i0 += 17) {
            float* ptr[2][17]; float ds[2][17], dc[2][17];
#pragma unroll
            for (int u = 0; u < 17; ++u)
#pragma unroll
                for (int q = 0; q < 2; ++q) { const int i = i0 + u; const int c = dd[q] == 0 ? i : (i < 4 ? 3 - i : 71 - i); ptr[q][u] = gla_ds_ptr(p, bb[q], dd[q], hh[q], c) + e[q]; ds[q][u] = *ptr[q][u]; dc[q][u] = dec[q][c * 64]; }
#pragma unroll
            for (int u = 0; u < 17; ++u)
#pragma unroll
                for (int q = 0; q < 2; ++q) { *ptr[q][u] = s[q]; s[q] = dc[q][u] * s[q] + ds[q][u]; }
        }
    }
}

__device__ void gla_c_item(unsigned char* shm, const Params& p, int b, int c, int h) {
    const u16* P0 = (const u16*)(p.ws + E_P0); u16* MG = (u16*)(p.ws + OFF_H);
    const int rowbase = gla_rowbase(b, c), t = threadIdx.x, lane = t & 63, w = t >> 6;
    gla_gates(shm, p, rowbase, h);
    const float* BC = (const float*)(shm + GL_BC);
    u16* qd = (u16*)(shm + GL_X0);
    u16* kd = qd + 2 * 64 * GL_LD;
    u16* vT = kd + 2 * 64 * GL_LD;
    u16* SpT = vT + 128 * GL_LD;
    u16* SC = (u16*)(shm + GL_BC);
    float* O = (float*)SpT;
    { const int l = t & 63, kg = t >> 6; const u16* rp = P0 + (size_t)(rowbase + l) * P0_LD + h * 64 + kg * 8;
      const u32x4v qw = *(const u32x4v*)(rp + P0_Q), kw = *(const u32x4v*)(rp + P0_K);
#pragma unroll
      for (int d = 0; d < 2; ++d) { u32x4v qo, ko;
#pragma unroll
          for (int e2 = 0; e2 < 4; ++e2) { const float e0 = BC[(d * 64 + l) * 65 + kg * 8 + 2 * e2], e1 = BC[(d * 64 + l) * 65 + kg * 8 + 2 * e2 + 1];
              qo[e2] = pk2(bflo(qw[e2]) * 0.125f * __expf(e0), bfhi(qw[e2]) * 0.125f * __expf(e1));
              ko[e2] = pk2(bflo(kw[e2]) * __expf(-e0), bfhi(kw[e2]) * __expf(-e1)); }
          *(u32x4v*)(qd + (d * 64 + l) * GL_LD + kg * 8) = qo; *(u32x4v*)(kd + (d * 64 + l) * GL_LD + kg * 8) = ko; } }
    gla_stage_vT(vT, P0, rowbase, h);
#pragma unroll
    for (int ps = 0; ps < 4; ++ps) { const int idx = ps * 4096 + t * 8, d = idx >> 13, rem = idx & 8191, v = rem >> 6, k0 = rem & 63;
        const float* src = gla_ds_ptr(p, b, d, h, c) + rem; const f32x4 a = *(const f32x4*)src, bq = *(const f32x4*)(src + 4);
        *(u32x4v*)(SpT + (d * 128 + v) * GL_LD + k0) = pack8(a, bq); }
    __syncthreads();
    { const int d = w >> 2, lb = w & 3; f32x4 acc[1][4]; zero_acc(acc);
      wave_mma<1, 4>(acc, qd + (d * 64 + lb * 16) * GL_LD, GL_LD, kd + d * 64 * GL_LD, GL_LD, 2);
      __syncthreads();
#pragma unroll
      for (int nt = 0; nt < 4; ++nt)
#pragma unroll
          for (int j = 0; j < 4; ++j) { const int l = lb * 16 + (lane >> 4) * 4 + j, s = nt * 16 + (lane & 15); const bool keep = d == 0 ? (s <= l) : (s >= l);
              SC[(d * 64 + l) * GL_LD + s] = f2bf(keep ? acc[0][nt][j] : 0.f); } }
    __syncthreads();
    f32x4 oacc[1][4]; zero_acc(oacc);
    const int lb = w & 3, vh = w >> 2;
#pragma unroll
    for (int d = 0; d < 2; ++d) {
        wave_mma<1, 4>(oacc, qd + (d * 64 + lb * 16) * GL_LD, GL_LD, SpT + (d * 128 + vh * 64) * GL_LD, GL_LD, 2);
        wave_mma<1, 4>(oacc, SC + (d * 64 + lb * 16) * GL_LD, GL_LD, vT + (vh * 64) * GL_LD, GL_LD, 2);
    }
    __syncthreads();
#pragma unroll
    for (int nt = 0; nt < 4; ++nt)
#pragma unroll
        for (int j = 0; j < 4; ++j) { const int l = lb * 16 + (lane >> 4) * 4 + j, v = vh * 64 + nt * 16 + (lane & 15); O[l * 132 + v] = oacc[0][nt][j]; }
    __syncthreads();
    { const int l = t >> 3, part = t & 7; float o[16]; float ss = 0.f;
#pragma unroll
      for (int i = 0; i < 4; ++i) { const f32x4 v4 = *(const f32x4*)(O + l * 132 + part * 16 + i * 4);
#pragma unroll
          for (int e = 0; e < 4; ++e) { o[i * 4 + e] = v4[e]; ss += v4[e] * v4[e]; } }
      ss += __shfl_xor(ss, 1, 64); ss += __shfl_xor(ss, 2, 64); ss += __shfl_xor(ss, 4, 64);
      const float rs = rsqrtf(ss * (1.0f / 128.0f) + EPS);
      const u16* rp = P0 + (size_t)(rowbase + l) * P0_LD + P0_R + h * 128 + part * 16; const float* gg = p.in[I_ABGNG] + h * 128 + part * 16;
      const u32x4v r0 = *(const u32x4v*)rp, r1 = *(const u32x4v*)(rp + 8); u32x4v o0, o1;
#pragma unroll
      for (int e2 = 0; e2 < 4; ++e2) {
          o0[e2] = pk2(o[2 * e2] * rs * gg[2 * e2] * siluf(bflo(r0[e2])), o[2 * e2 + 1] * rs * gg[2 * e2 + 1] * siluf(bfhi(r0[e2])));
          o1[e2] = pk2(o[8 + 2 * e2] * rs * gg[8 + 2 * e2] * siluf(bflo(r1[e2])), o[8 + 2 * e2 + 1] * rs * gg[8 + 2 * e2 + 1] * siluf(bfhi(r1[e2]))); }
      u16* dst = MG + (size_t)(rowbase + l) * DM + h * 128 + part * 16; *(u32x4v*)dst = o0; *(u32x4v*)(dst + 8) = o1; }
    __syncthreads();
}

__device__ void conv_phase(const Params& p) {
    u16* XBC = (u16*)(p.ws + E_XBC); const u16* HALO = (const u16*)(p.ws + A_HALO);
    const int t = threadIdx.x, cg = t & 127, q = __builtin_amdgcn_readfirstlane(t >> 7);
    for (int it = blockIdx.x; it < (RT / 64) * 3; it += gridDim.x) {
        const int rb = it / 3, cp = (it % 3) * 1024, c0 = cp + cg * 8;
        const bool first = rb < 256 ? ((rb & 63) == 0) : (((rb - 256) & 3) == 0);
        const bool last = rb < 256 ? ((rb & 63) == 63) : (((rb - 256) & 3) == 3);
        const bool z0 = (q == 0) && first, z1 = (q == 3) && last;
        u16* rowq = XBC + ((size_t)rb * 64 + 16 * q) * XBC_LD + cp;
        const u16* pre = (q == 0) ? (z0 ? rowq : HALO + ((size_t)(rb - 1) * 4 + 2) * XBC_LD + cp) : rowq - 2 * XBC_LD;
        const u16* post = (q == 3) ? (z1 ? rowq : HALO + ((size_t)(rb + 1) * 4) * XBC_LD + cp) : rowq + 16 * XBC_LD;
        u32x4v win[20];
        win[0] = *(const u32x4v*)(pre + cg * 8); win[1] = *(const u32x4v*)(pre + XBC_LD + cg * 8);
#pragma unroll
        for (int i = 0; i < 16; ++i) win[2 + i] = *(const u32x4v*)(rowq + (size_t)i * XBC_LD + cg * 8);
        win[18] = *(const u32x4v*)(post + cg * 8); win[19] = *(const u32x4v*)(post + XBC_LD + cg * 8);
        const u32x4v zero = {0u, 0u, 0u, 0u};
        if (z0) { win[0] = zero; win[1] = zero; }
        if (z1) { win[18] = zero; win[19] = zero; }
        float wt[5][8], bias[8];
#pragma unroll
        for (int j = 0; j < 5; ++j) { const f32x4 a = *(const f32x4*)(p.in[I_SSDCW] + j * 3072 + c0), b2 = *(const f32x4*)(p.in[I_SSDCW] + j * 3072 + c0 + 4);
#pragma unroll
            for (int e = 0; e < 4; ++e) { wt[j][e] = a[e]; wt[j][4 + e] = b2[e]; } }
        { const f32x4 a = *(const f32x4*)(p.in[I_SSDCB] + c0), b2 = *(const f32x4*)(p.in[I_SSDCB] + c0 + 4);
#pragma unroll
          for (int e = 0; e < 4; ++e) { bias[e] = a[e]; bias[4 + e] = b2[e]; } }
        __syncthreads();
#pragma unroll
        for (int r = 0; r < 16; ++r) {
            float o[8];
#pragma unroll
            for (int e = 0; e < 8; ++e) o[e] = bias[e];
#pragma unroll
            for (int j = 0; j < 5; ++j)
#pragma unroll
                for (int e2 = 0; e2 < 4; ++e2) { o[2 * e2] += wt[j][2 * e2] * bflo(win[r + j][e2]); o[2 * e2 + 1] += wt[j][2 * e2 + 1] * bfhi(win[r + j][e2]); }
            u32x4v ov;
#pragma unroll
            for (int e2 = 0; e2 < 4; ++e2) ov[e2] = pk2(siluf(o[2 * e2]), siluf(o[2 * e2 + 1]));
            *(u32x4v*)(rowq + (size_t)r * XBC_LD + cg * 8) = ov;
        }
    }
}
__device__ void dt_phase(unsigned char* shm, const Params& p) {
    const float* DTRAW = (const float*)(p.ws + A_DTRAW); float* DT = (float*)(p.ws + T_DT); float* ACUM = (float*)(p.ws + T_ACUM);
    float* tile = (float*)shm;
    float* tdt = tile + 128 * 65;
    const int t = threadIdx.x, col = t & 63;
    const float bias = p.in[I_SSDDTB][col], a = -__expf(p.in[I_SSDALOG][col]);
    for (int ch = blockIdx.x; ch < RT / 128; ch += gridDim.x) {
        const size_t r0 = (size_t)ch * 128;
#pragma unroll
        for (int i = 0; i < 16; ++i) { const int m = i * 8 + (t >> 6); const float d = softplusf(DTRAW[(r0 + m) * 64 + col] + bias); tdt[m * 65 + col] = d; tile[m * 65 + col] = d * a; }
        __syncthreads();
        if (t < 64) { float run = 0.f;
            if (t < 32) { for (int m = 0; m < 128; ++m) { run += tile[m * 65 + t]; tile[m * 65 + t] = run; } }
            else { for (int m = 127; m >= 0; --m) { run += tile[m * 65 + t]; tile[m * 65 + t] = run; } } }
        __syncthreads();
        { const int m = t & 127, cq = t >> 7;
#pragma unroll
          for (int i = 0; i < 16; ++i) { const int c = cq * 16 + i; ACUM[(size_t)c * RT + r0 + m] = tile[m * 65 + c]; DT[(size_t)c * RT + r0 + m] = tdt[m * 65 + c]; } }
        __syncthreads();
    }
}
constexpr int SP_LD = 136;
constexpr int SP_C = 0;
constexpr int SP_B = SP_C + 128 * SP_LD * 2;
constexpr int SP_CB = SP_B + 128 * SP_LD * 2;
constexpr int SP_AC = SP_CB + 128 * SP_LD * 2;
constexpr int SP_DT = SP_AC + 16 * 128 * 4;
constexpr int SP_END = SP_DT + 16 * 128 * 4;
static_assert(SP_END <= LDS_XB, "SSD par LDS");
__device__ void ssd_par_item(unsigned char* shm, const Params& p, int item) {
    const u16* XBC = (const u16*)(p.ws + E_XBC); u16* Y = (u16*)(p.ws + E_Y);
    const float* DT = (const float*)(p.ws + T_DT); const float* ACUM = (const float*)(p.ws + T_ACUM);
    const int g = item & 3, base = (item >> 2) * 128;
    u16* Cs = (u16*)(shm + SP_C); u16* Ms = Cs; u16* Bs = (u16*)(shm + SP_B); u16* xT = Bs; u16* CBs = (u16*)(shm + SP_CB);
    float* acs = (float*)(shm + SP_AC); float* dts = (float*)(shm + SP_DT);
    const int t = threadIdx.x, lane = t & 63, w = t >> 6, fr = lane & 15, fq = lane >> 4;
#pragma unroll
    for (int i = 0; i < 4; ++i) { const int idx = i * 512 + t, m = idx >> 4, seg = idx & 15; const u16* rp = XBC + (size_t)(base + m) * XBC_LD + g * 128 + seg * 8;
        *(u32x4v*)(Cs + m * SP_LD + seg * 8) = *(const u32x4v*)(rp + 2560); *(u32x4v*)(Bs + m * SP_LD + seg * 8) = *(const u32x4v*)(rp + 2048); }
#pragma unroll
    for (int i = 0; i < 4; ++i) { const int idx = i * 512 + t, q = idx >> 7, m = idx & 127, hh = q >> 1, dir = q & 1; const size_t o = (size_t)(dir * 32 + g * 8 + hh) * RT + base + m;
        acs[idx] = ACUM[o]; dts[idx] = DT[o]; }
    __syncthreads();
    { f32x4 acc[1][8]; zero_acc(acc);
      wave_mma<1, 8>(acc, Bs + (w * 16) * SP_LD, SP_LD, Cs, SP_LD, 4);
#pragma unroll
      for (int nt = 0; nt < 8; ++nt) { u32x2 o; o[0] = pk2(acc[0][nt][0], acc[0][nt][1]); o[1] = pk2(acc[0][nt][2], acc[0][nt][3]); *(u32x2*)(CBs + (nt * 16 + fr) * SP_LD + w * 16 + fq * 4) = o; } }
    __syncthreads();
    const int seg = t & 15, mq = t >> 4, xs_ = t & 127, pseg = t >> 7, mrow0 = w * 16;
    for (int hh = 0; hh < 8; ++hh) {
        const int h = g * 8 + hh;
        f32x4 yT[4][1]; zero_acc(yT);
        for (int dir = 0; dir < 2; ++dir) {
            const float* ac = acs + (hh * 2 + dir) * 128; const float* dtv = dts + (hh * 2 + dir) * 128;
            { const u16* xp = XBC + (size_t)(base + xs_) * XBC_LD + h * 64 + pseg * 16; const u32x4v x0 = *(const u32x4v*)xp, x1 = *(const u32x4v*)(xp + 8); const float d = dtv[xs_];
#pragma unroll
              for (int e2 = 0; e2 < 4; ++e2) { xT[(pseg * 16 + 2 * e2) * SP_LD + xs_] = f2bf(bflo(x0[e2]) * d); xT[(pseg * 16 + 2 * e2 + 1) * SP_LD + xs_] = f2bf(bfhi(x0[e2]) * d);
                  xT[(pseg * 16 + 8 + 2 * e2) * SP_LD + xs_] = f2bf(bflo(x1[e2]) * d); xT[(pseg * 16 + 8 + 2 * e2 + 1) * SP_LD + xs_] = f2bf(bfhi(x1[e2]) * d); } }
            { const f32x4 as0 = *(const f32x4*)(ac + seg * 8), as1 = *(const f32x4*)(ac + seg * 8 + 4);
#pragma unroll
              for (int i = 0; i < 4; ++i) { const int m = mq + 32 * i; u32x4v mv = {0u, 0u, 0u, 0u};
                  const bool any = dir == 0 ? (seg * 8 <= m) : (seg * 8 + 7 >= m);
                  if (any) { const u32x4v cw = *(const u32x4v*)(CBs + m * SP_LD + seg * 8); const float am = ac[m]; float v[8];
#pragma unroll
                      for (int e = 0; e < 8; ++e) { const int s = seg * 8 + e; const bool keep = dir == 0 ? (s <= m) : (s >= m); const float as = e < 4 ? as0[e & 3] : as1[e & 3];
                          const float cbv = (e & 1) ? bfhi(cw[e >> 1]) : bflo(cw[e >> 1]); v[e] = keep ? cbv * __expf(am - as) : 0.f; }
                      mv[0] = pk2(v[0], v[1]); mv[1] = pk2(v[2], v[3]); mv[2] = pk2(v[4], v[5]); mv[3] = pk2(v[6], v[7]); }
                  *(u32x4v*)(Ms + m * SP_LD + seg * 8) = mv; } }
            __syncthreads();
            wave_mma<4, 1>(yT, xT, SP_LD, Ms + mrow0 * SP_LD, SP_LD, 4);
            __syncthreads();
        }
        { const float dsk = p.in[I_SSDD][h]; const size_t row = (size_t)(base + mrow0 + fr);
#pragma unroll
          for (int mt = 0; mt < 4; ++mt) { const int p0 = h * 64 + mt * 16 + fq * 4; const u32x2 xs = *(const u32x2*)(XBC + row * XBC_LD + p0);
              u32x2 o; o[0] = pk2(yT[mt][0][0] + dsk * bflo(xs[0]), yT[mt][0][1] + dsk * bfhi(xs[0])); o[1] = pk2(yT[mt][0][2] + dsk * bflo(xs[1]), yT[mt][0][3] + dsk * bfhi(xs[1]));
              *(u32x2*)(Y + row * 2048 + p0) = o; } }
    }
}

constexpr int SS_LD = 136, SS_LB = 130;
constexpr int SS_C = 0;
constexpr int SS_B = SS_C + 128 * SS_LD * 2;
constexpr int SS_XW = SS_B + 128 * SS_LB * 2;
constexpr int SS_S = SS_XW + 32 * SS_LD * 2;
constexpr int SS_AC = SS_S + 32 * SS_LD * 2;
constexpr int SS_END = SS_AC + 512;
static_assert(SS_END <= LDS_XB, "SSD LDS");

__device__ __forceinline__ void lds_barrier() { asm volatile("s_waitcnt lgkmcnt(0)\n\ts_barrier" ::: "memory"); }
__device__ void ssd_item(unsigned char* shm, const Params& p, int b, int h, int ph) {
    const u16* XBC = (const u16*)(p.ws + E_XBC); u16* Y = (u16*)(p.ws + E_Y);
    const float* DT = (const float*)(p.ws + T_DT); const float* ACUM = (const float*)(p.ws + T_ACUM);
    u16* Cs = (u16*)(shm + SS_C); u16* Bs = (u16*)(shm + SS_B); u16* xwT = (u16*)(shm + SS_XW); u16* Sb = (u16*)(shm + SS_S);
    float* acs = (float*)(shm + SS_AC);
    const int t = threadIdx.x, lane = t & 63, w = t >> 6, g = h >> 3, fr = lane & 15, fq = lane >> 4;
    const int xcol = h * 64 + ph * 32, bcol = 2048 + g * 128, ccol = 2560 + g * 128;
    const int seg = t & 15, mq = t >> 4, xm = t & 127, xseg = t >> 7, mrow0 = w * 16;
    for (int dir = 0; dir < 2; ++dir) {
        const float* dtc = DT + (size_t)(dir * 32 + h) * RT; const float* acc_ = ACUM + (size_t)(dir * 32 + h) * RT;
        f32x4 accS[1][2]; zero_acc(accS);
        u32x4v rC[4], rB[4], rX; float rDt, rAcX, rAlast; u32x2 rY[2];
        { const u32x4v z4 = {0u, 0u, 0u, 0u}; const u32x2 z2 = {0u, 0u};
#pragma unroll
          for (int i = 0; i < 4; ++i) rC[i] = z4;
          rY[0] = z2; rY[1] = z2; }
#define SSD_BASE(st) ((st) < 2 ? RL + b * CTXL + (dir == 0 ? (st) : 1 - (st)) * 128 : b * SEQ + (dir == 0 ? (st) - 2 : 33 - (st)) * 128)
#define SSD_PREFETCH(st) do { const int base_ = SSD_BASE(st); const bool ctx_ = (st) < 2; \
            _Pragma("unroll") for (int i = 0; i < 4; ++i) { const int m = mq + 32 * i; const u16* rp = XBC + (size_t)(base_ + m) * XBC_LD + seg * 8; rB[i] = *(const u32x4v*)(rp + bcol); \
                if (!ctx_) rC[i] = *(const u32x4v*)(rp + ccol); } \
            rX = *(const u32x4v*)(XBC + (size_t)(base_ + xm) * XBC_LD + xcol + xseg * 8); rDt = dtc[base_ + xm]; rAcX = acc_[base_ + xm]; rAlast = acc_[base_ + (dir == 0 ? 127 : 0)]; \
            if (!ctx_) { _Pragma("unroll") for (int mt = 0; mt < 2; ++mt) rY[mt] = *(const u32x2*)(Y + (size_t)(base_ + mrow0 + fr) * 2048 + xcol + mt * 16 + fq * 4); } } while (0)
        SSD_PREFETCH(0);
        for (int step = 0; step < 34; ++step) {
            const bool isctx = step < 2;
            const int base = SSD_BASE(step);
            const float a_last = rAlast;
            if (xseg == 0) acs[xm] = rAcX;
#pragma unroll
            for (int i = 0; i < 4; ++i) { const int m = mq + 32 * i;
                unsigned* bd = (unsigned*)(Bs + m * SS_LB + seg * 8); bd[0] = rB[i][0]; bd[1] = rB[i][1]; bd[2] = rB[i][2]; bd[3] = rB[i][3];
                if (!isctx) *(u32x4v*)(Cs + m * SS_LD + seg * 8) = rC[i]; }
            { const float wgt = rDt * __expf(a_last - rAcX);
#pragma unroll
              for (int e = 0; e < 8; ++e) { const float x = (e & 1) ? bfhi(rX[e >> 1]) : bflo(rX[e >> 1]); xwT[(xseg * 8 + e) * SS_LD + xm] = f2bf(x * wgt); } }
            if (!isctx) {
#pragma unroll
                for (int nt = 0; nt < 2; ++nt) { u32x2 o; o[0] = pk2(accS[0][nt][0], accS[0][nt][1]); o[1] = pk2(accS[0][nt][2], accS[0][nt][3]); *(u32x2*)(Sb + (nt * 16 + fr) * SS_LD + mrow0 + fq * 4) = o; } }
            u32x2 cY[2];
#pragma unroll
            for (int mt = 0; mt < 2; ++mt) cY[mt] = rY[mt];
            lds_barrier();
            if (step + 1 < 34) SSD_PREFETCH(step + 1);
            if (!isctx) {
                f32x4 yT[2][1]; zero_acc(yT);
                wave_mma<2, 1>(yT, Sb, SS_LD, Cs + mrow0 * SS_LD, SS_LD, 4);
                const float sc = __expf(acs[mrow0 + fr]);
                const size_t row = (size_t)(base + mrow0 + fr);
#pragma unroll
                for (int mt = 0; mt < 2; ++mt) { u16* yp = Y + row * 2048 + xcol + mt * 16 + fq * 4; const u32x2 pv = cY[mt];
                    u32x2 o; o[0] = pk2(bflo(pv[0]) + sc * yT[mt][0][0], bfhi(pv[0]) + sc * yT[mt][0][1]); o[1] = pk2(bflo(pv[1]) + sc * yT[mt][0][2], bfhi(pv[1]) + sc * yT[mt][0][3]); *(u32x2*)yp = o; }
            }
            { const float dl = __expf(a_last);
#pragma unroll
              for (int nt = 0; nt < 2; ++nt)
#pragma unroll
                  for (int j = 0; j < 4; ++j) accS[0][nt][j] *= dl; }
#pragma unroll
            for (int k = 0; k < 4; ++k) {
                bf16x8 a;
#pragma unroll
                for (int e = 0; e < 8; ++e) a[e] = (short)Bs[(k * 32 + fq * 8 + e) * SS_LB + mrow0 + fr];
#pragma unroll
                for (int nt = 0; nt < 2; ++nt) { const bf16x8 bb = *(const bf16x8*)(xwT + (nt * 16 + fr) * SS_LD + k * 32 + fq * 8); accS[0][nt] = __builtin_amdgcn_mfma_f32_16x16x32_bf16(a, bb, accS[0][nt], 0, 0, 0); } }
            lds_barrier();
        }
#undef SSD_PREFETCH
#undef SSD_BASE
    }
}

__device__ void ssd_finish_phase(const Params& p) {
    u16* Y = (u16*)(p.ws + E_Y); const u16* Z = (const u16*)(p.ws + E_Z);
    const int lane = threadIdx.x & 63, wid = threadIdx.x >> 6;
    for (int it = blockIdx.x * 8 + wid; it < RL * 4; it += gridDim.x * 8) {
        const size_t off = (size_t)(it >> 2) * 2048 + (it & 3) * 512 + lane * 8;
        const u32x4v yw = *(const u32x4v*)(Y + off), zw = *(const u32x4v*)(Z + off);
        float v[8]; float ss = 0.f;
#pragma unroll
        for (int e2 = 0; e2 < 4; ++e2) { v[2 * e2] = bflo(yw[e2]) * siluf(bflo(zw[e2])); v[2 * e2 + 1] = bfhi(yw[e2]) * siluf(bfhi(zw[e2])); ss += v[2 * e2] * v[2 * e2] + v[2 * e2 + 1] * v[2 * e2 + 1]; }
        ss = wave_sum(ss);
        const float rs = rsqrtf(ss * (1.0f / 512.0f) + EPS);
        const float* gg = p.in[I_SSDNG] + (it & 3) * 512 + lane * 8; u32x4v o;
#pragma unroll
        for (int e2 = 0; e2 < 4; ++e2) o[e2] = pk2(v[2 * e2] * rs * gg[2 * e2], v[2 * e2 + 1] * rs * gg[2 * e2 + 1]);
        *(u32x4v*)(Y + off) = o;
    }
}

__global__ __launch_bounds__(512, 2) void mega(Params p) {
    extern __shared__ __attribute__((aligned(16))) unsigned char shm[];
    cg::grid_group grid = cg::this_grid();
    unsigned char* ws = p.ws;
    float* MOD = (float*)(ws + OFF_MOD); const float* MOD1 = MOD + 5 * NMOD * DM;
    u16* H = (u16*)(ws + OFF_H); float* XC = (float*)(ws + OFF_XC);
    const int bid = blockIdx.x, nb = gridDim.x;
    volatile LAS unsigned* xst = (volatile LAS unsigned*)(shm + LDS_XB);
    if (threadIdx.x < 2) xst[threadIdx.x] = 0u;
    __syncthreads();
    const XcdBarrier xb = xcd_barrier_post((unsigned*)(ws + OFF_BAR), xst);
    mod_gemv(shm, p);
    convert_weights_early(shm, p);
    if (p.ws == nullptr) grid.sync();
    xcd_barrier(xb);
    norm_mod_phase(p.in[I_X], p.in[I_CTX], p.in[I_NORMG], MOD, 0, 1, RT, 0, H);
    xcd_barrier(xb);
    { EpiBf16Plain E; E.O = (u16*)(ws + E_P0); E.ld = P0_LD; E.ncols = P0_LD; run_gemm(shm, H, (const u16*)(ws + A_AB_IN), RT, 2816, 1024, E); }
    xcd_barrier(xb);
    for (int it = bid; it < 4 * 68 * 4 + 4 * 34 * 4; it += nb) {
        if (it < 4 * 68 * 4) { const int h = it & 3, bc = it >> 2; gla_a_item(shm, p, bc / 68, bc % 68, h); }
        else { const int j = it - 4 * 68 * 4; const int gi = j & 3, bc = j >> 2; gmlp_item(shm, p, bc / 34, bc % 34, gi); }
    }
    xcd_barrier(xb);
    gla_scan_phase(p);
    xcd_barrier(xb);
    for (int it = bid; it < 4 * 68 * 4; it += nb) { const int h = it & 3, bc = it >> 2; gla_c_item(shm, p, bc / 68, bc % 68, h); }
    xcd_barrier(xb);
    { EpiRes E; E.src_lat = p.in[I_X]; E.src_ctx = p.in[I_CTX]; E.dst_lat = p.out; E.dst_ctx = XC; E.gate = MOD + 2 * DM; E.cm = 0; E.part = (float*)(ws + E_PART);
      run_gemm_split(shm, H, (const u16*)(ws + A_AB_OUT), 1024, 1024, E); }
    xcd_barrier(xb);
    norm_mod_phase(p.out, p.in[I_CTX], p.in[I_NORMG] + DM, MOD, 3, 4, RT, 0, H, (const float*)(ws + E_PART), 4, MOD + 4 * (NMOD * DM) + 2 * DM, XC);
    xcd_barrier(xb);
    { EpiSwiglu E; E.O = (u16*)(ws + E_ACT); run_gemm(shm, H, (const u16*)(ws + A_FF_IN0), RT, 5632, 1024, E); }
    xcd_barrier(xb);
    { EpiRes E; E.src_lat = p.out; E.src_ctx = XC; E.dst_lat = p.out; E.dst_ctx = XC; E.gate = MOD + 5 * DM; E.cm = 0; E.part = (float*)(ws + E_PART);
      run_gemm_split(shm, (const u16*)(ws + E_ACT), (const u16*)(ws + A_FF_OUT0), 1024, 2816, E); }
    xcd_barrier(xb);
    norm_mod_phase(p.out, XC, p.in[I_NORMG] + 2 * DM, MOD1, 0, 1, RT, 1, H, (const float*)(ws + E_PART), 11, MOD + 4 * (NMOD * DM) + 5 * DM, XC);
    xcd_barrier(xb);
    { EpiSsdIn E; E.XBC = (u16*)(ws + E_XBC); E.HALO = (u16*)(ws + A_HALO); E.DTRAW = (float*)(ws + A_DTRAW); run_gemm(shm, H, (const u16*)(ws + B_SSD_INA), RT, 3328, 1024, E); }
    xcd_barrier(xb);
    dt_phase(shm, p);
    conv_phase(p);
    xcd_barrier(xb);
    for (int it = bid; it < 4 * 32 * 4; it += nb) ssd_par_item(shm, p, it);
    xcd_barrier(xb);
    for (int it = bid; it < 4 * 32 * 2; it += nb) {
        const int xcd = it & 7, slot = it >> 3, grp = xcd * 2 + (slot >> 4), idx = slot & 15;
        ssd_item(shm, p, grp >> 2, (grp & 3) * 8 + (idx >> 1), idx & 1); }
    xcd_barrier(xb);
    { EpiBf16Plain E; E.O = (u16*)(ws + E_Z); E.ld = 2048; E.ncols = 2048; run_gemm(shm, H, (const u16*)(ws + B_WZ), RL, 2048, 1024, E); }
    convert_weights_late(shm, p);
    xcd_barrier(xb);
    ssd_finish_phase(p);
    xcd_barrier(xb);
    { EpiRes E; E.src_lat = p.out; E.src_ctx = XC; E.dst_lat = p.out; E.dst_ctx = XC; E.gate = MOD1 + 2 * DM; E.cm = 1; E.part = nullptr;
      run_gemm(shm, (const u16*)(ws + E_Y), (const u16*)(ws + A_SSD_OUT), RL, 1024, 2048, E); }
    xcd_barrier(xb);
    norm_mod_phase(p.out, XC, p.in[I_NORMG] + 3 * DM, MOD1, 3, 4, RL, 0, H);
    xcd_barrier(xb);
    { EpiSwiglu E; E.O = (u16*)(ws + E_ACT); run_gemm(shm, H, (const u16*)(ws + A_FF_IN1), RL, 5632, 1024, E); }
    xcd_barrier(xb);
    { EpiRes E; E.src_lat = p.out; E.src_ctx = XC; E.dst_lat = p.out; E.dst_ctx = XC; E.gate = MOD1 + 5 * DM; E.cm = 0; E.part = nullptr;
      run_gemm(shm, (const u16*)(ws + E_ACT), (const u16*)(ws + A_FF_OUT1), RL, 1024, 2816, E); }
    xcd_barrier(xb);
    final_norm_phase(p.out, p.in[I_FNG]);
}

extern "C" void kernel_launch(void* const* d_in, const int* in_sizes, int n_in, void* d_out, int out_size, void* d_ws, size_t ws_size, hipStream_t stream) {
    static int grid_blocks = 0;
    if (!grid_blocks) {
        int dev = 0, cus = 0, per_cu = 0;
        (void)hipGetDevice(&dev);
        (void)hipDeviceGetAttribute(&cus, hipDeviceAttributeMultiprocessorCount, dev);
        (void)hipFuncSetAttribute((const void*)mega, hipFuncAttributeMaxDynamicSharedMemorySize, LDS_BYTES);
        (void)hipOccupancyMaxActiveBlocksPerMultiprocessor(&per_cu, (const void*)mega, 512, LDS_BYTES);
        if (per_cu < 1) { fprintf(stderr, "occupancy query says %d blocks/CU\n", per_cu); per_cu = 1; }
        if (per_cu > 1) per_cu = 1;
        grid_blocks = cus * per_cu;
        if (ws_size < WS_END) fprintf(stderr, "workspace too small: %zu < %zu\n", ws_size, (size_t)WS_END);
    }
    Params p{};
    for (int i = 0; i < 26; ++i) p.in[i] = (const float*)d_in[i];
    p.out = (float*)d_out; p.ws = (unsigned char*)d_ws;
    (void)hipMemsetAsync((unsigned char*)d_ws + OFF_BAR, 0, XCD_BAR_WORDS * sizeof(unsigned), stream);
    void* args[] = {&p};
    hipError_t e = hipLaunchCooperativeKernel((const void*)mega, dim3(grid_blocks), dim3(512), args, LDS_BYTES, stream);
    if (e != hipSuccess) fprintf(stderr, "cooperative launch failed: %s (grid %d)\n", hipGetErrorString(e), grid_blocks);
}
```

```cpp
#include <hip/hip_runtime.h>
#include <hip/hip_cooperative_groups.h>
#include <cstdio>
namespace cg = cooperative_groups;
namespace pg8 {
#define PG8_LAS __attribute__((address_space(3)))
typedef unsigned short bf16_t;
typedef short bf16x8 __attribute__((ext_vector_type(8)));
typedef float f32x4 __attribute__((ext_vector_type(4)));
typedef unsigned u32x4 __attribute__((ext_vector_type(4)));
constexpr int BM = 256, BK = 64, HALF = 128, HTB = HALF * BK * 2  , STAGE_BYTES = 8 * HTB, NXCD = 8, WGM = 8;

__host__ __device__ __forceinline__ int lds_byte(int r, int c) { const int st = (r >> 4) * 2 + (c >> 5), rr = r & 15, cc = c & 31, ob = rr * 64 + cc * 2; return st * 1024 + (ob ^ (((ob >> 9) & 1) << 5)); }
__host__ __device__ __forceinline__ void stage_rc(int b, int& R, int& C) { const int st = b / 1024, sb = b % 1024, swz = sb ^ (((sb >> 9) & 1) << 5); R = (st >> 1) * 16 + swz / 64; C = (st & 1) * 32 + (swz % 64) / 2; }
__host__ __device__ __forceinline__ int perm32(int rho) { const int n = rho >> 4, i = rho & 15; return 8 * (i >> 2) + 4 * n + (i & 3); }

struct Unit { int pm, pn, kt0, nkt; };
struct Gemm { const bf16_t* A; const bf16_t* Bt; int M, N, K; };

struct StaticOrder {
    int nM, nN, nwg, G, c, nkt_all;
    __host__ __device__ void init(int M, int N, int G_, int c_, int K_ = 0) { nM = M / BM; nN = N / BM; nwg = nM * nN; G = G_; c = c_; nkt_all = K_ / BK; }
    __host__ __device__ bool next(int i, Unit& u) const {
        const long L = (long)i * G + c; if (L >= nwg) return false;
        int wgid = (int)L; { const int q = nwg / NXCD, r = nwg % NXCD, xcd = wgid % NXCD, off = wgid / NXCD; wgid = (xcd < r ? xcd * (q + 1) : r * (q + 1) + (xcd - r) * q) + off; }
        const int nig = WGM * nN, gid = wgid / nig, fm = gid * WGM, gsz = (nM - fm) < WGM ? (nM - fm) : WGM;
        u.pm = fm + ((wgid % nig) % gsz); u.pn = (wgid % nig) / gsz; u.kt0 = 0; u.nkt = nkt_all; return true;
    }
    __device__ __forceinline__ void a_ready(const Unit&) const {}
    __device__ __forceinline__ void done(const Unit&) const {}
};
__device__ __forceinline__ unsigned cvt_pk_bf16(float lo, float hi) { unsigned r; asm volatile("v_cvt_pk_bf16_f32 %0, %1, %2" : "=v"(r) : "v"(lo), "v"(hi)); return r; }
template <class Epi, class Sched, bool STAMP = false>
__device__ __forceinline__ void gemm_phase(PG8_LAS unsigned char* lds, const Gemm g, const Sched& S, const Epi& E, unsigned long long* stamps) {
    int tid_ = threadIdx.x; asm volatile("" : "+v"(tid_)); const int tid = tid_, wid = __builtin_amdgcn_readfirstlane(tid >> 6), lane = tid & 63, wr = wid >> 2, wc = wid & 3, fr = lane & 15, fq = lane >> 4;
    const int K = g.K;
    int ts_lo = 0, ts_hi = 0, nts = 0; const unsigned long long rt_entry = STAMP ? (unsigned long long)wall_clock64() : 0ull;
#define PG8_STAMP() do { if (STAMP && wid == 0 && nts < 64) { const unsigned long long _c = (unsigned long long)clock64(); \
        ts_lo = (lane == nts) ? (int)(unsigned)_c : ts_lo; ts_hi = (lane == nts) ? (int)(unsigned)(_c >> 32) : ts_hi; ++nts; } } while (0)
    PG8_STAMP();
    unsigned voffA[2], voffB[2];
#pragma unroll
    for (int i = 0; i < 2; ++i) { int R, C; stage_rc(tid * 16 + i * 8192, R, C); const int Rb = Epi::PERM ? ((R & ~31) + perm32(R & 31)) : R;
        voffA[i] = (unsigned)(R * K + C) * 2u; voffB[i] = (unsigned)(Rb * K + C) * 2u; }
    const size_t kstep = (size_t)(BK * 2);
    const size_t hstep = (size_t)HALF * K * 2;
    const size_t tstep = 2 * hstep;
    const unsigned ldsw = (unsigned)wid * 1024u;
    const int aoff = lds_byte(wr * 64 + fr, fq * 8), boff = lds_byte(wc * 32 + fr, fq * 8);
#define PG8_SA(b, h) (((b) * 2 + (h)) * HTB)
#define PG8_SB(b, h) ((4 + (b) * 2 + (h)) * HTB)
#define PG8_STAGE(bufoff, gbase, voff) do { _Pragma("unroll") for (int _i = 0; _i < 2; ++_i) \
        __builtin_amdgcn_global_load_lds((const unsigned*)((const char*)(gbase) + (voff)[_i]), (PG8_LAS unsigned*)(lds + (bufoff) + ldsw + _i * 8192), 16, 0, 0); } while (0)
#define PG8_LDA(dst, b, h) do { _Pragma("unroll") for (int m = 0; m < 4; ++m) _Pragma("unroll") for (int k = 0; k < 2; ++k) dst[m][k] = *(const PG8_LAS bf16x8*)(lds + PG8_SA(b, h) + aoff + m * 2048 + k * 1024); } while (0)
#define PG8_LDB(dst, b, h) do { _Pragma("unroll") for (int n = 0; n < 2; ++n) _Pragma("unroll") for (int k = 0; k < 2; ++k) dst[n][k] = *(const PG8_LAS bf16x8*)(lds + PG8_SB(b, h) + boff + n * 2048 + k * 1024); } while (0)
#define PG8_MMA(ai, bj, At, Bt) do { __builtin_amdgcn_s_setprio(1); _Pragma("unroll") for (int m = 0; m < 4; ++m) _Pragma("unroll") for (int n = 0; n < 2; ++n) _Pragma("unroll") for (int k = 0; k < 2; ++k) \
        acc[ai][bj][m][n] = __builtin_amdgcn_mfma_f32_16x16x32_bf16(Bt[n][k], At[m][k], acc[ai][bj][m][n], 0, 0, 0); __builtin_amdgcn_s_setprio(0); } while (0)
#define PG8_WAIT_V(n) asm volatile("s_waitcnt vmcnt(" #n ")" ::: "memory")
#define PG8_WAIT_L(n) asm volatile("s_waitcnt lgkmcnt(" #n ")" ::: "memory")
#define PG8_BAR __builtin_amdgcn_s_barrier()
#define PG8_SCHED __builtin_amdgcn_sched_barrier(0)
    Unit cur, nxt; int ui = 0;
    if (!S.next(0, cur)) return;
    f32x4 acc[2][2][4][2];
#pragma unroll
    for (int a = 0; a < 2; ++a)
#pragma unroll
        for (int b = 0; b < 2; ++b)
#pragma unroll
            for (int m = 0; m < 4; ++m)
#pragma unroll
                for (int n = 0; n < 2; ++n) acc[a][b][m][n] = (f32x4){0.f, 0.f, 0.f, 0.f};
    bf16x8 At[4][2], B0[2][2], B1[2][2];
    const char* cA = (const char*)g.A + (size_t)cur.pm * tstep + (size_t)cur.kt0 * kstep; const char* cB = (const char*)g.Bt + (size_t)cur.pn * tstep + (size_t)cur.kt0 * kstep;
    S.a_ready(cur);
    PG8_STAGE(PG8_SB(0, 0), cB, voffB); PG8_STAGE(PG8_SA(0, 0), cA, voffA); PG8_STAGE(PG8_SB(0, 1), cB + hstep, voffB); PG8_STAGE(PG8_SA(0, 1), cA + hstep, voffA);
    if (wr == 1) PG8_BAR;
    PG8_WAIT_V(4); PG8_BAR;
    PG8_STAGE(PG8_SB(1, 0), cB + kstep, voffB); PG8_STAGE(PG8_SA(1, 0), cA + kstep, voffA); PG8_STAGE(PG8_SB(1, 1), cB + hstep + kstep, voffB);
    PG8_WAIT_V(6); PG8_BAR;
    PG8_STAMP();
    for (;;) {
        const bool has_next = S.next(ui + 1, nxt);
        const char* nA = has_next ? (const char*)g.A + (size_t)nxt.pm * tstep + (size_t)nxt.kt0 * kstep : cA; const char* nB = has_next ? (const char*)g.Bt + (size_t)nxt.pn * tstep + (size_t)nxt.kt0 * kstep : cB;
        const int nt = cur.nkt;
        for (int t = 0; t < nt; t += 2) {
            const bool last = (t == nt - 2);
            const char* a1 = cA + (size_t)(t + 1) * kstep;
            const char* a2 = last ? nA : cA + (size_t)(t + 2) * kstep; const char* b2 = last ? nB : cB + (size_t)(t + 2) * kstep;
            const char* a3 = a2 + kstep; const char* b3 = b2 + kstep;
            if (last && has_next) S.a_ready(nxt);
            PG8_LDB(B0, 0, 0); PG8_SCHED; PG8_LDA(At, 0, 0); PG8_STAGE(PG8_SA(1, 1), a1 + hstep, voffA);
            PG8_WAIT_L(8); PG8_BAR; PG8_WAIT_L(0); PG8_MMA(0, 0, At, B0); PG8_BAR; PG8_SCHED;
            PG8_LDB(B1, 0, 1); PG8_STAGE(PG8_SB(0, 0), b2, voffB);
            PG8_BAR; PG8_WAIT_L(0); PG8_MMA(0, 1, At, B1); PG8_BAR;
            PG8_LDA(At, 0, 1); PG8_STAGE(PG8_SA(0, 0), a2, voffA);
            PG8_BAR; PG8_WAIT_L(0); PG8_MMA(1, 0, At, B0); PG8_BAR; PG8_SCHED;
            PG8_STAGE(PG8_SB(0, 1), b2 + hstep, voffB);
            PG8_WAIT_V(6); PG8_BAR; PG8_MMA(1, 1, At, B1); PG8_BAR;
            PG8_LDB(B0, 1, 0); PG8_SCHED; PG8_LDA(At, 1, 0); PG8_STAGE(PG8_SA(0, 1), a2 + hstep, voffA);
            PG8_WAIT_L(8); PG8_BAR; PG8_WAIT_L(0); PG8_MMA(0, 0, At, B0); PG8_BAR; PG8_SCHED;
            PG8_LDB(B1, 1, 1); PG8_STAGE(PG8_SB(1, 0), b3, voffB);
            PG8_BAR; PG8_WAIT_L(0); PG8_MMA(0, 1, At, B1); PG8_BAR;
            PG8_LDA(At, 1, 1); PG8_STAGE(PG8_SA(1, 0), a3, voffA);
            PG8_BAR; PG8_WAIT_L(0); PG8_MMA(1, 0, At, B0); PG8_BAR; PG8_SCHED;
            PG8_STAGE(PG8_SB(1, 1), b3 + hstep, voffB);
            PG8_WAIT_V(6); PG8_BAR; PG8_MMA(1, 1, At, B1); PG8_BAR;
        }
        PG8_STAMP();
        if constexpr (!Epi::AFTER_DRAIN) { E(acc, cur, wr, wc, fr, fq); S.done(cur); }
        PG8_STAMP();
        if (!has_next) break;
#pragma unroll
        for (int a = 0; a < 2; ++a)
#pragma unroll
            for (int b = 0; b < 2; ++b)
#pragma unroll
                for (int m = 0; m < 4; ++m)
#pragma unroll
                    for (int n = 0; n < 2; ++n) acc[a][b][m][n] = (f32x4){0.f, 0.f, 0.f, 0.f};
        cur = nxt; cA = nA; cB = nB; ++ui;
    }
    PG8_WAIT_V(0);
    if (wr == 0) PG8_BAR;
    PG8_BAR;
    if constexpr (Epi::AFTER_DRAIN) { E.fused(acc, cur, wr, wc, fr, fq, lds, wid, lane); S.done(cur); }
    PG8_STAMP();
    if (STAMP && wid == 0) { stamps[lane] = lane < nts ? (((unsigned long long)(unsigned)ts_hi << 32) | (unsigned)ts_lo) : 0ull;
        if (lane == 62) stamps[62] = rt_entry; if (lane == 63) stamps[63] = (unsigned long long)wall_clock64(); }
#undef PG8_STAMP
#undef PG8_SA
#undef PG8_SB
#undef PG8_STAGE
#undef PG8_LDA
#undef PG8_LDB
#undef PG8_MMA
#undef PG8_WAIT_V
#undef PG8_WAIT_L
#undef PG8_BAR
#undef PG8_SCHED
}
}

#define XB_TMO      128
#define XB_XCNT(j)  (256  + 64 * (j))
#define XB_XSUB(j)  (1280 + 64 * (j))
#define XB_XGEN(j)  (2304 + 64 * (j))
#define XB_TOP      3328
#define XB_TOPGEN   3392
#define XCD_BAR_WORDS 3456
#define XB_SPIN_CAP (1u << 18)
#define LAS __attribute__((address_space(3)))

__device__ __forceinline__ unsigned xb_ld(unsigned* p)              { return __hip_atomic_load(p, __ATOMIC_RELAXED, __HIP_MEMORY_SCOPE_AGENT); }
__device__ __forceinline__ unsigned xb_add(unsigned* p, unsigned v) { return __hip_atomic_fetch_add(p, v, __ATOMIC_RELAXED, __HIP_MEMORY_SCOPE_AGENT); }
__device__ __forceinline__ unsigned xb_xcc_id() { return (unsigned)__builtin_amdgcn_s_getreg((3 << 11) | 20) & 0xFu; }
#define XB_SPIN(cond, bar) do { unsigned _sp = 0; while (cond) { __builtin_amdgcn_s_sleep(1); \
    if ((++_sp & 255u) == 0u) { if (xb_ld(&(bar)[XB_TMO])) break; if (_sp > XB_SPIN_CAP) { atomicAdd(&(bar)[XB_TMO], 1u); break; } } } } while (0)

struct XcdBarrier {
    unsigned* bar; unsigned x;
    volatile LAS unsigned* st;
};

__device__ __forceinline__ XcdBarrier xcd_barrier_post(unsigned* bar, volatile LAS unsigned* st) {
    XcdBarrier b; b.bar = bar; b.x = xb_xcc_id(); b.st = st;
    if (threadIdx.x == 0) (void)xb_add(&bar[XB_XCNT(b.x)], 1u);
    return b;
}
__device__ __forceinline__ void xcd_barrier_complete(unsigned* bar, unsigned x, unsigned& nloc, unsigned& nx) {
    const unsigned G = gridDim.x * gridDim.y * gridDim.z;
    unsigned sum, cnt, mine, sp = 0u;
    for (;;) {
        sum = 0u; cnt = 0u; mine = 0u;
#pragma unroll
        for (unsigned j = 0; j < 16; ++j) { const unsigned c = xb_ld(&bar[XB_XCNT(j)]); sum += c; cnt += (c > 0u) ? 1u : 0u; mine = (j == x) ? c : mine; }
        if (sum == G) break;
        __builtin_amdgcn_s_sleep(1);
        if ((++sp & 255u) == 0u) { if (xb_ld(&bar[XB_TMO])) break; if (sp > XB_SPIN_CAP) { atomicAdd(&bar[XB_TMO], 1u); break; } }
    }
    nloc = mine > 0u ? mine : 1u; nx = cnt > 0u ? cnt : 1u;
}

__device__ __attribute__((noinline)) void xcd_barrier_impl(unsigned* bar_, unsigned x_, volatile LAS unsigned* st_) {
    XcdBarrier b; b.bar = bar_; b.x = x_; b.st = st_;
    asm volatile("s_waitcnt vmcnt(0)" ::: "memory");
    __syncthreads();
    if (threadIdx.x == 0) {
        unsigned* bar = b.bar;
        __builtin_amdgcn_s_waitcnt(0);
        unsigned nloc = b.st[0], nx = b.st[1];
        if (nloc == 0u) { xcd_barrier_complete(bar, b.x, nloc, nx); b.st[0] = nloc; b.st[1] = nx; }
        const unsigned old = xb_add(&bar[XB_XSUB(b.x)], 1u);
        const unsigned gen = old / nloc;
        if (old + 1u == (gen + 1u) * nloc) {
            __builtin_amdgcn_fence(__ATOMIC_RELEASE, "agent");
            asm volatile("s_waitcnt vmcnt(0)" ::: "memory");
            const unsigned og = xb_add(&bar[XB_TOP], 1u);
            const unsigned tg = og / nx;
            if (og + 1u == (tg + 1u) * nx) xb_add(&bar[XB_TOPGEN], 1u);
            else XB_SPIN(xb_ld(&bar[XB_TOPGEN]) == tg, bar);
            __builtin_amdgcn_fence(__ATOMIC_ACQUIRE, "agent");
            xb_add(&bar[XB_XGEN(b.x)], 1u);
            asm volatile("s_waitcnt vmcnt(0)" ::: "memory");
        } else {
            XB_SPIN(xb_ld(&bar[XB_XGEN(b.x)]) == gen, bar);
            __builtin_amdgcn_fence(__ATOMIC_ACQUIRE, "agent");
            asm volatile("s_waitcnt vmcnt(0)" ::: "memory");
        }
    }
    __syncthreads();
}

__device__ __forceinline__ void xcd_barrier(const XcdBarrier& b) { xcd_barrier_impl(b.bar, b.x, b.st); }

typedef unsigned short u16;
using pg8::bf16x8; using pg8::f32x4;
typedef unsigned u32x2 __attribute__((ext_vector_type(2)));
typedef unsigned u32x4v __attribute__((ext_vector_type(4)));

constexpr int DM = 1024, NB = 4, SEQ = 4096, CTXL = 256, RL = NB * SEQ, RC = NB * CTXL, RT = RL + RC;
constexpr int DFF = 2816, NMOD = 6;
constexpr int P0_LD = 2592;
constexpr int P0_K = 0, P0_V = 256, P0_LR = 768, P0_Q = 800, P0_R = 1056, P0_U = 1568, P0_G = 2080;
constexpr int XBC_LD = 3072;
constexpr float EPS = 1e-6f;

constexpr size_t OFF_MOD = 0;
constexpr size_t OFF_A = 262144;
constexpr size_t A_AB_IN = OFF_A, A_AB_OUT = A_AB_IN + (size_t)2816 * 1024 * 2, A_FF_IN0 = A_AB_OUT + (size_t)1024 * 1024 * 2, A_FF_OUT0 = A_FF_IN0 + (size_t)5632 * 1024 * 2;
constexpr size_t A_END = A_FF_OUT0 + (size_t)1024 * 2816 * 2;
constexpr size_t A_DTRAW = OFF_A, A_HALO = A_DTRAW + (size_t)RT * 64 * 4;
constexpr size_t A_SSD_OUT = OFF_A, A_FF_IN1 = A_SSD_OUT + (size_t)1024 * 2048 * 2, A_FF_OUT1 = A_FF_IN1 + (size_t)5632 * 1024 * 2;
constexpr size_t OFF_B = A_END;
constexpr size_t B_SSD_INA = OFF_B, B_WZ = B_SSD_INA + (size_t)3328 * 1024 * 2, B_END = B_WZ + (size_t)2048 * 1024 * 2;
constexpr size_t OFF_XC = B_END;
constexpr size_t OFF_H = OFF_XC + (size_t)RC * DM * 4;
constexpr size_t OFF_DSC = OFF_H + (size_t)RT * DM * 2;
constexpr size_t OFF_DEC = OFF_DSC + (size_t)4 * 2 * 4 * 4 * 8192 * 4;
constexpr size_t OFF_E = OFF_DEC + (size_t)4 * 2 * 4 * 68 * 64 * 4;
constexpr size_t E_P0 = OFF_E, E_ACT = OFF_E, E_XBC = OFF_E, E_Z = OFF_E;
constexpr size_t E_Y = OFF_E + (size_t)RT * XBC_LD * 2;
constexpr size_t T_DT = E_Y + (size_t)RL * 2048 * 2, T_ACUM = T_DT + (size_t)RT * 64 * 4;
constexpr size_t WS_END = T_ACUM + (size_t)RT * 64 * 4;
constexpr size_t E_PART = OFF_E + (size_t)100 * 1024 * 1024;
constexpr size_t A_CB = OFF_A;
static_assert(A_HALO + (size_t)272 * 4 * 3072 * 2 <= A_END && A_FF_OUT1 + (size_t)1024 * 2816 * 2 <= A_END && A_CB + (size_t)512 * 16384 * 2 <= A_END, "region A overflow");
static_assert(WS_END <= (size_t)256 * 1024 * 1024, "workspace over 256 MiB");

constexpr int LDS_BYTES = 144 * 1024;
constexpr int LDS_XB = LDS_BYTES - 16;
constexpr size_t OFF_BAR = 245760;

struct Params { const float* in[26]; float* out; unsigned char* ws; };
enum { I_X = 0, I_C, I_CTX, I_CCTX, I_MODW, I_MODB, I_NORMG, I_FFWIN, I_FFWOUT, I_ABWIN, I_ABGW, I_ABGB, I_ABGNG, I_ABVNG, I_ABSW, I_ABSB, I_ABWOUT,
       I_SSDWIN, I_SSDCW, I_SSDCB, I_SSDDTB, I_SSDALOG, I_SSDD, I_SSDNG, I_SSDWOUT, I_FNG };

__device__ __forceinline__ u16 f2bf(float f) { return __builtin_bit_cast(u16, (__bf16)f); }
__device__ __forceinline__ float bf2f(unsigned b) { return __uint_as_float(b << 16); }
typedef float f32x2v __attribute__((ext_vector_type(2)));
typedef __bf16 bf16x2v __attribute__((ext_vector_type(2)));
__device__ __forceinline__ unsigned pk2(float lo, float hi) { const f32x2v v = {lo, hi}; return __builtin_bit_cast(unsigned, __builtin_convertvector(v, bf16x2v)); }
__device__ __forceinline__ float bflo(unsigned w) { return __uint_as_float(w << 16); }
__device__ __forceinline__ float bfhi(unsigned w) { return __uint_as_float(w & 0xFFFF0000u); }
__device__ __forceinline__ float siluf(float x) { return x * __builtin_amdgcn_rcpf(1.0f + __expf(-x)); }
__device__ __forceinline__ float geluf(float x) { const float y = 0.7978845608028654f * (x + 0.044715f * x * x * x); const float th = 1.0f - 2.0f * __builtin_amdgcn_rcpf(1.0f + __expf(2.0f * y)); return 0.5f * x * (1.0f + th); }
__device__ __forceinline__ float softplusf(float x) { return fmaxf(x, 0.f) + log1pf(__expf(-fabsf(x))); }
__device__ __forceinline__ float logsigmoidf(float x) { return fminf(x, 0.f) - __logf(1.0f + __expf(-fabsf(x))); }
__device__ __forceinline__ float wave_sum(float v) {
#pragma unroll
    for (int o = 32; o > 0; o >>= 1) v += __shfl_xor(v, o, 64);
    return v;
}

template <int MT, int NT>
__device__ __forceinline__ void wave_mma(f32x4 (&acc)[MT][NT], const u16* A, int lda, const u16* B, int ldb, int ksteps) {
    const int lane = threadIdx.x & 63, fr = lane & 15, fq = lane >> 4;
    const u16* ap = A + fr * lda + fq * 8; const u16* bp = B + fr * ldb + fq * 8;
    for (int k = 0; k < ksteps; ++k) {
        bf16x8 a[MT], b[NT];
#pragma unroll
        for (int i = 0; i < MT; ++i) a[i] = *(const bf16x8*)(ap + i * 16 * lda + k * 32);
#pragma unroll
        for (int i = 0; i < NT; ++i) b[i] = *(const bf16x8*)(bp + i * 16 * ldb + k * 32);
#pragma unroll
        for (int i = 0; i < MT; ++i)
#pragma unroll
            for (int j = 0; j < NT; ++j) acc[i][j] = __builtin_amdgcn_mfma_f32_16x16x32_bf16(a[i], b[j], acc[i][j], 0, 0, 0);
    }
}
template <int MT, int NT> __device__ __forceinline__ void zero_acc(f32x4 (&acc)[MT][NT]) {
#pragma unroll
    for (int i = 0; i < MT; ++i)
#pragma unroll
        for (int j = 0; j < NT; ++j) acc[i][j] = (f32x4){0.f, 0.f, 0.f, 0.f};
}

__device__ __forceinline__ u32x4v pack8(const f32x4& a, const f32x4& b) { u32x4v r; r[0] = pk2(a[0], a[1]); r[1] = pk2(a[2], a[3]); r[2] = pk2(b[0], b[1]); r[3] = pk2(b[2], b[3]); return r; }

struct EpiBf16Plain {
    static constexpr bool PERM = true, AFTER_DRAIN = false;
    u16* O; int ld; int ncols;
    __device__ __forceinline__ void operator()(const f32x4 (&acc)[2][2][4][2], const pg8::Unit& u, int wr, int wc, int fr, int fq) const {
        const int row0 = u.pm * 256 + wr * 64 + fr, col0 = u.pn * 256 + wc * 32 + 8 * fq;
#pragma unroll
        for (int ai = 0; ai < 2; ++ai)
#pragma unroll
            for (int m = 0; m < 4; ++m) { const int row = row0 + ai * 128 + m * 16;
#pragma unroll
                for (int bj = 0; bj < 2; ++bj) { const int c = col0 + bj * 128; if (c < ncols) *(u32x4v*)(O + (size_t)row * ld + c) = pack8(acc[ai][bj][m][0], acc[ai][bj][m][1]); } }
    }
};
struct EpiSwiglu {
    static constexpr bool PERM = true, AFTER_DRAIN = false;
    u16* O;
    __device__ __forceinline__ void operator()(const f32x4 (&acc)[2][2][4][2], const pg8::Unit& u, int wr, int wc, int fr, int fq) const {
        const int row0 = u.pm * 256 + wr * 64 + fr, j0 = u.pn * 128 + wc * 32 + 8 * fq;
#pragma unroll
        for (int ai = 0; ai < 2; ++ai)
#pragma unroll
            for (int m = 0; m < 4; ++m) { const int row = row0 + ai * 128 + m * 16; f32x4 o0, o1;
#pragma unroll
                for (int i = 0; i < 4; ++i) { o0[i] = siluf(acc[ai][0][m][0][i]) * acc[ai][1][m][0][i]; o1[i] = siluf(acc[ai][0][m][1][i]) * acc[ai][1][m][1][i]; }
                *(u32x4v*)(O + (size_t)row * DFF + j0) = pack8(o0, o1); }
    }
};
struct EpiSsdIn {
    static constexpr bool PERM = true, AFTER_DRAIN = false;
    u16* XBC; u16* HALO; float* DTRAW;
    __device__ __forceinline__ void operator()(const f32x4 (&acc)[2][2][4][2], const pg8::Unit& u, int wr, int wc, int fr, int fq) const {
        const int row0 = u.pm * 256 + wr * 64 + fr, col0 = u.pn * 256 + wc * 32 + 8 * fq;
#pragma unroll
        for (int ai = 0; ai < 2; ++ai)
#pragma unroll
            for (int m = 0; m < 4; ++m) { const int row = row0 + ai * 128 + m * 16; const int rr = row & 63; const int slot = rr < 2 ? rr : (rr >= 62 ? rr - 60 : -1);
#pragma unroll
                for (int bj = 0; bj < 2; ++bj) { const int c = col0 + bj * 128;
                    if (c < 3072) { const u32x4v v = pack8(acc[ai][bj][m][0], acc[ai][bj][m][1]); *(u32x4v*)(XBC + (size_t)row * XBC_LD + c) = v;
                        if (slot >= 0) *(u32x4v*)(HALO + ((size_t)(row >> 6) * 4 + slot) * XBC_LD + c) = v; }
                    else if (c < 3136) { float* d = DTRAW + (size_t)row * 64 + (c - 3072); *(f32x4*)d = acc[ai][bj][m][0]; *(f32x4*)(d + 4) = acc[ai][bj][m][1]; } } }
    }
};
struct EpiRes {
    static constexpr bool PERM = false, AFTER_DRAIN = false;
    const float* src_lat; const float* src_ctx; float* dst_lat; float* dst_ctx; const float* gate; int cm; float* part;
    __device__ __forceinline__ void operator()(const f32x4 (&acc)[2][2][4][2], const pg8::Unit& u, int wr, int wc, int fr, int fq) const {
        const int row0 = u.pm * 256 + wr * 64 + fr, col0 = u.pn * 256 + wc * 32 + 4 * fq;
#pragma unroll
        for (int ai = 0; ai < 2; ++ai)
#pragma unroll
            for (int m = 0; m < 4; ++m) { const int row = row0 + ai * 128 + m * 16; const float* s; float* d; int mi;
                if (row < RL) { const int xr = cm ? ((row & ~4095) | ((row & 63) << 6) | ((row >> 6) & 63)) : row; s = src_lat + (size_t)xr * DM; d = dst_lat + (size_t)xr * DM; mi = row >> 12; }
                else { s = src_ctx + (size_t)(row - RL) * DM; d = dst_ctx + (size_t)(row - RL) * DM; mi = 4; }
                const float* gt = gate + mi * (NMOD * DM);
                if (part != nullptr && row >= RL) { float* pd = part + ((size_t)(u.kt0 >> 2) * RC + (row - RL)) * DM;
#pragma unroll
                    for (int bj = 0; bj < 2; ++bj)
#pragma unroll
                        for (int n = 0; n < 2; ++n) { const int c = col0 + bj * 128 + n * 16; *(f32x4*)(pd + c) = acc[ai][bj][m][n]; }
                    continue; }
#pragma unroll
                for (int bj = 0; bj < 2; ++bj)
#pragma unroll
                    for (int n = 0; n < 2; ++n) { const int c = col0 + bj * 128 + n * 16; const f32x4 g4 = *(const f32x4*)(gt + c), x4 = *(const f32x4*)(s + c);
                        *(f32x4*)(d + c) = x4 + g4 * acc[ai][bj][m][n]; } }
    }
};

template <class Epi> __device__ __forceinline__ void run_gemm(unsigned char* shm, const u16* A, const u16* Bt, int M, int N, int K, const Epi& E) {
    pg8::Gemm g; g.A = A; g.Bt = Bt; g.M = M; g.N = N; g.K = K;
    pg8::StaticOrder S; S.init(M, N, (int)gridDim.x, (int)blockIdx.x, K);
    pg8::gemm_phase<Epi, pg8::StaticOrder, false>((PG8_LAS unsigned char*)shm, g, S, E, nullptr);
}

struct SplitOrder {
    pg8::StaticOrder lat; int nlat, nsl, nctx, G, c, nN;
    __device__ void init(int N, int K, int G_, int c_) { lat.init(RL, N, G_, c_, K); nlat = lat.nwg; nN = N / 256; nsl = (K / 64) / 4; nctx = (RC / 256) * nN * nsl; G = G_; c = c_; }
    __device__ bool next(int i, pg8::Unit& u) const {
        const long L = (long)i * G + c; if (L < nlat) return lat.next(i, u);
        const int j = (int)(L - nlat); if (j >= nctx) return false;
        const int sl = j % nsl, tile = j / nsl; u.pm = RL / 256 + tile / nN; u.pn = tile % nN; u.kt0 = sl * 4; u.nkt = 4; return true; }
    __device__ __forceinline__ void a_ready(const pg8::Unit&) const {}
    __device__ __forceinline__ void done(const pg8::Unit&) const {}
};
template <class Epi> __device__ __forceinline__ void run_gemm_split(unsigned char* shm, const u16* A, const u16* Bt, int N, int K, const Epi& E) {
    pg8::Gemm g; g.A = A; g.Bt = Bt; g.M = RT; g.N = N; g.K = K;
    SplitOrder S; S.init(N, K, (int)gridDim.x, (int)blockIdx.x);
    pg8::gemm_phase<Epi, SplitOrder, false>((PG8_LAS unsigned char*)shm, g, S, E, nullptr);
}

__device__ __forceinline__ int wcol(int r, int N, int mode) {
    if (mode == 0) return r < N ? r : -1;
    if (mode == 1) { const int q = r >> 8, s = (r >> 7) & 1, i = r & 127; return s * DFF + 128 * q + i; }
    if (mode == 2) return r + 3136;
    return r < 3136 ? r : -1;
}
__device__ __forceinline__ void convert_tile(unsigned char* shm, const float* src, u16* dst, int K, int N, int mode, int ti) {
    u16* tile = (u16*)shm;
    const int t = threadIdx.x, rl = t & 63, k0 = t >> 6, r2 = t >> 3, kk = (t & 7) * 8;
    const int nkt = K >> 7, rb = (ti / nkt) << 6, kb = (ti % nkt) << 7;
    const int col = wcol(rb + rl, N, mode);
    const float* sp = src + (size_t)(kb + k0) * N + (col >= 0 ? col : 0);
    float v[16];
#pragma unroll
    for (int i = 0; i < 16; ++i) v[i] = sp[(size_t)(8 * i) * N];
#pragma unroll
    for (int i = 0; i < 16; ++i) tile[rl * 136 + k0 + 8 * i] = f2bf(col >= 0 ? v[i] : 0.f);
    __syncthreads();
    *(u32x4v*)(dst + (size_t)(rb + r2) * K + kb + kk) = *(const u32x4v*)(tile + r2 * 136 + kk);
    *(u32x4v*)(dst + (size_t)(rb + r2) * K + kb + 64 + kk) = *(const u32x4v*)(tile + r2 * 136 + 64 + kk);
    __syncthreads();
}
constexpr int wtiles(int NR, int K) { return (NR / 64) * (K / 128); }
__device__ void convert_weights_early(unsigned char* shm, const Params& p) {
    unsigned char* ws = p.ws;
    constexpr int T0 = wtiles(5632, 1024), T1 = wtiles(1024, 2816), T2 = wtiles(3328, 1024), T3 = wtiles(2816, 1024), T4 = wtiles(2048, 1024), T5 = wtiles(1024, 1024);
    for (int gi = blockIdx.x; gi < T0 + T1 + T2 + T3 + T4 + T5; gi += gridDim.x) {
        int ti = gi;
        if (ti < T0) { convert_tile(shm, p.in[I_FFWIN], (u16*)(ws + A_FF_IN0), 1024, 5632, 1, ti); continue; } ti -= T0;
        if (ti < T1) { convert_tile(shm, p.in[I_FFWOUT], (u16*)(ws + A_FF_OUT0), 2816, 1024, 0, ti); continue; } ti -= T1;
        if (ti < T2) { convert_tile(shm, p.in[I_SSDWIN], (u16*)(ws + B_SSD_INA), 1024, 5184, 3, ti); continue; } ti -= T2;
        if (ti < T3) { convert_tile(shm, p.in[I_ABWIN], (u16*)(ws + A_AB_IN), 1024, 2592, 0, ti); continue; } ti -= T3;
        if (ti < T4) { convert_tile(shm, p.in[I_SSDWIN], (u16*)(ws + B_WZ), 1024, 5184, 2, ti); continue; } ti -= T4;
        convert_tile(shm, p.in[I_ABWOUT], (u16*)(ws + A_AB_OUT), 1024, 1024, 0, ti);
    }
}
__device__ void convert_weights_late(unsigned char* shm, const Params& p) {
    unsigned char* ws = p.ws;
    constexpr int T0 = wtiles(5632, 1024), T1 = wtiles(1024, 2816), T2 = wtiles(1024, 2048);
    for (int gi = blockIdx.x; gi < T0 + T1 + T2; gi += gridDim.x) {
        int ti = gi;
        if (ti < T0) { convert_tile(shm, p.in[I_FFWIN] + (size_t)1024 * 5632, (u16*)(ws + A_FF_IN1), 1024, 5632, 1, ti); continue; } ti -= T0;
        if (ti < T1) { convert_tile(shm, p.in[I_FFWOUT] + (size_t)2816 * 1024, (u16*)(ws + A_FF_OUT1), 2816, 1024, 0, ti); continue; } ti -= T1;
        convert_tile(shm, p.in[I_SSDWOUT], (u16*)(ws + A_SSD_OUT), 2048, 1024, 0, ti);
    }
}
__device__ void mod_gemv(unsigned char* shm, const Params& p) {
    float* sc = (float*)shm;
    float* red = sc + 5 * 1024;
    const int t = threadIdx.x;
    for (int i = t; i < 5 * 1024; i += 512) { const float v = i < 4096 ? p.in[I_C][i] : p.in[I_CCTX][i - 4096]; sc[i] = siluf(v); }
    __syncthreads();
    float* MOD = (float*)(p.ws + OFF_MOD);
    const int n = t & 31, kc = t >> 5;
    for (int job = blockIdx.x; job < 2 * 192; job += gridDim.x) {
        const int l = job / 192, nb = (job % 192) * 32;
        const float* W = p.in[I_MODW] + (size_t)l * DM * (NMOD * DM) + nb + n;
        float a[5] = {0.f, 0.f, 0.f, 0.f, 0.f};
#pragma unroll 16
        for (int i = 0; i < 64; ++i) { const int k = kc + 16 * i; const float w = W[(size_t)k * (NMOD * DM)];
#pragma unroll
            for (int m = 0; m < 5; ++m) a[m] += sc[m * 1024 + k] * w; }
#pragma unroll
        for (int m = 0; m < 5; ++m) red[(kc * 5 + m) * 32 + n] = a[m];
        __syncthreads();
        if (t < 160) { const int m = t >> 5; float s = 0.f;
#pragma unroll
            for (int q = 0; q < 16; ++q) s += red[(q * 5 + m) * 32 + n];
            MOD[((size_t)l * 5 + m) * (NMOD * DM) + nb + n] = s + p.in[I_MODB][(size_t)l * (NMOD * DM) + nb + n]; }
        __syncthreads();
    }
}

__device__ void norm_mod_phase(const float* lat, const float* ctx, const float* ng, const float* modl  , int ishift, int iscale, int nrows, int cm, u16* H, const float* part = nullptr, int nsl = 0, const float* pgate = nullptr, float* xc_out = nullptr) {
    const int lane = threadIdx.x & 63, wid = threadIdx.x >> 6;
    for (int row = blockIdx.x * 8 + wid; row < nrows; row += gridDim.x * 8) {
        const float* s = row < RL ? lat + (size_t)row * DM : ctx + (size_t)(row - RL) * DM;
        const int mi = row < RL ? (row >> 12) : 4;
        f32x4 v[4], pg[4], psh[4], psc[4]; float ss = 0.f;
        const float* sh = modl + mi * (NMOD * DM) + ishift * DM; const float* scp = modl + mi * (NMOD * DM) + iscale * DM;
#pragma unroll
        for (int i = 0; i < 4; ++i) v[i] = *(const f32x4*)(s + i * 256 + lane * 4);
#pragma unroll
        for (int i = 0; i < 4; ++i) { const int c = i * 256 + lane * 4; pg[i] = *(const f32x4*)(ng + c); psh[i] = *(const f32x4*)(sh + c); psc[i] = *(const f32x4*)(scp + c); }
#pragma unroll
        for (int i = 0; i < 4; ++i) ss += v[i][0] * v[i][0] + v[i][1] * v[i][1] + v[i][2] * v[i][2] + v[i][3] * v[i][3];
        if (part != nullptr && row >= RL) {
            ss = 0.f;
#pragma unroll
            for (int i = 0; i < 4; ++i) { const int c = i * 256 + lane * 4; f32x4 a = {0.f, 0.f, 0.f, 0.f};
                for (int sl = 0; sl < nsl; ++sl) a += *(const f32x4*)(part + ((size_t)sl * RC + (row - RL)) * DM + c);
                v[i] += *(const f32x4*)(pgate + c) * a; *(f32x4*)(xc_out + (size_t)(row - RL) * DM + c) = v[i];
                ss += v[i][0] * v[i][0] + v[i][1] * v[i][1] + v[i][2] * v[i][2] + v[i][3] * v[i][3]; } }
        ss = wave_sum(ss);
        const float rs = rsqrtf(ss * (1.0f / DM) + EPS);
        const int dr = (cm && row < RL) ? ((row & ~4095) | ((row & 63) << 6) | ((row >> 6) & 63)) : row;
#pragma unroll
        for (int i = 0; i < 4; ++i) { const int c = i * 256 + lane * 4; const f32x4 g4 = pg[i], sh4 = psh[i], sc4 = psc[i];
            float o[4];
#pragma unroll
            for (int e = 0; e < 4; ++e) o[e] = (v[i][e] * rs * g4[e]) * (1.0f + sc4[e]) + sh4[e];
            u32x2 w; w[0] = pk2(o[0], o[1]); w[1] = pk2(o[2], o[3]); *(u32x2*)(H + (size_t)dr * DM + c) = w; }
    }
}
__device__ void final_norm_phase(float* X, const float* g) {
    const int lane = threadIdx.x & 63, wid = threadIdx.x >> 6;
    for (int row = blockIdx.x * 8 + wid; row < RL; row += gridDim.x * 8) {
        float* s = X + (size_t)row * DM; f32x4 v[4]; float ss = 0.f;
#pragma unroll
        for (int i = 0; i < 4; ++i) { v[i] = *(const f32x4*)(s + i * 256 + lane * 4); ss += v[i][0] * v[i][0] + v[i][1] * v[i][1] + v[i][2] * v[i][2] + v[i][3] * v[i][3]; }
        ss = wave_sum(ss);
        const float rs = rsqrtf(ss * (1.0f / DM) + EPS);
#pragma unroll
        for (int i = 0; i < 4; ++i) { const int c = i * 256 + lane * 4; const f32x4 g4 = *(const f32x4*)(g + c); f32x4 o;
#pragma unroll
            for (int e = 0; e < 4; ++e) o[e] = (v[i][e] * rs) * g4[e];
            *(f32x4*)(s + c) = o; }
    }
}

__device__ __forceinline__ int gla_rowbase(int b, int c) { return c < 4 ? RL + b * CTXL + c * 64 : b * SEQ + (c - 4) * 64; }
__device__ __forceinline__ float* gla_ds_ptr(const Params& p, int b, int d, int h, int c) {
    return c < 4 ? (float*)(p.ws + OFF_DSC) + ((size_t)((b * 2 + d) * 4 + h) * 4 + c) * 8192 : p.out + ((size_t)((b * 2 + d) * 4 + h) * 64 + (c - 4)) * 8192;
}
constexpr int GL_BC = 0;
constexpr int GL_LR = GL_BC + 2 * 64 * 65 * 4;
constexpr int GL_GW = GL_LR + 64 * 32 * 4;
constexpr int GL_X0 = GL_GW + 2 * 16 * 64 * 4;
constexpr int GL_LD = 72;

__device__ void gla_gates(unsigned char* shm, const Params& p, int rowbase, int h) {
    const u16* P0 = (const u16*)(p.ws + E_P0);
    float* BC = (float*)(shm + GL_BC); float* LR = (float*)(shm + GL_LR); float* QS = (float*)(shm + GL_GW);
    const int t = threadIdx.x;
    const int kk = t & 63, lq = (t >> 6) & 3, d = t >> 8;
    float gw[16];
#pragma unroll
    for (int j = 0; j < 16; ++j) gw[j] = p.in[I_ABGW][(size_t)(d * 16 + j) * 256 + h * 64 + kk];
    const float gb = p.in[I_ABGB][d * 256 + h * 64 + kk];
    if (t < 256) { const int row = t >> 2, part = t & 3; const u32x4v w = *(const u32x4v*)(P0 + (size_t)(rowbase + row) * P0_LD + P0_LR + part * 8);
        f32x4 lo, hi; lo[0] = bflo(w[0]); lo[1] = bfhi(w[0]); lo[2] = bflo(w[1]); lo[3] = bfhi(w[1]); hi[0] = bflo(w[2]); hi[1] = bfhi(w[2]); hi[2] = bflo(w[3]); hi[3] = bfhi(w[3]);
        *(f32x4*)(LR + row * 32 + part * 8) = lo; *(f32x4*)(LR + row * 32 + part * 8 + 4) = hi; }
    __syncthreads();
    float la[16];
#pragma unroll
    for (int i = 0; i < 16; ++i) { const int l = lq * 16 + i; const float* lr = LR + l * 32 + d * 16; float pre = gb;
#pragma unroll
        for (int j4 = 0; j4 < 4; ++j4) { const f32x4 v = *(const f32x4*)(lr + j4 * 4); pre += v[0] * gw[j4 * 4] + v[1] * gw[j4 * 4 + 1] + v[2] * gw[j4 * 4 + 2] + v[3] * gw[j4 * 4 + 3]; }
        la[i] = logsigmoidf(pre) * (1.0f / 16.0f); }
    if (d == 0) {
#pragma unroll
        for (int i = 1; i < 16; ++i) la[i] += la[i - 1];
        QS[(d * 4 + lq) * 64 + kk] = la[15];
    } else {
#pragma unroll
        for (int i = 14; i >= 0; --i) la[i] += la[i + 1];
        QS[(d * 4 + lq) * 64 + kk] = la[0];
    }
    __syncthreads();
    float off = 0.f;
    if (d == 0) { for (int q = 0; q < lq; ++q) off += QS[(0 * 4 + q) * 64 + kk]; }
    else { for (int q = 3; q > lq; --q) off += QS[(1 * 4 + q) * 64 + kk]; }
#pragma unroll
    for (int i = 0; i < 16; ++i) BC[(d * 64 + lq * 16 + i) * 65 + kk] = la[i] + off;
    __syncthreads();
}
__device__ __forceinline__ void gla_load_v(u32x4v& w0, u32x4v& w1, const u16* P0, int rowbase, int h) {
    const int t = threadIdx.x, l = t & 63, vg = t >> 6;
    const u16* src = P0 + (size_t)(rowbase + l) * P0_LD + P0_V + h * 128 + vg * 16;
    w0 = *(const u32x4v*)src; w1 = *(const u32x4v*)(src + 8);
}
__device__ __forceinline__ void gla_stage_vT(u16* vT, const u32x4v& w0, const u32x4v& w1) {
    const int t = threadIdx.x, l = t & 63, vg = t >> 6;
#pragma unroll
    for (int e = 0; e < 4; ++e) { vT[(vg * 16 + 2 * e) * GL_LD + l] = (u16)(w0[e] & 0xFFFF); vT[(vg * 16 + 2 * e + 1) * GL_LD + l] = (u16)(w0[e] >> 16);
        vT[(vg * 16 + 8 + 2 * e) * GL_LD + l] = (u16)(w1[e] & 0xFFFF); vT[(vg * 16 + 8 + 2 * e + 1) * GL_LD + l] = (u16)(w1[e] >> 16); }
}

__device__ void gla_a_item(unsigned char* shm, const Params& p, int b, int c, int h) {
    const u16* P0 = (const u16*)(p.ws + E_P0);
    const int rowbase = gla_rowbase(b, c), t = threadIdx.x, lane = t & 63, w = t >> 6;
    const u32x4v kw = *(const u32x4v*)(P0 + (size_t)(rowbase + (t & 63)) * P0_LD + P0_K + h * 64 + (t >> 6) * 8);
    u32x4v vw0, vw1; gla_load_v(vw0, vw1, P0, rowbase, h);
    gla_gates(shm, p, rowbase, h);
    const float* BC = (const float*)(shm + GL_BC);
    u16* kwT = (u16*)(shm + GL_X0);
    u16* vT = kwT + 2 * 64 * GL_LD;
    { const int l = t & 63, kg = t >> 6;
#pragma unroll
      for (int e = 0; e < 8; ++e) { const int k = kg * 8 + e; const float kv = (e & 1) ? bfhi(kw[e >> 1]) : bflo(kw[e >> 1]);
          const float w0 = __expf(BC[63 * 65 + k] - BC[l * 65 + k]), w1 = __expf(BC[(64 + 0) * 65 + k] - BC[(64 + l) * 65 + k]);
          kwT[k * GL_LD + l] = f2bf(kv * w0); kwT[(64 + k) * GL_LD + l] = f2bf(kv * w1); } }
    gla_stage_vT(vT, vw0, vw1);
    __syncthreads();
    { const int d = w >> 2, kb = w & 3; f32x4 acc[1][8]; zero_acc(acc);
      wave_mma<1, 8>(acc, kwT + (d * 64 + kb * 16) * GL_LD, GL_LD, vT, GL_LD, 2);
      float* DS = gla_ds_ptr(p, b, d, h, c);
#pragma unroll
      for (int nt = 0; nt < 8; ++nt) { const int v = nt * 16 + (lane & 15), k0 = kb * 16 + (lane >> 4) * 4; *(f32x4*)(DS + v * 64 + k0) = acc[0][nt]; } }
    if (t < 128) { const int d = t >> 6, kk = t & 63; const float bl = d == 0 ? BC[63 * 65 + kk] : BC[64 * 65 + kk];
        ((float*)(p.ws + OFF_DEC))[((size_t)((b * 2 + d) * 4 + h) * 68 + c) * 64 + kk] = __expf(bl); }
    __syncthreads();
}

__device__ void gmlp_item(unsigned char* shm, const Params& p, int b, int cc, int gi) {
    const u16* P0 = (const u16*)(p.ws + E_P0); u16* MG = (u16*)(p.ws + OFF_H);
    const int rowbase = cc < 2 ? RL + b * CTXL + cc * 128 : b * SEQ + (cc - 2) * 128;
    const int t = threadIdx.x, lane = t & 63, w = t >> 6;
    float* st = (float*)shm;
    u16* vnT = (u16*)(shm + 1024);
    u16* Ws = vnT + 128 * 136;
    { const int row = t >> 2, part = t & 3; const u16* src = P0 + (size_t)(rowbase + row) * P0_LD + P0_G + part * 128; float s = 0.f, ss = 0.f;
#pragma unroll 4
      for (int i = 0; i < 16; ++i) { const u32x4v wv = *(const u32x4v*)(src + i * 8);
#pragma unroll
          for (int e = 0; e < 4; ++e) { const float a = geluf(bflo(wv[e])), c2 = geluf(bfhi(wv[e])); s += a + c2; ss += a * a + c2 * c2; } }
      s += __shfl_xor(s, 1, 64); ss += __shfl_xor(ss, 1, 64); s += __shfl_xor(s, 2, 64); ss += __shfl_xor(ss, 2, 64);
      if (part == 0) { const float mu = s * (1.0f / 512.0f); const float var = fmaxf(ss * (1.0f / 512.0f) - mu * mu, 0.f); st[row * 2] = mu; st[row * 2 + 1] = rsqrtf(var + EPS); } }
    { const float* SW = p.in[I_ABSW] + (size_t)gi * 128 * 128;
#pragma unroll
      for (int ps = 0; ps < 8; ++ps) { const int idx = ps * 2048 + t * 4, tt = idx >> 7, s0 = idx & 127; const f32x4 v = *(const f32x4*)(SW + idx);
          u32x2 o; o[0] = pk2(v[0], v[1]); o[1] = pk2(v[2], v[3]); *(u32x2*)(Ws + tt * 136 + s0) = o; } }
    __syncthreads();
    { const int s = t & 127, cg4 = t >> 7; const u16* src = P0 + (size_t)(rowbase + s) * P0_LD + P0_G + gi * 128 + cg4 * 32; const float mu = st[s * 2], rstd = st[s * 2 + 1];
      const float* vg = p.in[I_ABVNG] + gi * 128 + cg4 * 32;
#pragma unroll
      for (int i = 0; i < 4; ++i) { const u32x4v wv = *(const u32x4v*)(src + i * 8);
#pragma unroll
          for (int e = 0; e < 8; ++e) { const float x = (e & 1) ? bfhi(wv[e >> 1]) : bflo(wv[e >> 1]); const int cl = i * 8 + e;
              vnT[(cg4 * 32 + cl) * 136 + s] = f2bf((geluf(x) - mu) * rstd * vg[cl]); } } }
    __syncthreads();
    { f32x4 acc[1][8]; zero_acc(acc);
      wave_mma<1, 8>(acc, vnT + (w * 16) * 136, 136, Ws, 136, 4);
      const int c0 = w * 16 + (lane >> 4) * 4;
#pragma unroll
      for (int nt = 0; nt < 8; ++nt) { const int tt = nt * 16 + (lane & 15); const float sb = p.in[I_ABSB][gi * 128 + tt];
          const u32x2 uw = *(const u32x2*)(P0 + (size_t)(rowbase + tt) * P0_LD + P0_U + gi * 128 + c0);
          const float o0 = geluf(bflo(uw[0])) * (acc[0][nt][0] + sb), o1 = geluf(bfhi(uw[0])) * (acc[0][nt][1] + sb), o2 = geluf(bflo(uw[1])) * (acc[0][nt][2] + sb), o3 = geluf(bfhi(uw[1])) * (acc[0][nt][3] + sb);
          u32x2 o; o[0] = pk2(o0, o1); o[1] = pk2(o2, o3); *(u32x2*)(MG + (size_t)(rowbase + tt) * DM + 512 + gi * 128 + c0) = o; } }
    __syncthreads();
}

__device__ void gla_scan_phase(const Params& p) {
    const float* DEC = (const float*)(p.ws + OFF_DEC);
    for (int g0 = blockIdx.x * 512 + threadIdx.x; g0 < 4 * 2 * 4 * 8192 / 2; g0 += gridDim.x * 512) {
        int e[2], bb[2], dd[2], hh[2]; const float* dec[2]; float s[2] = {0.f, 0.f};
#pragma unroll
        for (int q = 0; q < 2; ++q) { const int gidx = g0 + q * (4 * 2 * 4 * 8192 / 2); e[q] = gidx & 8191; const int bdh = gidx >> 13; hh[q] = bdh & 3; dd[q] = (bdh >> 2) & 1; bb[q] = bdh >> 3; dec[q] = DEC + (size_t)bdh * 68 * 64 + (e[q] & 63); }
        for (int i0 = 0; i0 < 68; i0 += 17) {
            float* ptr[2][17]; float ds[2][17], dc[2][17];
#pragma unroll
            for (int u = 0; u < 17; ++u)
#pragma unroll
                for (int q = 0; q < 2; ++q) { const int i = i0 + u; const int c = dd[q] == 0 ? i : (i < 4 ? 3 - i : 71 - i); ptr[q][u] = gla_ds_ptr(p, bb[q], dd[q], hh[q], c) + e[q]; ds[q][u] = *ptr[q][u]; dc[q][u] = dec[q][c * 64]; }
#pragma unroll
            for (int u = 0; u < 17; ++u)
#pragma unroll
                for (int q = 0; q < 2; ++q) { *ptr[q][u] = s[q]; s[q] = dc[q][u] * s[q] + ds[q][u]; }
        }
    }
}

__device__ void gla_c_item(unsigned char* shm, const Params& p, int b, int c, int h) {
    const u16* P0 = (const u16*)(p.ws + E_P0); u16* MG = (u16*)(p.ws + OFF_H);
    const int rowbase = gla_rowbase(b, c), t = threadIdx.x, lane = t & 63, w = t >> 6;
    const u16* rp_ = P0 + (size_t)(rowbase + (t & 63)) * P0_LD + h * 64 + (t >> 6) * 8;
    const u32x4v qw = *(const u32x4v*)(rp_ + P0_Q), kw = *(const u32x4v*)(rp_ + P0_K);
    u32x4v vw0, vw1; gla_load_v(vw0, vw1, P0, rowbase, h);
    f32x4 spa[4], spb[4];
#pragma unroll
    for (int ps = 0; ps < 4; ++ps) { const int idx = ps * 4096 + t * 8; const float* src = gla_ds_ptr(p, b, idx >> 13, h, c) + (idx & 8191); spa[ps] = *(const f32x4*)src; spb[ps] = *(const f32x4*)(src + 4); }
    const u16* rrp = P0 + (size_t)(rowbase + (t >> 3)) * P0_LD + P0_R + h * 128 + (t & 7) * 16;
    const u32x4v r0 = *(const u32x4v*)rrp, r1 = *(const u32x4v*)(rrp + 8);
    gla_gates(shm, p, rowbase, h);
    const float* BC = (const float*)(shm + GL_BC);
    u16* qd = (u16*)(shm + GL_X0);
    u16* kd = qd + 2 * 64 * GL_LD;
    u16* vT = kd + 2 * 64 * GL_LD;
    u16* SpT = vT + 128 * GL_LD;
    u16* SC = (u16*)(shm + GL_BC);
    float* O = (float*)SpT;
    { const int l = t & 63, kg = t >> 6;
#pragma unroll
      for (int d = 0; d < 2; ++d) { u32x4v qo, ko;
#pragma unroll
          for (int e2 = 0; e2 < 4; ++e2) { const float e0 = BC[(d * 64 + l) * 65 + kg * 8 + 2 * e2], e1 = BC[(d * 64 + l) * 65 + kg * 8 + 2 * e2 + 1];
              qo[e2] = pk2(bflo(qw[e2]) * 0.125f * __expf(e0), bfhi(qw[e2]) * 0.125f * __expf(e1));
              ko[e2] = pk2(bflo(kw[e2]) * __expf(-e0), bfhi(kw[e2]) * __expf(-e1)); }
          *(u32x4v*)(qd + (d * 64 + l) * GL_LD + kg * 8) = qo; *(u32x4v*)(kd + (d * 64 + l) * GL_LD + kg * 8) = ko; } }
    gla_stage_vT(vT, vw0, vw1);
#pragma unroll
    for (int ps = 0; ps < 4; ++ps) { const int idx = ps * 4096 + t * 8, d = idx >> 13, rem = idx & 8191, v = rem >> 6, k0 = rem & 63;
        *(u32x4v*)(SpT + (d * 128 + v) * GL_LD + k0) = pack8(spa[ps], spb[ps]); }
    __syncthreads();
    { const int d = w >> 2, lb = w & 3; f32x4 acc[1][4]; zero_acc(acc);
      wave_mma<1, 4>(acc, qd + (d * 64 + lb * 16) * GL_LD, GL_LD, kd + d * 64 * GL_LD, GL_LD, 2);
      __syncthreads();
#pragma unroll
      for (int nt = 0; nt < 4; ++nt)
#pragma unroll
          for (int j = 0; j < 4; ++j) { const int l = lb * 16 + (lane >> 4) * 4 + j, s = nt * 16 + (lane & 15); const bool keep = d == 0 ? (s <= l) : (s >= l);
              SC[(d * 64 + l) * GL_LD + s] = f2bf(keep ? acc[0][nt][j] : 0.f); } }
    __syncthreads();
    f32x4 oacc[1][4]; zero_acc(oacc);
    const int lb = w & 3, vh = w >> 2;
#pragma unroll
    for (int d = 0; d < 2; ++d) {
        wave_mma<1, 4>(oacc, qd + (d * 64 + lb * 16) * GL_LD, GL_LD, SpT + (d * 128 + vh * 64) * GL_LD, GL_LD, 2);
        wave_mma<1, 4>(oacc, SC + (d * 64 + lb * 16) * GL_LD, GL_LD, vT + (vh * 64) * GL_LD, GL_LD, 2);
    }
    __syncthreads();
#pragma unroll
    for (int nt = 0; nt < 4; ++nt)
#pragma unroll
        for (int j = 0; j < 4; ++j) { const int l = lb * 16 + (lane >> 4) * 4 + j, v = vh * 64 + nt * 16 + (lane & 15); O[l * 132 + v] = oacc[0][nt][j]; }
    __syncthreads();
    { const int l = t >> 3, part = t & 7; float o[16]; float ss = 0.f;
#pragma unroll
      for (int i = 0; i < 4; ++i) { const f32x4 v4 = *(const f32x4*)(O + l * 132 + part * 16 + i * 4);
#pragma unroll
          for (int e = 0; e < 4; ++e) { o[i * 4 + e] = v4[e]; ss += v4[e] * v4[e]; } }
      ss += __shfl_xor(ss, 1, 64); ss += __shfl_xor(ss, 2, 64); ss += __shfl_xor(ss, 4, 64);
      const float rs = rsqrtf(ss * (1.0f / 128.0f) + EPS);
      const float* gg = p.in[I_ABGNG] + h * 128 + part * 16; u32x4v o0, o1;
#pragma unroll
      for (int e2 = 0; e2 < 4; ++e2) {
          o0[e2] = pk2(o[2 * e2] * rs * gg[2 * e2] * siluf(bflo(r0[e2])), o[2 * e2 + 1] * rs * gg[2 * e2 + 1] * siluf(bfhi(r0[e2])));
          o1[e2] = pk2(o[8 + 2 * e2] * rs * gg[8 + 2 * e2] * siluf(bflo(r1[e2])), o[8 + 2 * e2 + 1] * rs * gg[8 + 2 * e2 + 1] * siluf(bfhi(r1[e2]))); }
      u16* dst = MG + (size_t)(rowbase + l) * DM + h * 128 + part * 16; *(u32x4v*)dst = o0; *(u32x4v*)(dst + 8) = o1; }
    __syncthreads();
}

__device__ void conv_phase(const Params& p) {
    u16* XBC = (u16*)(p.ws + E_XBC); const u16* HALO = (const u16*)(p.ws + A_HALO);
    const int t = threadIdx.x, cg = t & 127, q = __builtin_amdgcn_readfirstlane(t >> 7);
    for (int it = blockIdx.x; it < (RT / 64) * 3; it += gridDim.x) {
        const int rb = it / 3, cp = (it % 3) * 1024, c0 = cp + cg * 8;
        const bool first = rb < 256 ? ((rb & 63) == 0) : (((rb - 256) & 3) == 0);
        const bool last = rb < 256 ? ((rb & 63) == 63) : (((rb - 256) & 3) == 3);
        const bool z0 = (q == 0) && first, z1 = (q == 3) && last;
        u16* rowq = XBC + ((size_t)rb * 64 + 16 * q) * XBC_LD + cp;
        const u16* pre = (q == 0) ? (z0 ? rowq : HALO + ((size_t)(rb - 1) * 4 + 2) * XBC_LD + cp) : rowq - 2 * XBC_LD;
        const u16* post = (q == 3) ? (z1 ? rowq : HALO + ((size_t)(rb + 1) * 4) * XBC_LD + cp) : rowq + 16 * XBC_LD;
        u32x4v win[20];
        win[0] = *(const u32x4v*)(pre + cg * 8); win[1] = *(const u32x4v*)(pre + XBC_LD + cg * 8);
#pragma unroll
        for (int i = 0; i < 16; ++i) win[2 + i] = *(const u32x4v*)(rowq + (size_t)i * XBC_LD + cg * 8);
        win[18] = *(const u32x4v*)(post + cg * 8); win[19] = *(const u32x4v*)(post + XBC_LD + cg * 8);
        const u32x4v zero = {0u, 0u, 0u, 0u};
        if (z0) { win[0] = zero; win[1] = zero; }
        if (z1) { win[18] = zero; win[19] = zero; }
        float wt[5][8], bias[8];
#pragma unroll
        for (int j = 0; j < 5; ++j) { const f32x4 a = *(const f32x4*)(p.in[I_SSDCW] + j * 3072 + c0), b2 = *(const f32x4*)(p.in[I_SSDCW] + j * 3072 + c0 + 4);
#pragma unroll
            for (int e = 0; e < 4; ++e) { wt[j][e] = a[e]; wt[j][4 + e] = b2[e]; } }
        { const f32x4 a = *(const f32x4*)(p.in[I_SSDCB] + c0), b2 = *(const f32x4*)(p.in[I_SSDCB] + c0 + 4);
#pragma unroll
          for (int e = 0; e < 4; ++e) { bias[e] = a[e]; bias[4 + e] = b2[e]; } }
        __syncthreads();
#pragma unroll
        for (int r = 0; r < 16; ++r) {
            float o[8];
#pragma unroll
            for (int e = 0; e < 8; ++e) o[e] = bias[e];
#pragma unroll
            for (int j = 0; j < 5; ++j)
#pragma unroll
                for (int e2 = 0; e2 < 4; ++e2) { o[2 * e2] += wt[j][2 * e2] * bflo(win[r + j][e2]); o[2 * e2 + 1] += wt[j][2 * e2 + 1] * bfhi(win[r + j][e2]); }
            u32x4v ov;
#pragma unroll
            for (int e2 = 0; e2 < 4; ++e2) ov[e2] = pk2(siluf(o[2 * e2]), siluf(o[2 * e2 + 1]));
            *(u32x4v*)(rowq + (size_t)r * XBC_LD + cg * 8) = ov;
        }
    }
}
__device__ void dt_phase(unsigned char* shm, const Params& p) {
    const float* DTRAW = (const float*)(p.ws + A_DTRAW); float* DT = (float*)(p.ws + T_DT); float* ACUM = (float*)(p.ws + T_ACUM);
    float* tile = (float*)shm;
    float* tdt = tile + 128 * 65;
    const int t = threadIdx.x, col = t & 63;
    const float bias = p.in[I_SSDDTB][col], a = -__expf(p.in[I_SSDALOG][col]);
    for (int ch = blockIdx.x; ch < RT / 128; ch += gridDim.x) {
        const size_t r0 = (size_t)ch * 128;
#pragma unroll
        for (int i = 0; i < 16; ++i) { const int m = i * 8 + (t >> 6); const float d = softplusf(DTRAW[(r0 + m) * 64 + col] + bias); tdt[m * 65 + col] = d; tile[m * 65 + col] = d * a; }
        __syncthreads();
        if (t < 64) { float run = 0.f;
            if (t < 32) { for (int m = 0; m < 128; ++m) { run += tile[m * 65 + t]; tile[m * 65 + t] = run; } }
            else { for (int m = 127; m >= 0; --m) { run += tile[m * 65 + t]; tile[m * 65 + t] = run; } } }
        __syncthreads();
        { const int m = t & 127, cq = t >> 7;
#pragma unroll
          for (int i = 0; i < 16; ++i) { const int c = cq * 16 + i; ACUM[(size_t)c * RT + r0 + m] = tile[m * 65 + c]; DT[(size_t)c * RT + r0 + m] = tdt[m * 65 + c]; } }
        __syncthreads();
    }
}
constexpr int SP_LD = 136;
constexpr int SP_C = 0;
constexpr int SP_B = SP_C + 128 * SP_LD * 2;
constexpr int SP_CB = SP_B + 128 * SP_LD * 2;
constexpr int SP_AC = SP_CB + 128 * SP_LD * 2;
constexpr int SP_DT = SP_AC + 16 * 128 * 4;
constexpr int SP_END = SP_DT + 16 * 128 * 4;
static_assert(SP_END <= LDS_XB, "SSD par LDS");
__device__ void ssd_par_item(unsigned char* shm, const Params& p, int item) {
    const u16* XBC = (const u16*)(p.ws + E_XBC); u16* Y = (u16*)(p.ws + E_Y);
    const float* DT = (const float*)(p.ws + T_DT); const float* ACUM = (const float*)(p.ws + T_ACUM);
    const int g = item & 3, base = (item >> 2) * 128;
    u16* Cs = (u16*)(shm + SP_C); u16* Ms = Cs; u16* Bs = (u16*)(shm + SP_B); u16* xT = Bs; u16* CBs = (u16*)(shm + SP_CB);
    float* acs = (float*)(shm + SP_AC); float* dts = (float*)(shm + SP_DT);
    const int t = threadIdx.x, lane = t & 63, w = t >> 6, fr = lane & 15, fq = lane >> 4;
#pragma unroll
    for (int i = 0; i < 4; ++i) { const int idx = i * 512 + t, m = idx >> 4, seg = idx & 15; const u16* rp = XBC + (size_t)(base + m) * XBC_LD + g * 128 + seg * 8;
        *(u32x4v*)(Cs + m * SP_LD + seg * 8) = *(const u32x4v*)(rp + 2560); *(u32x4v*)(Bs + m * SP_LD + seg * 8) = *(const u32x4v*)(rp + 2048); }
#pragma unroll
    for (int i = 0; i < 4; ++i) { const int idx = i * 512 + t, q = idx >> 7, m = idx & 127, hh = q >> 1, dir = q & 1; const size_t o = (size_t)(dir * 32 + g * 8 + hh) * RT + base + m;
        acs[idx] = ACUM[o]; dts[idx] = DT[o]; }
    __syncthreads();
    { f32x4 acc[1][8]; zero_acc(acc);
      wave_mma<1, 8>(acc, Bs + (w * 16) * SP_LD, SP_LD, Cs, SP_LD, 4);
#pragma unroll
      for (int nt = 0; nt < 8; ++nt) { u32x2 o; o[0] = pk2(acc[0][nt][0], acc[0][nt][1]); o[1] = pk2(acc[0][nt][2], acc[0][nt][3]); *(u32x2*)(CBs + (nt * 16 + fr) * SP_LD + w * 16 + fq * 4) = o; } }
    __syncthreads();
    const int seg = t & 15, mq = t >> 4, xs_ = t & 127, pseg = t >> 7, mrow0 = w * 16;
    for (int hh = 0; hh < 8; ++hh) {
        const int h = g * 8 + hh;
        f32x4 yT[4][1]; zero_acc(yT);
        for (int dir = 0; dir < 2; ++dir) {
            const float* ac = acs + (hh * 2 + dir) * 128; const float* dtv = dts + (hh * 2 + dir) * 128;
            { const u16* xp = XBC + (size_t)(base + xs_) * XBC_LD + h * 64 + pseg * 16; const u32x4v x0 = *(const u32x4v*)xp, x1 = *(const u32x4v*)(xp + 8); const float d = dtv[xs_];
#pragma unroll
              for (int e2 = 0; e2 < 4; ++e2) { xT[(pseg * 16 + 2 * e2) * SP_LD + xs_] = f2bf(bflo(x0[e2]) * d); xT[(pseg * 16 + 2 * e2 + 1) * SP_LD + xs_] = f2bf(bfhi(x0[e2]) * d);
                  xT[(pseg * 16 + 8 + 2 * e2) * SP_LD + xs_] = f2bf(bflo(x1[e2]) * d); xT[(pseg * 16 + 8 + 2 * e2 + 1) * SP_LD + xs_] = f2bf(bfhi(x1[e2]) * d); } }
            { const f32x4 as0 = *(const f32x4*)(ac + seg * 8), as1 = *(const f32x4*)(ac + seg * 8 + 4);
#pragma unroll
              for (int i = 0; i < 4; ++i) { const int m = mq + 32 * i; u32x4v mv = {0u, 0u, 0u, 0u};
                  const bool any = dir == 0 ? (seg * 8 <= m) : (seg * 8 + 7 >= m);
                  if (any) { const u32x4v cw = *(const u32x4v*)(CBs + m * SP_LD + seg * 8); const float am = ac[m]; float v[8];
#pragma unroll
                      for (int e = 0; e < 8; ++e) { const int s = seg * 8 + e; const bool keep = dir == 0 ? (s <= m) : (s >= m); const float as = e < 4 ? as0[e & 3] : as1[e & 3];
                          const float cbv = (e & 1) ? bfhi(cw[e >> 1]) : bflo(cw[e >> 1]); v[e] = keep ? cbv * __expf(am - as) : 0.f; }
                      mv[0] = pk2(v[0], v[1]); mv[1] = pk2(v[2], v[3]); mv[2] = pk2(v[4], v[5]); mv[3] = pk2(v[6], v[7]); }
                  *(u32x4v*)(Ms + m * SP_LD + seg * 8) = mv; } }
            __syncthreads();
            wave_mma<4, 1>(yT, xT, SP_LD, Ms + mrow0 * SP_LD, SP_LD, 4);
            __syncthreads();
        }
        { const float dsk = p.in[I_SSDD][h]; const size_t row = (size_t)(base + mrow0 + fr);
#pragma unroll
          for (int mt = 0; mt < 4; ++mt) { const int p0 = h * 64 + mt * 16 + fq * 4; const u32x2 xs = *(const u32x2*)(XBC + row * XBC_LD + p0);
              u32x2 o; o[0] = pk2(yT[mt][0][0] + dsk * bflo(xs[0]), yT[mt][0][1] + dsk * bfhi(xs[0])); o[1] = pk2(yT[mt][0][2] + dsk * bflo(xs[1]), yT[mt][0][3] + dsk * bfhi(xs[1]));
              *(u32x2*)(Y + row * 2048 + p0) = o; } }
    }
}

constexpr int SS_LD = 136, SS_LB = 130;
constexpr int SS_C = 0;
constexpr int SS_B = SS_C + 128 * SS_LD * 2;
constexpr int SS_XW = SS_B + 128 * SS_LB * 2;
constexpr int SS_S = SS_XW + 32 * SS_LD * 2;
constexpr int SS_AC = SS_S + 32 * SS_LD * 2;
constexpr int SS_END = SS_AC + 512;
static_assert(SS_END <= LDS_XB, "SSD LDS");

__device__ __forceinline__ void lds_barrier() { asm volatile("s_waitcnt lgkmcnt(0)\n\ts_barrier" ::: "memory"); }
__device__ void ssd_item(unsigned char* shm, const Params& p, int b, int h, int ph) {
    const u16* XBC = (const u16*)(p.ws + E_XBC); u16* Y = (u16*)(p.ws + E_Y);
    const float* DT = (const float*)(p.ws + T_DT); const float* ACUM = (const float*)(p.ws + T_ACUM);
    u16* Cs = (u16*)(shm + SS_C); u16* Bs = (u16*)(shm + SS_B); u16* xwT = (u16*)(shm + SS_XW); u16* Sb = (u16*)(shm + SS_S);
    float* acs = (float*)(shm + SS_AC);
    const int t = threadIdx.x, lane = t & 63, w = t >> 6, g = h >> 3, fr = lane & 15, fq = lane >> 4;
    const int xcol = h * 64 + ph * 32, bcol = 2048 + g * 128, ccol = 2560 + g * 128;
    const int seg = t & 15, mq = t >> 4, xm = t & 127, xseg = t >> 7, mrow0 = w * 16;
    for (int dir = 0; dir < 2; ++dir) {
        const float* dtc = DT + (size_t)(dir * 32 + h) * RT; const float* acc_ = ACUM + (size_t)(dir * 32 + h) * RT;
        f32x4 accS[1][2]; zero_acc(accS);
        u32x4v rC[4], rB[4], rX; float rDt, rAcX, rAlast; u32x2 rY[2];
        { const u32x4v z4 = {0u, 0u, 0u, 0u}; const u32x2 z2 = {0u, 0u};
#pragma unroll
          for (int i = 0; i < 4; ++i) rC[i] = z4;
          rY[0] = z2; rY[1] = z2; }
#define SSD_BASE(st) ((st) < 2 ? RL + b * CTXL + (dir == 0 ? (st) : 1 - (st)) * 128 : b * SEQ + (dir == 0 ? (st) - 2 : 33 - (st)) * 128)
#define SSD_PREFETCH(st) do { const int base_ = SSD_BASE(st); const bool ctx_ = (st) < 2; \
            _Pragma("unroll") for (int i = 0; i < 4; ++i) { const int m = mq + 32 * i; const u16* rp = XBC + (size_t)(base_ + m) * XBC_LD + seg * 8; rB[i] = *(const u32x4v*)(rp + bcol); \
                if (!ctx_) rC[i] = *(const u32x4v*)(rp + ccol); } \
            rX = *(const u32x4v*)(XBC + (size_t)(base_ + xm) * XBC_LD + xcol + xseg * 8); rDt = dtc[base_ + xm]; rAcX = acc_[base_ + xm]; rAlast = acc_[base_ + (dir == 0 ? 127 : 0)]; \
            if (!ctx_) { _Pragma("unroll") for (int mt = 0; mt < 2; ++mt) rY[mt] = *(const u32x2*)(Y + (size_t)(base_ + mrow0 + fr) * 2048 + xcol + mt * 16 + fq * 4); } } while (0)
        SSD_PREFETCH(0);
        for (int step = 0; step < 34; ++step) {
            const bool isctx = step < 2;
            const int base = SSD_BASE(step);
            const float a_last = rAlast;
            if (xseg == 0) acs[xm] = rAcX;
#pragma unroll
            for (int i = 0; i < 4; ++i) { const int m = mq + 32 * i;
                unsigned* bd = (unsigned*)(Bs + m * SS_LB + seg * 8); bd[0] = rB[i][0]; bd[1] = rB[i][1]; bd[2] = rB[i][2]; bd[3] = rB[i][3];
                if (!isctx) *(u32x4v*)(Cs + m * SS_LD + seg * 8) = rC[i]; }
            { const float wgt = rDt * __expf(a_last - rAcX);
#pragma unroll
              for (int e = 0; e < 8; ++e) { const float x = (e & 1) ? bfhi(rX[e >> 1]) : bflo(rX[e >> 1]); xwT[(xseg * 8 + e) * SS_LD + xm] = f2bf(x * wgt); } }
            if (!isctx) {
#pragma unroll
                for (int nt = 0; nt < 2; ++nt) { u32x2 o; o[0] = pk2(accS[0][nt][0], accS[0][nt][1]); o[1] = pk2(accS[0][nt][2], accS[0][nt][3]); *(u32x2*)(Sb + (nt * 16 + fr) * SS_LD + mrow0 + fq * 4) = o; } }
            u32x2 cY[2];
#pragma unroll
            for (int mt = 0; mt < 2; ++mt) cY[mt] = rY[mt];
            lds_barrier();
            if (step + 1 < 34) SSD_PREFETCH(step + 1);
            if (!isctx) {
                f32x4 yT[2][1]; zero_acc(yT);
                wave_mma<2, 1>(yT, Sb, SS_LD, Cs + mrow0 * SS_LD, SS_LD, 4);
                const float sc = __expf(acs[mrow0 + fr]);
                const size_t row = (size_t)(base + mrow0 + fr);
#pragma unroll
                for (int mt = 0; mt < 2; ++mt) { u16* yp = Y + row * 2048 + xcol + mt * 16 + fq * 4; const u32x2 pv = cY[mt];
                    u32x2 o; o[0] = pk2(bflo(pv[0]) + sc * yT[mt][0][0], bfhi(pv[0]) + sc * yT[mt][0][1]); o[1] = pk2(bflo(pv[1]) + sc * yT[mt][0][2], bfhi(pv[1]) + sc * yT[mt][0][3]); *(u32x2*)yp = o; }
            }
            { const float dl = __expf(a_last);
#pragma unroll
              for (int nt = 0; nt < 2; ++nt)
#pragma unroll
                  for (int j = 0; j < 4; ++j) accS[0][nt][j] *= dl; }
#pragma unroll
            for (int k = 0; k < 4; ++k) {
                bf16x8 a;
#pragma unroll
                for (int e = 0; e < 8; ++e) a[e] = (short)Bs[(k * 32 + fq * 8 + e) * SS_LB + mrow0 + fr];
#pragma unroll
                for (int nt = 0; nt < 2; ++nt) { const bf16x8 bb = *(const bf16x8*)(xwT + (nt * 16 + fr) * SS_LD + k * 32 + fq * 8); accS[0][nt] = __builtin_amdgcn_mfma_f32_16x16x32_bf16(a, bb, accS[0][nt], 0, 0, 0); } }
            lds_barrier();
        }
#undef SSD_PREFETCH
#undef SSD_BASE
    }
}

__device__ void ssd_finish_phase(const Params& p) {
    u16* Y = (u16*)(p.ws + E_Y); const u16* Z = (const u16*)(p.ws + E_Z);
    const int lane = threadIdx.x & 63, wid = threadIdx.x >> 6;
    for (int it = blockIdx.x * 8 + wid; it < RL * 4; it += gridDim.x * 8) {
        const size_t off = (size_t)(it >> 2) * 2048 + (it & 3) * 512 + lane * 8;
        const u32x4v yw = *(const u32x4v*)(Y + off), zw = *(const u32x4v*)(Z + off);
        float v[8]; float ss = 0.f;
#pragma unroll
        for (int e2 = 0; e2 < 4; ++e2) { v[2 * e2] = bflo(yw[e2]) * siluf(bflo(zw[e2])); v[2 * e2 + 1] = bfhi(yw[e2]) * siluf(bfhi(zw[e2])); ss += v[2 * e2] * v[2 * e2] + v[2 * e2 + 1] * v[2 * e2 + 1]; }
        ss = wave_sum(ss);
        const float rs = rsqrtf(ss * (1.0f / 512.0f) + EPS);
        const float* gg = p.in[I_SSDNG] + (it & 3) * 512 + lane * 8; u32x4v o;
#pragma unroll
        for (int e2 = 0; e2 < 4; ++e2) o[e2] = pk2(v[2 * e2] * rs * gg[2 * e2], v[2 * e2 + 1] * rs * gg[2 * e2 + 1]);
        *(u32x4v*)(Y + off) = o;
    }
}

__global__ __launch_bounds__(512, 2) void mega(Params p) {
    extern __shared__ __attribute__((aligned(16))) unsigned char shm[];
    cg::grid_group grid = cg::this_grid();
    unsigned char* ws = p.ws;
    float* MOD = (float*)(ws + OFF_MOD); const float* MOD1 = MOD + 5 * NMOD * DM;
    u16* H = (u16*)(ws + OFF_H); float* XC = (float*)(ws + OFF_XC);
    const int bid = blockIdx.x, nb = gridDim.x;
    volatile LAS unsigned* xst = (volatile LAS unsigned*)(shm + LDS_XB);
    if (threadIdx.x < 2) xst[threadIdx.x] = 0u;
    __syncthreads();
    const XcdBarrier xb = xcd_barrier_post((unsigned*)(ws + OFF_BAR), xst);
    mod_gemv(shm, p);
    convert_weights_early(shm, p);
    if (p.ws == nullptr) grid.sync();
    xcd_barrier(xb);
    norm_mod_phase(p.in[I_X], p.in[I_CTX], p.in[I_NORMG], MOD, 0, 1, RT, 0, H);
    xcd_barrier(xb);
    { EpiBf16Plain E; E.O = (u16*)(ws + E_P0); E.ld = P0_LD; E.ncols = P0_LD; run_gemm(shm, H, (const u16*)(ws + A_AB_IN), RT, 2816, 1024, E); }
    xcd_barrier(xb);
    for (int it = bid; it < 4 * 68 * 4 + 4 * 34 * 4; it += nb) {
        if (it < 4 * 68 * 4) { const int h = it & 3, bc = it >> 2; gla_a_item(shm, p, bc / 68, bc % 68, h); }
        else { const int j = it - 4 * 68 * 4; const int gi = j & 3, bc = j >> 2; gmlp_item(shm, p, bc / 34, bc % 34, gi); }
    }
    xcd_barrier(xb);
    gla_scan_phase(p);
    xcd_barrier(xb);
    for (int it = bid; it < 4 * 68 * 4; it += nb) { const int h = it & 3, bc = it >> 2; gla_c_item(shm, p, bc / 68, bc % 68, h); }
    xcd_barrier(xb);
    { EpiRes E; E.src_lat = p.in[I_X]; E.src_ctx = p.in[I_CTX]; E.dst_lat = p.out; E.dst_ctx = XC; E.gate = MOD + 2 * DM; E.cm = 0; E.part = (float*)(ws + E_PART);
      run_gemm_split(shm, H, (const u16*)(ws + A_AB_OUT), 1024, 1024, E); }
    xcd_barrier(xb);
    norm_mod_phase(p.out, p.in[I_CTX], p.in[I_NORMG] + DM, MOD, 3, 4, RT, 0, H, (const float*)(ws + E_PART), 4, MOD + 4 * (NMOD * DM) + 2 * DM, XC);
    xcd_barrier(xb);
    { EpiSwiglu E; E.O = (u16*)(ws + E_ACT); run_gemm(shm, H, (const u16*)(ws + A_FF_IN0), RT, 5632, 1024, E); }
    xcd_barrier(xb);
    { EpiRes E; E.src_lat = p.out; E.src_ctx = XC; E.dst_lat = p.out; E.dst_ctx = XC; E.gate = MOD + 5 * DM; E.cm = 0; E.part = (float*)(ws + E_PART);
      run_gemm_split(shm, (const u16*)(ws + E_ACT), (const u16*)(ws + A_FF_OUT0), 1024, 2816, E); }
    xcd_barrier(xb);
    norm_mod_phase(p.out, XC, p.in[I_NORMG] + 2 * DM, MOD1, 0, 1, RT, 1, H, (const float*)(ws + E_PART), 11, MOD + 4 * (NMOD * DM) + 5 * DM, XC);
    xcd_barrier(xb);
    { EpiSsdIn E; E.XBC = (u16*)(ws + E_XBC); E.HALO = (u16*)(ws + A_HALO); E.DTRAW = (float*)(ws + A_DTRAW); run_gemm(shm, H, (const u16*)(ws + B_SSD_INA), RT, 3328, 1024, E); }
    xcd_barrier(xb);
    dt_phase(shm, p);
    conv_phase(p);
    xcd_barrier(xb);
    for (int it = bid; it < 4 * 32 * 4; it += nb) ssd_par_item(shm, p, it);
    xcd_barrier(xb);
    for (int it = bid; it < 4 * 32 * 2; it += nb) {
        const int xcd = it & 7, slot = it >> 3, grp = xcd * 2 + (slot >> 4), idx = slot & 15;
        ssd_item(shm, p, grp >> 2, (grp & 3) * 8 + (idx >> 1), idx & 1); }
    xcd_barrier(xb);
    { EpiBf16Plain E; E.O = (u16*)(ws + E_Z); E.ld = 2048; E.ncols = 2048; run_gemm(shm, H, (const u16*)(ws + B_WZ), RL, 2048, 1024, E); }
    convert_weights_late(shm, p);
    xcd_barrier(xb);
    ssd_finish_phase(p);
    xcd_barrier(xb);
    { EpiRes E; E.src_lat = p.out; E.src_ctx = XC; E.dst_lat = p.out; E.dst_ctx = XC; E.gate = MOD1 + 2 * DM; E.cm = 1; E.part = nullptr;
      run_gemm(shm, (const u16*)(ws + E_Y), (const u16*)(ws + A_SSD_OUT), RL, 1024, 2048, E); }
    xcd_barrier(xb);
    norm_mod_phase(p.out, XC, p.in[I_NORMG] + 3 * DM, MOD1, 3, 4, RL, 0, H);
    xcd_barrier(xb);
    { EpiSwiglu E; E.O = (u16*)(ws + E_ACT); run_gemm(shm, H, (const u16*)(ws + A_FF_IN1), RL, 5632, 1024, E); }
    xcd_barrier(xb);
    { EpiRes E; E.src_lat = p.out; E.src_ctx = XC; E.dst_lat = p.out; E.dst_ctx = XC; E.gate = MOD1 + 5 * DM; E.cm = 0; E.part = nullptr;
      run_gemm(shm, (const u16*)(ws + E_ACT), (const u16*)(ws + A_FF_OUT1), RL, 1024, 2816, E); }
    xcd_barrier(xb);
    final_norm_phase(p.out, p.in[I_FNG]);
}

extern "C" void kernel_launch(void* const* d_in, const int* in_sizes, int n_in, void* d_out, int out_size, void* d_ws, size_t ws_size, hipStream_t stream) {
    static int grid_blocks = 0;
    if (!grid_blocks) {
        int dev = 0, cus = 0, per_cu = 0;
        (void)hipGetDevice(&dev);
        (void)hipDeviceGetAttribute(&cus, hipDeviceAttributeMultiprocessorCount, dev);
        (void)hipFuncSetAttribute((const void*)mega, hipFuncAttributeMaxDynamicSharedMemorySize, LDS_BYTES);
        (void)hipOccupancyMaxActiveBlocksPerMultiprocessor(&per_cu, (const void*)mega, 512, LDS_BYTES);
        if (per_cu < 1) { fprintf(stderr, "occupancy query says %d blocks/CU\n", per_cu); per_cu = 1; }
        if (per_cu > 1) per_cu = 1;
        grid_blocks = cus * per_cu;
        if (ws_size < WS_END) fprintf(stderr, "workspace too small: %zu < %zu\n", ws_size, (size_t)WS_END);
    }
    Params p{};
    for (int i = 0; i < 26; ++i) p.in[i] = (const float*)d_in[i];
    p.out = (float*)d_out; p.ws = (unsigned char*)d_ws;
    (void)hipMemsetAsync((unsigned char*)d_ws + OFF_BAR, 0, XCD_BAR_WORDS * sizeof(unsigned), stream);
    void* args[] = {&p};
    hipError_t e = hipLaunchCooperativeKernel((const void*)mega, dim3(grid_blocks), dim3(512), args, LDS_BYTES, stream);
    if (e != hipSuccess) fprintf(stderr, "cooperative launch failed: %s (grid %d)\n", hipGetErrorString(e), grid_blocks);
}
```

```cpp
#include <hip/hip_runtime.h>
#include <hip/hip_cooperative_groups.h>
#include <cstdio>
namespace cg = cooperative_groups;
namespace pg8 {
#define PG8_LAS __attribute__((address_space(3)))
typedef unsigned short bf16_t;
typedef short bf16x8 __attribute__((ext_vector_type(8)));
typedef float f32x4 __attribute__((ext_vector_type(4)));
typedef unsigned u32x4 __attribute__((ext_vector_type(4)));
constexpr int BM = 256, BK = 64, HALF = 128, HTB = HALF * BK * 2  , STAGE_BYTES = 8 * HTB, NXCD = 8, WGM = 8;

__host__ __device__ __forceinline__ int lds_byte(int r, int c) { const int st = (r >> 4) * 2 + (c >> 5), rr = r & 15, cc = c & 31, ob = rr * 64 + cc * 2; return st * 1024 + (ob ^ (((ob >> 9) & 1) << 5)); }
__host__ __device__ __forceinline__ void stage_rc(int b, int& R, int& C) { const int st = b / 1024, sb = b % 1024, swz = sb ^ (((sb >> 9) & 1) << 5); R = (st >> 1) * 16 + swz / 64; C = (st & 1) * 32 + (swz % 64) / 2; }
__host__ __device__ __forceinline__ int perm32(int rho) { const int n = rho >> 4, i = rho & 15; return 8 * (i >> 2) + 4 * n + (i & 3); }

struct Unit { int pm, pn, kt0, nkt; };
struct Gemm { const bf16_t* A; const bf16_t* Bt; int M, N, K; };

struct StaticOrder {
    int nM, nN, nwg, G, c, nkt_all;
    __host__ __device__ void init(int M, int N, int G_, int c_, int K_ = 0) { nM = M / BM; nN = N / BM; nwg = nM * nN; G = G_; c = c_; nkt_all = K_ / BK; }
    __host__ __device__ bool next(int i, Unit& u) const {
        const long L = (long)i * G + c; if (L >= nwg) return false;
        int wgid = (int)L; { const int q = nwg / NXCD, r = nwg % NXCD, xcd = wgid % NXCD, off = wgid / NXCD; wgid = (xcd < r ? xcd * (q + 1) : r * (q + 1) + (xcd - r) * q) + off; }
        const int nig = WGM * nN, gid = wgid / nig, fm = gid * WGM, gsz = (nM - fm) < WGM ? (nM - fm) : WGM;
        u.pm = fm + ((wgid % nig) % gsz); u.pn = (wgid % nig) / gsz; u.kt0 = 0; u.nkt = nkt_all; return true;
    }
    __device__ __forceinline__ void a_ready(const Unit&) const {}
    __device__ __forceinline__ void done(const Unit&) const {}
};
__device__ __forceinline__ unsigned cvt_pk_bf16(float lo, float hi) { unsigned r; asm volatile("v_cvt_pk_bf16_f32 %0, %1, %2" : "=v"(r) : "v"(lo), "v"(hi)); return r; }
template <class Epi, class Sched, bool STAMP = false>
__device__ __forceinline__ void gemm_phase(PG8_LAS unsigned char* lds, const Gemm g, const Sched& S, const Epi& E, unsigned long long* stamps) {
    int tid_ = threadIdx.x; asm volatile("" : "+v"(tid_)); const int tid = tid_, wid = __builtin_amdgcn_readfirstlane(tid >> 6), lane = tid & 63, wr = wid >> 2, wc = wid & 3, fr = lane & 15, fq = lane >> 4;
    const int K = g.K;
    int ts_lo = 0, ts_hi = 0, nts = 0; const unsigned long long rt_entry = STAMP ? (unsigned long long)wall_clock64() : 0ull;
#define PG8_STAMP() do { if (STAMP && wid == 0 && nts < 64) { const unsigned long long _c = (unsigned long long)clock64(); \
        ts_lo = (lane == nts) ? (int)(unsigned)_c : ts_lo; ts_hi = (lane == nts) ? (int)(unsigned)(_c >> 32) : ts_hi; ++nts; } } while (0)
    PG8_STAMP();
    unsigned voffA[2], voffB[2];
#pragma unroll
    for (int i = 0; i < 2; ++i) { int R, C; stage_rc(tid * 16 + i * 8192, R, C); const int Rb = Epi::PERM ? ((R & ~31) + perm32(R & 31)) : R;
        voffA[i] = (unsigned)(R * K + C) * 2u; voffB[i] = (unsigned)(Rb * K + C) * 2u; }
    const size_t kstep = (size_t)(BK * 2);
    const size_t hstep = (size_t)HALF * K * 2;
    const size_t tstep = 2 * hstep;
    const unsigned ldsw = (unsigned)wid * 1024u;
    const int aoff = lds_byte(wr * 64 + fr, fq * 8), boff = lds_byte(wc * 32 + fr, fq * 8);
#define PG8_SA(b, h) (((b) * 2 + (h)) * HTB)
#define PG8_SB(b, h) ((4 + (b) * 2 + (h)) * HTB)
#define PG8_STAGE(bufoff, gbase, voff) do { _Pragma("unroll") for (int _i = 0; _i < 2; ++_i) \
        __builtin_amdgcn_global_load_lds((const unsigned*)((const char*)(gbase) + (voff)[_i]), (PG8_LAS unsigned*)(lds + (bufoff) + ldsw + _i * 8192), 16, 0, 0); } while (0)
#define PG8_LDA(dst, b, h) do { _Pragma("unroll") for (int m = 0; m < 4; ++m) _Pragma("unroll") for (int k = 0; k < 2; ++k) dst[m][k] = *(const PG8_LAS bf16x8*)(lds + PG8_SA(b, h) + aoff + m * 2048 + k * 1024); } while (0)
#define PG8_LDB(dst, b, h) do { _Pragma("unroll") for (int n = 0; n < 2; ++n) _Pragma("unroll") for (int k = 0; k < 2; ++k) dst[n][k] = *(const PG8_LAS bf16x8*)(lds + PG8_SB(b, h) + boff + n * 2048 + k * 1024); } while (0)
#define PG8_MMA(ai, bj, At, Bt) do { __builtin_amdgcn_s_setprio(1); _Pragma("unroll") for (int m = 0; m < 4; ++m) _Pragma("unroll") for (int n = 0; n < 2; ++n) _Pragma("unroll") for (int k = 0; k < 2; ++k) \
        acc[ai][bj][m][n] = __builtin_amdgcn_mfma_f32_16x16x32_bf16(Bt[n][k], At[m][k], acc[ai][bj][m][n], 0, 0, 0); __builtin_amdgcn_s_setprio(0); } while (0)
#define PG8_WAIT_V(n) asm volatile("s_waitcnt vmcnt(" #n ")" ::: "memory")
#define PG8_WAIT_L(n) asm volatile("s_waitcnt lgkmcnt(" #n ")" ::: "memory")
#define PG8_BAR __builtin_amdgcn_s_barrier()
#define PG8_SCHED __builtin_amdgcn_sched_barrier(0)
    Unit cur, nxt; int ui = 0;
    if (!S.next(0, cur)) return;
    f32x4 acc[2][2][4][2];
#pragma unroll
    for (int a = 0; a < 2; ++a)
#pragma unroll
        for (int b = 0; b < 2; ++b)
#pragma unroll
            for (int m = 0; m < 4; ++m)
#pragma unroll
                for (int n = 0; n < 2; ++n) acc[a][b][m][n] = (f32x4){0.f, 0.f, 0.f, 0.f};
    bf16x8 At[4][2], B0[2][2], B1[2][2];
    const char* cA = (const char*)g.A + (size_t)cur.pm * tstep + (size_t)cur.kt0 * kstep; const char* cB = (const char*)g.Bt + (size_t)cur.pn * tstep + (size_t)cur.kt0 * kstep;
    S.a_ready(cur);
    PG8_STAGE(PG8_SB(0, 0), cB, voffB); PG8_STAGE(PG8_SA(0, 0), cA, voffA); PG8_STAGE(PG8_SB(0, 1), cB + hstep, voffB); PG8_STAGE(PG8_SA(0, 1), cA + hstep, voffA);
    if (wr == 1) PG8_BAR;
    PG8_WAIT_V(4); PG8_BAR;
    PG8_STAGE(PG8_SB(1, 0), cB + kstep, voffB); PG8_STAGE(PG8_SA(1, 0), cA + kstep, voffA); PG8_STAGE(PG8_SB(1, 1), cB + hstep + kstep, voffB);
    PG8_WAIT_V(6); PG8_BAR;
    PG8_STAMP();
    for (;;) {
        const bool has_next = S.next(ui + 1, nxt);
        const char* nA = has_next ? (const char*)g.A + (size_t)nxt.pm * tstep + (size_t)nxt.kt0 * kstep : cA; const char* nB = has_next ? (const char*)g.Bt + (size_t)nxt.pn * tstep + (size_t)nxt.kt0 * kstep : cB;
        const int nt = cur.nkt;
        for (int t = 0; t < nt; t += 2) {
            const bool last = (t == nt - 2);
            const char* a1 = cA + (size_t)(t + 1) * kstep;
            const char* a2 = last ? nA : cA + (size_t)(t + 2) * kstep; const char* b2 = last ? nB : cB + (size_t)(t + 2) * kstep;
            const char* a3 = a2 + kstep; const char* b3 = b2 + kstep;
            if (last && has_next) S.a_ready(nxt);
            PG8_LDB(B0, 0, 0); PG8_SCHED; PG8_LDA(At, 0, 0); PG8_STAGE(PG8_SA(1, 1), a1 + hstep, voffA);
            PG8_WAIT_L(8); PG8_BAR; PG8_WAIT_L(0); PG8_MMA(0, 0, At, B0); PG8_BAR; PG8_SCHED;
            PG8_LDB(B1, 0, 1); PG8_STAGE(PG8_SB(0, 0), b2, voffB);
            PG8_BAR; PG8_WAIT_L(0); PG8_MMA(0, 1, At, B1); PG8_BAR;
            PG8_LDA(At, 0, 1); PG8_STAGE(PG8_SA(0, 0), a2, voffA);
            PG8_BAR; PG8_WAIT_L(0); PG8_MMA(1, 0, At, B0); PG8_BAR; PG8_SCHED;
            PG8_STAGE(PG8_SB(0, 1), b2 + hstep, voffB);
            PG8_WAIT_V(6); PG8_BAR; PG8_MMA(1, 1, At, B1); PG8_BAR;
            PG8_LDB(B0, 1, 0); PG8_SCHED; PG8_LDA(At, 1, 0); PG8_STAGE(PG8_SA(0, 1), a2 + hstep, voffA);
            PG8_WAIT_L(8); PG8_BAR; PG8_WAIT_L(0); PG8_MMA(0, 0, At, B0); PG8_BAR; PG8_SCHED;
            PG8_LDB(B1, 1, 1); PG8_STAGE(PG8_SB(1, 0), b3, voffB);
            PG8_BAR; PG8_WAIT_L(0); PG8_MMA(0, 1, At, B1); PG8_BAR;
            PG8_LDA(At, 1, 1); PG8_STAGE(PG8_SA(1, 0), a3, voffA);
            PG8_BAR; PG8_WAIT_L(0); PG8_MMA(1, 0, At, B0); PG8_BAR; PG8_SCHED;
            PG8_STAGE(PG8_SB(1, 1), b3 + hstep, voffB);
            PG8_WAIT_V(6); PG8_BAR; PG8_MMA(1, 1, At, B1); PG8_BAR;
        }
        PG8_STAMP();
        if constexpr (!Epi::AFTER_DRAIN) { E(acc, cur, wr, wc, fr, fq); S.done(cur); }
        PG8_STAMP();
        if (!has_next) break;
#pragma unroll
        for (int a = 0; a < 2; ++a)
#pragma unroll
            for (int b = 0; b < 2; ++b)
#pragma unroll
                for (int m = 0; m < 4; ++m)
#pragma unroll
                    for (int n = 0; n < 2; ++n) acc[a][b][m][n] = (f32x4){0.f, 0.f, 0.f, 0.f};
        cur = nxt; cA = nA; cB = nB; ++ui;
    }
    PG8_WAIT_V(0);
    if (wr == 0) PG8_BAR;
    PG8_BAR;
    if constexpr (Epi::AFTER_DRAIN) { E.fused(acc, cur, wr, wc, fr, fq, lds, wid, lane); S.done(cur); }
    PG8_STAMP();
    if (STAMP && wid == 0) { stamps[lane] = lane < nts ? (((unsigned long long)(unsigned)ts_hi << 32) | (unsigned)ts_lo) : 0ull;
        if (lane == 62) stamps[62] = rt_entry; if (lane == 63) stamps[63] = (unsigned long long)wall_clock64(); }
#undef PG8_STAMP
#undef PG8_SA
#undef PG8_SB
#undef PG8_STAGE
#undef PG8_LDA
#undef PG8_LDB
#undef PG8_MMA
#undef PG8_WAIT_V
#undef PG8_WAIT_L
#undef PG8_BAR
#undef PG8_SCHED
}
}

#define XB_TMO      128
#define XB_XCNT(j)  (256  + 64 * (j))
#define XB_XSUB(j)  (1280 + 64 * (j))
#define XB_XGEN(j)  (2304 + 64 * (j))
#define XB_TOP      3328
#define XB_TOPGEN   3392
#define XCD_BAR_WORDS 3456
#define XB_SPIN_CAP (1u << 18)
#define LAS __attribute__((address_space(3)))

__device__ __forceinline__ unsigned xb_ld(unsigned* p)              { return __hip_atomic_load(p, __ATOMIC_RELAXED, __HIP_MEMORY_SCOPE_AGENT); }
__device__ __forceinline__ unsigned xb_add(unsigned* p, unsigned v) { return __hip_atomic_fetch_add(p, v, __ATOMIC_RELAXED, __HIP_MEMORY_SCOPE_AGENT); }
__device__ __forceinline__ unsigned xb_xcc_id() { return (unsigned)__builtin_amdgcn_s_getreg((3 << 11) | 20) & 0xFu; }
#define XB_SPIN(cond, bar) do { unsigned _sp = 0; while (cond) { __builtin_amdgcn_s_sleep(1); \
    if ((++_sp & 255u) == 0u) { if (xb_ld(&(bar)[XB_TMO])) break; if (_sp > XB_SPIN_CAP) { atomicAdd(&(bar)[XB_TMO], 1u); break; } } } } while (0)

struct XcdBarrier {
    unsigned* bar; unsigned x;
    volatile LAS unsigned* st;
};

__device__ __forceinline__ XcdBarrier xcd_barrier_post(unsigned* bar, volatile LAS unsigned* st) {
    XcdBarrier b; b.bar = bar; b.x = xb_xcc_id(); b.st = st;
    if (threadIdx.x == 0) (void)xb_add(&bar[XB_XCNT(b.x)], 1u);
    return b;
}
__device__ __forceinline__ void xcd_barrier_complete(unsigned* bar, unsigned x, unsigned& nloc, unsigned& nx) {
    const unsigned G = gridDim.x * gridDim.y * gridDim.z;
    unsigned sum, cnt, mine, sp = 0u;
    for (;;) {
        sum = 0u; cnt = 0u; mine = 0u;
#pragma unroll
        for (unsigned j = 0; j < 16; ++j) { const unsigned c = xb_ld(&bar[XB_XCNT(j)]); sum += c; cnt += (c > 0u) ? 1u : 0u; mine = (j == x) ? c : mine; }
        if (sum == G) break;
        __builtin_amdgcn_s_sleep(1);
        if ((++sp & 255u) == 0u) { if (xb_ld(&bar[XB_TMO])) break; if (sp > XB_SPIN_CAP) { atomicAdd(&bar[XB_TMO], 1u); break; } }
    }
    nloc = mine > 0u ? mine : 1u; nx = cnt > 0u ? cnt : 1u;
}

__device__ __attribute__((noinline)) void xcd_barrier_impl(unsigned* bar_, unsigned x_, volatile LAS unsigned* st_) {
    XcdBarrier b; b.bar = bar_; b.x = x_; b.st = st_;
    asm volatile("s_waitcnt vmcnt(0)" ::: "memory");
    __syncthreads();
    if (threadIdx.x == 0) {
        unsigned* bar = b.bar;
        __builtin_amdgcn_s_waitcnt(0);
        unsigned nloc = b.st[0], nx = b.st[1];
        if (nloc == 0u) { xcd_barrier_complete(bar, b.x, nloc, nx); b.st[0] = nloc; b.st[1] = nx; }
        const unsigned old = xb_add(&bar[XB_XSUB(b.x)], 1u);
        const unsigned gen = old / nloc;
        if (old + 1u == (gen + 1u) * nloc) {
            __builtin_amdgcn_fence(__ATOMIC_RELEASE, "agent");
            asm volatile("s_waitcnt vmcnt(0)" ::: "memory");
            const unsigned og = xb_add(&bar[XB_TOP], 1u);
            const unsigned tg = og / nx;
            if (og + 1u == (tg + 1u) * nx) xb_add(&bar[XB_TOPGEN], 1u);
            else XB_SPIN(xb_ld(&bar[XB_TOPGEN]) == tg, bar);
            __builtin_amdgcn_fence(__ATOMIC_ACQUIRE, "agent");
            xb_add(&bar[XB_XGEN(b.x)], 1u);
            asm volatile("s_waitcnt vmcnt(0)" ::: "memory");
        } else {
            XB_SPIN(xb_ld(&bar[XB_XGEN(b.x)]) == gen, bar);
            __builtin_amdgcn_fence(__ATOMIC_ACQUIRE, "agent");
            asm volatile("s_waitcnt vmcnt(0)" ::: "memory");
        }
    }
    __syncthreads();
}

__device__ __forceinline__ void xcd_barrier(const XcdBarrier& b) { xcd_barrier_impl(b.bar, b.x, b.st); }

typedef unsigned short u16;
using pg8::bf16x8; using pg8::f32x4;
typedef unsigned u32x2 __attribute__((ext_vector_type(2)));
typedef unsigned u32x4v __attribute__((ext_vector_type(4)));

constexpr int DM = 1024, NB = 4, SEQ = 4096, CTXL = 256, RL = NB * SEQ, RC = NB * CTXL, RT = RL + RC;
constexpr int DFF = 2816, NMOD = 6;
constexpr int P0_LD = 2592;
constexpr int P0_K = 0, P0_V = 256, P0_LR = 768, P0_Q = 800, P0_R = 1056, P0_U = 1568, P0_G = 2080;
constexpr int XBC_LD = 3072;
constexpr float EPS = 1e-6f;

constexpr size_t OFF_MOD = 0;
constexpr size_t OFF_A = 262144;
constexpr size_t A_AB_IN = OFF_A, A_AB_OUT = A_AB_IN + (size_t)2816 * 1024 * 2, A_FF_IN0 = A_AB_OUT + (size_t)1024 * 1024 * 2, A_FF_OUT0 = A_FF_IN0 + (size_t)5632 * 1024 * 2;
constexpr size_t A_END = A_FF_OUT0 + (size_t)1024 * 2816 * 2;
constexpr size_t A_DTRAW = OFF_A, A_HALO = A_DTRAW + (size_t)RT * 64 * 4;
constexpr size_t A_SSD_OUT = OFF_A, A_FF_IN1 = A_SSD_OUT + (size_t)1024 * 2048 * 2, A_FF_OUT1 = A_FF_IN1 + (size_t)5632 * 1024 * 2;
constexpr size_t OFF_B = A_END;
constexpr size_t B_SSD_INA = OFF_B, B_WZ = B_SSD_INA + (size_t)3328 * 1024 * 2, B_END = B_WZ + (size_t)2048 * 1024 * 2;
constexpr size_t OFF_XC = B_END;
constexpr size_t OFF_H = OFF_XC + (size_t)RC * DM * 4;
constexpr size_t OFF_DSC = OFF_H + (size_t)RT * DM * 2;
constexpr size_t OFF_DEC = OFF_DSC + (size_t)4 * 2 * 4 * 4 * 8192 * 4;
constexpr size_t OFF_E = OFF_DEC + (size_t)4 * 2 * 4 * 68 * 64 * 4;
constexpr size_t E_P0 = OFF_E, E_ACT = OFF_E, E_XBC = OFF_E, E_Z = OFF_E;
constexpr size_t E_Y = OFF_E + (size_t)RT * XBC_LD * 2;
constexpr size_t T_DT = E_Y + (size_t)RL * 2048 * 2, T_ACUM = T_DT + (size_t)RT * 64 * 4;
constexpr size_t WS_END = T_ACUM + (size_t)RT * 64 * 4;
constexpr size_t E_PART = OFF_E + (size_t)100 * 1024 * 1024;
constexpr size_t A_CB = OFF_A;
static_assert(A_HALO + (size_t)272 * 4 * 3072 * 2 <= A_END && A_FF_OUT1 + (size_t)1024 * 2816 * 2 <= A_END && A_CB + (size_t)512 * 16384 * 2 <= A_END, "region A overflow");
static_assert(WS_END <= (size_t)256 * 1024 * 1024, "workspace over 256 MiB");

constexpr int LDS_BYTES = 144 * 1024;
constexpr int LDS_XB = LDS_BYTES - 16;
constexpr size_t OFF_BAR = 245760;

struct Params { const float* in[26]; float* out; unsigned char* ws; };
enum { I_X = 0, I_C, I_CTX, I_CCTX, I_MODW, I_MODB, I_NORMG, I_FFWIN, I_FFWOUT, I_ABWIN, I_ABGW, I_ABGB, I_ABGNG, I_ABVNG, I_ABSW, I_ABSB, I_ABWOUT,
       I_SSDWIN, I_SSDCW, I_SSDCB, I_SSDDTB, I_SSDALOG, I_SSDD, I_SSDNG, I_SSDWOUT, I_FNG };

__device__ __forceinline__ u16 f2bf(float f) { return __builtin_bit_cast(u16, (__bf16)f); }
__device__ __forceinline__ float bf2f(unsigned b) { return __uint_as_float(b << 16); }
typedef float f32x2v __attribute__((ext_vector_type(2)));
typedef __bf16 bf16x2v __attribute__((ext_vector_type(2)));
__device__ __forceinline__ unsigned pk2(float lo, float hi) { const f32x2v v = {lo, hi}; return __builtin_bit_cast(unsigned, __builtin_convertvector(v, bf16x2v)); }
__device__ __forceinline__ float bflo(unsigned w) { return __uint_as_float(w << 16); }
__device__ __forceinline__ float bfhi(unsigned w) { return __uint_as_float(w & 0xFFFF0000u); }
__device__ __forceinline__ float siluf(float x) { return x * __builtin_amdgcn_rcpf(1.0f + __expf(-x)); }
__device__ __forceinline__ float geluf(float x) { const float y = 0.7978845608028654f * (x + 0.044715f * x * x * x); const float th = 1.0f - 2.0f * __builtin_amdgcn_rcpf(1.0f + __expf(2.0f * y)); return 0.5f * x * (1.0f + th); }
__device__ __forceinline__ float softplusf(float x) { return fmaxf(x, 0.f) + log1pf(__expf(-fabsf(x))); }
__device__ __forceinline__ float logsigmoidf(float x) { return fminf(x, 0.f) - __logf(1.0f + __expf(-fabsf(x))); }
__device__ __forceinline__ float wave_sum(float v) {
#pragma unroll
    for (int o = 32; o > 0; o >>= 1) v += __shfl_xor(v, o, 64);
    return v;
}

template <int MT, int NT>
__device__ __forceinline__ void wave_mma(f32x4 (&acc)[MT][NT], const u16* A, int lda, const u16* B, int ldb, int ksteps) {
    const int lane = threadIdx.x & 63, fr = lane & 15, fq = lane >> 4;
    const u16* ap = A + fr * lda + fq * 8; const u16* bp = B + fr * ldb + fq * 8;
    for (int k = 0; k < ksteps; ++k) {
        bf16x8 a[MT], b[NT];
#pragma unroll
        for (int i = 0; i < MT; ++i) a[i] = *(const bf16x8*)(ap + i * 16 * lda + k * 32);
#pragma unroll
        for (int i = 0; i < NT; ++i) b[i] = *(const bf16x8*)(bp + i * 16 * ldb + k * 32);
#pragma unroll
        for (int i = 0; i < MT; ++i)
#pragma unroll
            for (int j = 0; j < NT; ++j) acc[i][j] = __builtin_amdgcn_mfma_f32_16x16x32_bf16(a[i], b[j], acc[i][j], 0, 0, 0);
    }
}
template <int MT, int NT> __device__ __forceinline__ void zero_acc(f32x4 (&acc)[MT][NT]) {
#pragma unroll
    for (int i = 0; i < MT; ++i)
#pragma unroll
        for (int j = 0; j < NT; ++j) acc[i][j] = (f32x4){0.f, 0.f, 0.f, 0.f};
}

__device__ __forceinline__ u32x4v pack8(const f32x4& a, const f32x4& b) { u32x4v r; r[0] = pk2(a[0], a[1]); r[1] = pk2(a[2], a[3]); r[2] = pk2(b[0], b[1]); r[3] = pk2(b[2], b[3]); return r; }

struct EpiBf16Plain {
    static constexpr bool PERM = true, AFTER_DRAIN = false;
    u16* O; int ld; int ncols;
    __device__ __forceinline__ void operator()(const f32x4 (&acc)[2][2][4][2], const pg8::Unit& u, int wr, int wc, int fr, int fq) const {
        const int row0 = u.pm * 256 + wr * 64 + fr, col0 = u.pn * 256 + wc * 32 + 8 * fq;
#pragma unroll
        for (int ai = 0; ai < 2; ++ai)
#pragma unroll
            for (int m = 0; m < 4; ++m) { const int row = row0 + ai * 128 + m * 16;
#pragma unroll
                for (int bj = 0; bj < 2; ++bj) { const int c = col0 + bj * 128; if (c < ncols) *(u32x4v*)(O + (size_t)row * ld + c) = pack8(acc[ai][bj][m][0], acc[ai][bj][m][1]); } }
    }
};
struct EpiSwiglu {
    static constexpr bool PERM = true, AFTER_DRAIN = false;
    u16* O;
    __device__ __forceinline__ void operator()(const f32x4 (&acc)[2][2][4][2], const pg8::Unit& u, int wr, int wc, int fr, int fq) const {
        const int row0 = u.pm * 256 + wr * 64 + fr, j0 = u.pn * 128 + wc * 32 + 8 * fq;
#pragma unroll
        for (int ai = 0; ai < 2; ++ai)
#pragma unroll
            for (int m = 0; m < 4; ++m) { const int row = row0 + ai * 128 + m * 16; f32x4 o0, o1;
#pragma unroll
                for (int i = 0; i < 4; ++i) { o0[i] = siluf(acc[ai][0][m][0][i]) * acc[ai][1][m][0][i]; o1[i] = siluf(acc[ai][0][m][1][i]) * acc[ai][1][m][1][i]; }
                *(u32x4v*)(O + (size_t)row * DFF + j0) = pack8(o0, o1); }
    }
};
struct EpiSsdIn {
    static constexpr bool PERM = true, AFTER_DRAIN = false;
    u16* XBC; u16* HALO; float* DTRAW;
    __device__ __forceinline__ void operator()(const f32x4 (&acc)[2][2][4][2], const pg8::Unit& u, int wr, int wc, int fr, int fq) const {
        const int row0 = u.pm * 256 + wr * 64 + fr, col0 = u.pn * 256 + wc * 32 + 8 * fq;
#pragma unroll
        for (int ai = 0; ai < 2; ++ai)
#pragma unroll
            for (int m = 0; m < 4; ++m) { const int row = row0 + ai * 128 + m * 16; const int rr = row & 63; const int slot = rr < 2 ? rr : (rr >= 62 ? rr - 60 : -1);
#pragma unroll
                for (int bj = 0; bj < 2; ++bj) { const int c = col0 + bj * 128;
                    if (c < 3072) { const u32x4v v = pack8(acc[ai][bj][m][0], acc[ai][bj][m][1]); *(u32x4v*)(XBC + (size_t)row * XBC_LD + c) = v;
                        if (slot >= 0) *(u32x4v*)(HALO + ((size_t)(row >> 6) * 4 + slot) * XBC_LD + c) = v; }
                    else if (c < 3136) { float* d = DTRAW + (size_t)row * 64 + (c - 3072); *(f32x4*)d = acc[ai][bj][m][0]; *(f32x4*)(d + 4) = acc[ai][bj][m][1]; } } }
    }
};
struct EpiRes {
    static constexpr bool PERM = false, AFTER_DRAIN = false;
    const float* src_lat; const float* src_ctx; float* dst_lat; float* dst_ctx; const float* gate; int cm; float* part;
    __device__ __forceinline__ void operator()(const f32x4 (&acc)[2][2][4][2], const pg8::Unit& u, int wr, int wc, int fr, int fq) const {
        const int row0 = u.pm * 256 + wr * 64 + fr, col0 = u.pn * 256 + wc * 32 + 4 * fq;
#pragma unroll
        for (int ai = 0; ai < 2; ++ai)
#pragma unroll
            for (int m = 0; m < 4; ++m) { const int row = row0 + ai * 128 + m * 16; const float* s; float* d; int mi;
                if (row < RL) { const int xr = cm ? ((row & ~4095) | ((row & 63) << 6) | ((row >> 6) & 63)) : row; s = src_lat + (size_t)xr * DM; d = dst_lat + (size_t)xr * DM; mi = row >> 12; }
                else { s = src_ctx + (size_t)(row - RL) * DM; d = dst_ctx + (size_t)(row - RL) * DM; mi = 4; }
                const float* gt = gate + mi * (NMOD * DM);
                if (part != nullptr && row >= RL) { float* pd = part + ((size_t)(u.kt0 >> 2) * RC + (row - RL)) * DM;
#pragma unroll
                    for (int bj = 0; bj < 2; ++bj)
#pragma unroll
                        for (int n = 0; n < 2; ++n) { const int c = col0 + bj * 128 + n * 16; *(f32x4*)(pd + c) = acc[ai][bj][m][n]; }
                    continue; }
#pragma unroll
                for (int bj = 0; bj < 2; ++bj)
#pragma unroll
                    for (int n = 0; n < 2; ++n) { const int c = col0 + bj * 128 + n * 16; const f32x4 g4 = *(const f32x4*)(gt + c), x4 = *(const f32x4*)(s + c);
                        *(f32x4*)(d + c) = x4 + g4 * acc[ai][bj][m][n]; } }
    }
};

template <class Epi> __device__ __forceinline__ void run_gemm(unsigned char* shm, const u16* A, const u16* Bt, int M, int N, int K, const Epi& E) {
    pg8::Gemm g; g.A = A; g.Bt = Bt; g.M = M; g.N = N; g.K = K;
    pg8::StaticOrder S; S.init(M, N, (int)gridDim.x, (int)blockIdx.x, K);
    pg8::gemm_phase<Epi, pg8::StaticOrder, false>((PG8_LAS unsigned char*)shm, g, S, E, nullptr);
}

struct SplitOrder {
    pg8::StaticOrder lat; int nlat, nsl, nctx, G, c, nN;
    __device__ void init(int N, int K, int G_, int c_) { lat.init(RL, N, G_, c_, K); nlat = lat.nwg; nN = N / 256; nsl = (K / 64) / 4; nctx = (RC / 256) * nN * nsl; G = G_; c = c_; }
    __device__ bool next(int i, pg8::Unit& u) const {
        const long L = (long)i * G + c; if (L < nlat) return lat.next(i, u);
        const int j = (int)(L - nlat); if (j >= nctx) return false;
        const int sl = j % nsl, tile = j / nsl; u.pm = RL / 256 + tile / nN; u.pn = tile % nN; u.kt0 = sl * 4; u.nkt = 4; return true; }
    __device__ __forceinline__ void a_ready(const pg8::Unit&) const {}
    __device__ __forceinline__ void done(const pg8::Unit&) const {}
};
template <class Epi> __device__ __forceinline__ void run_gemm_split(unsigned char* shm, const u16* A, const u16* Bt, int N, int K, const Epi& E) {
    pg8::Gemm g; g.A = A; g.Bt = Bt; g.M = RT; g.N = N; g.K = K;
    SplitOrder S; S.init(N, K, (int)gridDim.x, (int)blockIdx.x);
    pg8::gemm_phase<Epi, SplitOrder, false>((PG8_LAS unsigned char*)shm, g, S, E, nullptr);
}

__device__ __forceinline__ int wcol(int r, int N, int mode) {
    if (mode == 0) return r < N ? r : -1;
    if (mode == 1) { const int q = r >> 8, s = (r >> 7) & 1, i = r & 127; return s * DFF + 128 * q + i; }
    if (mode == 2) return r + 3136;
    return r < 3136 ? r : -1;
}
__device__ __forceinline__ void convert_tile(unsigned char* shm, const float* src, u16* dst, int K, int N, int mode, int ti) {
    u16* tile = (u16*)shm;
    const int t = threadIdx.x, rl = t & 63, k0 = t >> 6, r2 = t >> 3, kk = (t & 7) * 8;
    const int nkt = K >> 7, rb = (ti / nkt) << 6, kb = (ti % nkt) << 7;
    const int col = wcol(rb + rl, N, mode);
    const float* sp = src + (size_t)(kb + k0) * N + (col >= 0 ? col : 0);
    float v[16];
#pragma unroll
    for (int i = 0; i < 16; ++i) v[i] = sp[(size_t)(8 * i) * N];
#pragma unroll
    for (int i = 0; i < 16; ++i) tile[rl * 136 + k0 + 8 * i] = f2bf(col >= 0 ? v[i] : 0.f);
    __syncthreads();
    *(u32x4v*)(dst + (size_t)(rb + r2) * K + kb + kk) = *(const u32x4v*)(tile + r2 * 136 + kk);
    *(u32x4v*)(dst + (size_t)(rb + r2) * K + kb + 64 + kk) = *(const u32x4v*)(tile + r2 * 136 + 64 + kk);
    __syncthreads();
}
constexpr int wtiles(int NR, int K) { return (NR / 64) * (K / 128); }
__device__ void convert_weights_early(unsigned char* shm, const Params& p) {
    unsigned char* ws = p.ws;
    constexpr int T0 = wtiles(5632, 1024), T1 = wtiles(1024, 2816), T2 = wtiles(3328, 1024), T3 = wtiles(2816, 1024), T4 = wtiles(2048, 1024), T5 = wtiles(1024, 1024);
    for (int gi = blockIdx.x; gi < T0 + T1 + T2 + T3 + T4 + T5; gi += gridDim.x) {
        int ti = gi;
        if (ti < T0) { convert_tile(shm, p.in[I_FFWIN], (u16*)(ws + A_FF_IN0), 1024, 5632, 1, ti); continue; } ti -= T0;
        if (ti < T1) { convert_tile(shm, p.in[I_FFWOUT], (u16*)(ws + A_FF_OUT0), 2816, 1024, 0, ti); continue; } ti -= T1;
        if (ti < T2) { convert_tile(shm, p.in[I_SSDWIN], (u16*)(ws + B_SSD_INA), 1024, 5184, 3, ti); continue; } ti -= T2;
        if (ti < T3) { convert_tile(shm, p.in[I_ABWIN], (u16*)(ws + A_AB_IN), 1024, 2592, 0, ti); continue; } ti -= T3;
        if (ti < T4) { convert_tile(shm, p.in[I_SSDWIN], (u16*)(ws + B_WZ), 1024, 5184, 2, ti); continue; } ti -= T4;
        convert_tile(shm, p.in[I_ABWOUT], (u16*)(ws + A_AB_OUT), 1024, 1024, 0, ti);
    }
}
__device__ void convert_weights_late(unsigned char* shm, const Params& p) {
    unsigned char* ws = p.ws;
    constexpr int T0 = wtiles(5632, 1024), T1 = wtiles(1024, 2816), T2 = wtiles(1024, 2048);
    for (int gi = blockIdx.x; gi < T0 + T1 + T2; gi += gridDim.x) {
        int ti = gi;
        if (ti < T0) { convert_tile(shm, p.in[I_FFWIN] + (size_t)1024 * 5632, (u16*)(ws + A_FF_IN1), 1024, 5632, 1, ti); continue; } ti -= T0;
        if (ti < T1) { convert_tile(shm, p.in[I_FFWOUT] + (size_t)2816 * 1024, (u16*)(ws + A_FF_OUT1), 2816, 1024, 0, ti); continue; } ti -= T1;
        convert_tile(shm, p.in[I_SSDWOUT], (u16*)(ws + A_SSD_OUT), 2048, 1024, 0, ti);
    }
}
__device__ void mod_gemv(unsigned char* shm, const Params& p) {
    float* sc = (float*)shm;
    float* red = sc + 5 * 1024;
    const int t = threadIdx.x;
    for (int i = t; i < 5 * 1024; i += 512) { const float v = i < 4096 ? p.in[I_C][i] : p.in[I_CCTX][i - 4096]; sc[i] = siluf(v); }
    __syncthreads();
    float* MOD = (float*)(p.ws + OFF_MOD);
    const int n = t & 31, kc = t >> 5;
    for (int job = blockIdx.x; job < 2 * 192; job += gridDim.x) {
        const int l = job / 192, nb = (job % 192) * 32;
        const float* W = p.in[I_MODW] + (size_t)l * DM * (NMOD * DM) + nb + n;
        float a[5] = {0.f, 0.f, 0.f, 0.f, 0.f};
#pragma unroll 16
        for (int i = 0; i < 64; ++i) { const int k = kc + 16 * i; const float w = W[(size_t)k * (NMOD * DM)];
#pragma unroll
            for (int m = 0; m < 5; ++m) a[m] += sc[m * 1024 + k] * w; }
#pragma unroll
        for (int m = 0; m < 5; ++m) red[(kc * 5 + m) * 32 + n] = a[m];
        __syncthreads();
        if (t < 160) { const int m = t >> 5; float s = 0.f;
#pragma unroll
            for (int q = 0; q < 16; ++q) s += red[(q * 5 + m) * 32 + n];
            MOD[((size_t)l * 5 + m) * (NMOD * DM) + nb + n] = s + p.in[I_MODB][(size_t)l * (NMOD * DM) + nb + n]; }
        __syncthreads();
    }
}

__device__ void norm_mod_phase(const float* lat, const float* ctx, const float* ng, const float* modl  , int ishift, int iscale, int nrows, int cm, u16* H, const float* part = nullptr, int nsl = 0, const float* pgate = nullptr, float* xc_out = nullptr) {
    const int lane = threadIdx.x & 63, wid = threadIdx.x >> 6;
    for (int row = blockIdx.x * 8 + wid; row < nrows; row += gridDim.x * 8) {
        const float* s = row < RL ? lat + (size_t)row * DM : ctx + (size_t)(row - RL) * DM;
        const int mi = row < RL ? (row >> 12) : 4;
        f32x4 v[4], pg[4], psh[4], psc[4]; float ss = 0.f;
        const float* sh = modl + mi * (NMOD * DM) + ishift * DM; const float* scp = modl + mi * (NMOD * DM) + iscale * DM;
#pragma unroll
        for (int i = 0; i < 4; ++i) v[i] = *(const f32x4*)(s + i * 256 + lane * 4);
#pragma unroll
        for (int i = 0; i < 4; ++i) { const int c = i * 256 + lane * 4; pg[i] = *(const f32x4*)(ng + c); psh[i] = *(const f32x4*)(sh + c); psc[i] = *(const f32x4*)(scp + c); }
#pragma unroll
        for (int i = 0; i < 4; ++i) ss += v[i][0] * v[i][0] + v[i][1] * v[i][1] + v[i][2] * v[i][2] + v[i][3] * v[i][3];
        if (part != nullptr && row >= RL) {
            ss = 0.f;
#pragma unroll
            for (int i = 0; i < 4; ++i) { const int c = i * 256 + lane * 4; f32x4 a = {0.f, 0.f, 0.f, 0.f};
                for (int sl = 0; sl < nsl; ++sl) a += *(const f32x4*)(part + ((size_t)sl * RC + (row - RL)) * DM + c);
                v[i] += *(const f32x4*)(pgate + c) * a; *(f32x4*)(xc_out + (size_t)(row - RL) * DM + c) = v[i];
                ss += v[i][0] * v[i][0] + v[i][1] * v[i][1] + v[i][2] * v[i][2] + v[i][3] * v[i][3]; } }
        ss = wave_sum(ss);
        const float rs = rsqrtf(ss * (1.0f / DM) + EPS);
        const int dr = (cm && row < RL) ? ((row & ~4095) | ((row & 63) << 6) | ((row >> 6) & 63)) : row;
#pragma unroll
        for (int i = 0; i < 4; ++i) { const int c = i * 256 + lane * 4; const f32x4 g4 = pg[i], sh4 = psh[i], sc4 = psc[i];
            float o[4];
#pragma unroll
            for (int e = 0; e < 4; ++e) o[e] = (v[i][e] * rs * g4[e]) * (1.0f + sc4[e]) + sh4[e];
            u32x2 w; w[0] = pk2(o[0], o[1]); w[1] = pk2(o[2], o[3]); *(u32x2*)(H + (size_t)dr * DM + c) = w; }
    }
}
__device__ void final_norm_phase(float* X, const float* g) {
    const int lane = threadIdx.x & 63, wid = threadIdx.x >> 6;
    for (int row = blockIdx.x * 8 + wid; row < RL; row += gridDim.x * 8) {
        float* s = X + (size_t)row * DM; f32x4 v[4]; float ss = 0.f;
#pragma unroll
        for (int i = 0; i < 4; ++i) { v[i] = *(const f32x4*)(s + i * 256 + lane * 4); ss += v[i][0] * v[i][0] + v[i][1] * v[i][1] + v[i][2] * v[i][2] + v[i][3] * v[i][3]; }
        ss = wave_sum(ss);
        const float rs = rsqrtf(ss * (1.0f / DM) + EPS);
#pragma unroll
        for (int i = 0; i < 4; ++i) { const int c = i * 256 + lane * 4; const f32x4 g4 = *(const f32x4*)(g + c); f32x4 o;
#pragma unroll
            for (int e = 0; e < 4; ++e) o[e] = (v[i][e] * rs) * g4[e];
            *(f32x4*)(s + c) = o; }
    }
}

__device__ __forceinline__ int gla_rowbase(int b, int c) { return c < 4 ? RL + b * CTXL + c * 64 : b * SEQ + (c - 4) * 64; }
__device__ __forceinline__ float* gla_ds_ptr(const Params& p, int b, int d, int h, int c) {
    return c < 4 ? (float*)(p.ws + OFF_DSC) + ((size_t)((b * 2 + d) * 4 + h) * 4 + c) * 8192 : p.out + ((size_t)((b * 2 + d) * 4 + h) * 64 + (c - 4)) * 8192;
}
constexpr int GL_BC = 0;
constexpr int GL_LR = GL_BC + 2 * 64 * 65 * 4;
constexpr int GL_GW = GL_LR + 64 * 32 * 4;
constexpr int GL_X0 = GL_GW + 2 * 16 * 64 * 4;
constexpr int GL_LD = 72;

__device__ void gla_gates(unsigned char* shm, const Params& p, int rowbase, int h) {
    const u16* P0 = (const u16*)(p.ws + E_P0);
    float* BC = (float*)(shm + GL_BC); float* LR = (float*)(shm + GL_LR); float* QS = (float*)(shm + GL_GW);
    const int t = threadIdx.x;
    const int kk = t & 63, lq = (t >> 6) & 3, d = t >> 8;
    float gw[16];
#pragma unroll
    for (int j = 0; j < 16; ++j) gw[j] = p.in[I_ABGW][(size_t)(d * 16 + j) * 256 + h * 64 + kk];
    const float gb = p.in[I_ABGB][d * 256 + h * 64 + kk];
    if (t < 256) { const int row = t >> 2, part = t & 3; const u32x4v w = *(const u32x4v*)(P0 + (size_t)(rowbase + row) * P0_LD + P0_LR + part * 8);
        f32x4 lo, hi; lo[0] = bflo(w[0]); lo[1] = bfhi(w[0]); lo[2] = bflo(w[1]); lo[3] = bfhi(w[1]); hi[0] = bflo(w[2]); hi[1] = bfhi(w[2]); hi[2] = bflo(w[3]); hi[3] = bfhi(w[3]);
        *(f32x4*)(LR + row * 32 + part * 8) = lo; *(f32x4*)(LR + row * 32 + part * 8 + 4) = hi; }
    __syncthreads();
    float la[16];
#pragma unroll
    for (int i = 0; i < 16; ++i) { const int l = lq * 16 + i; const float* lr = LR + l * 32 + d * 16; float pre = gb;
#pragma unroll
        for (int j4 = 0; j4 < 4; ++j4) { const f32x4 v = *(const f32x4*)(lr + j4 * 4); pre += v[0] * gw[j4 * 4] + v[1] * gw[j4 * 4 + 1] + v[2] * gw[j4 * 4 + 2] + v[3] * gw[j4 * 4 + 3]; }
        la[i] = logsigmoidf(pre) * (1.0f / 16.0f); }
    if (d == 0) {
#pragma unroll
        for (int i = 1; i < 16; ++i) la[i] += la[i - 1];
        QS[(d * 4 + lq) * 64 + kk] = la[15];
    } else {
#pragma unroll
        for (int i = 14; i >= 0; --i) la[i] += la[i + 1];
        QS[(d * 4 + lq) * 64 + kk] = la[0];
    }
    __syncthreads();
    float off = 0.f;
    if (d == 0) { for (int q = 0; q < lq; ++q) off += QS[(0 * 4 + q) * 64 + kk]; }
    else { for (int q = 3; q > lq; --q) off += QS[(1 * 4 + q) * 64 + kk]; }
#pragma unroll
    for (int i = 0; i < 16; ++i) BC[(d * 64 + lq * 16 + i) * 65 + kk] = la[i] + off;
    __syncthreads();
}
__device__ __forceinline__ void gla_load_v(u32x4v& w0, u32x4v& w1, const u16* P0, int rowbase, int h) {
    const int t = threadIdx.x, l = t & 63, vg = t >> 6;
    const u16* src = P0 + (size_t)(rowbase + l) * P0_LD + P0_V + h * 128 + vg * 16;
    w0 = *(const u32x4v*)src; w1 = *(const u32x4v*)(src + 8);
}
__device__ __forceinline__ void gla_stage_vT(u16* vT, const u32x4v& w0, const u32x4v& w1) {
    const int t = threadIdx.x, l = t & 63, vg = t >> 6;
#pragma unroll
    for (int e = 0; e < 4; ++e) { vT[(vg * 16 + 2 * e) * GL_LD + l] = (u16)(w0[e] & 0xFFFF); vT[(vg * 16 + 2 * e + 1) * GL_LD + l] = (u16)(w0[e] >> 16);
        vT[(vg * 16 + 8 + 2 * e) * GL_LD + l] = (u16)(w1[e] & 0xFFFF); vT[(vg * 16 + 8 + 2 * e + 1) * GL_LD + l] = (u16)(w1[e] >> 16); }
}

__device__ void gla_a_item(unsigned char* shm, const Params& p, int b, int c, int h) {
    const u16* P0 = (const u16*)(p.ws + E_P0);
    const int rowbase = gla_rowbase(b, c), t = threadIdx.x, lane = t & 63, w = t >> 6;
    const u32x4v kw = *(const u32x4v*)(P0 + (size_t)(rowbase + (t & 63)) * P0_LD + P0_K + h * 64 + (t >> 6) * 8);
    u32x4v vw0, vw1; gla_load_v(vw0, vw1, P0, rowbase, h);
    gla_gates(shm, p, rowbase, h);
    const float* BC = (const float*)(shm + GL_BC);
    u16* kwT = (u16*)(shm + GL_X0);
    u16* vT = kwT + 2 * 64 * GL_LD;
    { const int l = t & 63, kg = t >> 6;
#pragma unroll
      for (int e = 0; e < 8; ++e) { const int k = kg * 8 + e; const float kv = (e & 1) ? bfhi(kw[e >> 1]) : bflo(kw[e >> 1]);
          const float w0 = __expf(BC[63 * 65 + k] - BC[l * 65 + k]), w1 = __expf(BC[(64 + 0) * 65 + k] - BC[(64 + l) * 65 + k]);
          kwT[k * GL_LD + l] = f2bf(kv * w0); kwT[(64 + k) * GL_LD + l] = f2bf(kv * w1); } }
    gla_stage_vT(vT, vw0, vw1);
    __syncthreads();
    { const int d = w >> 2, kb = w & 3; f32x4 acc[1][8]; zero_acc(acc);
      wave_mma<1, 8>(acc, kwT + (d * 64 + kb * 16) * GL_LD, GL_LD, vT, GL_LD, 2);
      float* DS = gla_ds_ptr(p, b, d, h, c);
#pragma unroll
      for (int nt = 0; nt < 8; ++nt) { const int v = nt * 16 + (lane & 15), k0 = kb * 16 + (lane >> 4) * 4; *(f32x4*)(DS + v * 64 + k0) = acc[0][nt]; } }
    if (t < 128) { const int d = t >> 6, kk = t & 63; const float bl = d == 0 ? BC[63 * 65 + kk] : BC[64 * 65 + kk];
        ((float*)(p.ws + OFF_DEC))[((size_t)((b * 2 + d) * 4 + h) * 68 + c) * 64 + kk] = __expf(bl); }
    __syncthreads();
}

__device__ void gmlp_item(unsigned char* shm, const Params& p, int b, int cc, int gi) {
    const u16* P0 = (const u16*)(p.ws + E_P0); u16* MG = (u16*)(p.ws + OFF_H);
    const int rowbase = cc < 2 ? RL + b * CTXL + cc * 128 : b * SEQ + (cc - 2) * 128;
    const int t = threadIdx.x, lane = t & 63, w = t >> 6;
    float* st = (float*)shm;
    u16* vnT = (u16*)(shm + 1024);
    u16* Ws = vnT + 128 * 136;
    { const int row = t >> 2, part = t & 3; const u16* src = P0 + (size_t)(rowbase + row) * P0_LD + P0_G + part * 128; float s = 0.f, ss = 0.f;
#pragma unroll 4
      for (int i = 0; i < 16; ++i) { const u32x4v wv = *(const u32x4v*)(src + i * 8);
#pragma unroll
          for (int e = 0; e < 4; ++e) { const float a = geluf(bflo(wv[e])), c2 = geluf(bfhi(wv[e])); s += a + c2; ss += a * a + c2 * c2; } }
      s += __shfl_xor(s, 1, 64); ss += __shfl_xor(ss, 1, 64); s += __shfl_xor(s, 2, 64); ss += __shfl_xor(ss, 2, 64);
      if (part == 0) { const float mu = s * (1.0f / 512.0f); const float var = fmaxf(ss * (1.0f / 512.0f) - mu * mu, 0.f); st[row * 2] = mu; st[row * 2 + 1] = rsqrtf(var + EPS); } }
    { const float* SW = p.in[I_ABSW] + (size_t)gi * 128 * 128;
#pragma unroll
      for (int ps = 0; ps < 8; ++ps) { const int idx = ps * 2048 + t * 4, tt = idx >> 7, s0 = idx & 127; const f32x4 v = *(const f32x4*)(SW + idx);
          u32x2 o; o[0] = pk2(v[0], v[1]); o[1] = pk2(v[2], v[3]); *(u32x2*)(Ws + tt * 136 + s0) = o; } }
    __syncthreads();
    { const int s = t & 127, cg4 = t >> 7; const u16* src = P0 + (size_t)(rowbase + s) * P0_LD + P0_G + gi * 128 + cg4 * 32; const float mu = st[s * 2], rstd = st[s * 2 + 1];
      const float* vg = p.in[I_ABVNG] + gi * 128 + cg4 * 32;
#pragma unroll
      for (int i = 0; i < 4; ++i) { const u32x4v wv = *(const u32x4v*)(src + i * 8);
#pragma unroll
          for (int e = 0; e < 8; ++e) { const float x = (e & 1) ? bfhi(wv[e >> 1]) : bflo(wv[e >> 1]); const int cl = i * 8 + e;
              vnT[(cg4 * 32 + cl) * 136 + s] = f2bf((geluf(x) - mu) * rstd * vg[cl]); } } }
    __syncthreads();
    { f32x4 acc[1][8]; zero_acc(acc);
      wave_mma<1, 8>(acc, vnT + (w * 16) * 136, 136, Ws, 136, 4);
      const int c0 = w * 16 + (lane >> 4) * 4;
#pragma unroll
      for (int nt = 0; nt < 8; ++nt) { const int tt = nt * 16 + (lane & 15); const float sb = p.in[I_ABSB][gi * 128 + tt];
          const u32x2 uw = *(const u32x2*)(P0 + (size_t)(rowbase + tt) * P0_LD + P0_U + gi * 128 + c0);
          const float o0 = geluf(bflo(uw[0])) * (acc[0][nt][0] + sb), o1 = geluf(bfhi(uw[0])) * (acc[0][nt][1] + sb), o2 = geluf(bflo(uw[1])) * (acc[0][nt][2] + sb), o3 = geluf(bfhi(uw[1])) * (acc[0][nt][3] + sb);
          u32x2 o; o[0] = pk2(o0, o1); o[1] = pk2(o2, o3); *(u32x2*)(MG + (size_t)(rowbase + tt) * DM + 512 + gi * 128 + c0) = o; } }
    __syncthreads();
}

__device__ void gla_scan_phase(const Params& p) {
    const float* DEC = (const float*)(p.ws + OFF_DEC);
    for (int g0 = blockIdx.x * 512 + threadIdx.x; g0 < 4 * 2 * 4 * 8192 / 2; g0 += gridDim.x * 512) {
        int e[2], bb[2], dd[2], hh[2]; const float* dec[2]; float s[2] = {0.f, 0.f};
#pragma unroll
        for (int q = 0; q < 2; ++q) { const int gidx = g0 + q * (4 * 2 * 4 * 8192 / 2); e[q] = gidx & 8191; const int bdh = gidx >> 13; hh[q] = bdh & 3; dd[q] = (bdh >> 2) & 1; bb[q] = bdh >> 3; dec[q] = DEC + (size_t)bdh * 68 * 64 + (e[q] & 63); }
        for (int i0 = 0; i0 < 68; i0 += 17) {
            float* ptr[2][17]; float ds[2][17], dc[2][17];
#pragma unroll
            for (int u = 0; u < 17; ++u)
#pragma unroll
                for (int q = 0; q < 2; ++q) { const int i = i0 + u; const int c = dd[q] == 0 ? i : (i < 4 ? 3 - i : 71 - i); ptr[q][u] = gla_ds_ptr(p, bb[q], dd[q], hh[q], c) + e[q]; ds[q][u] = *ptr[q][u]; dc[q][u] = dec[q][c * 64]; }
#pragma unroll
            for (int u = 0; u < 17; ++u)
#pragma unroll
                for (int q = 0; q < 2; ++q) { *ptr[q][u] = s[q]; s[q] = dc[q][u] * s[q] + ds[q][u]; }
        }
    }
}

__device__ void gla_c_item(unsigned char* shm, const Params& p, int b, int c, int h) {
    const u16* P0 = (const u16*)(p.ws + E_P0); u16* MG = (u16*)(p.ws + OFF_H);
    const int rowbase = gla_rowbase(b, c), t = threadIdx.x, lane = t & 63, w = t >> 6;
    const u16* rp_ = P0 + (size_t)(rowbase + (t & 63)) * P0_LD + h * 64 + (t >> 6) * 8;
    const u32x4v qw = *(const u32x4v*)(rp_ + P0_Q), kw = *(const u32x4v*)(rp_ + P0_K);
    u32x4v vw0, vw1; gla_load_v(vw0, vw1, P0, rowbase, h);
    f32x4 spa[4], spb[4];
#pragma unroll
    for (int ps = 0; ps < 4; ++ps) { const int idx = ps * 4096 + t * 8; const float* src = gla_ds_ptr(p, b, idx >> 13, h, c) + (idx & 8191); spa[ps] = *(const f32x4*)src; spb[ps] = *(const f32x4*)(src + 4); }
    const u16* rrp = P0 + (size_t)(rowbase + (t >> 3)) * P0_LD + P0_R + h * 128 + (t & 7) * 16;
    const u32x4v r0 = *(const u32x4v*)rrp, r1 = *(const u32x4v*)(rrp + 8);
    gla_gates(shm, p, rowbase, h);
    const float* BC = (const float*)(shm + GL_BC);
    u16* qd = (u16*)(shm + GL_X0);
    u16* kd = qd + 2 * 64 * GL_LD;
    u16* vT = kd + 2 * 64 * GL_LD;
    u16* SpT = vT + 128 * GL_LD;
    u16* SC = (u16*)(shm + GL_BC);
    float* O = (float*)SpT;
    { const int l = t & 63, kg = t >> 6;
#pragma unroll
      for (int d = 0; d < 2; ++d) { u32x4v qo, ko;
#pragma unroll
          for (int e2 = 0; e2 < 4; ++e2) { const float e0 = BC[(d * 64 + l) * 65 + kg * 8 + 2 * e2], e1 = BC[(d * 64 + l) * 65 + kg * 8 + 2 * e2 + 1];
              qo[e2] = pk2(bflo(qw[e2]) * 0.125f * __expf(e0), bfhi(qw[e2]) * 0.125f * __expf(e1));
              ko[e2] = pk2(bflo(kw[e2]) * __expf(-e0), bfhi(kw[e2]) * __expf(-e1)); }
          *(u32x4v*)(qd + (d * 64 + l) * GL_LD + kg * 8) = qo; *(u32x4v*)(kd + (d * 64 + l) * GL_LD + kg * 8) = ko; } }
    gla_stage_vT(vT, vw0, vw1);
#pragma unroll
    for (int ps = 0; ps < 4; ++ps) { const int idx = ps * 4096 + t * 8, d = idx >> 13, rem = idx & 8191, v = rem >> 6, k0 = rem & 63;
        *(u32x4v*)(SpT + (d * 128 + v) * GL_LD + k0) = pack8(spa[ps], spb[ps]); }
    __syncthreads();
    { const int d = w >> 2, lb = w & 3; f32x4 acc[1][4]; zero_acc(acc);
      wave_mma<1, 4>(acc, qd + (d * 64 + lb * 16) * GL_LD, GL_LD, kd + d * 64 * GL_LD, GL_LD, 2);
      __syncthreads();
#pragma unroll
      for (int nt = 0; nt < 4; ++nt)
#pragma unroll
          for (int j = 0; j < 4; ++j) { const int l = lb * 16 + (lane >> 4) * 4 + j, s = nt * 16 + (lane & 15); const bool keep = d == 0 ? (s <= l) : (s >= l);
              SC[(d * 64 + l) * GL_LD + s] = f2bf(keep ? acc[0][nt][j] : 0.f); } }
    __syncthreads();
    f32x4 oacc[1][4]; zero_acc(oacc);
    const int lb = w & 3, vh = w >> 2;
#pragma unroll
    for (int d = 0; d < 2; ++d) {
        wave_mma<1, 4>(oacc, qd + (d * 64 + lb * 16) * GL_LD, GL_LD, SpT + (d * 128 + vh * 64) * GL_LD, GL_LD, 2);
        wave_mma<1, 4>(oacc, SC + (d * 64 + lb * 16) * GL_LD, GL_LD, vT + (vh * 64) * GL_LD, GL_LD, 2);
    }
    __syncthreads();
#pragma unroll
    for (int nt = 0; nt < 4; ++nt)
#pragma unroll
        for (int j = 0; j < 4; ++j) { const int l = lb * 16 + (lane >> 4) * 4 + j, v = vh * 64 + nt * 16 + (lane & 15); O[l * 132 + v] = oacc[0][nt][j]; }
    __syncthreads();
    { const int l = t >> 3, part = t & 7; float o[16]; float ss = 0.f;
#pragma unroll
      for (int i = 0; i < 4; ++i) { const f32x4 v4 = *(const f32x4*)(O + l * 132 + part * 16 + i * 4);
#pragma unroll
          for (int e = 0; e < 4; ++e) { o[i * 4 + e] = v4[e]; ss += v4[e] * v4[e]; } }
      ss += __shfl_xor(ss, 1, 64); ss += __shfl_xor(ss, 2, 64); ss += __shfl_xor(ss, 4, 64);
      const float rs = rsqrtf(ss * (1.0f / 128.0f) + EPS);
      const float* gg = p.in[I_ABGNG] + h * 128 + part * 16; u32x4v o0, o1;
#pragma unroll
      for (int e2 = 0; e2 < 4; ++e2) {
          o0[e2] = pk2(o[2 * e2] * rs * gg[2 * e2] * siluf(bflo(r0[e2])), o[2 * e2 + 1] * rs * gg[2 * e2 + 1] * siluf(bfhi(r0[e2])));
          o1[e2] = pk2(o[8 + 2 * e2] * rs * gg[8 + 2 * e2] * siluf(bflo(r1[e2])), o[8 + 2 * e2 + 1] * rs * gg[8 + 2 * e2 + 1] * siluf(bfhi(r1[e2]))); }
      u16* dst = MG + (size_t)(rowbase + l) * DM + h * 128 + part * 16; *(u32x4v*)dst = o0; *(u32x4v*)(dst + 8) = o1; }
    __syncthreads();
}

__device__ void conv_phase(const Params& p) {
    u16* XBC = (u16*)(p.ws + E_XBC); const u16* HALO = (const u16*)(p.ws + A_HALO);
    const int t = threadIdx.x, cg = t & 127, q = __builtin_amdgcn_readfirstlane(t >> 7);
    for (int it = blockIdx.x; it < (RT / 64) * 3; it += gridDim.x) {
        const int rb = it / 3, cp = (it % 3) * 1024, c0 = cp + cg * 8;
        const bool first = rb < 256 ? ((rb & 63) == 0) : (((rb - 256) & 3) == 0);
        const bool last = rb < 256 ? ((rb & 63) == 63) : (((rb - 256) & 3) == 3);
        const bool z0 = (q == 0) && first, z1 = (q == 3) && last;
        u16* rowq = XBC + ((size_t)rb * 64 + 16 * q) * XBC_LD + cp;
        const u16* pre = (q == 0) ? (z0 ? rowq : HALO + ((size_t)(rb - 1) * 4 + 2) * XBC_LD + cp) : rowq - 2 * XBC_LD;
        const u16* post = (q == 3) ? (z1 ? rowq : HALO + ((size_t)(rb + 1) * 4) * XBC_LD + cp) : rowq + 16 * XBC_LD;
        u32x4v win[20];
        win[0] = *(const u32x4v*)(pre + cg * 8); win[1] = *(const u32x4v*)(pre + XBC_LD + cg * 8);
#pragma unroll
        for (int i = 0; i < 16; ++i) win[2 + i] = *(const u32x4v*)(rowq + (size_t)i * XBC_LD + cg * 8);
        win[18] = *(const u32x4v*)(post + cg * 8); win[19] = *(const u32x4v*)(post + XBC_LD + cg * 8);
        const u32x4v zero = {0u, 0u, 0u, 0u};
        if (z0) { win[0] = zero; win[1] = zero; }
        if (z1) { win[18] = zero; win[19] = zero; }
        float wt[5][8], bias[8];
#pragma unroll
        for (int j = 0; j < 5; ++j) { const f32x4 a = *(const f32x4*)(p.in[I_SSDCW] + j * 3072 + c0), b2 = *(const f32x4*)(p.in[I_SSDCW] + j * 3072 + c0 + 4);
#pragma unroll
            for (int e = 0; e < 4; ++e) { wt[j][e] = a[e]; wt[j][4 + e] = b2[e]; } }
        { const f32x4 a = *(const f32x4*)(p.in[I_SSDCB] + c0), b2 = *(const f32x4*)(p.in[I_SSDCB] + c0 + 4);
#pragma unroll
          for (int e = 0; e < 4; ++e) { bias[e] = a[e]; bias[4 + e] = b2[e]; } }
        __syncthreads();
#pragma unroll
        for (int r = 0; r < 16; ++r) {
            float o[8];
#pragma unroll
            for (int e = 0; e < 8; ++e) o[e] = bias[e];
#pragma unroll
            for (int j = 0; j < 5; ++j)
#pragma unroll
                for (int e2 = 0; e2 < 4; ++e2) { o[2 * e2] += wt[j][2 * e2] * bflo(win[r + j][e2]); o[2 * e2 + 1] += wt[j][2 * e2 + 1] * bfhi(win[r + j][e2]); }
            u32x4v ov;
#pragma unroll
            for (int e2 = 0; e2 < 4; ++e2) ov[e2] = pk2(siluf(o[2 * e2]), siluf(o[2 * e2 + 1]));
            *(u32x4v*)(rowq + (size_t)r * XBC_LD + cg * 8) = ov;
        }
    }
}
__device__ void dt_phase(unsigned char* shm, const Params& p) {
    const float* DTRAW = (const float*)(p.ws + A_DTRAW); float* DT = (float*)(p.ws + T_DT); float* ACUM = (float*)(p.ws + T_ACUM);
    float* tile = (float*)shm;
    float* tdt = tile + 128 * 65;
    const int t = threadIdx.x, col = t & 63;
    const float bias = p.in[I_SSDDTB][col], a = -__expf(p.in[I_SSDALOG][col]);
    for (int ch = blockIdx.x; ch < RT / 128; ch += gridDim.x) {
        const size_t r0 = (size_t)ch * 128;
#pragma unroll
        for (int i = 0; i < 16; ++i) { const int m = i * 8 + (t >> 6); const float d = softplusf(DTRAW[(r0 + m) * 64 + col] + bias); tdt[m * 65 + col] = d; tile[m * 65 + col] = d * a; }
        __syncthreads();
        if (t < 64) { float run = 0.f;
            if (t < 32) { for (int m = 0; m < 128; ++m) { run += tile[m * 65 + t]; tile[m * 65 + t] = run; } }
            else { for (int m = 127; m >= 0; --m) { run += tile[m * 65 + t]; tile[m * 65 + t] = run; } } }
        __syncthreads();
        { const int m = t & 127, cq = t >> 7;
#pragma unroll
          for (int i = 0; i < 16; ++i) { const int c = cq * 16 + i; ACUM[(size_t)c * RT + r0 + m] = tile[m * 65 + c]; DT[(size_t)c * RT + r0 + m] = tdt[m * 65 + c]; } }
        __syncthreads();
    }
}
constexpr int SP_LD = 136;
constexpr int SP_C = 0;
constexpr int SP_B = SP_C + 128 * SP_LD * 2;
constexpr int SP_CB = SP_B + 128 * SP_LD * 2;
constexpr int SP_AC = SP_CB + 128 * SP_LD * 2;
constexpr int SP_DT = SP_AC + 16 * 128 * 4;
constexpr int SP_END = SP_DT + 16 * 128 * 4;
static_assert(SP_END <= LDS_XB, "SSD par LDS");
__device__ void ssd_par_item(unsigned char* shm, const Params& p, int item) {
    const u16* XBC = (const u16*)(p.ws + E_XBC); u16* Y = (u16*)(p.ws + E_Y);
    const float* DT = (const float*)(p.ws + T_DT); const float* ACUM = (const float*)(p.ws + T_ACUM);
    const int g = item & 3, base = (item >> 2) * 128;
    u16* Cs = (u16*)(shm + SP_C); u16* Ms = Cs; u16* Bs = (u16*)(shm + SP_B); u16* xT = Bs; u16* CBs = (u16*)(shm + SP_CB);
    float* acs = (float*)(shm + SP_AC); float* dts = (float*)(shm + SP_DT);
    const int t = threadIdx.x, lane = t & 63, w = t >> 6, fr = lane & 15, fq = lane >> 4;
#pragma unroll
    for (int i = 0; i < 4; ++i) { const int idx = i * 512 + t, m = idx >> 4, seg = idx & 15; const u16* rp = XBC + (size_t)(base + m) * XBC_LD + g * 128 + seg * 8;
        *(u32x4v*)(Cs + m * SP_LD + seg * 8) = *(const u32x4v*)(rp + 2560); *(u32x4v*)(Bs + m * SP_LD + seg * 8) = *(const u32x4v*)(rp + 2048); }
#pragma unroll
    for (int i = 0; i < 4; ++i) { const int idx = i * 512 + t, q = idx >> 7, m = idx & 127, hh = q >> 1, dir = q & 1; const size_t o = (size_t)(dir * 32 + g * 8 + hh) * RT + base + m;
        acs[idx] = ACUM[o]; dts[idx] = DT[o]; }
    __syncthreads();
    { f32x4 acc[1][8]; zero_acc(acc);
      wave_mma<1, 8>(acc, Bs + (w * 16) * SP_LD, SP_LD, Cs, SP_LD, 4);
#pragma unroll
      for (int nt = 0; nt < 8; ++nt) { u32x2 o; o[0] = pk2(acc[0][nt][0], acc[0][nt][1]); o[1] = pk2(acc[0][nt][2], acc[0][nt][3]); *(u32x2*)(CBs + (nt * 16 + fr) * SP_LD + w * 16 + fq * 4) = o; } }
    __syncthreads();
    const int seg = t & 15, mq = t >> 4, xs_ = t & 127, pseg = t >> 7, mrow0 = w * 16;
    for (int hh = 0; hh < 8; ++hh) {
        const int h = g * 8 + hh;
        const float* af = acs + (hh * 2) * 128; const float* ab = af + 128; const float* dtf = dts + (hh * 2) * 128; const float* dtb = dtf + 128;
        { const u16* xp = XBC + (size_t)(base + xs_) * XBC_LD + h * 64 + pseg * 16; const u32x4v x0 = *(const u32x4v*)xp, x1 = *(const u32x4v*)(xp + 8);
#pragma unroll
          for (int e2 = 0; e2 < 4; ++e2) { xT[(pseg * 16 + 2 * e2) * SP_LD + xs_] = (u16)(x0[e2] & 0xFFFFu); xT[(pseg * 16 + 2 * e2 + 1) * SP_LD + xs_] = (u16)(x0[e2] >> 16);
              xT[(pseg * 16 + 8 + 2 * e2) * SP_LD + xs_] = (u16)(x1[e2] & 0xFFFFu); xT[(pseg * 16 + 8 + 2 * e2 + 1) * SP_LD + xs_] = (u16)(x1[e2] >> 16); } }
        { float afs[8], abs_[8], wf[8], wb[8];
#pragma unroll
          for (int q = 0; q < 2; ++q) { const f32x4 a4 = *(const f32x4*)(af + seg * 8 + 4 * q), b4 = *(const f32x4*)(ab + seg * 8 + 4 * q), c4 = *(const f32x4*)(dtf + seg * 8 + 4 * q), d4 = *(const f32x4*)(dtb + seg * 8 + 4 * q);
#pragma unroll
              for (int e = 0; e < 4; ++e) { afs[4 * q + e] = a4[e]; abs_[4 * q + e] = b4[e]; wf[4 * q + e] = c4[e]; wb[4 * q + e] = d4[e]; } }
#pragma unroll
          for (int i = 0; i < 4; ++i) { const int m = mq + 32 * i; const u32x4v cw = *(const u32x4v*)(CBs + m * SP_LD + seg * 8); const float amf = af[m], amb = ab[m]; float v[8];
#pragma unroll
              for (int e = 0; e < 8; ++e) { const int s2 = seg * 8 + e; const float cbv = (e & 1) ? bfhi(cw[e >> 1]) : bflo(cw[e >> 1]);
                  const float arg = s2 < m ? (amf - afs[e]) : (s2 > m ? (amb - abs_[e]) : 0.f); const float wgt = s2 < m ? wf[e] : (s2 > m ? wb[e] : wf[e] + wb[e]);
                  v[e] = cbv * __expf(arg) * wgt; }
              u32x4v mv; mv[0] = pk2(v[0], v[1]); mv[1] = pk2(v[2], v[3]); mv[2] = pk2(v[4], v[5]); mv[3] = pk2(v[6], v[7]);
              *(u32x4v*)(Ms + m * SP_LD + seg * 8) = mv; } }
        __syncthreads();
        f32x4 yT[4][1]; zero_acc(yT);
        wave_mma<4, 1>(yT, xT, SP_LD, Ms + mrow0 * SP_LD, SP_LD, 4);
        __syncthreads();
        { const float dsk = p.in[I_SSDD][h]; const size_t row = (size_t)(base + mrow0 + fr);
#pragma unroll
          for (int mt = 0; mt < 4; ++mt) { const int p0 = h * 64 + mt * 16 + fq * 4; const u32x2 xs = *(const u32x2*)(XBC + row * XBC_LD + p0);
              u32x2 o; o[0] = pk2(yT[mt][0][0] + dsk * bflo(xs[0]), yT[mt][0][1] + dsk * bfhi(xs[0])); o[1] = pk2(yT[mt][0][2] + dsk * bflo(xs[1]), yT[mt][0][3] + dsk * bfhi(xs[1]));
              *(u32x2*)(Y + row * 2048 + p0) = o; } }
    }
}

constexpr int SS_LD = 136, SS_LB = 130;
constexpr int SS_C = 0;
constexpr int SS_B = SS_C + 128 * SS_LD * 2;
constexpr int SS_XW = SS_B + 128 * SS_LB * 2;
constexpr int SS_S = SS_XW + 32 * SS_LD * 2;
constexpr int SS_AC = SS_S + 32 * SS_LD * 2;
constexpr int SS_END = SS_AC + 512;
static_assert(SS_END <= LDS_XB, "SSD LDS");

__device__ __forceinline__ void lds_barrier() { asm volatile("s_waitcnt lgkmcnt(0)\n\ts_barrier" ::: "memory"); }
__device__ void ssd_item(unsigned char* shm, const Params& p, int b, int h, int ph) {
    const u16* XBC = (const u16*)(p.ws + E_XBC); u16* Y = (u16*)(p.ws + E_Y);
    const float* DT = (const float*)(p.ws + T_DT); const float* ACUM = (const float*)(p.ws + T_ACUM);
    u16* Cs = (u16*)(shm + SS_C); u16* Bs = (u16*)(shm + SS_B); u16* xwT = (u16*)(shm + SS_XW); u16* Sb = (u16*)(shm + SS_S);
    float* acs = (float*)(shm + SS_AC);
    const int t = threadIdx.x, lane = t & 63, w = t >> 6, g = h >> 3, fr = lane & 15, fq = lane >> 4;
    const int xcol = h * 64 + ph * 32, bcol = 2048 + g * 128, ccol = 2560 + g * 128;
    const int seg = t & 15, mq = t >> 4, xm = t & 127, xseg = t >> 7, mrow0 = w * 16;
    for (int dir = 0; dir < 2; ++dir) {
        const float* dtc = DT + (size_t)(dir * 32 + h) * RT; const float* acc_ = ACUM + (size_t)(dir * 32 + h) * RT;
        f32x4 accS[1][2]; zero_acc(accS);
        u32x4v rC[4], rB[4], rX; float rDt, rAcX, rAlast; u32x2 rY[2];
        { const u32x4v z4 = {0u, 0u, 0u, 0u}; const u32x2 z2 = {0u, 0u};
#pragma unroll
          for (int i = 0; i < 4; ++i) rC[i] = z4;
          rY[0] = z2; rY[1] = z2; }
#define SSD_BASE(st) ((st) < 2 ? RL + b * CTXL + (dir == 0 ? (st) : 1 - (st)) * 128 : b * SEQ + (dir == 0 ? (st) - 2 : 33 - (st)) * 128)
#define SSD_PREFETCH(st) do { const int base_ = SSD_BASE(st); const bool ctx_ = (st) < 2; \
            _Pragma("unroll") for (int i = 0; i < 4; ++i) { const int m = mq + 32 * i; const u16* rp = XBC + (size_t)(base_ + m) * XBC_LD + seg * 8; rB[i] = *(const u32x4v*)(rp + bcol); \
                if (!ctx_) rC[i] = *(const u32x4v*)(rp + ccol); } \
            rX = *(const u32x4v*)(XBC + (size_t)(base_ + xm) * XBC_LD + xcol + xseg * 8); rDt = dtc[base_ + xm]; rAcX = acc_[base_ + xm]; rAlast = acc_[base_ + (dir == 0 ? 127 : 0)]; \
            if (!ctx_) { _Pragma("unroll") for (int mt = 0; mt < 2; ++mt) rY[mt] = *(const u32x2*)(Y + (size_t)(base_ + mrow0 + fr) * 2048 + xcol + mt * 16 + fq * 4); } } while (0)
        SSD_PREFETCH(0);
        for (int step = 0; step < 34; ++step) {
            const bool isctx = step < 2;
            const int base = SSD_BASE(step);
            const float a_last = rAlast;
            if (xseg == 0) acs[xm] = rAcX;
#pragma unroll
            for (int i = 0; i < 4; ++i) { const int m = mq + 32 * i;
                unsigned* bd = (unsigned*)(Bs + m * SS_LB + seg * 8); bd[0] = rB[i][0]; bd[1] = rB[i][1]; bd[2] = rB[i][2]; bd[3] = rB[i][3];
                if (!isctx) *(u32x4v*)(Cs + m * SS_LD + seg * 8) = rC[i]; }
            { const float wgt = rDt * __expf(a_last - rAcX);
#pragma unroll
              for (int e = 0; e < 8; ++e) { const float x = (e & 1) ? bfhi(rX[e >> 1]) : bflo(rX[e >> 1]); xwT[(xseg * 8 + e) * SS_LD + xm] = f2bf(x * wgt); } }
            if (!isctx) {
#pragma unroll
                for (int nt = 0; nt < 2; ++nt) { u32x2 o; o[0] = pk2(accS[0][nt][0], accS[0][nt][1]); o[1] = pk2(accS[0][nt][2], accS[0][nt][3]); *(u32x2*)(Sb + (nt * 16 + fr) * SS_LD + mrow0 + fq * 4) = o; } }
            u32x2 cY[2];
#pragma unroll
            for (int mt = 0; mt < 2; ++mt) cY[mt] = rY[mt];
            lds_barrier();
            if (step + 1 < 34) SSD_PREFETCH(step + 1);
            if (!isctx) {
                f32x4 yT[2][1]; zero_acc(yT);
                wave_mma<2, 1>(yT, Sb, SS_LD, Cs + mrow0 * SS_LD, SS_LD, 4);
                const float sc = __expf(acs[mrow0 + fr]);
                const size_t row = (size_t)(base + mrow0 + fr);
#pragma unroll
                for (int mt = 0; mt < 2; ++mt) { u16* yp = Y + row * 2048 + xcol + mt * 16 + fq * 4; const u32x2 pv = cY[mt];
                    u32x2 o; o[0] = pk2(bflo(pv[0]) + sc * yT[mt][0][0], bfhi(pv[0]) + sc * yT[mt][0][1]); o[1] = pk2(bflo(pv[1]) + sc * yT[mt][0][2], bfhi(pv[1]) + sc * yT[mt][0][3]); *(u32x2*)yp = o; }
            }
            { const float dl = __expf(a_last);
#pragma unroll
              for (int nt = 0; nt < 2; ++nt)
#pragma unroll
                  for (int j = 0; j < 4; ++j) accS[0][nt][j] *= dl; }
#pragma unroll
            for (int k = 0; k < 4; ++k) {
                bf16x8 a;
#pragma unroll
                for (int e = 0; e < 8; ++e) a[e] = (short)Bs[(k * 32 + fq * 8 + e) * SS_LB + mrow0 + fr];
#pragma unroll
                for (int nt = 0; nt < 2; ++nt) { const bf16x8 bb = *(const bf16x8*)(xwT + (nt * 16 + fr) * SS_LD + k * 32 + fq * 8); accS[0][nt] = __builtin_amdgcn_mfma_f32_16x16x32_bf16(a, bb, accS[0][nt], 0, 0, 0); } }
            lds_barrier();
        }
#undef SSD_PREFETCH
#undef SSD_BASE
    }
}

__device__ void ssd_finish_phase(const Params& p) {
    u16* Y = (u16*)(p.ws + E_Y); const u16* Z = (const u16*)(p.ws + E_Z);
    const int lane = threadIdx.x & 63, wid = threadIdx.x >> 6;
    const int stride = gridDim.x * 8;
    for (int it0 = blockIdx.x * 8 + wid; it0 < RL * 4; it0 += 4 * stride) {
        u32x4v yw[4], zw[4]; size_t off[4]; bool ok[4];
#pragma unroll
        for (int u = 0; u < 4; ++u) { const int it = it0 + u * stride; ok[u] = it < RL * 4; off[u] = ok[u] ? (size_t)(it >> 2) * 2048 + (it & 3) * 512 + lane * 8 : 0;
            yw[u] = *(const u32x4v*)(Y + off[u]); zw[u] = *(const u32x4v*)(Z + off[u]); }
#pragma unroll
        for (int u = 0; u < 4; ++u) { const int it = it0 + u * stride;
            float v[8]; float ss = 0.f;
#pragma unroll
            for (int e2 = 0; e2 < 4; ++e2) { v[2 * e2] = bflo(yw[u][e2]) * siluf(bflo(zw[u][e2])); v[2 * e2 + 1] = bfhi(yw[u][e2]) * siluf(bfhi(zw[u][e2])); ss += v[2 * e2] * v[2 * e2] + v[2 * e2 + 1] * v[2 * e2 + 1]; }
            ss = wave_sum(ss);
            const float rs = rsqrtf(ss * (1.0f / 512.0f) + EPS);
            const float* gg = p.in[I_SSDNG] + (it & 3) * 512 + lane * 8; u32x4v o;
#pragma unroll
            for (int e2 = 0; e2 < 4; ++e2) o[e2] = pk2(v[2 * e2] * rs * gg[2 * e2], v[2 * e2 + 1] * rs * gg[2 * e2 + 1]);
            if (ok[u]) *(u32x4v*)(Y + off[u]) = o; }
    }
}

__global__ __launch_bounds__(512, 2) void mega(Params p) {
    extern __shared__ __attribute__((aligned(16))) unsigned char shm[];
    cg::grid_group grid = cg::this_grid();
    unsigned char* ws = p.ws;
    float* MOD = (float*)(ws + OFF_MOD); const float* MOD1 = MOD + 5 * NMOD * DM;
    u16* H = (u16*)(ws + OFF_H); float* XC = (float*)(ws + OFF_XC);
    const int bid = blockIdx.x, nb = gridDim.x;
    volatile LAS unsigned* xst = (volatile LAS unsigned*)(shm + LDS_XB);
    if (threadIdx.x < 2) xst[threadIdx.x] = 0u;
    __syncthreads();
    const XcdBarrier xb = xcd_barrier_post((unsigned*)(ws + OFF_BAR), xst);
    mod_gemv(shm, p);
    convert_weights_early(shm, p);
    if (p.ws == nullptr) grid.sync();
    xcd_barrier(xb);
    norm_mod_phase(p.in[I_X], p.in[I_CTX], p.in[I_NORMG], MOD, 0, 1, RT, 0, H);
    xcd_barrier(xb);
    { EpiBf16Plain E; E.O = (u16*)(ws + E_P0); E.ld = P0_LD; E.ncols = P0_LD; run_gemm(shm, H, (const u16*)(ws + A_AB_IN), RT, 2816, 1024, E); }
    xcd_barrier(xb);
    for (int it = bid; it < 4 * 68 * 4 + 4 * 34 * 4; it += nb) {
        if (it < 4 * 68 * 4) { const int h = it & 3, bc = it >> 2; gla_a_item(shm, p, bc / 68, bc % 68, h); }
        else { const int j = it - 4 * 68 * 4; const int gi = j & 3, bc = j >> 2; gmlp_item(shm, p, bc / 34, bc % 34, gi); }
    }
    xcd_barrier(xb);
    gla_scan_phase(p);
    xcd_barrier(xb);
    for (int it = bid; it < 4 * 68 * 4; it += nb) { const int h = it & 3, bc = it >> 2; gla_c_item(shm, p, bc / 68, bc % 68, h); }
    xcd_barrier(xb);
    { EpiRes E; E.src_lat = p.in[I_X]; E.src_ctx = p.in[I_CTX]; E.dst_lat = p.out; E.dst_ctx = XC; E.gate = MOD + 2 * DM; E.cm = 0; E.part = (float*)(ws + E_PART);
      run_gemm_split(shm, H, (const u16*)(ws + A_AB_OUT), 1024, 1024, E); }
    xcd_barrier(xb);
    norm_mod_phase(p.out, p.in[I_CTX], p.in[I_NORMG] + DM, MOD, 3, 4, RT, 0, H, (const float*)(ws + E_PART), 4, MOD + 4 * (NMOD * DM) + 2 * DM, XC);
    xcd_barrier(xb);
    { EpiSwiglu E; E.O = (u16*)(ws + E_ACT); run_gemm(shm, H, (const u16*)(ws + A_FF_IN0), RT, 5632, 1024, E); }
    xcd_barrier(xb);
    { EpiRes E; E.src_lat = p.out; E.src_ctx = XC; E.dst_lat = p.out; E.dst_ctx = XC; E.gate = MOD + 5 * DM; E.cm = 0; E.part = (float*)(ws + E_PART);
      run_gemm_split(shm, (const u16*)(ws + E_ACT), (const u16*)(ws + A_FF_OUT0), 1024, 2816, E); }
    xcd_barrier(xb);
    norm_mod_phase(p.out, XC, p.in[I_NORMG] + 2 * DM, MOD1, 0, 1, RT, 1, H, (const float*)(ws + E_PART), 11, MOD + 4 * (NMOD * DM) + 5 * DM, XC);
    xcd_barrier(xb);
    { EpiSsdIn E; E.XBC = (u16*)(ws + E_XBC); E.HALO = (u16*)(ws + A_HALO); E.DTRAW = (float*)(ws + A_DTRAW); run_gemm(shm, H, (const u16*)(ws + B_SSD_INA), RT, 3328, 1024, E); }
    xcd_barrier(xb);
    dt_phase(shm, p);
    conv_phase(p);
    xcd_barrier(xb);
    for (int it = bid; it < 4 * 32 * 4; it += nb) ssd_par_item(shm, p, it);
    xcd_barrier(xb);
    for (int it = bid; it < 4 * 32 * 2; it += nb) {
        const int xcd = it & 7, slot = it >> 3, grp = xcd * 2 + (slot >> 4), idx = slot & 15;
        ssd_item(shm, p, grp >> 2, (grp & 3) * 8 + (idx >> 1), idx & 1); }
    xcd_barrier(xb);
    { EpiBf16Plain E; E.O = (u16*)(ws + E_Z); E.ld = 2048; E.ncols = 2048; run_gemm(shm, H, (const u16*)(ws + B_WZ), RL, 2048, 1024, E); }
    convert_weights_late(shm, p);
    xcd_barrier(xb);
    ssd_finish_phase(p);
    xcd_barrier(xb);
    { EpiRes E; E.src_lat = p.out; E.src_ctx = XC; E.dst_lat = p.out; E.dst_ctx = XC; E.gate = MOD1 + 2 * DM; E.cm = 1; E.part = nullptr;
      run_gemm(shm, (const u16*)(ws + E_Y), (const u16*)(ws + A_SSD_OUT), RL, 1024, 2048, E); }
    xcd_barrier(xb);
    norm_mod_phase(p.out, XC, p.in[I_NORMG] + 3 * DM, MOD1, 3, 4, RL, 0, H);
    xcd_barrier(xb);
    { EpiSwiglu E; E.O = (u16*)(ws + E_ACT); run_gemm(shm, H, (const u16*)(ws + A_FF_IN1), RL, 5632, 1024, E); }
    xcd_barrier(xb);
    { EpiRes E; E.src_lat = p.out; E.src_ctx = XC; E.dst_lat = p.out; E.dst_ctx = XC; E.gate = MOD1 + 5 * DM; E.cm = 0; E.part = nullptr;
      run_gemm(shm, (const u16*)(ws + E_ACT), (const u16*)(ws + A_FF_OUT1), RL, 1024, 2816, E); }
    xcd_barrier(xb);
    final_norm_phase(p.out, p.in[I_FNG]);
}

extern "C" void kernel_launch(void* const* d_in, const int* in_sizes, int n_in, void* d_out, int out_size, void* d_ws, size_t ws_size, hipStream_t stream) {
    static int grid_blocks = 0;
    if (!grid_blocks) {
        int dev = 0, cus = 0, per_cu = 0;
        (void)hipGetDevice(&dev);
        (void)hipDeviceGetAttribute(&cus, hipDeviceAttributeMultiprocessorCount, dev);
        (void)hipFuncSetAttribute((const void*)mega, hipFuncAttributeMaxDynamicSharedMemorySize, LDS_BYTES);
        (void)hipOccupancyMaxActiveBlocksPerMultiprocessor(&per_cu, (const void*)mega, 512, LDS_BYTES);
        if (per_cu < 1) { fprintf(stderr, "occupancy query says %d blocks/CU\n", per_cu); per_cu = 1; }
        if (per_cu > 1) per_cu = 1;
        grid_blocks = cus * per_cu;
        if (ws_size < WS_END) fprintf(stderr, "workspace too small: %zu < %zu\n", ws_size, (size_t)WS_END);
    }
    Params p{};
    for (int i = 0; i < 26; ++i) p.in[i] = (const float*)d_in[i];
    p.out = (float*)d_out; p.ws = (unsigned char*)d_ws;
    (void)hipMemsetAsync((unsigned char*)d_ws + OFF_BAR, 0, XCD_BAR_WORDS * sizeof(unsigned), stream);
    void* args[] = {&p};
    hipError_t e = hipLaunchCooperativeKernel((const void*)mega, dim3(grid_blocks), dim3(512), args, LDS_BYTES, stream);
    if (e != hipSuccess) fprintf(stderr, "cooperative launch failed: %s (grid %d)\n", hipGetErrorString(e), grid_blocks);
}
```

```cpp
#include <hip/hip_runtime.h>
#include <hip/hip_cooperative_groups.h>
#include <cstdio>
namespace cg = cooperative_groups;
namespace pg8 {
#define PG8_LAS __attribute__((address_space(3)))
typedef unsigned short bf16_t;
typedef short bf16x8 __attribute__((ext_vector_type(8)));
typedef float f32x4 __attribute__((ext_vector_type(4)));
typedef unsigned u32x4 __attribute__((ext_vector_type(4)));
constexpr int BM = 256, BK = 64, HALF = 128, HTB = HALF * BK * 2  , STAGE_BYTES = 8 * HTB, NXCD = 8, WGM = 8;

__host__ __device__ __forceinline__ int lds_byte(int r, int c) { const int st = (r >> 4) * 2 + (c >> 5), rr = r & 15, cc = c & 31, ob = rr * 64 + cc * 2; return st * 1024 + (ob ^ (((ob >> 9) & 1) << 5)); }
__host__ __device__ __forceinline__ void stage_rc(int b, int& R, int& C) { const int st = b / 1024, sb = b % 1024, swz = sb ^ (((sb >> 9) & 1) << 5); R = (st >> 1) * 16 + swz / 64; C = (st & 1) * 32 + (swz % 64) / 2; }
__host__ __device__ __forceinline__ int perm32(int rho) { const int n = rho >> 4, i = rho & 15; return 8 * (i >> 2) + 4 * n + (i & 3); }

struct Unit { int pm, pn, kt0, nkt; };
struct Gemm { const bf16_t* A; const bf16_t* Bt; int M, N, K; };

struct StaticOrder {
    int nM, nN, nwg, G, c, nkt_all;
    __host__ __device__ void init(int M, int N, int G_, int c_, int K_ = 0) { nM = M / BM; nN = N / BM; nwg = nM * nN; G = G_; c = c_; nkt_all = K_ / BK; }
    __host__ __device__ bool next(int i, Unit& u) const {
        const long L = (long)i * G + c; if (L >= nwg) return false;
        int wgid = (int)L; { const int q = nwg / NXCD, r = nwg % NXCD, xcd = wgid % NXCD, off = wgid / NXCD; wgid = (xcd < r ? xcd * (q + 1) : r * (q + 1) + (xcd - r) * q) + off; }
        const int nig = WGM * nN, gid = wgid / nig, fm = gid * WGM, gsz = (nM - fm) < WGM ? (nM - fm) : WGM;
        u.pm = fm + ((wgid % nig) % gsz); u.pn = (wgid % nig) / gsz; u.kt0 = 0; u.nkt = nkt_all; return true;
    }
    __device__ __forceinline__ void a_ready(const Unit&) const {}
    __device__ __forceinline__ void done(const Unit&) const {}
};
__device__ __forceinline__ unsigned cvt_pk_bf16(float lo, float hi) { unsigned r; asm volatile("v_cvt_pk_bf16_f32 %0, %1, %2" : "=v"(r) : "v"(lo), "v"(hi)); return r; }
template <class Epi, class Sched, bool STAMP = false>
__device__ __forceinline__ void gemm_phase(PG8_LAS unsigned char* lds, const Gemm g, const Sched& S, const Epi& E, unsigned long long* stamps) {
    int tid_ = threadIdx.x; asm volatile("" : "+v"(tid_)); const int tid = tid_, wid = __builtin_amdgcn_readfirstlane(tid >> 6), lane = tid & 63, wr = wid >> 2, wc = wid & 3, fr = lane & 15, fq = lane >> 4;
    const int K = g.K;
    int ts_lo = 0, ts_hi = 0, nts = 0; const unsigned long long rt_entry = STAMP ? (unsigned long long)wall_clock64() : 0ull;
#define PG8_STAMP() do { if (STAMP && wid == 0 && nts < 64) { const unsigned long long _c = (unsigned long long)clock64(); \
        ts_lo = (lane == nts) ? (int)(unsigned)_c : ts_lo; ts_hi = (lane == nts) ? (int)(unsigned)(_c >> 32) : ts_hi; ++nts; } } while (0)
    PG8_STAMP();
    unsigned voffA[2], voffB[2];
#pragma unroll
    for (int i = 0; i < 2; ++i) { int R, C; stage_rc(tid * 16 + i * 8192, R, C); const int Rb = Epi::PERM ? ((R & ~31) + perm32(R & 31)) : R;
        voffA[i] = (unsigned)(R * K + C) * 2u; voffB[i] = (unsigned)(Rb * K + C) * 2u; }
    const size_t kstep = (size_t)(BK * 2);
    const size_t hstep = (size_t)HALF * K * 2;
    const size_t tstep = 2 * hstep;
    const unsigned ldsw = (unsigned)wid * 1024u;
    const int aoff = lds_byte(wr * 64 + fr, fq * 8), boff = lds_byte(wc * 32 + fr, fq * 8);
#define PG8_SA(b, h) (((b) * 2 + (h)) * HTB)
#define PG8_SB(b, h) ((4 + (b) * 2 + (h)) * HTB)
#define PG8_STAGE(bufoff, gbase, voff) do { _Pragma("unroll") for (int _i = 0; _i < 2; ++_i) \
        __builtin_amdgcn_global_load_lds((const unsigned*)((const char*)(gbase) + (voff)[_i]), (PG8_LAS unsigned*)(lds + (bufoff) + ldsw + _i * 8192), 16, 0, 0); } while (0)
#define PG8_LDA(dst, b, h) do { _Pragma("unroll") for (int m = 0; m < 4; ++m) _Pragma("unroll") for (int k = 0; k < 2; ++k) dst[m][k] = *(const PG8_LAS bf16x8*)(lds + PG8_SA(b, h) + aoff + m * 2048 + k * 1024); } while (0)
#define PG8_LDB(dst, b, h) do { _Pragma("unroll") for (int n = 0; n < 2; ++n) _Pragma("unroll") for (int k = 0; k < 2; ++k) dst[n][k] = *(const PG8_LAS bf16x8*)(lds + PG8_SB(b, h) + boff + n * 2048 + k * 1024); } while (0)
#define PG8_MMA(ai, bj, At, Bt) do { __builtin_amdgcn_s_setprio(1); _Pragma("unroll") for (int m = 0; m < 4; ++m) _Pragma("unroll") for (int n = 0; n < 2; ++n) _Pragma("unroll") for (int k = 0; k < 2; ++k) \
        acc[ai][bj][m][n] = __builtin_amdgcn_mfma_f32_16x16x32_bf16(Bt[n][k], At[m][k], acc[ai][bj][m][n], 0, 0, 0); __builtin_amdgcn_s_setprio(0); } while (0)
#define PG8_WAIT_V(n) asm volatile("s_waitcnt vmcnt(" #n ")" ::: "memory")
#define PG8_WAIT_L(n) asm volatile("s_waitcnt lgkmcnt(" #n ")" ::: "memory")
#define PG8_BAR __builtin_amdgcn_s_barrier()
#define PG8_SCHED __builtin_amdgcn_sched_barrier(0)
    Unit cur, nxt; int ui = 0;
    if (!S.next(0, cur)) return;
    f32x4 acc[2][2][4][2];
#pragma unroll
    for (int a = 0; a < 2; ++a)
#pragma unroll
        for (int b = 0; b < 2; ++b)
#pragma unroll
            for (int m = 0; m < 4; ++m)
#pragma unroll
                for (int n = 0; n < 2; ++n) acc[a][b][m][n] = (f32x4){0.f, 0.f, 0.f, 0.f};
    bf16x8 At[4][2], B0[2][2], B1[2][2];
    const char* cA = (const char*)g.A + (size_t)cur.pm * tstep + (size_t)cur.kt0 * kstep; const char* cB = (const char*)g.Bt + (size_t)cur.pn * tstep + (size_t)cur.kt0 * kstep;
    S.a_ready(cur);
    PG8_STAGE(PG8_SB(0, 0), cB, voffB); PG8_STAGE(PG8_SA(0, 0), cA, voffA); PG8_STAGE(PG8_SB(0, 1), cB + hstep, voffB); PG8_STAGE(PG8_SA(0, 1), cA + hstep, voffA);
    if (wr == 1) PG8_BAR;
    PG8_WAIT_V(4); PG8_BAR;
    PG8_STAGE(PG8_SB(1, 0), cB + kstep, voffB); PG8_STAGE(PG8_SA(1, 0), cA + kstep, voffA); PG8_STAGE(PG8_SB(1, 1), cB + hstep + kstep, voffB);
    PG8_WAIT_V(6); PG8_BAR;
    PG8_STAMP();
    for (;;) {
        const bool has_next = S.next(ui + 1, nxt);
        const char* nA = has_next ? (const char*)g.A + (size_t)nxt.pm * tstep + (size_t)nxt.kt0 * kstep : cA; const char* nB = has_next ? (const char*)g.Bt + (size_t)nxt.pn * tstep + (size_t)nxt.kt0 * kstep : cB;
        const int nt = cur.nkt;
        for (int t = 0; t < nt; t += 2) {
            const bool last = (t == nt - 2);
            const char* a1 = cA + (size_t)(t + 1) * kstep;
            const char* a2 = last ? nA : cA + (size_t)(t + 2) * kstep; const char* b2 = last ? nB : cB + (size_t)(t + 2) * kstep;
            const char* a3 = a2 + kstep; const char* b3 = b2 + kstep;
            if (last && has_next) S.a_ready(nxt);
            PG8_LDB(B0, 0, 0); PG8_SCHED; PG8_LDA(At, 0, 0); PG8_STAGE(PG8_SA(1, 1), a1 + hstep, voffA);
            PG8_WAIT_L(8); PG8_BAR; PG8_WAIT_L(0); PG8_MMA(0, 0, At, B0); PG8_BAR; PG8_SCHED;
            PG8_LDB(B1, 0, 1); PG8_STAGE(PG8_SB(0, 0), b2, voffB);
            PG8_BAR; PG8_WAIT_L(0); PG8_MMA(0, 1, At, B1); PG8_BAR;
            PG8_LDA(At, 0, 1); PG8_STAGE(PG8_SA(0, 0), a2, voffA);
            PG8_BAR; PG8_WAIT_L(0); PG8_MMA(1, 0, At, B0); PG8_BAR; PG8_SCHED;
            PG8_STAGE(PG8_SB(0, 1), b2 + hstep, voffB);
            PG8_WAIT_V(6); PG8_BAR; PG8_MMA(1, 1, At, B1); PG8_BAR;
            PG8_LDB(B0, 1, 0); PG8_SCHED; PG8_LDA(At, 1, 0); PG8_STAGE(PG8_SA(0, 1), a2 + hstep, voffA);
            PG8_WAIT_L(8); PG8_BAR; PG8_WAIT_L(0); PG8_MMA(0, 0, At, B0); PG8_BAR; PG8_SCHED;
            PG8_LDB(B1, 1, 1); PG8_STAGE(PG8_SB(1, 0), b3, voffB);
            PG8_BAR; PG8_WAIT_L(0); PG8_MMA(0, 1, At, B1); PG8_BAR;
            PG8_LDA(At, 1, 1); PG8_STAGE(PG8_SA(1, 0), a3, voffA);
            PG8_BAR; PG8_WAIT_L(0); PG8_MMA(1, 0, At, B0); PG8_BAR; PG8_SCHED;
            PG8_STAGE(PG8_SB(1, 1), b3 + hstep, voffB);
            PG8_WAIT_V(6); PG8_BAR; PG8_MMA(1, 1, At, B1); PG8_BAR;
        }
        PG8_STAMP();
        if constexpr (!Epi::AFTER_DRAIN) { E(acc, cur, wr, wc, fr, fq); S.done(cur); }
        PG8_STAMP();
        if (!has_next) break;
#pragma unroll
        for (int a = 0; a < 2; ++a)
#pragma unroll
            for (int b = 0; b < 2; ++b)
#pragma unroll
                for (int m = 0; m < 4; ++m)
#pragma unroll
                    for (int n = 0; n < 2; ++n) acc[a][b][m][n] = (f32x4){0.f, 0.f, 0.f, 0.f};
        cur = nxt; cA = nA; cB = nB; ++ui;
    }
    PG8_WAIT_V(0);
    if (wr == 0) PG8_BAR;
    PG8_BAR;
    if constexpr (Epi::AFTER_DRAIN) { E.fused(acc, cur, wr, wc, fr, fq, lds, wid, lane); S.done(cur); }
    PG8_STAMP();
    if (STAMP && wid == 0) { stamps[lane] = lane < nts ? (((unsigned long long)(unsigned)ts_hi << 32) | (unsigned)ts_lo) : 0ull;
        if (lane == 62) stamps[62] = rt_entry; if (lane == 63) stamps[63] = (unsigned long long)wall_clock64(); }
#undef PG8_STAMP
#undef PG8_SA
#undef PG8_SB
#undef PG8_STAGE
#undef PG8_LDA
#undef PG8_LDB
#undef PG8_MMA
#undef PG8_WAIT_V
#undef PG8_WAIT_L
#undef PG8_BAR
#undef PG8_SCHED
}
}

#define XB_TMO      128
#define XB_XCNT(j)  (256  + 64 * (j))
#define XB_XSUB(j)  (1280 + 64 * (j))
#define XB_XGEN(j)  (2304 + 64 * (j))
#define XB_TOP      3328
#define XB_TOPGEN   3392
#define XCD_BAR_WORDS 3456
#define XB_SPIN_CAP (1u << 18)
#define LAS __attribute__((address_space(3)))

__device__ __forceinline__ unsigned xb_ld(unsigned* p)              { return __hip_atomic_load(p, __ATOMIC_RELAXED, __HIP_MEMORY_SCOPE_AGENT); }
__device__ __forceinline__ unsigned xb_add(unsigned* p, unsigned v) { return __hip_atomic_fetch_add(p, v, __ATOMIC_RELAXED, __HIP_MEMORY_SCOPE_AGENT); }
__device__ __forceinline__ unsigned xb_xcc_id() { return (unsigned)__builtin_amdgcn_s_getreg((3 << 11) | 20) & 0xFu; }
#define XB_SPIN(cond, bar) do { unsigned _sp = 0; while (cond) { __builtin_amdgcn_s_sleep(1); \
    if ((++_sp & 255u) == 0u) { if (xb_ld(&(bar)[XB_TMO])) break; if (_sp > XB_SPIN_CAP) { atomicAdd(&(bar)[XB_TMO], 1u); break; } } } } while (0)

struct XcdBarrier {
    unsigned* bar; unsigned x;
    volatile LAS unsigned* st;
};

__device__ __forceinline__ XcdBarrier xcd_barrier_post(unsigned* bar, volatile LAS unsigned* st) {
    XcdBarrier b; b.bar = bar; b.x = xb_xcc_id(); b.st = st;
    if (threadIdx.x == 0) (void)xb_add(&bar[XB_XCNT(b.x)], 1u);
    return b;
}
__device__ __forceinline__ void xcd_barrier_complete(unsigned* bar, unsigned x, unsigned& nloc, unsigned& nx) {
    const unsigned G = gridDim.x * gridDim.y * gridDim.z;
    unsigned sum, cnt, mine, sp = 0u;
    for (;;) {
        sum = 0u; cnt = 0u; mine = 0u;
#pragma unroll
        for (unsigned j = 0; j < 16; ++j) { const unsigned c = xb_ld(&bar[XB_XCNT(j)]); sum += c; cnt += (c > 0u) ? 1u : 0u; mine = (j == x) ? c : mine; }
        if (sum == G) break;
        __builtin_amdgcn_s_sleep(1);
        if ((++sp & 255u) == 0u) { if (xb_ld(&bar[XB_TMO])) break; if (sp > XB_SPIN_CAP) { atomicAdd(&bar[XB_TMO], 1u); break; } }
    }
    nloc = mine > 0u ? mine : 1u; nx = cnt > 0u ? cnt : 1u;
}

__device__ __attribute__((noinline)) void xcd_barrier_impl(unsigned* bar_, unsigned x_, volatile LAS unsigned* st_) {
    XcdBarrier b; b.bar = bar_; b.x = x_; b.st = st_;
    asm volatile("s_waitcnt vmcnt(0)" ::: "memory");
    __syncthreads();
    if (threadIdx.x == 0) {
        unsigned* bar = b.bar;
        __builtin_amdgcn_s_waitcnt(0);
        unsigned nloc = b.st[0], nx = b.st[1];
        if (nloc == 0u) { xcd_barrier_complete(bar, b.x, nloc, nx); b.st[0] = nloc; b.st[1] = nx; }
        const unsigned old = xb_add(&bar[XB_XSUB(b.x)], 1u);
        const unsigned gen = old / nloc;
        if (old + 1u == (gen + 1u) * nloc) {
            __builtin_amdgcn_fence(__ATOMIC_RELEASE, "agent");
            asm volatile("s_waitcnt vmcnt(0)" ::: "memory");
            const unsigned og = xb_add(&bar[XB_TOP], 1u);
            const unsigned tg = og / nx;
            if (og + 1u == (tg + 1u) * nx) xb_add(&bar[XB_TOPGEN], 1u);
            else XB_SPIN(xb_ld(&bar[XB_TOPGEN]) == tg, bar);
            __builtin_amdgcn_fence(__ATOMIC_ACQUIRE, "agent");
            xb_add(&bar[XB_XGEN(b.x)], 1u);
            asm volatile("s_waitcnt vmcnt(0)" ::: "memory");
        } else {
            XB_SPIN(xb_ld(&bar[XB_XGEN(b.x)]) == gen, bar);
            __builtin_amdgcn_fence(__ATOMIC_ACQUIRE, "agent");
            asm volatile("s_waitcnt vmcnt(0)" ::: "memory");
        }
    }
    __syncthreads();
}

__device__ __forceinline__ void xcd_barrier(const XcdBarrier& b) { xcd_barrier_impl(b.bar, b.x, b.st); }

typedef unsigned short u16;
using pg8::bf16x8; using pg8::f32x4;
typedef unsigned u32x2 __attribute__((ext_vector_type(2)));
typedef unsigned u32x4v __attribute__((ext_vector_type(4)));

constexpr int DM = 1024, NB = 4, SEQ = 4096, CTXL = 256, RL = NB * SEQ, RC = NB * CTXL, RT = RL + RC;
constexpr int DFF = 2816, NMOD = 6;
constexpr int P0_LD = 2592;
constexpr int P0_K = 0, P0_V = 256, P0_LR = 768, P0_Q = 800, P0_R = 1056, P0_U = 1568, P0_G = 2080;
constexpr int XBC_LD = 3072;
constexpr float EPS = 1e-6f;

constexpr size_t OFF_MOD = 0;
constexpr size_t OFF_A = 262144;
constexpr size_t A_AB_IN = OFF_A, A_AB_OUT = A_AB_IN + (size_t)2816 * 1024 * 2, A_FF_IN0 = A_AB_OUT + (size_t)1024 * 1024 * 2, A_FF_OUT0 = A_FF_IN0 + (size_t)5632 * 1024 * 2;
constexpr size_t A_END = A_FF_OUT0 + (size_t)1024 * 2816 * 2;
constexpr size_t A_DTRAW = OFF_A, A_HALO = A_DTRAW + (size_t)RT * 64 * 4;
constexpr size_t A_SSD_OUT = OFF_A, A_FF_IN1 = A_SSD_OUT + (size_t)1024 * 2048 * 2, A_FF_OUT1 = A_FF_IN1 + (size_t)5632 * 1024 * 2;
constexpr size_t OFF_B = A_END;
constexpr size_t B_SSD_INA = OFF_B, B_WZ = B_SSD_INA + (size_t)3328 * 1024 * 2, B_END = B_WZ + (size_t)2048 * 1024 * 2;
constexpr size_t OFF_XC = B_END;
constexpr size_t OFF_H = OFF_XC + (size_t)RC * DM * 4;
constexpr size_t OFF_DSC = OFF_H + (size_t)RT * DM * 2;
constexpr size_t OFF_DEC = OFF_DSC + (size_t)4 * 2 * 4 * 4 * 8192 * 4;
constexpr size_t OFF_E = OFF_DEC + (size_t)4 * 2 * 4 * 68 * 64 * 4;
constexpr size_t E_P0 = OFF_E, E_ACT = OFF_E, E_XBC = OFF_E, E_Z = OFF_E;
constexpr size_t E_Y = OFF_E + (size_t)RT * XBC_LD * 2;
constexpr size_t T_DT = E_Y + (size_t)RL * 2048 * 2, T_ACUM = T_DT + (size_t)RT * 64 * 4;
constexpr size_t WS_END = T_ACUM + (size_t)RT * 64 * 4;
constexpr size_t E_PART = OFF_E + (size_t)100 * 1024 * 1024;
constexpr size_t A_CB = OFF_A;
static_assert(A_HALO + (size_t)272 * 4 * 3072 * 2 <= A_END && A_FF_OUT1 + (size_t)1024 * 2816 * 2 <= A_END && A_CB + (size_t)512 * 16384 * 2 <= A_END, "region A overflow");
static_assert(WS_END <= (size_t)256 * 1024 * 1024, "workspace over 256 MiB");

constexpr int LDS_BYTES = 144 * 1024;
constexpr int LDS_XB = LDS_BYTES - 16;
constexpr size_t OFF_BAR = 245760;

struct Params { const float* in[26]; float* out; unsigned char* ws; };
enum { I_X = 0, I_C, I_CTX, I_CCTX, I_MODW, I_MODB, I_NORMG, I_FFWIN, I_FFWOUT, I_ABWIN, I_ABGW, I_ABGB, I_ABGNG, I_ABVNG, I_ABSW, I_ABSB, I_ABWOUT,
       I_SSDWIN, I_SSDCW, I_SSDCB, I_SSDDTB, I_SSDALOG, I_SSDD, I_SSDNG, I_SSDWOUT, I_FNG };

__device__ __forceinline__ u16 f2bf(float f) { return __builtin_bit_cast(u16, (__bf16)f); }
__device__ __forceinline__ float bf2f(unsigned b) { return __uint_as_float(b << 16); }
typedef float f32x2v __attribute__((ext_vector_type(2)));
typedef __bf16 bf16x2v __attribute__((ext_vector_type(2)));
__device__ __forceinline__ unsigned pk2(float lo, float hi) { const f32x2v v = {lo, hi}; return __builtin_bit_cast(unsigned, __builtin_convertvector(v, bf16x2v)); }
__device__ __forceinline__ float bflo(unsigned w) { return __uint_as_float(w << 16); }
__device__ __forceinline__ float bfhi(unsigned w) { return __uint_as_float(w & 0xFFFF0000u); }
__device__ __forceinline__ float siluf(float x) { return x * __builtin_amdgcn_rcpf(1.0f + __expf(-x)); }
__device__ __forceinline__ float geluf(float x) { const float y = 0.7978845608028654f * (x + 0.044715f * x * x * x); const float th = 1.0f - 2.0f * __builtin_amdgcn_rcpf(1.0f + __expf(2.0f * y)); return 0.5f * x * (1.0f + th); }
__device__ __forceinline__ float softplusf(float x) { return fmaxf(x, 0.f) + log1pf(__expf(-fabsf(x))); }
__device__ __forceinline__ float logsigmoidf(float x) { return fminf(x, 0.f) - __logf(1.0f + __expf(-fabsf(x))); }
__device__ __forceinline__ float wave_sum(float v) {
#pragma unroll
    for (int o = 32; o > 0; o >>= 1) v += __shfl_xor(v, o, 64);
    return v;
}

template <int MT, int NT>
__device__ __forceinline__ void wave_mma(f32x4 (&acc)[MT][NT], const u16* A, int lda, const u16* B, int ldb, int ksteps) {
    const int lane = threadIdx.x & 63, fr = lane & 15, fq = lane >> 4;
    const u16* ap = A + fr * lda + fq * 8; const u16* bp = B + fr * ldb + fq * 8;
    for (int k = 0; k < ksteps; ++k) {
        bf16x8 a[MT], b[NT];
#pragma unroll
        for (int i = 0; i < MT; ++i) a[i] = *(const bf16x8*)(ap + i * 16 * lda + k * 32);
#pragma unroll
        for (int i = 0; i < NT; ++i) b[i] = *(const bf16x8*)(bp + i * 16 * ldb + k * 32);
#pragma unroll
        for (int i = 0; i < MT; ++i)
#pragma unroll
            for (int j = 0; j < NT; ++j) acc[i][j] = __builtin_amdgcn_mfma_f32_16x16x32_bf16(a[i], b[j], acc[i][j], 0, 0, 0);
    }
}
template <int MT, int NT> __device__ __forceinline__ void zero_acc(f32x4 (&acc)[MT][NT]) {
#pragma unroll
    for (int i = 0; i < MT; ++i)
#pragma unroll
        for (int j = 0; j < NT; ++j) acc[i][j] = (f32x4){0.f, 0.f, 0.f, 0.f};
}

__device__ __forceinline__ u32x4v pack8(const f32x4& a, const f32x4& b) { u32x4v r; r[0] = pk2(a[0], a[1]); r[1] = pk2(a[2], a[3]); r[2] = pk2(b[0], b[1]); r[3] = pk2(b[2], b[3]); return r; }

struct EpiBf16Plain {
    static constexpr bool PERM = true, AFTER_DRAIN = false;
    u16* O; int ld; int ncols;
    __device__ __forceinline__ void operator()(const f32x4 (&acc)[2][2][4][2], const pg8::Unit& u, int wr, int wc, int fr, int fq) const {
        const int row0 = u.pm * 256 + wr * 64 + fr, col0 = u.pn * 256 + wc * 32 + 8 * fq;
#pragma unroll
        for (int ai = 0; ai < 2; ++ai)
#pragma unroll
            for (int m = 0; m < 4; ++m) { const int row = row0 + ai * 128 + m * 16;
#pragma unroll
                for (int bj = 0; bj < 2; ++bj) { const int c = col0 + bj * 128; if (c < ncols) *(u32x4v*)(O + (size_t)row * ld + c) = pack8(acc[ai][bj][m][0], acc[ai][bj][m][1]); } }
    }
};
struct EpiSwiglu {
    static constexpr bool PERM = true, AFTER_DRAIN = false;
    u16* O;
    __device__ __forceinline__ void operator()(const f32x4 (&acc)[2][2][4][2], const pg8::Unit& u, int wr, int wc, int fr, int fq) const {
        const int row0 = u.pm * 256 + wr * 64 + fr, j0 = u.pn * 128 + wc * 32 + 8 * fq;
#pragma unroll
        for (int ai = 0; ai < 2; ++ai)
#pragma unroll
            for (int m = 0; m < 4; ++m) { const int row = row0 + ai * 128 + m * 16; f32x4 o0, o1;
#pragma unroll
                for (int i = 0; i < 4; ++i) { o0[i] = siluf(acc[ai][0][m][0][i]) * acc[ai][1][m][0][i]; o1[i] = siluf(acc[ai][0][m][1][i]) * acc[ai][1][m][1][i]; }
                *(u32x4v*)(O + (size_t)row * DFF + j0) = pack8(o0, o1); }
    }
};
struct EpiSsdIn {
    static constexpr bool PERM = true, AFTER_DRAIN = false;
    u16* XBC; u16* HALO; float* DTRAW;
    __device__ __forceinline__ void operator()(const f32x4 (&acc)[2][2][4][2], const pg8::Unit& u, int wr, int wc, int fr, int fq) const {
        const int row0 = u.pm * 256 + wr * 64 + fr, col0 = u.pn * 256 + wc * 32 + 8 * fq;
#pragma unroll
        for (int ai = 0; ai < 2; ++ai)
#pragma unroll
            for (int m = 0; m < 4; ++m) { const int row = row0 + ai * 128 + m * 16; const int rr = row & 63; const int slot = rr < 2 ? rr : (rr >= 62 ? rr - 60 : -1);
#pragma unroll
                for (int bj = 0; bj < 2; ++bj) { const int c = col0 + bj * 128;
                    if (c < 3072) { const u32x4v v = pack8(acc[ai][bj][m][0], acc[ai][bj][m][1]); *(u32x4v*)(XBC + (size_t)row * XBC_LD + c) = v;
                        if (slot >= 0) *(u32x4v*)(HALO + ((size_t)(row >> 6) * 4 + slot) * XBC_LD + c) = v; }
                    else if (c < 3136) { float* d = DTRAW + (size_t)row * 64 + (c - 3072); *(f32x4*)d = acc[ai][bj][m][0]; *(f32x4*)(d + 4) = acc[ai][bj][m][1]; } } }
    }
};
struct EpiRes {
    static constexpr bool PERM = false, AFTER_DRAIN = false;
    const float* src_lat; const float* src_ctx; float* dst_lat; float* dst_ctx; const float* gate; int cm; float* part;
    __device__ __forceinline__ void operator()(const f32x4 (&acc)[2][2][4][2], const pg8::Unit& u, int wr, int wc, int fr, int fq) const {
        const int row0 = u.pm * 256 + wr * 64 + fr, col0 = u.pn * 256 + wc * 32 + 4 * fq;
#pragma unroll
        for (int ai = 0; ai < 2; ++ai)
#pragma unroll
            for (int m = 0; m < 4; ++m) { const int row = row0 + ai * 128 + m * 16; const float* s; float* d; int mi;
                if (row < RL) { const int xr = cm ? ((row & ~4095) | ((row & 63) << 6) | ((row >> 6) & 63)) : row; s = src_lat + (size_t)xr * DM; d = dst_lat + (size_t)xr * DM; mi = row >> 12; }
                else { s = src_ctx + (size_t)(row - RL) * DM; d = dst_ctx + (size_t)(row - RL) * DM; mi = 4; }
                const float* gt = gate + mi * (NMOD * DM);
                if (part != nullptr && row >= RL) { float* pd = part + ((size_t)(u.kt0 >> 2) * RC + (row - RL)) * DM;
#pragma unroll
                    for (int bj = 0; bj < 2; ++bj)
#pragma unroll
                        for (int n = 0; n < 2; ++n) { const int c = col0 + bj * 128 + n * 16; *(f32x4*)(pd + c) = acc[ai][bj][m][n]; }
                    continue; }
#pragma unroll
                for (int bj = 0; bj < 2; ++bj)
#pragma unroll
                    for (int n = 0; n < 2; ++n) { const int c = col0 + bj * 128 + n * 16; const f32x4 g4 = *(const f32x4*)(gt + c), x4 = *(const f32x4*)(s + c);
                        *(f32x4*)(d + c) = x4 + g4 * acc[ai][bj][m][n]; } }
    }
};

template <class Epi> __device__ __forceinline__ void run_gemm(unsigned char* shm, const u16* A, const u16* Bt, int M, int N, int K, const Epi& E) {
    pg8::Gemm g; g.A = A; g.Bt = Bt; g.M = M; g.N = N; g.K = K;
    pg8::StaticOrder S; S.init(M, N, (int)gridDim.x, (int)blockIdx.x, K);
    pg8::gemm_phase<Epi, pg8::StaticOrder, false>((PG8_LAS unsigned char*)shm, g, S, E, nullptr);
}

struct SplitOrder {
    pg8::StaticOrder lat; int nlat, nsl, nctx, G, c, nN;
    __device__ void init(int N, int K, int G_, int c_) { lat.init(RL, N, G_, c_, K); nlat = lat.nwg; nN = N / 256; nsl = (K / 64) / 4; nctx = (RC / 256) * nN * nsl; G = G_; c = c_; }
    __device__ bool next(int i, pg8::Unit& u) const {
        const long L = (long)i * G + c; if (L < nlat) return lat.next(i, u);
        const int j = (int)(L - nlat); if (j >= nctx) return false;
        const int sl = j % nsl, tile = j / nsl; u.pm = RL / 256 + tile / nN; u.pn = tile % nN; u.kt0 = sl * 4; u.nkt = 4; return true; }
    __device__ __forceinline__ void a_ready(const pg8::Unit&) const {}
    __device__ __forceinline__ void done(const pg8::Unit&) const {}
};
template <class Epi> __device__ __forceinline__ void run_gemm_split(unsigned char* shm, const u16* A, const u16* Bt, int N, int K, const Epi& E) {
    pg8::Gemm g; g.A = A; g.Bt = Bt; g.M = RT; g.N = N; g.K = K;
    SplitOrder S; S.init(N, K, (int)gridDim.x, (int)blockIdx.x);
    pg8::gemm_phase<Epi, SplitOrder, false>((PG8_LAS unsigned char*)shm, g, S, E, nullptr);
}

__device__ __forceinline__ int wcol(int r, int N, int mode) {
    if (mode == 0) return r < N ? r : -1;
    if (mode == 1) { const int q = r >> 8, s = (r >> 7) & 1, i = r & 127; return s * DFF + 128 * q + i; }
    if (mode == 2) return r + 3136;
    return r < 3136 ? r : -1;
}
__device__ __forceinline__ void convert_tile(unsigned char* shm, const float* src, u16* dst, int K, int N, int mode, int ti) {
    u16* tile = (u16*)shm;
    const int t = threadIdx.x, rl = t & 63, k0 = t >> 6, r2 = t >> 3, kk = (t & 7) * 8;
    const int nkt = K >> 7, rb = (ti / nkt) << 6, kb = (ti % nkt) << 7;
    const int col = wcol(rb + rl, N, mode);
    const float* sp = src + (size_t)(kb + k0) * N + (col >= 0 ? col : 0);
    float v[16];
#pragma unroll
    for (int i = 0; i < 16; ++i) v[i] = sp[(size_t)(8 * i) * N];
#pragma unroll
    for (int i = 0; i < 16; ++i) tile[rl * 136 + k0 + 8 * i] = f2bf(col >= 0 ? v[i] : 0.f);
    __syncthreads();
    *(u32x4v*)(dst + (size_t)(rb + r2) * K + kb + kk) = *(const u32x4v*)(tile + r2 * 136 + kk);
    *(u32x4v*)(dst + (size_t)(rb + r2) * K + kb + 64 + kk) = *(const u32x4v*)(tile + r2 * 136 + 64 + kk);
    __syncthreads();
}
constexpr int wtiles(int NR, int K) { return (NR / 64) * (K / 128); }
__device__ void convert_weights_early(unsigned char* shm, const Params& p) {
    unsigned char* ws = p.ws;
    constexpr int T0 = wtiles(5632, 1024), T1 = wtiles(1024, 2816), T2 = wtiles(3328, 1024), T3 = wtiles(2816, 1024), T4 = wtiles(2048, 1024), T5 = wtiles(1024, 1024);
    for (int gi = blockIdx.x; gi < T0 + T1 + T2 + T3 + T4 + T5; gi += gridDim.x) {
        int ti = gi;
        if (ti < T0) { convert_tile(shm, p.in[I_FFWIN], (u16*)(ws + A_FF_IN0), 1024, 5632, 1, ti); continue; } ti -= T0;
        if (ti < T1) { convert_tile(shm, p.in[I_FFWOUT], (u16*)(ws + A_FF_OUT0), 2816, 1024, 0, ti); continue; } ti -= T1;
        if (ti < T2) { convert_tile(shm, p.in[I_SSDWIN], (u16*)(ws + B_SSD_INA), 1024, 5184, 3, ti); continue; } ti -= T2;
        if (ti < T3) { convert_tile(shm, p.in[I_ABWIN], (u16*)(ws + A_AB_IN), 1024, 2592, 0, ti); continue; } ti -= T3;
        if (ti < T4) { convert_tile(shm, p.in[I_SSDWIN], (u16*)(ws + B_WZ), 1024, 5184, 2, ti); continue; } ti -= T4;
        convert_tile(shm, p.in[I_ABWOUT], (u16*)(ws + A_AB_OUT), 1024, 1024, 0, ti);
    }
}
__device__ void convert_weights_late(unsigned char* shm, const Params& p) {
    unsigned char* ws = p.ws;
    constexpr int T0 = wtiles(5632, 1024), T1 = wtiles(1024, 2816), T2 = wtiles(1024, 2048);
    for (int gi = blockIdx.x; gi < T0 + T1 + T2; gi += gridDim.x) {
        int ti = gi;
        if (ti < T0) { convert_tile(shm, p.in[I_FFWIN] + (size_t)1024 * 5632, (u16*)(ws + A_FF_IN1), 1024, 5632, 1, ti); continue; } ti -= T0;
        if (ti < T1) { convert_tile(shm, p.in[I_FFWOUT] + (size_t)2816 * 1024, (u16*)(ws + A_FF_OUT1), 2816, 1024, 0, ti); continue; } ti -= T1;
        convert_tile(shm, p.in[I_SSDWOUT], (u16*)(ws + A_SSD_OUT), 2048, 1024, 0, ti);
    }
}
__device__ void mod_gemv(unsigned char* shm, const Params& p) {
    float* sc = (float*)shm;
    float* red = sc + 5 * 1024;
    const int t = threadIdx.x;
    for (int i = t; i < 5 * 1024; i += 512) { const float v = i < 4096 ? p.in[I_C][i] : p.in[I_CCTX][i - 4096]; sc[i] = siluf(v); }
    __syncthreads();
    float* MOD = (float*)(p.ws + OFF_MOD);
    const int n = t & 31, kc = t >> 5;
    for (int job = blockIdx.x; job < 2 * 192; job += gridDim.x) {
        const int l = job / 192, nb = (job % 192) * 32;
        const float* W = p.in[I_MODW] + (size_t)l * DM * (NMOD * DM) + nb + n;
        float a[5] = {0.f, 0.f, 0.f, 0.f, 0.f};
#pragma unroll 16
        for (int i = 0; i < 64; ++i) { const int k = kc + 16 * i; const float w = W[(size_t)k * (NMOD * DM)];
#pragma unroll
            for (int m = 0; m < 5; ++m) a[m] += sc[m * 1024 + k] * w; }
#pragma unroll
        for (int m = 0; m < 5; ++m) red[(kc * 5 + m) * 32 + n] = a[m];
        __syncthreads();
        if (t < 160) { const int m = t >> 5; float s = 0.f;
#pragma unroll
            for (int q = 0; q < 16; ++q) s += red[(q * 5 + m) * 32 + n];
            MOD[((size_t)l * 5 + m) * (NMOD * DM) + nb + n] = s + p.in[I_MODB][(size_t)l * (NMOD * DM) + nb + n]; }
        __syncthreads();
    }
}

__device__ void norm_mod_phase(const float* lat, const float* ctx, const float* ng, const float* modl  , int ishift, int iscale, int nrows, int cm, u16* H, const float* part = nullptr, int nsl = 0, const float* pgate = nullptr, float* xc_out = nullptr) {
    const int lane = threadIdx.x & 63, wid = threadIdx.x >> 6;
    for (int row = blockIdx.x * 8 + wid; row < nrows; row += gridDim.x * 8) {
        const float* s = row < RL ? lat + (size_t)row * DM : ctx + (size_t)(row - RL) * DM;
        const int mi = row < RL ? (row >> 12) : 4;
        f32x4 v[4], pg[4], psh[4], psc[4]; float ss = 0.f;
        const float* sh = modl + mi * (NMOD * DM) + ishift * DM; const float* scp = modl + mi * (NMOD * DM) + iscale * DM;
#pragma unroll
        for (int i = 0; i < 4; ++i) v[i] = *(const f32x4*)(s + i * 256 + lane * 4);
#pragma unroll
        for (int i = 0; i < 4; ++i) { const int c = i * 256 + lane * 4; pg[i] = *(const f32x4*)(ng + c); psh[i] = *(const f32x4*)(sh + c); psc[i] = *(const f32x4*)(scp + c); }
#pragma unroll
        for (int i = 0; i < 4; ++i) ss += v[i][0] * v[i][0] + v[i][1] * v[i][1] + v[i][2] * v[i][2] + v[i][3] * v[i][3];
        if (part != nullptr && row >= RL) {
            ss = 0.f;
#pragma unroll
            for (int i = 0; i < 4; ++i) { const int c = i * 256 + lane * 4; f32x4 a = {0.f, 0.f, 0.f, 0.f};
                for (int sl = 0; sl < nsl; ++sl) a += *(const f32x4*)(part + ((size_t)sl * RC + (row - RL)) * DM + c);
                v[i] += *(const f32x4*)(pgate + c) * a; *(f32x4*)(xc_out + (size_t)(row - RL) * DM + c) = v[i];
                ss += v[i][0] * v[i][0] + v[i][1] * v[i][1] + v[i][2] * v[i][2] + v[i][3] * v[i][3]; } }
        ss = wave_sum(ss);
        const float rs = rsqrtf(ss * (1.0f / DM) + EPS);
        const int dr = (cm && row < RL) ? ((row & ~4095) | ((row & 63) << 6) | ((row >> 6) & 63)) : row;
#pragma unroll
        for (int i = 0; i < 4; ++i) { const int c = i * 256 + lane * 4; const f32x4 g4 = pg[i], sh4 = psh[i], sc4 = psc[i];
            float o[4];
#pragma unroll
            for (int e = 0; e < 4; ++e) o[e] = (v[i][e] * rs * g4[e]) * (1.0f + sc4[e]) + sh4[e];
            u32x2 w; w[0] = pk2(o[0], o[1]); w[1] = pk2(o[2], o[3]); *(u32x2*)(H + (size_t)dr * DM + c) = w; }
    }
}
__device__ void final_norm_phase(float* X, const float* g) {
    const int lane = threadIdx.x & 63, wid = threadIdx.x >> 6;
    for (int row = blockIdx.x * 8 + wid; row < RL; row += gridDim.x * 8) {
        float* s = X + (size_t)row * DM; f32x4 v[4]; float ss = 0.f;
#pragma unroll
        for (int i = 0; i < 4; ++i) { v[i] = *(const f32x4*)(s + i * 256 + lane * 4); ss += v[i][0] * v[i][0] + v[i][1] * v[i][1] + v[i][2] * v[i][2] + v[i][3] * v[i][3]; }
        ss = wave_sum(ss);
        const float rs = rsqrtf(ss * (1.0f / DM) + EPS);
#pragma unroll
        for (int i = 0; i < 4; ++i) { const int c = i * 256 + lane * 4; const f32x4 g4 = *(const f32x4*)(g + c); f32x4 o;
#pragma unroll
            for (int e = 0; e < 4; ++e) o[e] = (v[i][e] * rs) * g4[e];
            *(f32x4*)(s + c) = o; }
    }
}

__device__ __forceinline__ int gla_rowbase(int b, int c) { return c < 4 ? RL + b * CTXL + c * 64 : b * SEQ + (c - 4) * 64; }
__device__ __forceinline__ float* gla_ds_ptr(const Params& p, int b, int d, int h, int c) {
    return c < 4 ? (float*)(p.ws + OFF_DSC) + ((size_t)((b * 2 + d) * 4 + h) * 4 + c) * 8192 : p.out + ((size_t)((b * 2 + d) * 4 + h) * 64 + (c - 4)) * 8192;
}
constexpr int GL_BC = 0;
constexpr int GL_LR = GL_BC + 2 * 64 * 65 * 4;
constexpr int GL_GW = GL_LR + 64 * 32 * 4;
constexpr int GL_X0 = GL_GW + 2 * 16 * 64 * 4;
constexpr int GL_LD = 72;

__device__ void gla_gates(unsigned char* shm, const Params& p, int rowbase, int h) {
    const u16* P0 = (const u16*)(p.ws + E_P0);
    float* BC = (float*)(shm + GL_BC); float* LR = (float*)(shm + GL_LR); float* QS = (float*)(shm + GL_GW);
    const int t = threadIdx.x;
    const int kk = t & 63, lq = (t >> 6) & 3, d = t >> 8;
    float gw[16];
#pragma unroll
    for (int j = 0; j < 16; ++j) gw[j] = p.in[I_ABGW][(size_t)(d * 16 + j) * 256 + h * 64 + kk];
    const float gb = p.in[I_ABGB][d * 256 + h * 64 + kk];
    if (t < 256) { const int row = t >> 2, part = t & 3; const u32x4v w = *(const u32x4v*)(P0 + (size_t)(rowbase + row) * P0_LD + P0_LR + part * 8);
        f32x4 lo, hi; lo[0] = bflo(w[0]); lo[1] = bfhi(w[0]); lo[2] = bflo(w[1]); lo[3] = bfhi(w[1]); hi[0] = bflo(w[2]); hi[1] = bfhi(w[2]); hi[2] = bflo(w[3]); hi[3] = bfhi(w[3]);
        *(f32x4*)(LR + row * 32 + part * 8) = lo; *(f32x4*)(LR + row * 32 + part * 8 + 4) = hi; }
    __syncthreads();
    float la[16];
#pragma unroll
    for (int i = 0; i < 16; ++i) { const int l = lq * 16 + i; const float* lr = LR + l * 32 + d * 16; float pre = gb;
#pragma unroll
        for (int j4 = 0; j4 < 4; ++j4) { const f32x4 v = *(const f32x4*)(lr + j4 * 4); pre += v[0] * gw[j4 * 4] + v[1] * gw[j4 * 4 + 1] + v[2] * gw[j4 * 4 + 2] + v[3] * gw[j4 * 4 + 3]; }
        la[i] = logsigmoidf(pre) * (1.0f / 16.0f); }
    if (d == 0) {
#pragma unroll
        for (int i = 1; i < 16; ++i) la[i] += la[i - 1];
        QS[(d * 4 + lq) * 64 + kk] = la[15];
    } else {
#pragma unroll
        for (int i = 14; i >= 0; --i) la[i] += la[i + 1];
        QS[(d * 4 + lq) * 64 + kk] = la[0];
    }
    __syncthreads();
    float off = 0.f;
    if (d == 0) { for (int q = 0; q < lq; ++q) off += QS[(0 * 4 + q) * 64 + kk]; }
    else { for (int q = 3; q > lq; --q) off += QS[(1 * 4 + q) * 64 + kk]; }
#pragma unroll
    for (int i = 0; i < 16; ++i) BC[(d * 64 + lq * 16 + i) * 65 + kk] = la[i] + off;
    __syncthreads();
}
__device__ __forceinline__ void gla_load_v(u32x4v& w0, u32x4v& w1, const u16* P0, int rowbase, int h) {
    const int t = threadIdx.x, l = t & 63, vg = t >> 6;
    const u16* src = P0 + (size_t)(rowbase + l) * P0_LD + P0_V + h * 128 + vg * 16;
    w0 = *(const u32x4v*)src; w1 = *(const u32x4v*)(src + 8);
}
__device__ __forceinline__ void gla_stage_vT(u16* vT, const u32x4v& w0, const u32x4v& w1) {
    const int t = threadIdx.x, l = t & 63, vg = t >> 6;
#pragma unroll
    for (int e = 0; e < 4; ++e) { vT[(vg * 16 + 2 * e) * GL_LD + l] = (u16)(w0[e] & 0xFFFF); vT[(vg * 16 + 2 * e + 1) * GL_LD + l] = (u16)(w0[e] >> 16);
        vT[(vg * 16 + 8 + 2 * e) * GL_LD + l] = (u16)(w1[e] & 0xFFFF); vT[(vg * 16 + 8 + 2 * e + 1) * GL_LD + l] = (u16)(w1[e] >> 16); }
}

__device__ void gla_a_item(unsigned char* shm, const Params& p, int b, int c, int h) {
    const u16* P0 = (const u16*)(p.ws + E_P0);
    const int rowbase = gla_rowbase(b, c), t = threadIdx.x, lane = t & 63, w = t >> 6;
    const u32x4v kw = *(const u32x4v*)(P0 + (size_t)(rowbase + (t & 63)) * P0_LD + P0_K + h * 64 + (t >> 6) * 8);
    u32x4v vw0, vw1; gla_load_v(vw0, vw1, P0, rowbase, h);
    gla_gates(shm, p, rowbase, h);
    const float* BC = (const float*)(shm + GL_BC);
    u16* kwT = (u16*)(shm + GL_X0);
    u16* vT = kwT + 2 * 64 * GL_LD;
    { const int l = t & 63, kg = t >> 6;
#pragma unroll
      for (int e = 0; e < 8; ++e) { const int k = kg * 8 + e; const float kv = (e & 1) ? bfhi(kw[e >> 1]) : bflo(kw[e >> 1]);
          const float w0 = __expf(BC[63 * 65 + k] - BC[l * 65 + k]), w1 = __expf(BC[(64 + 0) * 65 + k] - BC[(64 + l) * 65 + k]);
          kwT[k * GL_LD + l] = f2bf(kv * w0); kwT[(64 + k) * GL_LD + l] = f2bf(kv * w1); } }
    gla_stage_vT(vT, vw0, vw1);
    __syncthreads();
    { const int d = w >> 2, kb = w & 3; f32x4 acc[1][8]; zero_acc(acc);
      wave_mma<1, 8>(acc, kwT + (d * 64 + kb * 16) * GL_LD, GL_LD, vT, GL_LD, 2);
      float* DS = gla_ds_ptr(p, b, d, h, c);
#pragma unroll
      for (int nt = 0; nt < 8; ++nt) { const int v = nt * 16 + (lane & 15), k0 = kb * 16 + (lane >> 4) * 4; *(f32x4*)(DS + v * 64 + k0) = acc[0][nt]; } }
    if (t < 128) { const int d = t >> 6, kk = t & 63; const float bl = d == 0 ? BC[63 * 65 + kk] : BC[64 * 65 + kk];
        ((float*)(p.ws + OFF_DEC))[((size_t)((b * 2 + d) * 4 + h) * 68 + c) * 64 + kk] = __expf(bl); }
    __syncthreads();
}

__device__ void gmlp_item(unsigned char* shm, const Params& p, int b, int cc, int gi) {
    const u16* P0 = (const u16*)(p.ws + E_P0); u16* MG = (u16*)(p.ws + OFF_H);
    const int rowbase = cc < 2 ? RL + b * CTXL + cc * 128 : b * SEQ + (cc - 2) * 128;
    const int t = threadIdx.x, lane = t & 63, w = t >> 6;
    float* st = (float*)shm;
    u16* vnT = (u16*)(shm + 1024);
    u16* Ws = vnT + 128 * 136;
    { const int row = t >> 2, part = t & 3; const u16* src = P0 + (size_t)(rowbase + row) * P0_LD + P0_G + part * 128; float s = 0.f, ss = 0.f;
#pragma unroll 4
      for (int i = 0; i < 16; ++i) { const u32x4v wv = *(const u32x4v*)(src + i * 8);
#pragma unroll
          for (int e = 0; e < 4; ++e) { const float a = geluf(bflo(wv[e])), c2 = geluf(bfhi(wv[e])); s += a + c2; ss += a * a + c2 * c2; } }
      s += __shfl_xor(s, 1, 64); ss += __shfl_xor(ss, 1, 64); s += __shfl_xor(s, 2, 64); ss += __shfl_xor(ss, 2, 64);
      if (part == 0) { const float mu = s * (1.0f / 512.0f); const float var = fmaxf(ss * (1.0f / 512.0f) - mu * mu, 0.f); st[row * 2] = mu; st[row * 2 + 1] = rsqrtf(var + EPS); } }
    { const float* SW = p.in[I_ABSW] + (size_t)gi * 128 * 128;
#pragma unroll
      for (int ps = 0; ps < 8; ++ps) { const int idx = ps * 2048 + t * 4, tt = idx >> 7, s0 = idx & 127; const f32x4 v = *(const f32x4*)(SW + idx);
          u32x2 o; o[0] = pk2(v[0], v[1]); o[1] = pk2(v[2], v[3]); *(u32x2*)(Ws + tt * 136 + s0) = o; } }
    __syncthreads();
    { const int s = t & 127, cg4 = t >> 7; const u16* src = P0 + (size_t)(rowbase + s) * P0_LD + P0_G + gi * 128 + cg4 * 32; const float mu = st[s * 2], rstd = st[s * 2 + 1];
      const float* vg = p.in[I_ABVNG] + gi * 128 + cg4 * 32;
#pragma unroll
      for (int i = 0; i < 4; ++i) { const u32x4v wv = *(const u32x4v*)(src + i * 8);
#pragma unroll
          for (int e = 0; e < 8; ++e) { const float x = (e & 1) ? bfhi(wv[e >> 1]) : bflo(wv[e >> 1]); const int cl = i * 8 + e;
              vnT[(cg4 * 32 + cl) * 136 + s] = f2bf((geluf(x) - mu) * rstd * vg[cl]); } } }
    __syncthreads();
    { f32x4 acc[1][8]; zero_acc(acc);
      wave_mma<1, 8>(acc, vnT + (w * 16) * 136, 136, Ws, 136, 4);
      const int c0 = w * 16 + (lane >> 4) * 4;
#pragma unroll
      for (int nt = 0; nt < 8; ++nt) { const int tt = nt * 16 + (lane & 15); const float sb = p.in[I_ABSB][gi * 128 + tt];
          const u32x2 uw = *(const u32x2*)(P0 + (size_t)(rowbase + tt) * P0_LD + P0_U + gi * 128 + c0);
          const float o0 = geluf(bflo(uw[0])) * (acc[0][nt][0] + sb), o1 = geluf(bfhi(uw[0])) * (acc[0][nt][1] + sb), o2 = geluf(bflo(uw[1])) * (acc[0][nt][2] + sb), o3 = geluf(bfhi(uw[1])) * (acc[0][nt][3] + sb);
          u32x2 o; o[0] = pk2(o0, o1); o[1] = pk2(o2, o3); *(u32x2*)(MG + (size_t)(rowbase + tt) * DM + 512 + gi * 128 + c0) = o; } }
    __syncthreads();
}

__device__ void gla_scan_phase(const Params& p) {
    const float* DEC = (const float*)(p.ws + OFF_DEC);
    for (int g0 = blockIdx.x * 512 + threadIdx.x; g0 < 4 * 2 * 4 * 8192 / 2; g0 += gridDim.x * 512) {
        int e[2], bb[2], dd[2], hh[2]; const float* dec[2]; float s[2] = {0.f, 0.f};
#pragma unroll
        for (int q = 0; q < 2; ++q) { const int gidx = g0 + q * (4 * 2 * 4 * 8192 / 2); e[q] = gidx & 8191; const int bdh = gidx >> 13; hh[q] = bdh & 3; dd[q] = (bdh >> 2) & 1; bb[q] = bdh >> 3; dec[q] = DEC + (size_t)bdh * 68 * 64 + (e[q] & 63); }
        for (int i0 = 0; i0 < 68; i0 += 17) {
            float* ptr[2][17]; float ds[2][17], dc[2][17];
#pragma unroll
            for (int u = 0; u < 17; ++u)
#pragma unroll
                for (int q = 0; q < 2; ++q) { const int i = i0 + u; const int c = dd[q] == 0 ? i : (i < 4 ? 3 - i : 71 - i); ptr[q][u] = gla_ds_ptr(p, bb[q], dd[q], hh[q], c) + e[q]; ds[q][u] = *ptr[q][u]; dc[q][u] = dec[q][c * 64]; }
#pragma unroll
            for (int u = 0; u < 17; ++u)
#pragma unroll
                for (int q = 0; q < 2; ++q) { *ptr[q][u] = s[q]; s[q] = dc[q][u] * s[q] + ds[q][u]; }
        }
    }
}

__device__ void gla_c_item(unsigned char* shm, const Params& p, int b, int c, int h) {
    const u16* P0 = (const u16*)(p.ws + E_P0); u16* MG = (u16*)(p.ws + OFF_H);
    const int rowbase = gla_rowbase(b, c), t = threadIdx.x, lane = t & 63, w = t >> 6;
    const u16* rp_ = P0 + (size_t)(rowbase + (t & 63)) * P0_LD + h * 64 + (t >> 6) * 8;
    const u32x4v qw = *(const u32x4v*)(rp_ + P0_Q), kw = *(const u32x4v*)(rp_ + P0_K);
    u32x4v vw0, vw1; gla_load_v(vw0, vw1, P0, rowbase, h);
    f32x4 spa[4], spb[4];
#pragma unroll
    for (int ps = 0; ps < 4; ++ps) { const int idx = ps * 4096 + t * 8; const float* src = gla_ds_ptr(p, b, idx >> 13, h, c) + (idx & 8191); spa[ps] = *(const f32x4*)src; spb[ps] = *(const f32x4*)(src + 4); }
    const u16* rrp = P0 + (size_t)(rowbase + (t >> 3)) * P0_LD + P0_R + h * 128 + (t & 7) * 16;
    const u32x4v r0 = *(const u32x4v*)rrp, r1 = *(const u32x4v*)(rrp + 8);
    gla_gates(shm, p, rowbase, h);
    const float* BC = (const float*)(shm + GL_BC);
    u16* qd = (u16*)(shm + GL_X0);
    u16* kd = qd + 2 * 64 * GL_LD;
    u16* vT = kd + 2 * 64 * GL_LD;
    u16* SpT = vT + 128 * GL_LD;
    u16* SC = (u16*)(shm + GL_BC);
    float* O = (float*)SpT;
    { const int l = t & 63, kg = t >> 6;
#pragma unroll
      for (int d = 0; d < 2; ++d) { u32x4v qo, ko;
#pragma unroll
          for (int e2 = 0; e2 < 4; ++e2) { const float e0 = BC[(d * 64 + l) * 65 + kg * 8 + 2 * e2], e1 = BC[(d * 64 + l) * 65 + kg * 8 + 2 * e2 + 1];
              qo[e2] = pk2(bflo(qw[e2]) * 0.125f * __expf(e0), bfhi(qw[e2]) * 0.125f * __expf(e1));
              ko[e2] = pk2(bflo(kw[e2]) * __expf(-e0), bfhi(kw[e2]) * __expf(-e1)); }
          *(u32x4v*)(qd + (d * 64 + l) * GL_LD + kg * 8) = qo; *(u32x4v*)(kd + (d * 64 + l) * GL_LD + kg * 8) = ko; } }
    gla_stage_vT(vT, vw0, vw1);
#pragma unroll
    for (int ps = 0; ps < 4; ++ps) { const int idx = ps * 4096 + t * 8, d = idx >> 13, rem = idx & 8191, v = rem >> 6, k0 = rem & 63;
        *(u32x4v*)(SpT + (d * 128 + v) * GL_LD + k0) = pack8(spa[ps], spb[ps]); }
    __syncthreads();
    { const int d = w >> 2, lb = w & 3; f32x4 acc[1][4]; zero_acc(acc);
      wave_mma<1, 4>(acc, qd + (d * 64 + lb * 16) * GL_LD, GL_LD, kd + d * 64 * GL_LD, GL_LD, 2);
      __syncthreads();
#pragma unroll
      for (int nt = 0; nt < 4; ++nt)
#pragma unroll
          for (int j = 0; j < 4; ++j) { const int l = lb * 16 + (lane >> 4) * 4 + j, s = nt * 16 + (lane & 15); const bool keep = d == 0 ? (s <= l) : (s >= l);
              SC[(d * 64 + l) * GL_LD + s] = f2bf(keep ? acc[0][nt][j] : 0.f); } }
    __syncthreads();
    f32x4 oacc[1][4]; zero_acc(oacc);
    const int lb = w & 3, vh = w >> 2;
#pragma unroll
    for (int d = 0; d < 2; ++d) {
        wave_mma<1, 4>(oacc, qd + (d * 64 + lb * 16) * GL_LD, GL_LD, SpT + (d * 128 + vh * 64) * GL_LD, GL_LD, 2);
        wave_mma<1, 4>(oacc, SC + (d * 64 + lb * 16) * GL_LD, GL_LD, vT + (vh * 64) * GL_LD, GL_LD, 2);
    }
    __syncthreads();
#pragma unroll
    for (int nt = 0; nt < 4; ++nt)
#pragma unroll
        for (int j = 0; j < 4; ++j) { const int l = lb * 16 + (lane >> 4) * 4 + j, v = vh * 64 + nt * 16 + (lane & 15); O[l * 132 + v] = oacc[0][nt][j]; }
    __syncthreads();
    { const int l = t >> 3, part = t & 7; float o[16]; float ss = 0.f;
#pragma unroll
      for (int i = 0; i < 4; ++i) { const f32x4 v4 = *(const f32x4*)(O + l * 132 + part * 16 + i * 4);
#pragma unroll
          for (int e = 0; e < 4; ++e) { o[i * 4 + e] = v4[e]; ss += v4[e] * v4[e]; } }
      ss += __shfl_xor(ss, 1, 64); ss += __shfl_xor(ss, 2, 64); ss += __shfl_xor(ss, 4, 64);
      const float rs = rsqrtf(ss * (1.0f / 128.0f) + EPS);
      const float* gg = p.in[I_ABGNG] + h * 128 + part * 16; u32x4v o0, o1;
#pragma unroll
      for (int e2 = 0; e2 < 4; ++e2) {
          o0[e2] = pk2(o[2 * e2] * rs * gg[2 * e2] * siluf(bflo(r0[e2])), o[2 * e2 + 1] * rs * gg[2 * e2 + 1] * siluf(bfhi(r0[e2])));
          o1[e2] = pk2(o[8 + 2 * e2] * rs * gg[8 + 2 * e2] * siluf(bflo(r1[e2])), o[8 + 2 * e2 + 1] * rs * gg[8 + 2 * e2 + 1] * siluf(bfhi(r1[e2]))); }
      u16* dst = MG + (size_t)(rowbase + l) * DM + h * 128 + part * 16; *(u32x4v*)dst = o0; *(u32x4v*)(dst + 8) = o1; }
    __syncthreads();
}

__device__ void conv_phase(const Params& p) {
    u16* XBC = (u16*)(p.ws + E_XBC); const u16* HALO = (const u16*)(p.ws + A_HALO);
    const int t = threadIdx.x, cg = t & 127, q = __builtin_amdgcn_readfirstlane(t >> 7);
    for (int it = blockIdx.x; it < (RT / 64) * 3; it += gridDim.x) {
        const int rb = it / 3, cp = (it % 3) * 1024, c0 = cp + cg * 8;
        const bool first = rb < 256 ? ((rb & 63) == 0) : (((rb - 256) & 3) == 0);
        const bool last = rb < 256 ? ((rb & 63) == 63) : (((rb - 256) & 3) == 3);
        const bool z0 = (q == 0) && first, z1 = (q == 3) && last;
        u16* rowq = XBC + ((size_t)rb * 64 + 16 * q) * XBC_LD + cp;
        const u16* pre = (q == 0) ? (z0 ? rowq : HALO + ((size_t)(rb - 1) * 4 + 2) * XBC_LD + cp) : rowq - 2 * XBC_LD;
        const u16* post = (q == 3) ? (z1 ? rowq : HALO + ((size_t)(rb + 1) * 4) * XBC_LD + cp) : rowq + 16 * XBC_LD;
        u32x4v win[20];
        win[0] = *(const u32x4v*)(pre + cg * 8); win[1] = *(const u32x4v*)(pre + XBC_LD + cg * 8);
#pragma unroll
        for (int i = 0; i < 16; ++i) win[2 + i] = *(const u32x4v*)(rowq + (size_t)i * XBC_LD + cg * 8);
        win[18] = *(const u32x4v*)(post + cg * 8); win[19] = *(const u32x4v*)(post + XBC_LD + cg * 8);
        const u32x4v zero = {0u, 0u, 0u, 0u};
        if (z0) { win[0] = zero; win[1] = zero; }
        if (z1) { win[18] = zero; win[19] = zero; }
        float wt[5][8], bias[8];
#pragma unroll
        for (int j = 0; j < 5; ++j) { const f32x4 a = *(const f32x4*)(p.in[I_SSDCW] + j * 3072 + c0), b2 = *(const f32x4*)(p.in[I_SSDCW] + j * 3072 + c0 + 4);
#pragma unroll
            for (int e = 0; e < 4; ++e) { wt[j][e] = a[e]; wt[j][4 + e] = b2[e]; } }
        { const f32x4 a = *(const f32x4*)(p.in[I_SSDCB] + c0), b2 = *(const f32x4*)(p.in[I_SSDCB] + c0 + 4);
#pragma unroll
          for (int e = 0; e < 4; ++e) { bias[e] = a[e]; bias[4 + e] = b2[e]; } }
        __syncthreads();
#pragma unroll
        for (int r = 0; r < 16; ++r) {
            float o[8];
#pragma unroll
            for (int e = 0; e < 8; ++e) o[e] = bias[e];
#pragma unroll
            for (int j = 0; j < 5; ++j)
#pragma unroll
                for (int e2 = 0; e2 < 4; ++e2) { o[2 * e2] += wt[j][2 * e2] * bflo(win[r + j][e2]); o[2 * e2 + 1] += wt[j][2 * e2 + 1] * bfhi(win[r + j][e2]); }
            u32x4v ov;
#pragma unroll
            for (int e2 = 0; e2 < 4; ++e2) ov[e2] = pk2(siluf(o[2 * e2]), siluf(o[2 * e2 + 1]));
            *(u32x4v*)(rowq + (size_t)r * XBC_LD + cg * 8) = ov;
        }
    }
}
__device__ void dt_phase(unsigned char* shm, const Params& p) {
    const float* DTRAW = (const float*)(p.ws + A_DTRAW); float* DT = (float*)(p.ws + T_DT); float* ACUM = (float*)(p.ws + T_ACUM);
    float* tile = (float*)shm;
    float* tdt = tile + 128 * 65;
    const int t = threadIdx.x, col = t & 63;
    const float bias = p.in[I_SSDDTB][col], a = -__expf(p.in[I_SSDALOG][col]);
    for (int ch = blockIdx.x; ch < RT / 128; ch += gridDim.x) {
        const size_t r0 = (size_t)ch * 128;
#pragma unroll
        for (int i = 0; i < 16; ++i) { const int m = i * 8 + (t >> 6); const float d = softplusf(DTRAW[(r0 + m) * 64 + col] + bias); tdt[m * 65 + col] = d; tile[m * 65 + col] = d * a; }
        __syncthreads();
        if (t < 64) { float run = 0.f;
            if (t < 32) { for (int m = 0; m < 128; ++m) { run += tile[m * 65 + t]; tile[m * 65 + t] = run; } }
            else { for (int m = 127; m >= 0; --m) { run += tile[m * 65 + t]; tile[m * 65 + t] = run; } } }
        __syncthreads();
        { const int m = t & 127, cq = t >> 7;
#pragma unroll
          for (int i = 0; i < 16; ++i) { const int c = cq * 16 + i; ACUM[(size_t)c * RT + r0 + m] = tile[m * 65 + c]; DT[(size_t)c * RT + r0 + m] = tdt[m * 65 + c]; } }
        __syncthreads();
    }
}
constexpr int SP_LD = 136;
constexpr int SP_C = 0;
constexpr int SP_B = SP_C + 128 * SP_LD * 2;
constexpr int SP_CB = SP_B + 128 * SP_LD * 2;
constexpr int SP_AC = SP_CB + 128 * SP_LD * 2;
constexpr int SP_DT = SP_AC + 16 * 128 * 4;
constexpr int SP_END = SP_DT + 16 * 128 * 4;
static_assert(SP_END <= LDS_XB, "SSD par LDS");
__device__ void ssd_par_item(unsigned char* shm, const Params& p, int item) {
    const u16* XBC = (const u16*)(p.ws + E_XBC); u16* Y = (u16*)(p.ws + E_Y);
    const float* DT = (const float*)(p.ws + T_DT); const float* ACUM = (const float*)(p.ws + T_ACUM);
    const int g = item & 3, base = (item >> 2) * 128;
    u16* Cs = (u16*)(shm + SP_C); u16* Ms = Cs; u16* Bs = (u16*)(shm + SP_B); u16* xT = Bs; u16* CBs = (u16*)(shm + SP_CB);
    float* acs = (float*)(shm + SP_AC); float* dts = (float*)(shm + SP_DT);
    const int t = threadIdx.x, lane = t & 63, w = t >> 6, fr = lane & 15, fq = lane >> 4;
#pragma unroll
    for (int i = 0; i < 4; ++i) { const int idx = i * 512 + t, m = idx >> 4, seg = idx & 15; const u16* rp = XBC + (size_t)(base + m) * XBC_LD + g * 128 + seg * 8;
        *(u32x4v*)(Cs + m * SP_LD + seg * 8) = *(const u32x4v*)(rp + 2560); *(u32x4v*)(Bs + m * SP_LD + seg * 8) = *(const u32x4v*)(rp + 2048); }
#pragma unroll
    for (int i = 0; i < 4; ++i) { const int idx = i * 512 + t, q = idx >> 7, m = idx & 127, hh = q >> 1, dir = q & 1; const size_t o = (size_t)(dir * 32 + g * 8 + hh) * RT + base + m;
        acs[idx] = ACUM[o]; dts[idx] = DT[o]; }
    __syncthreads();
    { f32x4 acc[1][8]; zero_acc(acc);
      wave_mma<1, 8>(acc, Bs + (w * 16) * SP_LD, SP_LD, Cs, SP_LD, 4);
#pragma unroll
      for (int nt = 0; nt < 8; ++nt) { u32x2 o; o[0] = pk2(acc[0][nt][0], acc[0][nt][1]); o[1] = pk2(acc[0][nt][2], acc[0][nt][3]); *(u32x2*)(CBs + (nt * 16 + fr) * SP_LD + w * 16 + fq * 4) = o; } }
    __syncthreads();
    const int seg = t & 15, mq = t >> 4, xs_ = t & 127, pseg = t >> 7, mrow0 = w * 16;
    u32x4v nx0, nx1;
    { const u16* xp = XBC + (size_t)(base + xs_) * XBC_LD + (g * 8) * 64 + pseg * 16; nx0 = *(const u32x4v*)xp; nx1 = *(const u32x4v*)(xp + 8); }
    for (int hh = 0; hh < 8; ++hh) {
        const int h = g * 8 + hh;
        const float* af = acs + (hh * 2) * 128; const float* ab = af + 128; const float* dtf = dts + (hh * 2) * 128; const float* dtb = dtf + 128;
        u32x2 xsv[4];
        { const size_t row = (size_t)(base + mrow0 + fr);
#pragma unroll
          for (int mt = 0; mt < 4; ++mt) xsv[mt] = *(const u32x2*)(XBC + row * XBC_LD + h * 64 + mt * 16 + fq * 4); }
        { const u32x4v x0 = nx0, x1 = nx1;
          if (hh < 7) { const u16* xp = XBC + (size_t)(base + xs_) * XBC_LD + (h + 1) * 64 + pseg * 16; nx0 = *(const u32x4v*)xp; nx1 = *(const u32x4v*)(xp + 8); }
#pragma unroll
          for (int e2 = 0; e2 < 4; ++e2) { xT[(pseg * 16 + 2 * e2) * SP_LD + xs_] = (u16)(x0[e2] & 0xFFFFu); xT[(pseg * 16 + 2 * e2 + 1) * SP_LD + xs_] = (u16)(x0[e2] >> 16);
              xT[(pseg * 16 + 8 + 2 * e2) * SP_LD + xs_] = (u16)(x1[e2] & 0xFFFFu); xT[(pseg * 16 + 8 + 2 * e2 + 1) * SP_LD + xs_] = (u16)(x1[e2] >> 16); } }
        { float afs[8], abs_[8], wf[8], wb[8];
#pragma unroll
          for (int q = 0; q < 2; ++q) { const f32x4 a4 = *(const f32x4*)(af + seg * 8 + 4 * q), b4 = *(const f32x4*)(ab + seg * 8 + 4 * q), c4 = *(const f32x4*)(dtf + seg * 8 + 4 * q), d4 = *(const f32x4*)(dtb + seg * 8 + 4 * q);
#pragma unroll
              for (int e = 0; e < 4; ++e) { afs[4 * q + e] = a4[e]; abs_[4 * q + e] = b4[e]; wf[4 * q + e] = c4[e]; wb[4 * q + e] = d4[e]; } }
#pragma unroll
          for (int i = 0; i < 4; ++i) { const int m = mq + 32 * i; const u32x4v cw = *(const u32x4v*)(CBs + m * SP_LD + seg * 8); const float amf = af[m], amb = ab[m]; float v[8];
#pragma unroll
              for (int e = 0; e < 8; ++e) { const int s2 = seg * 8 + e; const float cbv = (e & 1) ? bfhi(cw[e >> 1]) : bflo(cw[e >> 1]);
                  const float arg = s2 < m ? (amf - afs[e]) : (s2 > m ? (amb - abs_[e]) : 0.f); const float wgt = s2 < m ? wf[e] : (s2 > m ? wb[e] : wf[e] + wb[e]);
                  v[e] = cbv * __expf(arg) * wgt; }
              u32x4v mv; mv[0] = pk2(v[0], v[1]); mv[1] = pk2(v[2], v[3]); mv[2] = pk2(v[4], v[5]); mv[3] = pk2(v[6], v[7]);
              *(u32x4v*)(Ms + m * SP_LD + seg * 8) = mv; } }
        __syncthreads();
        f32x4 yT[4][1]; zero_acc(yT);
        wave_mma<4, 1>(yT, xT, SP_LD, Ms + mrow0 * SP_LD, SP_LD, 4);
        __syncthreads();
        { const float dsk = p.in[I_SSDD][h]; const size_t row = (size_t)(base + mrow0 + fr);
#pragma unroll
          for (int mt = 0; mt < 4; ++mt) { const int p0 = h * 64 + mt * 16 + fq * 4; const u32x2 xs = xsv[mt];
              u32x2 o; o[0] = pk2(yT[mt][0][0] + dsk * bflo(xs[0]), yT[mt][0][1] + dsk * bfhi(xs[0])); o[1] = pk2(yT[mt][0][2] + dsk * bflo(xs[1]), yT[mt][0][3] + dsk * bfhi(xs[1]));
              *(u32x2*)(Y + row * 2048 + p0) = o; } }
    }
}

constexpr int SS_LD = 136, SS_LB = 130;
constexpr int SS_C = 0;
constexpr int SS_B = SS_C + 128 * SS_LD * 2;
constexpr int SS_XW = SS_B + 128 * SS_LB * 2;
constexpr int SS_S = SS_XW + 32 * SS_LD * 2;
constexpr int SS_AC = SS_S + 32 * SS_LD * 2;
constexpr int SS_END = SS_AC + 512;
static_assert(SS_END <= LDS_XB, "SSD LDS");

__device__ __forceinline__ void lds_barrier() { asm volatile("s_waitcnt lgkmcnt(0)\n\ts_barrier" ::: "memory"); }
struct SsdPre { u32x4v rC[4], rB[4], rX; u32x2 rY[2]; float rDt, rAcX, rAlast; };
__device__ __forceinline__ void ssd_item(unsigned char* shm, const Params& p, int b, int h, int ph) {
    const u16* XBC = (const u16*)(p.ws + E_XBC); u16* Y = (u16*)(p.ws + E_Y);
    const float* DT = (const float*)(p.ws + T_DT); const float* ACUM = (const float*)(p.ws + T_ACUM);
    u16* Cs = (u16*)(shm + SS_C); u16* Bs = (u16*)(shm + SS_B); u16* xwT = (u16*)(shm + SS_XW); u16* Sb = (u16*)(shm + SS_S);
    float* acs = (float*)(shm + SS_AC);
    const int t = threadIdx.x, lane = t & 63, w = t >> 6, g = h >> 3, fr = lane & 15, fq = lane >> 4;
    const int xcol = h * 64 + ph * 32, bcol = 2048 + g * 128, ccol = 2560 + g * 128;
    const int seg = t & 15, mq = t >> 4, xm = t & 127, xseg = t >> 7, mrow0 = w * 16;
    for (int dir = 0; dir < 2; ++dir) {
        const float* dtc = DT + (size_t)(dir * 32 + h) * RT; const float* acc_ = ACUM + (size_t)(dir * 32 + h) * RT;
        f32x4 accS[1][2]; zero_acc(accS);
        SsdPre R0, R1;
        { const u32x4v z4 = {0u, 0u, 0u, 0u}; const u32x2 z2 = {0u, 0u};
#pragma unroll
          for (int i = 0; i < 4; ++i) { R0.rC[i] = z4; R1.rC[i] = z4; }
          R0.rY[0] = z2; R0.rY[1] = z2; R1.rY[0] = z2; R1.rY[1] = z2; }
        auto base_of = [&](int st) __attribute__((always_inline)) { return st < 2 ? RL + b * CTXL + (dir == 0 ? st : 1 - st) * 128 : b * SEQ + (dir == 0 ? st - 2 : 33 - st) * 128; };
        auto prefetch = [&](SsdPre& R, int st) __attribute__((always_inline)) {
            const int base_ = base_of(st); const bool ctx_ = st < 2;
#pragma unroll
            for (int i = 0; i < 4; ++i) { const int m = mq + 32 * i; const u16* rp = XBC + (size_t)(base_ + m) * XBC_LD + seg * 8; R.rB[i] = *(const u32x4v*)(rp + bcol); if (!ctx_) R.rC[i] = *(const u32x4v*)(rp + ccol); }
            R.rX = *(const u32x4v*)(XBC + (size_t)(base_ + xm) * XBC_LD + xcol + xseg * 8); R.rDt = dtc[base_ + xm]; R.rAcX = acc_[base_ + xm]; R.rAlast = acc_[base_ + (dir == 0 ? 127 : 0)];
            if (!ctx_) {
#pragma unroll
                for (int mt = 0; mt < 2; ++mt) R.rY[mt] = *(const u32x2*)(Y + (size_t)(base_ + mrow0 + fr) * 2048 + xcol + mt * 16 + fq * 4); } };
        auto do_step = [&](SsdPre& R, int step) __attribute__((always_inline)) {
            const bool isctx = step < 2;
            const int base = base_of(step);
            const float a_last = R.rAlast;
            if (xseg == 0) acs[xm] = R.rAcX;
#pragma unroll
            for (int i = 0; i < 4; ++i) { const int m = mq + 32 * i;
                unsigned* bd = (unsigned*)(Bs + m * SS_LB + seg * 8); bd[0] = R.rB[i][0]; bd[1] = R.rB[i][1]; bd[2] = R.rB[i][2]; bd[3] = R.rB[i][3];
                if (!isctx) *(u32x4v*)(Cs + m * SS_LD + seg * 8) = R.rC[i]; }
            { const float wgt = R.rDt * __expf(a_last - R.rAcX);
#pragma unroll
              for (int e = 0; e < 8; ++e) { const float x = (e & 1) ? bfhi(R.rX[e >> 1]) : bflo(R.rX[e >> 1]); xwT[(xseg * 8 + e) * SS_LD + xm] = f2bf(x * wgt); } }
            if (!isctx) {
#pragma unroll
                for (int nt = 0; nt < 2; ++nt) { u32x2 o; o[0] = pk2(accS[0][nt][0], accS[0][nt][1]); o[1] = pk2(accS[0][nt][2], accS[0][nt][3]); *(u32x2*)(Sb + (nt * 16 + fr) * SS_LD + mrow0 + fq * 4) = o; } }
            u32x2 cY[2];
#pragma unroll
            for (int mt = 0; mt < 2; ++mt) cY[mt] = R.rY[mt];
            lds_barrier();
            if (step + 2 < 34) prefetch(R, step + 2);
            if (!isctx) {
                f32x4 yT[2][1]; zero_acc(yT);
                { bf16x8 fa[4][2], fb[4];
#pragma unroll
                  for (int k = 0; k < 4; ++k) { fa[k][0] = *(const bf16x8*)(Sb + fr * SS_LD + k * 32 + fq * 8); fa[k][1] = *(const bf16x8*)(Sb + (16 + fr) * SS_LD + k * 32 + fq * 8);
                      fb[k] = *(const bf16x8*)(Cs + (mrow0 + fr) * SS_LD + k * 32 + fq * 8); }
#pragma unroll
                  for (int k = 0; k < 4; ++k) { yT[0][0] = __builtin_amdgcn_mfma_f32_16x16x32_bf16(fa[k][0], fb[k], yT[0][0], 0, 0, 0); yT[1][0] = __builtin_amdgcn_mfma_f32_16x16x32_bf16(fa[k][1], fb[k], yT[1][0], 0, 0, 0); } }
                const float sc = __expf(acs[mrow0 + fr]);
                const size_t row = (size_t)(base + mrow0 + fr);
#pragma unroll
                for (int mt = 0; mt < 2; ++mt) { u16* yp = Y + row * 2048 + xcol + mt * 16 + fq * 4; const u32x2 pv = cY[mt];
                    u32x2 o; o[0] = pk2(bflo(pv[0]) + sc * yT[mt][0][0], bfhi(pv[0]) + sc * yT[mt][0][1]); o[1] = pk2(bflo(pv[1]) + sc * yT[mt][0][2], bfhi(pv[1]) + sc * yT[mt][0][3]); *(u32x2*)yp = o; }
            }
            { const float dl = __expf(a_last);
#pragma unroll
              for (int nt = 0; nt < 2; ++nt)
#pragma unroll
                  for (int j = 0; j < 4; ++j) accS[0][nt][j] *= dl; }
            { bf16x8 ga[4], gb[4][2];
#pragma unroll
              for (int k = 0; k < 4; ++k) {
#pragma unroll
                  for (int e = 0; e < 8; ++e) ga[k][e] = (short)Bs[(k * 32 + fq * 8 + e) * SS_LB + mrow0 + fr];
#pragma unroll
                  for (int nt = 0; nt < 2; ++nt) gb[k][nt] = *(const bf16x8*)(xwT + (nt * 16 + fr) * SS_LD + k * 32 + fq * 8); }
#pragma unroll
              for (int k = 0; k < 4; ++k)
#pragma unroll
                  for (int nt = 0; nt < 2; ++nt) accS[0][nt] = __builtin_amdgcn_mfma_f32_16x16x32_bf16(ga[k], gb[k][nt], accS[0][nt], 0, 0, 0); }
            lds_barrier();
        };
        prefetch(R0, 0); prefetch(R1, 1);
        for (int step = 0; step < 34; step += 2) { do_step(R0, step); do_step(R1, step + 1); }
        asm volatile("s_waitcnt vmcnt(0)" ::: "memory");
    }
}

__device__ void ssd_finish_phase(const Params& p) {
    u16* Y = (u16*)(p.ws + E_Y); const u16* Z = (const u16*)(p.ws + E_Z);
    const int lane = threadIdx.x & 63, wid = threadIdx.x >> 6;
    const int stride = gridDim.x * 8;
    for (int it0 = blockIdx.x * 8 + wid; it0 < RL * 4; it0 += 4 * stride) {
        u32x4v yw[4], zw[4]; size_t off[4]; bool ok[4];
#pragma unroll
        for (int u = 0; u < 4; ++u) { const int it = it0 + u * stride; ok[u] = it < RL * 4; off[u] = ok[u] ? (size_t)(it >> 2) * 2048 + (it & 3) * 512 + lane * 8 : 0;
            yw[u] = *(const u32x4v*)(Y + off[u]); zw[u] = *(const u32x4v*)(Z + off[u]); }
#pragma unroll
        for (int u = 0; u < 4; ++u) { const int it = it0 + u * stride;
            float v[8]; float ss = 0.f;
#pragma unroll
            for (int e2 = 0; e2 < 4; ++e2) { v[2 * e2] = bflo(yw[u][e2]) * siluf(bflo(zw[u][e2])); v[2 * e2 + 1] = bfhi(yw[u][e2]) * siluf(bfhi(zw[u][e2])); ss += v[2 * e2] * v[2 * e2] + v[2 * e2 + 1] * v[2 * e2 + 1]; }
            ss = wave_sum(ss);
            const float rs = rsqrtf(ss * (1.0f / 512.0f) + EPS);
            const float* gg = p.in[I_SSDNG] + (it & 3) * 512 + lane * 8; u32x4v o;
#pragma unroll
            for (int e2 = 0; e2 < 4; ++e2) o[e2] = pk2(v[2 * e2] * rs * gg[2 * e2], v[2 * e2 + 1] * rs * gg[2 * e2 + 1]);
            if (ok[u]) *(u32x4v*)(Y + off[u]) = o; }
    }
}

__global__ __launch_bounds__(512, 2) void mega(Params p) {
    extern __shared__ __attribute__((aligned(16))) unsigned char shm[];
    cg::grid_group grid = cg::this_grid();
    unsigned char* ws = p.ws;
    float* MOD = (float*)(ws + OFF_MOD); const float* MOD1 = MOD + 5 * NMOD * DM;
    u16* H = (u16*)(ws + OFF_H); float* XC = (float*)(ws + OFF_XC);
    const int bid = blockIdx.x, nb = gridDim.x;
    volatile LAS unsigned* xst = (volatile LAS unsigned*)(shm + LDS_XB);
    if (threadIdx.x < 2) xst[threadIdx.x] = 0u;
    __syncthreads();
    const XcdBarrier xb = xcd_barrier_post((unsigned*)(ws + OFF_BAR), xst);
    mod_gemv(shm, p);
    convert_weights_early(shm, p);
    if (p.ws == nullptr) grid.sync();
    xcd_barrier(xb);
    norm_mod_phase(p.in[I_X], p.in[I_CTX], p.in[I_NORMG], MOD, 0, 1, RT, 0, H);
    xcd_barrier(xb);
    { EpiBf16Plain E; E.O = (u16*)(ws + E_P0); E.ld = P0_LD; E.ncols = P0_LD; run_gemm(shm, H, (const u16*)(ws + A_AB_IN), RT, 2816, 1024, E); }
    xcd_barrier(xb);
    for (int it = bid; it < 4 * 68 * 4 + 4 * 34 * 4; it += nb) {
        if (it < 4 * 68 * 4) { const int h = it & 3, bc = it >> 2; gla_a_item(shm, p, bc / 68, bc % 68, h); }
        else { const int j = it - 4 * 68 * 4; const int gi = j & 3, bc = j >> 2; gmlp_item(shm, p, bc / 34, bc % 34, gi); }
    }
    xcd_barrier(xb);
    gla_scan_phase(p);
    xcd_barrier(xb);
    for (int it = bid; it < 4 * 68 * 4; it += nb) { const int h = it & 3, bc = it >> 2; gla_c_item(shm, p, bc / 68, bc % 68, h); }
    xcd_barrier(xb);
    { EpiRes E; E.src_lat = p.in[I_X]; E.src_ctx = p.in[I_CTX]; E.dst_lat = p.out; E.dst_ctx = XC; E.gate = MOD + 2 * DM; E.cm = 0; E.part = (float*)(ws + E_PART);
      run_gemm_split(shm, H, (const u16*)(ws + A_AB_OUT), 1024, 1024, E); }
    xcd_barrier(xb);
    norm_mod_phase(p.out, p.in[I_CTX], p.in[I_NORMG] + DM, MOD, 3, 4, RT, 0, H, (const float*)(ws + E_PART), 4, MOD + 4 * (NMOD * DM) + 2 * DM, XC);
    xcd_barrier(xb);
    { EpiSwiglu E; E.O = (u16*)(ws + E_ACT); run_gemm(shm, H, (const u16*)(ws + A_FF_IN0), RT, 5632, 1024, E); }
    xcd_barrier(xb);
    { EpiRes E; E.src_lat = p.out; E.src_ctx = XC; E.dst_lat = p.out; E.dst_ctx = XC; E.gate = MOD + 5 * DM; E.cm = 0; E.part = (float*)(ws + E_PART);
      run_gemm_split(shm, (const u16*)(ws + E_ACT), (const u16*)(ws + A_FF_OUT0), 1024, 2816, E); }
    xcd_barrier(xb);
    norm_mod_phase(p.out, XC, p.in[I_NORMG] + 2 * DM, MOD1, 0, 1, RT, 1, H, (const float*)(ws + E_PART), 11, MOD + 4 * (NMOD * DM) + 5 * DM, XC);
    xcd_barrier(xb);
    { EpiSsdIn E; E.XBC = (u16*)(ws + E_XBC); E.HALO = (u16*)(ws + A_HALO); E.DTRAW = (float*)(ws + A_DTRAW); run_gemm(shm, H, (const u16*)(ws + B_SSD_INA), RT, 3328, 1024, E); }
    xcd_barrier(xb);
    dt_phase(shm, p);
    conv_phase(p);
    xcd_barrier(xb);
    for (int it = bid; it < 4 * 32 * 4; it += nb) ssd_par_item(shm, p, it);
    xcd_barrier(xb);
    {
        unsigned* cnt = (unsigned*)(ws + OFF_BAR) + XCD_BAR_WORDS;
        volatile int* s_item_p = (volatile int*)(shm + LDS_XB + 8);
        if (nb == 256) {
            if (threadIdx.x == 0) { int item = -1;
                for (int k = 0; k < 8 && item < 0; ++k) { const unsigned y = (xb.x + k) & 7u; const unsigned r = xb_add(&cnt[y * 16], 1u); if (r < 32u) item = (int)(y * 32u + r); }
                *s_item_p = item; }
            __syncthreads();
            const int item = *s_item_p;
            if (item >= 0) { const int grp = item >> 4, idx = item & 15; ssd_item(shm, p, grp >> 2, (grp & 3) * 8 + (idx >> 1), idx & 1); }
        } else {
            for (int it = bid; it < 4 * 32 * 2; it += nb) { const int grp = it >> 4, idx = it & 15; ssd_item(shm, p, grp >> 2, (grp & 3) * 8 + (idx >> 1), idx & 1); }
        }
    }
    xcd_barrier(xb);
    { EpiBf16Plain E; E.O = (u16*)(ws + E_Z); E.ld = 2048; E.ncols = 2048; run_gemm(shm, H, (const u16*)(ws + B_WZ), RL, 2048, 1024, E); }
    convert_weights_late(shm, p);
    xcd_barrier(xb);
    ssd_finish_phase(p);
    xcd_barrier(xb);
    { EpiRes E; E.src_lat = p.out; E.src_ctx = XC; E.dst_lat = p.out; E.dst_ctx = XC; E.gate = MOD1 + 2 * DM; E.cm = 1; E.part = nullptr;
      run_gemm(shm, (const u16*)(ws + E_Y), (const u16*)(ws + A_SSD_OUT), RL, 1024, 2048, E); }
    xcd_barrier(xb);
    norm_mod_phase(p.out, XC, p.in[I_NORMG] + 3 * DM, MOD1, 3, 4, RL, 0, H);
    xcd_barrier(xb);
    { EpiSwiglu E; E.O = (u16*)(ws + E_ACT); run_gemm(shm, H, (const u16*)(ws + A_FF_IN1), RL, 5632, 1024, E); }
    xcd_barrier(xb);
    { EpiRes E; E.src_lat = p.out; E.src_ctx = XC; E.dst_lat = p.out; E.dst_ctx = XC; E.gate = MOD1 + 5 * DM; E.cm = 0; E.part = nullptr;
      run_gemm(shm, (const u16*)(ws + E_ACT), (const u16*)(ws + A_FF_OUT1), RL, 1024, 2816, E); }
    xcd_barrier(xb);
    final_norm_phase(p.out, p.in[I_FNG]);
}

extern "C" void kernel_launch(void* const* d_in, const int* in_sizes, int n_in, void* d_out, int out_size, void* d_ws, size_t ws_size, hipStream_t stream) {
    static int grid_blocks = 0;
    if (!grid_blocks) {
        int dev = 0, cus = 0, per_cu = 0;
        (void)hipGetDevice(&dev);
        (void)hipDeviceGetAttribute(&cus, hipDeviceAttributeMultiprocessorCount, dev);
        (void)hipFuncSetAttribute((const void*)mega, hipFuncAttributeMaxDynamicSharedMemorySize, LDS_BYTES);
        (void)hipOccupancyMaxActiveBlocksPerMultiprocessor(&per_cu, (const void*)mega, 512, LDS_BYTES);
        if (per_cu < 1) { fprintf(stderr, "occupancy query says %d blocks/CU\n", per_cu); per_cu = 1; }
        if (per_cu > 1) per_cu = 1;
        grid_blocks = cus * per_cu;
        if (ws_size < WS_END) fprintf(stderr, "workspace too small: %zu < %zu\n", ws_size, (size_t)WS_END);
    }
    Params p{};
    for (int i = 0; i < 26; ++i) p.in[i] = (const float*)d_in[i];
    p.out = (float*)d_out; p.ws = (unsigned char*)d_ws;
    (void)hipMemsetAsync((unsigned char*)d_ws + OFF_BAR, 0, (XCD_BAR_WORDS + 128) * sizeof(unsigned), stream);
    void* args[] = {&p};
    hipError_t e = hipLaunchCooperativeKernel((const void*)mega, dim3(grid_blocks), dim3(512), args, LDS_BYTES, stream);
    if (e != hipSuccess) fprintf(stderr, "cooperative launch failed: %s (grid %d)\n", hipGetErrorString(e), grid_blocks);
}
```

```cpp
#include <hip/hip_runtime.h>
#include <hip/hip_cooperative_groups.h>
#include <cstdio>
namespace cg = cooperative_groups;
namespace pg8 {
#define PG8_LAS __attribute__((address_space(3)))
typedef unsigned short bf16_t;
typedef short bf16x8 __attribute__((ext_vector_type(8)));
typedef float f32x4 __attribute__((ext_vector_type(4)));
typedef unsigned u32x4 __attribute__((ext_vector_type(4)));
constexpr int BM = 256, BK = 64, HALF = 128, HTB = HALF * BK * 2  , STAGE_BYTES = 8 * HTB, NXCD = 8, WGM = 8;

__host__ __device__ __forceinline__ int lds_byte(int r, int c) { const int st = (r >> 4) * 2 + (c >> 5), rr = r & 15, cc = c & 31, ob = rr * 64 + cc * 2; return st * 1024 + (ob ^ (((ob >> 9) & 1) << 5)); }
__host__ __device__ __forceinline__ void stage_rc(int b, int& R, int& C) { const int st = b / 1024, sb = b % 1024, swz = sb ^ (((sb >> 9) & 1) << 5); R = (st >> 1) * 16 + swz / 64; C = (st & 1) * 32 + (swz % 64) / 2; }
__host__ __device__ __forceinline__ int perm32(int rho) { const int n = rho >> 4, i = rho & 15; return 8 * (i >> 2) + 4 * n + (i & 3); }

struct Unit { int pm, pn, kt0, nkt; };
struct Gemm { const bf16_t* A; const bf16_t* Bt; int M, N, K; };

struct StaticOrder {
    int nM, nN, nwg, G, c, nkt_all;
    __host__ __device__ void init(int M, int N, int G_, int c_, int K_ = 0) { nM = M / BM; nN = N / BM; nwg = nM * nN; G = G_; c = c_; nkt_all = K_ / BK; }
    __host__ __device__ bool next(int i, Unit& u) const {
        const long L = (long)i * G + c; if (L >= nwg) return false;
        int wgid = (int)L; { const int q = nwg / NXCD, r = nwg % NXCD, xcd = wgid % NXCD, off = wgid / NXCD; wgid = (xcd < r ? xcd * (q + 1) : r * (q + 1) + (xcd - r) * q) + off; }
        const int nig = WGM * nN, gid = wgid / nig, fm = gid * WGM, gsz = (nM - fm) < WGM ? (nM - fm) : WGM;
        u.pm = fm + ((wgid % nig) % gsz); u.pn = (wgid % nig) / gsz; u.kt0 = 0; u.nkt = nkt_all; return true;
    }
    __device__ __forceinline__ void a_ready(const Unit&) const {}
    __device__ __forceinline__ void done(const Unit&) const {}
};
__device__ __forceinline__ unsigned cvt_pk_bf16(float lo, float hi) { unsigned r; asm volatile("v_cvt_pk_bf16_f32 %0, %1, %2" : "=v"(r) : "v"(lo), "v"(hi)); return r; }
template <class Epi, class Sched, bool STAMP = false>
__device__ __forceinline__ void gemm_phase(PG8_LAS unsigned char* lds, const Gemm g, const Sched& S, const Epi& E, unsigned long long* stamps) {
    int tid_ = threadIdx.x; asm volatile("" : "+v"(tid_)); const int tid = tid_, wid = __builtin_amdgcn_readfirstlane(tid >> 6), lane = tid & 63, wr = wid >> 2, wc = wid & 3, fr = lane & 15, fq = lane >> 4;
    const int K = g.K;
    int ts_lo = 0, ts_hi = 0, nts = 0; const unsigned long long rt_entry = STAMP ? (unsigned long long)wall_clock64() : 0ull;
#define PG8_STAMP() do { if (STAMP && wid == 0 && nts < 64) { const unsigned long long _c = (unsigned long long)clock64(); \
        ts_lo = (lane == nts) ? (int)(unsigned)_c : ts_lo; ts_hi = (lane == nts) ? (int)(unsigned)(_c >> 32) : ts_hi; ++nts; } } while (0)
    PG8_STAMP();
    unsigned voffA[2], voffB[2];
#pragma unroll
    for (int i = 0; i < 2; ++i) { int R, C; stage_rc(tid * 16 + i * 8192, R, C); const int Rb = Epi::PERM ? ((R & ~31) + perm32(R & 31)) : R;
        voffA[i] = (unsigned)(R * K + C) * 2u; voffB[i] = (unsigned)(Rb * K + C) * 2u; }
    const size_t kstep = (size_t)(BK * 2);
    const size_t hstep = (size_t)HALF * K * 2;
    const size_t tstep = 2 * hstep;
    const unsigned ldsw = (unsigned)wid * 1024u;
    const int aoff = lds_byte(wr * 64 + fr, fq * 8), boff = lds_byte(wc * 32 + fr, fq * 8);
#define PG8_SA(b, h) (((b) * 2 + (h)) * HTB)
#define PG8_SB(b, h) ((4 + (b) * 2 + (h)) * HTB)
#define PG8_STAGE(bufoff, gbase, voff) do { _Pragma("unroll") for (int _i = 0; _i < 2; ++_i) \
        __builtin_amdgcn_global_load_lds((const unsigned*)((const char*)(gbase) + (voff)[_i]), (PG8_LAS unsigned*)(lds + (bufoff) + ldsw + _i * 8192), 16, 0, 0); } while (0)
#define PG8_LDA(dst, b, h) do { _Pragma("unroll") for (int m = 0; m < 4; ++m) _Pragma("unroll") for (int k = 0; k < 2; ++k) dst[m][k] = *(const PG8_LAS bf16x8*)(lds + PG8_SA(b, h) + aoff + m * 2048 + k * 1024); } while (0)
#define PG8_LDB(dst, b, h) do { _Pragma("unroll") for (int n = 0; n < 2; ++n) _Pragma("unroll") for (int k = 0; k < 2; ++k) dst[n][k] = *(const PG8_LAS bf16x8*)(lds + PG8_SB(b, h) + boff + n * 2048 + k * 1024); } while (0)
#define PG8_MMA(ai, bj, At, Bt) do { __builtin_amdgcn_s_setprio(1); _Pragma("unroll") for (int m = 0; m < 4; ++m) _Pragma("unroll") for (int n = 0; n < 2; ++n) _Pragma("unroll") for (int k = 0; k < 2; ++k) \
        acc[ai][bj][m][n] = __builtin_amdgcn_mfma_f32_16x16x32_bf16(Bt[n][k], At[m][k], acc[ai][bj][m][n], 0, 0, 0); __builtin_amdgcn_s_setprio(0); } while (0)
#define PG8_WAIT_V(n) asm volatile("s_waitcnt vmcnt(" #n ")" ::: "memory")
#define PG8_WAIT_L(n) asm volatile("s_waitcnt lgkmcnt(" #n ")" ::: "memory")
#define PG8_BAR __builtin_amdgcn_s_barrier()
#define PG8_SCHED __builtin_amdgcn_sched_barrier(0)
    Unit cur, nxt; int ui = 0;
    if (!S.next(0, cur)) return;
    f32x4 acc[2][2][4][2];
#pragma unroll
    for (int a = 0; a < 2; ++a)
#pragma unroll
        for (int b = 0; b < 2; ++b)
#pragma unroll
            for (int m = 0; m < 4; ++m)
#pragma unroll
                for (int n = 0; n < 2; ++n) acc[a][b][m][n] = (f32x4){0.f, 0.f, 0.f, 0.f};
    bf16x8 At[4][2], B0[2][2], B1[2][2];
    const char* cA = (const char*)g.A + (size_t)cur.pm * tstep + (size_t)cur.kt0 * kstep; const char* cB = (const char*)g.Bt + (size_t)cur.pn * tstep + (size_t)cur.kt0 * kstep;
    S.a_ready(cur);
    PG8_STAGE(PG8_SB(0, 0), cB, voffB); PG8_STAGE(PG8_SA(0, 0), cA, voffA); PG8_STAGE(PG8_SB(0, 1), cB + hstep, voffB); PG8_STAGE(PG8_SA(0, 1), cA + hstep, voffA);
    if (wr == 1) PG8_BAR;
    PG8_WAIT_V(4); PG8_BAR;
    PG8_STAGE(PG8_SB(1, 0), cB + kstep, voffB); PG8_STAGE(PG8_SA(1, 0), cA + kstep, voffA); PG8_STAGE(PG8_SB(1, 1), cB + hstep + kstep, voffB);
    PG8_WAIT_V(6); PG8_BAR;
    PG8_STAMP();
    for (;;) {
        const bool has_next = S.next(ui + 1, nxt);
        const char* nA = has_next ? (const char*)g.A + (size_t)nxt.pm * tstep + (size_t)nxt.kt0 * kstep : cA; const char* nB = has_next ? (const char*)g.Bt + (size_t)nxt.pn * tstep + (size_t)nxt.kt0 * kstep : cB;
        const int nt = cur.nkt;
        for (int t = 0; t < nt; t += 2) {
            const bool last = (t == nt - 2);
            const char* a1 = cA + (size_t)(t + 1) * kstep;
            const char* a2 = last ? nA : cA + (size_t)(t + 2) * kstep; const char* b2 = last ? nB : cB + (size_t)(t + 2) * kstep;
            const char* a3 = a2 + kstep; const char* b3 = b2 + kstep;
            if (last && has_next) S.a_ready(nxt);
            PG8_LDB(B0, 0, 0); PG8_SCHED; PG8_LDA(At, 0, 0); PG8_STAGE(PG8_SA(1, 1), a1 + hstep, voffA);
            PG8_WAIT_L(8); PG8_BAR; PG8_WAIT_L(0); PG8_MMA(0, 0, At, B0); PG8_BAR; PG8_SCHED;
            PG8_LDB(B1, 0, 1); PG8_STAGE(PG8_SB(0, 0), b2, voffB);
            PG8_BAR; PG8_WAIT_L(0); PG8_MMA(0, 1, At, B1); PG8_BAR;
            PG8_LDA(At, 0, 1); PG8_STAGE(PG8_SA(0, 0), a2, voffA);
            PG8_BAR; PG8_WAIT_L(0); PG8_MMA(1, 0, At, B0); PG8_BAR; PG8_SCHED;
            PG8_STAGE(PG8_SB(0, 1), b2 + hstep, voffB);
            PG8_WAIT_V(6); PG8_BAR; PG8_MMA(1, 1, At, B1); PG8_BAR;
            PG8_LDB(B0, 1, 0); PG8_SCHED; PG8_LDA(At, 1, 0); PG8_STAGE(PG8_SA(0, 1), a2 + hstep, voffA);
            PG8_WAIT_L(8); PG8_BAR; PG8_WAIT_L(0); PG8_MMA(0, 0, At, B0); PG8_BAR; PG8_SCHED;
            PG8_LDB(B1, 1, 1); PG8_STAGE(PG8_SB(1, 0), b3, voffB);
            PG8_BAR; PG8_WAIT_L(0); PG8_MMA(0, 1, At, B1); PG8_BAR;
            PG8_LDA(At, 1, 1); PG8_STAGE(PG8_SA(1, 0), a3, voffA);
            PG8_BAR; PG8_WAIT_L(0); PG8_MMA(1, 0, At, B0); PG8_BAR; PG8_SCHED;
            PG8_STAGE(PG8_SB(1, 1), b3 + hstep, voffB);
            PG8_WAIT_V(6); PG8_BAR; PG8_MMA(1, 1, At, B1); PG8_BAR;
        }
        PG8_STAMP();
        if constexpr (!Epi::AFTER_DRAIN) { E(acc, cur, wr, wc, fr, fq); S.done(cur); }
        PG8_STAMP();
        if (!has_next) break;
#pragma unroll
        for (int a = 0; a < 2; ++a)
#pragma unroll
            for (int b = 0; b < 2; ++b)
#pragma unroll
                for (int m = 0; m < 4; ++m)
#pragma unroll
                    for (int n = 0; n < 2; ++n) acc[a][b][m][n] = (f32x4){0.f, 0.f, 0.f, 0.f};
        cur = nxt; cA = nA; cB = nB; ++ui;
    }
    PG8_WAIT_V(0);
    if (wr == 0) PG8_BAR;
    PG8_BAR;
    if constexpr (Epi::AFTER_DRAIN) { E.fused(acc, cur, wr, wc, fr, fq, lds, wid, lane); S.done(cur); }
    PG8_STAMP();
    if (STAMP && wid == 0) { stamps[lane] = lane < nts ? (((unsigned long long)(unsigned)ts_hi << 32) | (unsigned)ts_lo) : 0ull;
        if (lane == 62) stamps[62] = rt_entry; if (lane == 63) stamps[63] = (unsigned long long)wall_clock64(); }
#undef PG8_STAMP
#undef PG8_SA
#undef PG8_SB
#undef PG8_STAGE
#undef PG8_LDA
#undef PG8_LDB
#undef PG8_MMA
#undef PG8_WAIT_V
#undef PG8_WAIT_L
#undef PG8_BAR
#undef PG8_SCHED
}
}

#define XB_TMO      128
#define XB_XCNT(j)  (256  + 64 * (j))
#define XB_XSUB(j)  (1280 + 64 * (j))
#define XB_XGEN(j)  (2304 + 64 * (j))
#define XB_TOP      3328
#define XB_TOPGEN   3392
#define XCD_BAR_WORDS 3456
#define XB_SPIN_CAP (1u << 18)
#define LAS __attribute__((address_space(3)))

__device__ __forceinline__ unsigned xb_ld(unsigned* p)              { return __hip_atomic_load(p, __ATOMIC_RELAXED, __HIP_MEMORY_SCOPE_AGENT); }
__device__ __forceinline__ unsigned xb_add(unsigned* p, unsigned v) { return __hip_atomic_fetch_add(p, v, __ATOMIC_RELAXED, __HIP_MEMORY_SCOPE_AGENT); }
__device__ __forceinline__ unsigned xb_xcc_id() { return (unsigned)__builtin_amdgcn_s_getreg((3 << 11) | 20) & 0xFu; }
#define XB_SPIN(cond, bar) do { unsigned _sp = 0; while (cond) { __builtin_amdgcn_s_sleep(1); \
    if ((++_sp & 255u) == 0u) { if (xb_ld(&(bar)[XB_TMO])) break; if (_sp > XB_SPIN_CAP) { atomicAdd(&(bar)[XB_TMO], 1u); break; } } } } while (0)

struct XcdBarrier {
    unsigned* bar; unsigned x;
    volatile LAS unsigned* st;
};

__device__ __forceinline__ XcdBarrier xcd_barrier_post(unsigned* bar, volatile LAS unsigned* st) {
    XcdBarrier b; b.bar = bar; b.x = xb_xcc_id(); b.st = st;
    if (threadIdx.x == 0) (void)xb_add(&bar[XB_XCNT(b.x)], 1u);
    return b;
}
__device__ __forceinline__ void xcd_barrier_complete(unsigned* bar, unsigned x, unsigned& nloc, unsigned& nx) {
    const unsigned G = gridDim.x * gridDim.y * gridDim.z;
    unsigned sum, cnt, mine, sp = 0u;
    for (;;) {
        sum = 0u; cnt = 0u; mine = 0u;
#pragma unroll
        for (unsigned j = 0; j < 16; ++j) { const unsigned c = xb_ld(&bar[XB_XCNT(j)]); sum += c; cnt += (c > 0u) ? 1u : 0u; mine = (j == x) ? c : mine; }
        if (sum == G) break;
        __builtin_amdgcn_s_sleep(1);
        if ((++sp & 255u) == 0u) { if (xb_ld(&bar[XB_TMO])) break; if (sp > XB_SPIN_CAP) { atomicAdd(&bar[XB_TMO], 1u); break; } }
    }
    nloc = mine > 0u ? mine : 1u; nx = cnt > 0u ? cnt : 1u;
}

__device__ __attribute__((noinline)) void xcd_barrier_impl(unsigned* bar_, unsigned x_, volatile LAS unsigned* st_) {
    XcdBarrier b; b.bar = bar_; b.x = x_; b.st = st_;
    asm volatile("s_waitcnt vmcnt(0)" ::: "memory");
    __syncthreads();
    if (threadIdx.x == 0) {
        unsigned* bar = b.bar;
        __builtin_amdgcn_s_waitcnt(0);
        unsigned nloc = b.st[0], nx = b.st[1];
        if (nloc == 0u) { xcd_barrier_complete(bar, b.x, nloc, nx); b.st[0] = nloc; b.st[1] = nx; }
        const unsigned old = xb_add(&bar[XB_XSUB(b.x)], 1u);
        const unsigned gen = old / nloc;
        if (old + 1u == (gen + 1u) * nloc) {
            __builtin_amdgcn_fence(__ATOMIC_RELEASE, "agent");
            asm volatile("s_waitcnt vmcnt(0)" ::: "memory");
            const unsigned og = xb_add(&bar[XB_TOP], 1u);
            const unsigned tg = og / nx;
            if (og + 1u == (tg + 1u) * nx) xb_add(&bar[XB_TOPGEN], 1u);
            else XB_SPIN(xb_ld(&bar[XB_TOPGEN]) == tg, bar);
            __builtin_amdgcn_fence(__ATOMIC_ACQUIRE, "agent");
            xb_add(&bar[XB_XGEN(b.x)], 1u);
            asm volatile("s_waitcnt vmcnt(0)" ::: "memory");
        } else {
            XB_SPIN(xb_ld(&bar[XB_XGEN(b.x)]) == gen, bar);
            __builtin_amdgcn_fence(__ATOMIC_ACQUIRE, "agent");
            asm volatile("s_waitcnt vmcnt(0)" ::: "memory");
        }
    }
    __syncthreads();
}

__device__ __forceinline__ void xcd_barrier(const XcdBarrier& b) { xcd_barrier_impl(b.bar, b.x, b.st); }

typedef unsigned short u16;
using pg8::bf16x8; using pg8::f32x4;
typedef unsigned u32x2 __attribute__((ext_vector_type(2)));
typedef unsigned u32x4v __attribute__((ext_vector_type(4)));

constexpr int DM = 1024, NB = 4, SEQ = 4096, CTXL = 256, RL = NB * SEQ, RC = NB * CTXL, RT = RL + RC;
constexpr int DFF = 2816, NMOD = 6;
constexpr int P0_LD = 2592;
constexpr int P0_K = 0, P0_V = 256, P0_LR = 768, P0_Q = 800, P0_R = 1056, P0_U = 1568, P0_G = 2080;
constexpr int XBC_LD = 3072;
constexpr float EPS = 1e-6f;

constexpr size_t OFF_MOD = 0;
constexpr size_t OFF_A = 262144;
constexpr size_t A_AB_IN = OFF_A, A_AB_OUT = A_AB_IN + (size_t)2816 * 1024 * 2, A_FF_IN0 = A_AB_OUT + (size_t)1024 * 1024 * 2, A_FF_OUT0 = A_FF_IN0 + (size_t)5632 * 1024 * 2;
constexpr size_t A_END = A_FF_OUT0 + (size_t)1024 * 2816 * 2;
constexpr size_t A_DTRAW = OFF_A, A_HALO = A_DTRAW + (size_t)RT * 64 * 4;
constexpr size_t A_SSD_OUT = OFF_A, A_FF_IN1 = A_SSD_OUT + (size_t)1024 * 2048 * 2, A_FF_OUT1 = A_FF_IN1 + (size_t)5632 * 1024 * 2;
constexpr size_t OFF_B = A_END;
constexpr size_t B_SSD_INA = OFF_B, B_WZ = B_SSD_INA + (size_t)3328 * 1024 * 2, B_END = B_WZ + (size_t)2048 * 1024 * 2;
constexpr size_t OFF_XC = B_END;
constexpr size_t OFF_H = OFF_XC + (size_t)RC * DM * 4;
constexpr size_t OFF_DSC = OFF_H + (size_t)RT * DM * 2;
constexpr size_t OFF_DEC = OFF_DSC + (size_t)4 * 2 * 4 * 4 * 8192 * 4;
constexpr size_t OFF_E = OFF_DEC + (size_t)4 * 2 * 4 * 68 * 64 * 4;
constexpr size_t E_P0 = OFF_E, E_ACT = OFF_E, E_XBC = OFF_E, E_Z = OFF_E;
constexpr size_t E_Y = OFF_E + (size_t)RT * XBC_LD * 2;
constexpr size_t T_DT = E_Y + (size_t)RL * 2048 * 2, T_ACUM = T_DT + (size_t)RT * 64 * 4;
constexpr size_t WS_END = T_ACUM + (size_t)RT * 64 * 4;
constexpr size_t E_PART = OFF_E + (size_t)100 * 1024 * 1024;
constexpr size_t A_CB = OFF_A;
static_assert(A_HALO + (size_t)272 * 4 * 3072 * 2 <= A_END && A_FF_OUT1 + (size_t)1024 * 2816 * 2 <= A_END && A_CB + (size_t)512 * 16384 * 2 <= A_END, "region A overflow");
static_assert(WS_END <= (size_t)256 * 1024 * 1024, "workspace over 256 MiB");

constexpr int LDS_BYTES = 144 * 1024;
constexpr int LDS_XB = LDS_BYTES - 16;
constexpr size_t OFF_BAR = 245760;

struct Params { const float* in[26]; float* out; unsigned char* ws; };
enum { I_X = 0, I_C, I_CTX, I_CCTX, I_MODW, I_MODB, I_NORMG, I_FFWIN, I_FFWOUT, I_ABWIN, I_ABGW, I_ABGB, I_ABGNG, I_ABVNG, I_ABSW, I_ABSB, I_ABWOUT,
       I_SSDWIN, I_SSDCW, I_SSDCB, I_SSDDTB, I_SSDALOG, I_SSDD, I_SSDNG, I_SSDWOUT, I_FNG };

__device__ __forceinline__ u16 f2bf(float f) { return __builtin_bit_cast(u16, (__bf16)f); }
__device__ __forceinline__ float bf2f(unsigned b) { return __uint_as_float(b << 16); }
typedef float f32x2v __attribute__((ext_vector_type(2)));
typedef __bf16 bf16x2v __attribute__((ext_vector_type(2)));
__device__ __forceinline__ unsigned pk2(float lo, float hi) { const f32x2v v = {lo, hi}; return __builtin_bit_cast(unsigned, __builtin_convertvector(v, bf16x2v)); }
__device__ __forceinline__ float bflo(unsigned w) { return __uint_as_float(w << 16); }
__device__ __forceinline__ float bfhi(unsigned w) { return __uint_as_float(w & 0xFFFF0000u); }
__device__ __forceinline__ float siluf(float x) { return x * __builtin_amdgcn_rcpf(1.0f + __expf(-x)); }
__device__ __forceinline__ float geluf(float x) { const float y = 0.7978845608028654f * (x + 0.044715f * x * x * x); const float th = 1.0f - 2.0f * __builtin_amdgcn_rcpf(1.0f + __expf(2.0f * y)); return 0.5f * x * (1.0f + th); }
__device__ __forceinline__ float softplusf(float x) { return fmaxf(x, 0.f) + log1pf(__expf(-fabsf(x))); }
__device__ __forceinline__ float logsigmoidf(float x) { return fminf(x, 0.f) - __logf(1.0f + __expf(-fabsf(x))); }
__device__ __forceinline__ float wave_sum(float v) {
#pragma unroll
    for (int o = 32; o > 0; o >>= 1) v += __shfl_xor(v, o, 64);
    return v;
}

template <int MT, int NT>
__device__ __forceinline__ void wave_mma(f32x4 (&acc)[MT][NT], const u16* A, int lda, const u16* B, int ldb, int ksteps) {
    const int lane = threadIdx.x & 63, fr = lane & 15, fq = lane >> 4;
    const u16* ap = A + fr * lda + fq * 8; const u16* bp = B + fr * ldb + fq * 8;
    for (int k = 0; k < ksteps; ++k) {
        bf16x8 a[MT], b[NT];
#pragma unroll
        for (int i = 0; i < MT; ++i) a[i] = *(const bf16x8*)(ap + i * 16 * lda + k * 32);
#pragma unroll
        for (int i = 0; i < NT; ++i) b[i] = *(const bf16x8*)(bp + i * 16 * ldb + k * 32);
#pragma unroll
        for (int i = 0; i < MT; ++i)
#pragma unroll
            for (int j = 0; j < NT; ++j) acc[i][j] = __builtin_amdgcn_mfma_f32_16x16x32_bf16(a[i], b[j], acc[i][j], 0, 0, 0);
    }
}
template <int MT, int NT> __device__ __forceinline__ void zero_acc(f32x4 (&acc)[MT][NT]) {
#pragma unroll
    for (int i = 0; i < MT; ++i)
#pragma unroll
        for (int j = 0; j < NT; ++j) acc[i][j] = (f32x4){0.f, 0.f, 0.f, 0.f};
}

__device__ __forceinline__ u32x4v pack8(const f32x4& a, const f32x4& b) { u32x4v r; r[0] = pk2(a[0], a[1]); r[1] = pk2(a[2], a[3]); r[2] = pk2(b[0], b[1]); r[3] = pk2(b[2], b[3]); return r; }

struct EpiBf16Plain {
    static constexpr bool PERM = true, AFTER_DRAIN = false;
    u16* O; int ld; int ncols;
    __device__ __forceinline__ void operator()(const f32x4 (&acc)[2][2][4][2], const pg8::Unit& u, int wr, int wc, int fr, int fq) const {
        const int row0 = u.pm * 256 + wr * 64 + fr, col0 = u.pn * 256 + wc * 32 + 8 * fq;
#pragma unroll
        for (int ai = 0; ai < 2; ++ai)
#pragma unroll
            for (int m = 0; m < 4; ++m) { const int row = row0 + ai * 128 + m * 16;
#pragma unroll
                for (int bj = 0; bj < 2; ++bj) { const int c = col0 + bj * 128; if (c < ncols) *(u32x4v*)(O + (size_t)row * ld + c) = pack8(acc[ai][bj][m][0], acc[ai][bj][m][1]); } }
    }
};
struct EpiSwiglu {
    static constexpr bool PERM = true, AFTER_DRAIN = false;
    u16* O;
    __device__ __forceinline__ void operator()(const f32x4 (&acc)[2][2][4][2], const pg8::Unit& u, int wr, int wc, int fr, int fq) const {
        const int row0 = u.pm * 256 + wr * 64 + fr, j0 = u.pn * 128 + wc * 32 + 8 * fq;
#pragma unroll
        for (int ai = 0; ai < 2; ++ai)
#pragma unroll
            for (int m = 0; m < 4; ++m) { const int row = row0 + ai * 128 + m * 16; f32x4 o0, o1;
#pragma unroll
                for (int i = 0; i < 4; ++i) { o0[i] = siluf(acc[ai][0][m][0][i]) * acc[ai][1][m][0][i]; o1[i] = siluf(acc[ai][0][m][1][i]) * acc[ai][1][m][1][i]; }
                *(u32x4v*)(O + (size_t)row * DFF + j0) = pack8(o0, o1); }
    }
};
struct EpiSsdIn {
    static constexpr bool PERM = true, AFTER_DRAIN = false;
    u16* XBC; u16* HALO; float* DTRAW;
    __device__ __forceinline__ void operator()(const f32x4 (&acc)[2][2][4][2], const pg8::Unit& u, int wr, int wc, int fr, int fq) const {
        const int row0 = u.pm * 256 + wr * 64 + fr, col0 = u.pn * 256 + wc * 32 + 8 * fq;
#pragma unroll
        for (int ai = 0; ai < 2; ++ai)
#pragma unroll
            for (int m = 0; m < 4; ++m) { const int row = row0 + ai * 128 + m * 16; const int rr = row & 63; const int slot = rr < 2 ? rr : (rr >= 62 ? rr - 60 : -1);
#pragma unroll
                for (int bj = 0; bj < 2; ++bj) { const int c = col0 + bj * 128;
                    if (c < 3072) { const u32x4v v = pack8(acc[ai][bj][m][0], acc[ai][bj][m][1]); *(u32x4v*)(XBC + (size_t)row * XBC_LD + c) = v;
                        if (slot >= 0) *(u32x4v*)(HALO + ((size_t)(row >> 6) * 4 + slot) * XBC_LD + c) = v; }
                    else if (c < 3136) { float* d = DTRAW + (size_t)row * 64 + (c - 3072); *(f32x4*)d = acc[ai][bj][m][0]; *(f32x4*)(d + 4) = acc[ai][bj][m][1]; } } }
    }
};
struct EpiRes {
    static constexpr bool PERM = false, AFTER_DRAIN = false;
    const float* src_lat; const float* src_ctx; float* dst_lat; float* dst_ctx; const float* gate; int cm; float* part;
    __device__ __forceinline__ void operator()(const f32x4 (&acc)[2][2][4][2], const pg8::Unit& u, int wr, int wc, int fr, int fq) const {
        const int row0 = u.pm * 256 + wr * 64 + fr, col0 = u.pn * 256 + wc * 32 + 4 * fq;
#pragma unroll
        for (int ai = 0; ai < 2; ++ai)
#pragma unroll
            for (int m = 0; m < 4; ++m) { const int row = row0 + ai * 128 + m * 16; const float* s; float* d; int mi;
                if (row < RL) { const int xr = cm ? ((row & ~4095) | ((row & 63) << 6) | ((row >> 6) & 63)) : row; s = src_lat + (size_t)xr * DM; d = dst_lat + (size_t)xr * DM; mi = row >> 12; }
                else { s = src_ctx + (size_t)(row - RL) * DM; d = dst_ctx + (size_t)(row - RL) * DM; mi = 4; }
                const float* gt = gate + mi * (NMOD * DM);
                if (part != nullptr && row >= RL) { float* pd = part + ((size_t)(u.kt0 >> 2) * RC + (row - RL)) * DM;
#pragma unroll
                    for (int bj = 0; bj < 2; ++bj)
#pragma unroll
                        for (int n = 0; n < 2; ++n) { const int c = col0 + bj * 128 + n * 16; *(f32x4*)(pd + c) = acc[ai][bj][m][n]; }
                    continue; }
#pragma unroll
                for (int bj = 0; bj < 2; ++bj)
#pragma unroll
                    for (int n = 0; n < 2; ++n) { const int c = col0 + bj * 128 + n * 16; const f32x4 g4 = *(const f32x4*)(gt + c), x4 = *(const f32x4*)(s + c);
                        *(f32x4*)(d + c) = x4 + g4 * acc[ai][bj][m][n]; } }
    }
};

template <class Epi> __device__ __forceinline__ void run_gemm(unsigned char* shm, const u16* A, const u16* Bt, int M, int N, int K, const Epi& E) {
    pg8::Gemm g; g.A = A; g.Bt = Bt; g.M = M; g.N = N; g.K = K;
    pg8::StaticOrder S; S.init(M, N, (int)gridDim.x, (int)blockIdx.x, K);
    pg8::gemm_phase<Epi, pg8::StaticOrder, false>((PG8_LAS unsigned char*)shm, g, S, E, nullptr);
}

struct SplitOrder {
    pg8::StaticOrder lat; int nlat, nsl, nctx, G, c, nN;
    __device__ void init(int N, int K, int G_, int c_) { lat.init(RL, N, G_, c_, K); nlat = lat.nwg; nN = N / 256; nsl = (K / 64) / 4; nctx = (RC / 256) * nN * nsl; G = G_; c = c_; }
    __device__ bool next(int i, pg8::Unit& u) const {
        const long L = (long)i * G + c; if (L < nlat) return lat.next(i, u);
        const int j = (int)(L - nlat); if (j >= nctx) return false;
        const int sl = j % nsl, tile = j / nsl; u.pm = RL / 256 + tile / nN; u.pn = tile % nN; u.kt0 = sl * 4; u.nkt = 4; return true; }
    __device__ __forceinline__ void a_ready(const pg8::Unit&) const {}
    __device__ __forceinline__ void done(const pg8::Unit&) const {}
};
template <class Epi> __device__ __forceinline__ void run_gemm_split(unsigned char* shm, const u16* A, const u16* Bt, int N, int K, const Epi& E) {
    pg8::Gemm g; g.A = A; g.Bt = Bt; g.M = RT; g.N = N; g.K = K;
    SplitOrder S; S.init(N, K, (int)gridDim.x, (int)blockIdx.x);
    pg8::gemm_phase<Epi, SplitOrder, false>((PG8_LAS unsigned char*)shm, g, S, E, nullptr);
}

__device__ __forceinline__ int wcol(int r, int N, int mode) {
    if (mode == 0) return r < N ? r : -1;
    if (mode == 1) { const int q = r >> 8, s = (r >> 7) & 1, i = r & 127; return s * DFF + 128 * q + i; }
    if (mode == 2) return r + 3136;
    return r < 3136 ? r : -1;
}
__device__ __forceinline__ void convert_tile(unsigned char* shm, const float* src, u16* dst, int K, int N, int mode, int ti) {
    u16* tile = (u16*)shm;
    const int t = threadIdx.x, rl = t & 63, k0 = t >> 6, r2 = t >> 3, kk = (t & 7) * 8;
    const int nkt = K >> 7, rb = (ti / nkt) << 6, kb = (ti % nkt) << 7;
    const int col = wcol(rb + rl, N, mode);
    const float* sp = src + (size_t)(kb + k0) * N + (col >= 0 ? col : 0);
    float v[16];
#pragma unroll
    for (int i = 0; i < 16; ++i) v[i] = sp[(size_t)(8 * i) * N];
#pragma unroll
    for (int i = 0; i < 16; ++i) tile[rl * 136 + k0 + 8 * i] = f2bf(col >= 0 ? v[i] : 0.f);
    __syncthreads();
    *(u32x4v*)(dst + (size_t)(rb + r2) * K + kb + kk) = *(const u32x4v*)(tile + r2 * 136 + kk);
    *(u32x4v*)(dst + (size_t)(rb + r2) * K + kb + 64 + kk) = *(const u32x4v*)(tile + r2 * 136 + 64 + kk);
    __syncthreads();
}
constexpr int wtiles(int NR, int K) { return (NR / 64) * (K / 128); }
__device__ void convert_weights_early(unsigned char* shm, const Params& p) {
    unsigned char* ws = p.ws;
    constexpr int T0 = wtiles(5632, 1024), T1 = wtiles(1024, 2816), T2 = wtiles(3328, 1024), T3 = wtiles(2816, 1024), T4 = wtiles(2048, 1024), T5 = wtiles(1024, 1024);
    for (int gi = blockIdx.x; gi < T0 + T1 + T2 + T3 + T4 + T5; gi += gridDim.x) {
        int ti = gi;
        if (ti < T0) { convert_tile(shm, p.in[I_FFWIN], (u16*)(ws + A_FF_IN0), 1024, 5632, 1, ti); continue; } ti -= T0;
        if (ti < T1) { convert_tile(shm, p.in[I_FFWOUT], (u16*)(ws + A_FF_OUT0), 2816, 1024, 0, ti); continue; } ti -= T1;
        if (ti < T2) { convert_tile(shm, p.in[I_SSDWIN], (u16*)(ws + B_SSD_INA), 1024, 5184, 3, ti); continue; } ti -= T2;
        if (ti < T3) { convert_tile(shm, p.in[I_ABWIN], (u16*)(ws + A_AB_IN), 1024, 2592, 0, ti); continue; } ti -= T3;
        if (ti < T4) { convert_tile(shm, p.in[I_SSDWIN], (u16*)(ws + B_WZ), 1024, 5184, 2, ti); continue; } ti -= T4;
        convert_tile(shm, p.in[I_ABWOUT], (u16*)(ws + A_AB_OUT), 1024, 1024, 0, ti);
    }
}
__device__ void convert_weights_late(unsigned char* shm, const Params& p) {
    unsigned char* ws = p.ws;
    constexpr int T0 = wtiles(5632, 1024), T1 = wtiles(1024, 2816), T2 = wtiles(1024, 2048);
    for (int gi = blockIdx.x; gi < T0 + T1 + T2; gi += gridDim.x) {
        int ti = gi;
        if (ti < T0) { convert_tile(shm, p.in[I_FFWIN] + (size_t)1024 * 5632, (u16*)(ws + A_FF_IN1), 1024, 5632, 1, ti); continue; } ti -= T0;
        if (ti < T1) { convert_tile(shm, p.in[I_FFWOUT] + (size_t)2816 * 1024, (u16*)(ws + A_FF_OUT1), 2816, 1024, 0, ti); continue; } ti -= T1;
        convert_tile(shm, p.in[I_SSDWOUT], (u16*)(ws + A_SSD_OUT), 2048, 1024, 0, ti);
    }
}
__device__ void mod_gemv(unsigned char* shm, const Params& p) {
    float* sc = (float*)shm;
    float* red = sc + 5 * 1024;
    const int t = threadIdx.x;
    for (int i = t; i < 5 * 1024; i += 512) { const float v = i < 4096 ? p.in[I_C][i] : p.in[I_CCTX][i - 4096]; sc[i] = siluf(v); }
    __syncthreads();
    float* MOD = (float*)(p.ws + OFF_MOD);
    const int n = t & 31, kc = t >> 5;
    for (int job = blockIdx.x; job < 2 * 192; job += gridDim.x) {
        const int l = job / 192, nb = (job % 192) * 32;
        const float* W = p.in[I_MODW] + (size_t)l * DM * (NMOD * DM) + nb + n;
        float a[5] = {0.f, 0.f, 0.f, 0.f, 0.f};
#pragma unroll 16
        for (int i = 0; i < 64; ++i) { const int k = kc + 16 * i; const float w = W[(size_t)k * (NMOD * DM)];
#pragma unroll
            for (int m = 0; m < 5; ++m) a[m] += sc[m * 1024 + k] * w; }
#pragma unroll
        for (int m = 0; m < 5; ++m) red[(kc * 5 + m) * 32 + n] = a[m];
        __syncthreads();
        if (t < 160) { const int m = t >> 5; float s = 0.f;
#pragma unroll
            for (int q = 0; q < 16; ++q) s += red[(q * 5 + m) * 32 + n];
            MOD[((size_t)l * 5 + m) * (NMOD * DM) + nb + n] = s + p.in[I_MODB][(size_t)l * (NMOD * DM) + nb + n]; }
        __syncthreads();
    }
}

__device__ void norm_mod_phase(const float* lat, const float* ctx, const float* ng, const float* modl  , int ishift, int iscale, int nrows, int cm, u16* H, const float* part = nullptr, int nsl = 0, const float* pgate = nullptr, float* xc_out = nullptr) {
    const int lane = threadIdx.x & 63, wid = threadIdx.x >> 6;
    for (int row = blockIdx.x * 8 + wid; row < nrows; row += gridDim.x * 8) {
        const float* s = row < RL ? lat + (size_t)row * DM : ctx + (size_t)(row - RL) * DM;
        const int mi = row < RL ? (row >> 12) : 4;
        f32x4 v[4], pg[4], psh[4], psc[4]; float ss = 0.f;
        const float* sh = modl + mi * (NMOD * DM) + ishift * DM; const float* scp = modl + mi * (NMOD * DM) + iscale * DM;
#pragma unroll
        for (int i = 0; i < 4; ++i) v[i] = *(const f32x4*)(s + i * 256 + lane * 4);
#pragma unroll
        for (int i = 0; i < 4; ++i) { const int c = i * 256 + lane * 4; pg[i] = *(const f32x4*)(ng + c); psh[i] = *(const f32x4*)(sh + c); psc[i] = *(const f32x4*)(scp + c); }
#pragma unroll
        for (int i = 0; i < 4; ++i) ss += v[i][0] * v[i][0] + v[i][1] * v[i][1] + v[i][2] * v[i][2] + v[i][3] * v[i][3];
        if (part != nullptr && row >= RL) {
            ss = 0.f;
#pragma unroll
            for (int i = 0; i < 4; ++i) { const int c = i * 256 + lane * 4; f32x4 a = {0.f, 0.f, 0.f, 0.f};
                for (int sl = 0; sl < nsl; ++sl) a += *(const f32x4*)(part + ((size_t)sl * RC + (row - RL)) * DM + c);
                v[i] += *(const f32x4*)(pgate + c) * a; *(f32x4*)(xc_out + (size_t)(row - RL) * DM + c) = v[i];
                ss += v[i][0] * v[i][0] + v[i][1] * v[i][1] + v[i][2] * v[i][2] + v[i][3] * v[i][3]; } }
        ss = wave_sum(ss);
        const float rs = rsqrtf(ss * (1.0f / DM) + EPS);
        const int dr = (cm && row < RL) ? ((row & ~4095) | ((row & 63) << 6) | ((row >> 6) & 63)) : row;
#pragma unroll
        for (int i = 0; i < 4; ++i) { const int c = i * 256 + lane * 4; const f32x4 g4 = pg[i], sh4 = psh[i], sc4 = psc[i];
            float o[4];
#pragma unroll
            for (int e = 0; e < 4; ++e) o[e] = (v[i][e] * rs * g4[e]) * (1.0f + sc4[e]) + sh4[e];
            u32x2 w; w[0] = pk2(o[0], o[1]); w[1] = pk2(o[2], o[3]); *(u32x2*)(H + (size_t)dr * DM + c) = w; }
    }
}
__device__ void final_norm_phase(float* X, const float* g) {
    const int lane = threadIdx.x & 63, wid = threadIdx.x >> 6;
    for (int row = blockIdx.x * 8 + wid; row < RL; row += gridDim.x * 8) {
        float* s = X + (size_t)row * DM; f32x4 v[4]; float ss = 0.f;
#pragma unroll
        for (int i = 0; i < 4; ++i) { v[i] = *(const f32x4*)(s + i * 256 + lane * 4); ss += v[i][0] * v[i][0] + v[i][1] * v[i][1] + v[i][2] * v[i][2] + v[i][3] * v[i][3]; }
        ss = wave_sum(ss);
        const float rs = rsqrtf(ss * (1.0f / DM) + EPS);
#pragma unroll
        for (int i = 0; i < 4; ++i) { const int c = i * 256 + lane * 4; const f32x4 g4 = *(const f32x4*)(g + c); f32x4 o;
#pragma unroll
            for (int e = 0; e < 4; ++e) o[e] = (v[i][e] * rs) * g4[e];
            *(f32x4*)(s + c) = o; }
    }
}

__device__ __forceinline__ int gla_rowbase(int b, int c) { return c < 4 ? RL + b * CTXL + c * 64 : b * SEQ + (c - 4) * 64; }
__device__ __forceinline__ float* gla_ds_ptr(const Params& p, int b, int d, int h, int c) {
    return c < 4 ? (float*)(p.ws + OFF_DSC) + ((size_t)((b * 2 + d) * 4 + h) * 4 + c) * 8192 : p.out + ((size_t)((b * 2 + d) * 4 + h) * 64 + (c - 4)) * 8192;
}
constexpr int GL_BC = 0;
constexpr int GL_LR = GL_BC + 2 * 64 * 65 * 4;
constexpr int GL_GW = GL_LR + 64 * 32 * 4;
constexpr int GL_X0 = GL_GW + 2 * 16 * 64 * 4;
constexpr int GL_LD = 72;

__device__ void gla_gates(unsigned char* shm, const Params& p, int rowbase, int h) {
    const u16* P0 = (const u16*)(p.ws + E_P0);
    float* BC = (float*)(shm + GL_BC); float* LR = (float*)(shm + GL_LR); float* QS = (float*)(shm + GL_GW);
    const int t = threadIdx.x;
    const int kk = t & 63, lq = (t >> 6) & 3, d = t >> 8;
    float gw[16];
#pragma unroll
    for (int j = 0; j < 16; ++j) gw[j] = p.in[I_ABGW][(size_t)(d * 16 + j) * 256 + h * 64 + kk];
    const float gb = p.in[I_ABGB][d * 256 + h * 64 + kk];
    if (t < 256) { const int row = t >> 2, part = t & 3; const u32x4v w = *(const u32x4v*)(P0 + (size_t)(rowbase + row) * P0_LD + P0_LR + part * 8);
        f32x4 lo, hi; lo[0] = bflo(w[0]); lo[1] = bfhi(w[0]); lo[2] = bflo(w[1]); lo[3] = bfhi(w[1]); hi[0] = bflo(w[2]); hi[1] = bfhi(w[2]); hi[2] = bflo(w[3]); hi[3] = bfhi(w[3]);
        *(f32x4*)(LR + row * 32 + part * 8) = lo; *(f32x4*)(LR + row * 32 + part * 8 + 4) = hi; }
    __syncthreads();
    float la[16];
#pragma unroll
    for (int i = 0; i < 16; ++i) { const int l = lq * 16 + i; const float* lr = LR + l * 32 + d * 16; float pre = gb;
#pragma unroll
        for (int j4 = 0; j4 < 4; ++j4) { const f32x4 v = *(const f32x4*)(lr + j4 * 4); pre += v[0] * gw[j4 * 4] + v[1] * gw[j4 * 4 + 1] + v[2] * gw[j4 * 4 + 2] + v[3] * gw[j4 * 4 + 3]; }
        la[i] = logsigmoidf(pre) * (1.0f / 16.0f); }
    if (d == 0) {
#pragma unroll
        for (int i = 1; i < 16; ++i) la[i] += la[i - 1];
        QS[(d * 4 + lq) * 64 + kk] = la[15];
    } else {
#pragma unroll
        for (int i = 14; i >= 0; --i) la[i] += la[i + 1];
        QS[(d * 4 + lq) * 64 + kk] = la[0];
    }
    __syncthreads();
    float off = 0.f;
    if (d == 0) { for (int q = 0; q < lq; ++q) off += QS[(0 * 4 + q) * 64 + kk]; }
    else { for (int q = 3; q > lq; --q) off += QS[(1 * 4 + q) * 64 + kk]; }
#pragma unroll
    for (int i = 0; i < 16; ++i) BC[(d * 64 + lq * 16 + i) * 65 + kk] = la[i] + off;
    __syncthreads();
}
__device__ __forceinline__ void gla_load_v(u32x4v& w0, u32x4v& w1, const u16* P0, int rowbase, int h) {
    const int t = threadIdx.x, l = t & 63, vg = t >> 6;
    const u16* src = P0 + (size_t)(rowbase + l) * P0_LD + P0_V + h * 128 + vg * 16;
    w0 = *(const u32x4v*)src; w1 = *(const u32x4v*)(src + 8);
}
__device__ __forceinline__ void gla_stage_vT(u16* vT, const u32x4v& w0, const u32x4v& w1) {
    const int t = threadIdx.x, l = t & 63, vg = t >> 6;
#pragma unroll
    for (int e = 0; e < 4; ++e) { vT[(vg * 16 + 2 * e) * GL_LD + l] = (u16)(w0[e] & 0xFFFF); vT[(vg * 16 + 2 * e + 1) * GL_LD + l] = (u16)(w0[e] >> 16);
        vT[(vg * 16 + 8 + 2 * e) * GL_LD + l] = (u16)(w1[e] & 0xFFFF); vT[(vg * 16 + 8 + 2 * e + 1) * GL_LD + l] = (u16)(w1[e] >> 16); }
}

__device__ void gla_a_item(unsigned char* shm, const Params& p, int b, int c, int h) {
    const u16* P0 = (const u16*)(p.ws + E_P0);
    const int rowbase = gla_rowbase(b, c), t = threadIdx.x, lane = t & 63, w = t >> 6;
    const u32x4v kw = *(const u32x4v*)(P0 + (size_t)(rowbase + (t & 63)) * P0_LD + P0_K + h * 64 + (t >> 6) * 8);
    u32x4v vw0, vw1; gla_load_v(vw0, vw1, P0, rowbase, h);
    gla_gates(shm, p, rowbase, h);
    const float* BC = (const float*)(shm + GL_BC);
    u16* kwT = (u16*)(shm + GL_X0);
    u16* vT = kwT + 2 * 64 * GL_LD;
    { const int l = t & 63, kg = t >> 6;
#pragma unroll
      for (int e = 0; e < 8; ++e) { const int k = kg * 8 + e; const float kv = (e & 1) ? bfhi(kw[e >> 1]) : bflo(kw[e >> 1]);
          const float w0 = __expf(BC[63 * 65 + k] - BC[l * 65 + k]), w1 = __expf(BC[(64 + 0) * 65 + k] - BC[(64 + l) * 65 + k]);
          kwT[k * GL_LD + l] = f2bf(kv * w0); kwT[(64 + k) * GL_LD + l] = f2bf(kv * w1); } }
    gla_stage_vT(vT, vw0, vw1);
    __syncthreads();
    { const int d = w >> 2, kb = w & 3; f32x4 acc[1][8]; zero_acc(acc);
      wave_mma<1, 8>(acc, kwT + (d * 64 + kb * 16) * GL_LD, GL_LD, vT, GL_LD, 2);
      float* DS = gla_ds_ptr(p, b, d, h, c);
#pragma unroll
      for (int nt = 0; nt < 8; ++nt) { const int v = nt * 16 + (lane & 15), k0 = kb * 16 + (lane >> 4) * 4; *(f32x4*)(DS + v * 64 + k0) = acc[0][nt]; } }
    if (t < 128) { const int d = t >> 6, kk = t & 63; const float bl = d == 0 ? BC[63 * 65 + kk] : BC[64 * 65 + kk];
        ((float*)(p.ws + OFF_DEC))[((size_t)((b * 2 + d) * 4 + h) * 68 + c) * 64 + kk] = __expf(bl); }
    __syncthreads();
}

__device__ void gmlp_item(unsigned char* shm, const Params& p, int b, int cc, int gi) {
    const u16* P0 = (const u16*)(p.ws + E_P0); u16* MG = (u16*)(p.ws + OFF_H);
    const int rowbase = cc < 2 ? RL + b * CTXL + cc * 128 : b * SEQ + (cc - 2) * 128;
    const int t = threadIdx.x, lane = t & 63, w = t >> 6;
    float* st = (float*)shm;
    u16* vnT = (u16*)(shm + 1024);
    u16* Ws = vnT + 128 * 136;
    { const int row = t >> 2, part = t & 3; const u16* src = P0 + (size_t)(rowbase + row) * P0_LD + P0_G + part * 128; float s = 0.f, ss = 0.f;
#pragma unroll 4
      for (int i = 0; i < 16; ++i) { const u32x4v wv = *(const u32x4v*)(src + i * 8);
#pragma unroll
          for (int e = 0; e < 4; ++e) { const float a = geluf(bflo(wv[e])), c2 = geluf(bfhi(wv[e])); s += a + c2; ss += a * a + c2 * c2; } }
      s += __shfl_xor(s, 1, 64); ss += __shfl_xor(ss, 1, 64); s += __shfl_xor(s, 2, 64); ss += __shfl_xor(ss, 2, 64);
      if (part == 0) { const float mu = s * (1.0f / 512.0f); const float var = fmaxf(ss * (1.0f / 512.0f) - mu * mu, 0.f); st[row * 2] = mu; st[row * 2 + 1] = rsqrtf(var + EPS); } }
    { const float* SW = p.in[I_ABSW] + (size_t)gi * 128 * 128;
#pragma unroll
      for (int ps = 0; ps < 8; ++ps) { const int idx = ps * 2048 + t * 4, tt = idx >> 7, s0 = idx & 127; const f32x4 v = *(const f32x4*)(SW + idx);
          u32x2 o; o[0] = pk2(v[0], v[1]); o[1] = pk2(v[2], v[3]); *(u32x2*)(Ws + tt * 136 + s0) = o; } }
    __syncthreads();
    { const int s = t & 127, cg4 = t >> 7; const u16* src = P0 + (size_t)(rowbase + s) * P0_LD + P0_G + gi * 128 + cg4 * 32; const float mu = st[s * 2], rstd = st[s * 2 + 1];
      const float* vg = p.in[I_ABVNG] + gi * 128 + cg4 * 32;
#pragma unroll
      for (int i = 0; i < 4; ++i) { const u32x4v wv = *(const u32x4v*)(src + i * 8);
#pragma unroll
          for (int e = 0; e < 8; ++e) { const float x = (e & 1) ? bfhi(wv[e >> 1]) : bflo(wv[e >> 1]); const int cl = i * 8 + e;
              vnT[(cg4 * 32 + cl) * 136 + s] = f2bf((geluf(x) - mu) * rstd * vg[cl]); } } }
    __syncthreads();
    { f32x4 acc[1][8]; zero_acc(acc);
      wave_mma<1, 8>(acc, vnT + (w * 16) * 136, 136, Ws, 136, 4);
      const int c0 = w * 16 + (lane >> 4) * 4;
#pragma unroll
      for (int nt = 0; nt < 8; ++nt) { const int tt = nt * 16 + (lane & 15); const float sb = p.in[I_ABSB][gi * 128 + tt];
          const u32x2 uw = *(const u32x2*)(P0 + (size_t)(rowbase + tt) * P0_LD + P0_U + gi * 128 + c0);
          const float o0 = geluf(bflo(uw[0])) * (acc[0][nt][0] + sb), o1 = geluf(bfhi(uw[0])) * (acc[0][nt][1] + sb), o2 = geluf(bflo(uw[1])) * (acc[0][nt][2] + sb), o3 = geluf(bfhi(uw[1])) * (acc[0][nt][3] + sb);
          u32x2 o; o[0] = pk2(o0, o1); o[1] = pk2(o2, o3); *(u32x2*)(MG + (size_t)(rowbase + tt) * DM + 512 + gi * 128 + c0) = o; } }
    __syncthreads();
}

__device__ void gla_scan_phase(const Params& p) {
    const float* DEC = (const float*)(p.ws + OFF_DEC);
    for (int g0 = blockIdx.x * 512 + threadIdx.x; g0 < 4 * 2 * 4 * 8192 / 2; g0 += gridDim.x * 512) {
        int e[2], bb[2], dd[2], hh[2]; const float* dec[2]; float s[2] = {0.f, 0.f};
#pragma unroll
        for (int q = 0; q < 2; ++q) { const int gidx = g0 + q * (4 * 2 * 4 * 8192 / 2); e[q] = gidx & 8191; const int bdh = gidx >> 13; hh[q] = bdh & 3; dd[q] = (bdh >> 2) & 1; bb[q] = bdh >> 3; dec[q] = DEC + (size_t)bdh * 68 * 64 + (e[q] & 63); }
        for (int i0 = 0; i0 < 68; i0 += 17) {
            float* ptr[2][17]; float ds[2][17], dc[2][17];
#pragma unroll
            for (int u = 0; u < 17; ++u)
#pragma unroll
                for (int q = 0; q < 2; ++q) { const int i = i0 + u; const int c = dd[q] == 0 ? i : (i < 4 ? 3 - i : 71 - i); ptr[q][u] = gla_ds_ptr(p, bb[q], dd[q], hh[q], c) + e[q]; ds[q][u] = *ptr[q][u]; dc[q][u] = dec[q][c * 64]; }
#pragma unroll
            for (int u = 0; u < 17; ++u)
#pragma unroll
                for (int q = 0; q < 2; ++q) { *ptr[q][u] = s[q]; s[q] = dc[q][u] * s[q] + ds[q][u]; }
        }
    }
}

__device__ void gla_c_item(unsigned char* shm, const Params& p, int b, int c, int h) {
    const u16* P0 = (const u16*)(p.ws + E_P0); u16* MG = (u16*)(p.ws + OFF_H);
    const int rowbase = gla_rowbase(b, c), t = threadIdx.x, lane = t & 63, w = t >> 6;
    const u16* rp_ = P0 + (size_t)(rowbase + (t & 63)) * P0_LD + h * 64 + (t >> 6) * 8;
    const u32x4v qw = *(const u32x4v*)(rp_ + P0_Q), kw = *(const u32x4v*)(rp_ + P0_K);
    u32x4v vw0, vw1; gla_load_v(vw0, vw1, P0, rowbase, h);
    f32x4 spa[4], spb[4];
#pragma unroll
    for (int ps = 0; ps < 4; ++ps) { const int idx = ps * 4096 + t * 8; const float* src = gla_ds_ptr(p, b, idx >> 13, h, c) + (idx & 8191); spa[ps] = *(const f32x4*)src; spb[ps] = *(const f32x4*)(src + 4); }
    const u16* rrp = P0 + (size_t)(rowbase + (t >> 3)) * P0_LD + P0_R + h * 128 + (t & 7) * 16;
    const u32x4v r0 = *(const u32x4v*)rrp, r1 = *(const u32x4v*)(rrp + 8);
    gla_gates(shm, p, rowbase, h);
    const float* BC = (const float*)(shm + GL_BC);
    u16* qd = (u16*)(shm + GL_X0);
    u16* kd = qd + 2 * 64 * GL_LD;
    u16* vT = kd + 2 * 64 * GL_LD;
    u16* SpT = vT + 128 * GL_LD;
    u16* SC = (u16*)(shm + GL_BC);
    float* O = (float*)SpT;
    { const int l = t & 63, kg = t >> 6;
#pragma unroll
      for (int d = 0; d < 2; ++d) { u32x4v qo, ko;
#pragma unroll
          for (int e2 = 0; e2 < 4; ++e2) { const float e0 = BC[(d * 64 + l) * 65 + kg * 8 + 2 * e2], e1 = BC[(d * 64 + l) * 65 + kg * 8 + 2 * e2 + 1];
              qo[e2] = pk2(bflo(qw[e2]) * 0.125f * __expf(e0), bfhi(qw[e2]) * 0.125f * __expf(e1));
              ko[e2] = pk2(bflo(kw[e2]) * __expf(-e0), bfhi(kw[e2]) * __expf(-e1)); }
          *(u32x4v*)(qd + (d * 64 + l) * GL_LD + kg * 8) = qo; *(u32x4v*)(kd + (d * 64 + l) * GL_LD + kg * 8) = ko; } }
    gla_stage_vT(vT, vw0, vw1);
#pragma unroll
    for (int ps = 0; ps < 4; ++ps) { const int idx = ps * 4096 + t * 8, d = idx >> 13, rem = idx & 8191, v = rem >> 6, k0 = rem & 63;
        *(u32x4v*)(SpT + (d * 128 + v) * GL_LD + k0) = pack8(spa[ps], spb[ps]); }
    __syncthreads();
    { const int d = w >> 2, lb = w & 3; f32x4 acc[1][4]; zero_acc(acc);
      wave_mma<1, 4>(acc, qd + (d * 64 + lb * 16) * GL_LD, GL_LD, kd + d * 64 * GL_LD, GL_LD, 2);
      __syncthreads();
#pragma unroll
      for (int nt = 0; nt < 4; ++nt)
#pragma unroll
          for (int j = 0; j < 4; ++j) { const int l = lb * 16 + (lane >> 4) * 4 + j, s = nt * 16 + (lane & 15); const bool keep = d == 0 ? (s <= l) : (s >= l);
              SC[(d * 64 + l) * GL_LD + s] = f2bf(keep ? acc[0][nt][j] : 0.f); } }
    __syncthreads();
    f32x4 oacc[1][4]; zero_acc(oacc);
    const int lb = w & 3, vh = w >> 2;
#pragma unroll
    for (int d = 0; d < 2; ++d) {
        wave_mma<1, 4>(oacc, qd + (d * 64 + lb * 16) * GL_LD, GL_LD, SpT + (d * 128 + vh * 64) * GL_LD, GL_LD, 2);
        wave_mma<1, 4>(oacc, SC + (d * 64 + lb * 16) * GL_LD, GL_LD, vT + (vh * 64) * GL_LD, GL_LD, 2);
    }
    __syncthreads();
#pragma unroll
    for (int nt = 0; nt < 4; ++nt)
#pragma unroll
        for (int j = 0; j < 4; ++j) { const int l = lb * 16 + (lane >> 4) * 4 + j, v = vh * 64 + nt * 16 + (lane & 15); O[l * 132 + v] = oacc[0][nt][j]; }
    __syncthreads();
    { const int l = t >> 3, part = t & 7; float o[16]; float ss = 0.f;
#pragma unroll
      for (int i = 0; i < 4; ++i) { const f32x4 v4 = *(const f32x4*)(O + l * 132 + part * 16 + i * 4);
#pragma unroll
          for (int e = 0; e < 4; ++e) { o[i * 4 + e] = v4[e]; ss += v4[e] * v4[e]; } }
      ss += __shfl_xor(ss, 1, 64); ss += __shfl_xor(ss, 2, 64); ss += __shfl_xor(ss, 4, 64);
      const float rs = rsqrtf(ss * (1.0f / 128.0f) + EPS);
      const float* gg = p.in[I_ABGNG] + h * 128 + part * 16; u32x4v o0, o1;
#pragma unroll
      for (int e2 = 0; e2 < 4; ++e2) {
          o0[e2] = pk2(o[2 * e2] * rs * gg[2 * e2] * siluf(bflo(r0[e2])), o[2 * e2 + 1] * rs * gg[2 * e2 + 1] * siluf(bfhi(r0[e2])));
          o1[e2] = pk2(o[8 + 2 * e2] * rs * gg[8 + 2 * e2] * siluf(bflo(r1[e2])), o[8 + 2 * e2 + 1] * rs * gg[8 + 2 * e2 + 1] * siluf(bfhi(r1[e2]))); }
      u16* dst = MG + (size_t)(rowbase + l) * DM + h * 128 + part * 16; *(u32x4v*)dst = o0; *(u32x4v*)(dst + 8) = o1; }
    __syncthreads();
}

__device__ void conv_phase(const Params& p) {
    u16* XBC = (u16*)(p.ws + E_XBC); const u16* HALO = (const u16*)(p.ws + A_HALO);
    const int t = threadIdx.x, cg = t & 127, q = __builtin_amdgcn_readfirstlane(t >> 7);
    for (int it = blockIdx.x; it < (RT / 64) * 3; it += gridDim.x) {
        const int rb = it / 3, cp = (it % 3) * 1024, c0 = cp + cg * 8;
        const bool first = rb < 256 ? ((rb & 63) == 0) : (((rb - 256) & 3) == 0);
        const bool last = rb < 256 ? ((rb & 63) == 63) : (((rb - 256) & 3) == 3);
        const bool z0 = (q == 0) && first, z1 = (q == 3) && last;
        u16* rowq = XBC + ((size_t)rb * 64 + 16 * q) * XBC_LD + cp;
        const u16* pre = (q == 0) ? (z0 ? rowq : HALO + ((size_t)(rb - 1) * 4 + 2) * XBC_LD + cp) : rowq - 2 * XBC_LD;
        const u16* post = (q == 3) ? (z1 ? rowq : HALO + ((size_t)(rb + 1) * 4) * XBC_LD + cp) : rowq + 16 * XBC_LD;
        u32x4v win[20];
        win[0] = *(const u32x4v*)(pre + cg * 8); win[1] = *(const u32x4v*)(pre + XBC_LD + cg * 8);
#pragma unroll
        for (int i = 0; i < 16; ++i) win[2 + i] = *(const u32x4v*)(rowq + (size_t)i * XBC_LD + cg * 8);
        win[18] = *(const u32x4v*)(post + cg * 8); win[19] = *(const u32x4v*)(post + XBC_LD + cg * 8);
        const u32x4v zero = {0u, 0u, 0u, 0u};
        if (z0) { win[0] = zero; win[1] = zero; }
        if (z1) { win[18] = zero; win[19] = zero; }
        float wt[5][8], bias[8];
#pragma unroll
        for (int j = 0; j < 5; ++j) { const f32x4 a = *(const f32x4*)(p.in[I_SSDCW] + j * 3072 + c0), b2 = *(const f32x4*)(p.in[I_SSDCW] + j * 3072 + c0 + 4);
#pragma unroll
            for (int e = 0; e < 4; ++e) { wt[j][e] = a[e]; wt[j][4 + e] = b2[e]; } }
        { const f32x4 a = *(const f32x4*)(p.in[I_SSDCB] + c0), b2 = *(const f32x4*)(p.in[I_SSDCB] + c0 + 4);
#pragma unroll
          for (int e = 0; e < 4; ++e) { bias[e] = a[e]; bias[4 + e] = b2[e]; } }
        __syncthreads();
#pragma unroll
        for (int r = 0; r < 16; ++r) {
            float o[8];
#pragma unroll
            for (int e = 0; e < 8; ++e) o[e] = bias[e];
#pragma unroll
            for (int j = 0; j < 5; ++j)
#pragma unroll
                for (int e2 = 0; e2 < 4; ++e2) { o[2 * e2] += wt[j][2 * e2] * bflo(win[r + j][e2]); o[2 * e2 + 1] += wt[j][2 * e2 + 1] * bfhi(win[r + j][e2]); }
            u32x4v ov;
#pragma unroll
            for (int e2 = 0; e2 < 4; ++e2) ov[e2] = pk2(siluf(o[2 * e2]), siluf(o[2 * e2 + 1]));
            *(u32x4v*)(rowq + (size_t)r * XBC_LD + cg * 8) = ov;
        }
    }
}
__device__ void dt_phase(unsigned char* shm, const Params& p) {
    const float* DTRAW = (const float*)(p.ws + A_DTRAW); float* DT = (float*)(p.ws + T_DT); float* ACUM = (float*)(p.ws + T_ACUM);
    float* tile = (float*)shm;
    float* tdt = tile + 128 * 65;
    const int t = threadIdx.x, col = t & 63;
    const float bias = p.in[I_SSDDTB][col], a = -__expf(p.in[I_SSDALOG][col]);
    for (int ch = blockIdx.x; ch < RT / 128; ch += gridDim.x) {
        const size_t r0 = (size_t)ch * 128;
#pragma unroll
        for (int i = 0; i < 16; ++i) { const int m = i * 8 + (t >> 6); const float d = softplusf(DTRAW[(r0 + m) * 64 + col] + bias); tdt[m * 65 + col] = d; tile[m * 65 + col] = d * a; }
        __syncthreads();
        if (t < 64) { float run = 0.f;
            if (t < 32) { for (int m = 0; m < 128; ++m) { run += tile[m * 65 + t]; tile[m * 65 + t] = run; } }
            else { for (int m = 127; m >= 0; --m) { run += tile[m * 65 + t]; tile[m * 65 + t] = run; } } }
        __syncthreads();
        { const int m = t & 127, cq = t >> 7;
#pragma unroll
          for (int i = 0; i < 16; ++i) { const int c = cq * 16 + i; ACUM[(size_t)c * RT + r0 + m] = tile[m * 65 + c]; DT[(size_t)c * RT + r0 + m] = tdt[m * 65 + c]; } }
        __syncthreads();
    }
}
constexpr int SP_LD = 136;
constexpr int SP_C = 0;
constexpr int SP_B = SP_C + 128 * SP_LD * 2;
constexpr int SP_CB = SP_B + 128 * SP_LD * 2;
constexpr int SP_AC = SP_CB + 128 * SP_LD * 2;
constexpr int SP_DT = SP_AC + 16 * 128 * 4;
constexpr int SP_END = SP_DT + 16 * 128 * 4;
static_assert(SP_END <= LDS_XB, "SSD par LDS");
__device__ void ssd_par_item(unsigned char* shm, const Params& p, int item) {
    const u16* XBC = (const u16*)(p.ws + E_XBC); u16* Y = (u16*)(p.ws + E_Y);
    const float* DT = (const float*)(p.ws + T_DT); const float* ACUM = (const float*)(p.ws + T_ACUM);
    const int g = item & 3, base = (item >> 2) * 128;
    u16* Cs = (u16*)(shm + SP_C); u16* Ms = Cs; u16* Bs = (u16*)(shm + SP_B); u16* xT = Bs; u16* CBs = (u16*)(shm + SP_CB);
    float* acs = (float*)(shm + SP_AC); float* dts = (float*)(shm + SP_DT);
    const int t = threadIdx.x, lane = t & 63, w = t >> 6, fr = lane & 15, fq = lane >> 4;
#pragma unroll
    for (int i = 0; i < 4; ++i) { const int idx = i * 512 + t, m = idx >> 4, seg = idx & 15; const u16* rp = XBC + (size_t)(base + m) * XBC_LD + g * 128 + seg * 8;
        *(u32x4v*)(Cs + m * SP_LD + seg * 8) = *(const u32x4v*)(rp + 2560); *(u32x4v*)(Bs + m * SP_LD + seg * 8) = *(const u32x4v*)(rp + 2048); }
#pragma unroll
    for (int i = 0; i < 4; ++i) { const int idx = i * 512 + t, q = idx >> 7, m = idx & 127, hh = q >> 1, dir = q & 1; const size_t o = (size_t)(dir * 32 + g * 8 + hh) * RT + base + m;
        acs[idx] = ACUM[o]; dts[idx] = DT[o]; }
    __syncthreads();
    { f32x4 acc[1][8]; zero_acc(acc);
      wave_mma<1, 8>(acc, Bs + (w * 16) * SP_LD, SP_LD, Cs, SP_LD, 4);
#pragma unroll
      for (int nt = 0; nt < 8; ++nt) { u32x2 o; o[0] = pk2(acc[0][nt][0], acc[0][nt][1]); o[1] = pk2(acc[0][nt][2], acc[0][nt][3]); *(u32x2*)(CBs + (nt * 16 + fr) * SP_LD + w * 16 + fq * 4) = o; } }
    __syncthreads();
    const int seg = t & 15, mq = t >> 4, xs_ = t & 127, pseg = t >> 7, mrow0 = w * 16;
    u32x4v nx0, nx1;
    { const u16* xp = XBC + (size_t)(base + xs_) * XBC_LD + (g * 8) * 64 + pseg * 16; nx0 = *(const u32x4v*)xp; nx1 = *(const u32x4v*)(xp + 8); }
    for (int hh = 0; hh < 8; ++hh) {
        const int h = g * 8 + hh;
        const float* af = acs + (hh * 2) * 128; const float* ab = af + 128; const float* dtf = dts + (hh * 2) * 128; const float* dtb = dtf + 128;
        u32x2 xsv[4];
        { const size_t row = (size_t)(base + mrow0 + fr);
#pragma unroll
          for (int mt = 0; mt < 4; ++mt) xsv[mt] = *(const u32x2*)(XBC + row * XBC_LD + h * 64 + mt * 16 + fq * 4); }
        { const u32x4v x0 = nx0, x1 = nx1;
          if (hh < 7) { const u16* xp = XBC + (size_t)(base + xs_) * XBC_LD + (h + 1) * 64 + pseg * 16; nx0 = *(const u32x4v*)xp; nx1 = *(const u32x4v*)(xp + 8); }
#pragma unroll
          for (int e2 = 0; e2 < 4; ++e2) { xT[(pseg * 16 + 2 * e2) * SP_LD + xs_] = (u16)(x0[e2] & 0xFFFFu); xT[(pseg * 16 + 2 * e2 + 1) * SP_LD + xs_] = (u16)(x0[e2] >> 16);
              xT[(pseg * 16 + 8 + 2 * e2) * SP_LD + xs_] = (u16)(x1[e2] & 0xFFFFu); xT[(pseg * 16 + 8 + 2 * e2 + 1) * SP_LD + xs_] = (u16)(x1[e2] >> 16); } }
        { float afs[8], abs_[8], wf[8], wb[8];
#pragma unroll
          for (int q = 0; q < 2; ++q) { const f32x4 a4 = *(const f32x4*)(af + seg * 8 + 4 * q), b4 = *(const f32x4*)(ab + seg * 8 + 4 * q), c4 = *(const f32x4*)(dtf + seg * 8 + 4 * q), d4 = *(const f32x4*)(dtb + seg * 8 + 4 * q);
#pragma unroll
              for (int e = 0; e < 4; ++e) { afs[4 * q + e] = a4[e]; abs_[4 * q + e] = b4[e]; wf[4 * q + e] = c4[e]; wb[4 * q + e] = d4[e]; } }
#pragma unroll
          for (int i = 0; i < 4; ++i) { const int m = mq + 32 * i; const u32x4v cw = *(const u32x4v*)(CBs + m * SP_LD + seg * 8); const float amf = af[m], amb = ab[m]; float v[8];
#pragma unroll
              for (int e = 0; e < 8; ++e) { const int s2 = seg * 8 + e; const float cbv = (e & 1) ? bfhi(cw[e >> 1]) : bflo(cw[e >> 1]);
                  const float arg = s2 < m ? (amf - afs[e]) : (s2 > m ? (amb - abs_[e]) : 0.f); const float wgt = s2 < m ? wf[e] : (s2 > m ? wb[e] : wf[e] + wb[e]);
                  v[e] = cbv * __expf(arg) * wgt; }
              u32x4v mv; mv[0] = pk2(v[0], v[1]); mv[1] = pk2(v[2], v[3]); mv[2] = pk2(v[4], v[5]); mv[3] = pk2(v[6], v[7]);
              *(u32x4v*)(Ms + m * SP_LD + seg * 8) = mv; } }
        __syncthreads();
        f32x4 yT[4][1]; zero_acc(yT);
        wave_mma<4, 1>(yT, xT, SP_LD, Ms + mrow0 * SP_LD, SP_LD, 4);
        __syncthreads();
        { const float dsk = p.in[I_SSDD][h]; const size_t row = (size_t)(base + mrow0 + fr);
#pragma unroll
          for (int mt = 0; mt < 4; ++mt) { const int p0 = h * 64 + mt * 16 + fq * 4; const u32x2 xs = xsv[mt];
              u32x2 o; o[0] = pk2(yT[mt][0][0] + dsk * bflo(xs[0]), yT[mt][0][1] + dsk * bfhi(xs[0])); o[1] = pk2(yT[mt][0][2] + dsk * bflo(xs[1]), yT[mt][0][3] + dsk * bfhi(xs[1]));
              *(u32x2*)(Y + row * 2048 + p0) = o; } }
    }
}

constexpr int SS_LD = 136, SS_LB = 130;
constexpr int SS_C = 0;
constexpr int SS_B = SS_C + 128 * SS_LD * 2;
constexpr int SS_XW = SS_B + 128 * 256;
constexpr int SS_S = SS_XW + 32 * SS_LD * 2;
constexpr int SS_AC = SS_S + 32 * SS_LD * 2;
constexpr int SS_END = SS_AC + 512;
static_assert(SS_END <= LDS_XB, "SSD LDS");

__device__ __forceinline__ void lds_barrier() { asm volatile("s_waitcnt lgkmcnt(0)\n\ts_barrier" ::: "memory"); }
__device__ __forceinline__ unsigned ssd_off_b(unsigned row, unsigned ch) { return 256u * row + 16u * (ch ^ (((row & 3u) << 2) | ((row >> 2) & 3u))); }
__device__ __forceinline__ unsigned ssd_tr_addr(unsigned lane, unsigned c, unsigned ks, unsigned t) { const unsigned g = lane >> 4, q = (lane & 15u) >> 2, p = lane & 3u; return ssd_off_b(32u * ks + 8u * g + 4u * t + q, 2u * c + (p >> 1)) + 8u * (p & 1u); }
typedef unsigned short u16x4v __attribute__((ext_vector_type(4)));
struct SsdPre { u32x4v rC[4], rB[4], rX; u32x2 rY[2]; float rDt, rAcX, rAlast; };
__device__ __forceinline__ void ssd_item(unsigned char* shm, const Params& p, int b, int h, int ph) {
    const u16* XBC = (const u16*)(p.ws + E_XBC); u16* Y = (u16*)(p.ws + E_Y);
    const float* DT = (const float*)(p.ws + T_DT); const float* ACUM = (const float*)(p.ws + T_ACUM);
    u16* Cs = (u16*)(shm + SS_C); u16* Bs = (u16*)(shm + SS_B); u16* xwT = (u16*)(shm + SS_XW); u16* Sb = (u16*)(shm + SS_S);
    float* acs = (float*)(shm + SS_AC);
    const int t = threadIdx.x, lane = t & 63, w = t >> 6, g = h >> 3, fr = lane & 15, fq = lane >> 4;
    const int xcol = h * 64 + ph * 32, bcol = 2048 + g * 128, ccol = 2560 + g * 128;
    const int seg = t & 15, mq = t >> 4, xm = t & 127, xseg = t >> 7, mrow0 = w * 16;
    unsigned tra[8];
    { const unsigned bs_lds = (unsigned)(size_t)((__attribute__((address_space(3))) unsigned char*)(shm + SS_B));
#pragma unroll
      for (int k = 0; k < 4; ++k)
#pragma unroll
          for (int tq = 0; tq < 2; ++tq) tra[2 * k + tq] = bs_lds + ssd_tr_addr((unsigned)lane, (unsigned)w, (unsigned)k, (unsigned)tq); }
    for (int dir = 0; dir < 2; ++dir) {
        const float* dtc = DT + (size_t)(dir * 32 + h) * RT; const float* acc_ = ACUM + (size_t)(dir * 32 + h) * RT;
        f32x4 accS[1][2]; zero_acc(accS);
        SsdPre R0, R1;
        { const u32x4v z4 = {0u, 0u, 0u, 0u}; const u32x2 z2 = {0u, 0u};
#pragma unroll
          for (int i = 0; i < 4; ++i) { R0.rC[i] = z4; R1.rC[i] = z4; }
          R0.rY[0] = z2; R0.rY[1] = z2; R1.rY[0] = z2; R1.rY[1] = z2; }
        auto base_of = [&](int st) __attribute__((always_inline)) { return st < 2 ? RL + b * CTXL + (dir == 0 ? st : 1 - st) * 128 : b * SEQ + (dir == 0 ? st - 2 : 33 - st) * 128; };
        auto prefetch = [&](SsdPre& R, int st) __attribute__((always_inline)) {
            const int base_ = base_of(st); const bool ctx_ = st < 2;
#pragma unroll
            for (int i = 0; i < 4; ++i) { const int m = mq + 32 * i; const u16* rp = XBC + (size_t)(base_ + m) * XBC_LD + seg * 8; R.rB[i] = *(const u32x4v*)(rp + bcol); if (!ctx_) R.rC[i] = *(const u32x4v*)(rp + ccol); }
            R.rX = *(const u32x4v*)(XBC + (size_t)(base_ + xm) * XBC_LD + xcol + xseg * 8); R.rDt = dtc[base_ + xm]; R.rAcX = acc_[base_ + xm]; R.rAlast = acc_[base_ + (dir == 0 ? 127 : 0)];
        };
        auto prefetch_y = [&](SsdPre& R, int st) __attribute__((always_inline)) {
            if (st >= 2) { const int base_ = base_of(st);
#pragma unroll
                for (int mt = 0; mt < 2; ++mt) R.rY[mt] = *(const u32x2*)(Y + (size_t)(base_ + mrow0 + fr) * 2048 + xcol + mt * 16 + fq * 4); } };
        auto do_step = [&](SsdPre& R, int step) __attribute__((always_inline)) {
            const bool isctx = step < 2;
            const int base = base_of(step);
            const float a_last = __uint_as_float(__builtin_amdgcn_readfirstlane(__float_as_uint(R.rAlast)));
            const bool pf = step + 2 < 34; const int base2 = base_of(pf ? step + 2 : step);
            if (xseg == 0) acs[xm] = R.rAcX;
            const float wgt = R.rDt * __expf(a_last - R.rAcX);
            if (pf) { R.rDt = dtc[base2 + xm]; R.rAcX = acc_[base2 + xm]; R.rAlast = acc_[base2 + (dir == 0 ? 127 : 0)]; }
#pragma unroll
            for (int i = 0; i < 4; ++i) { const int m = mq + 32 * i; const u16* rp2 = XBC + (size_t)(base2 + m) * XBC_LD + seg * 8;
                *(u32x4v*)((unsigned char*)Bs + ssd_off_b((unsigned)m, (unsigned)seg)) = R.rB[i];
                if (pf) R.rB[i] = *(const u32x4v*)(rp2 + bcol);
                if (!isctx) *(u32x4v*)(Cs + m * SS_LD + seg * 8) = R.rC[i];
                if (pf) R.rC[i] = *(const u32x4v*)(rp2 + ccol); }
            {
#pragma unroll
              for (int e = 0; e < 8; ++e) { const float x = (e & 1) ? bfhi(R.rX[e >> 1]) : bflo(R.rX[e >> 1]); xwT[(xseg * 8 + e) * SS_LD + xm] = f2bf(x * wgt); }
              if (pf) R.rX = *(const u32x4v*)(XBC + (size_t)(base2 + xm) * XBC_LD + xcol + xseg * 8); }
            if (!isctx) {
#pragma unroll
                for (int nt = 0; nt < 2; ++nt) { u32x2 o; o[0] = pk2(accS[0][nt][0], accS[0][nt][1]); o[1] = pk2(accS[0][nt][2], accS[0][nt][3]); *(u32x2*)(Sb + (nt * 16 + fr) * SS_LD + mrow0 + fq * 4) = o; } }
            lds_barrier();
            if (!isctx) {
                f32x4 yT[2][1]; zero_acc(yT);
                { bf16x8 fa[4][2], fb[4];
#pragma unroll
                  for (int k = 0; k < 4; ++k) { fa[k][0] = *(const bf16x8*)(Sb + fr * SS_LD + k * 32 + fq * 8); fa[k][1] = *(const bf16x8*)(Sb + (16 + fr) * SS_LD + k * 32 + fq * 8);
                      fb[k] = *(const bf16x8*)(Cs + (mrow0 + fr) * SS_LD + k * 32 + fq * 8); }
#pragma unroll
                  for (int k = 0; k < 4; ++k) { yT[0][0] = __builtin_amdgcn_mfma_f32_16x16x32_bf16(fa[k][0], fb[k], yT[0][0], 0, 0, 0); yT[1][0] = __builtin_amdgcn_mfma_f32_16x16x32_bf16(fa[k][1], fb[k], yT[1][0], 0, 0, 0); } }
                const float sc = __expf(acs[mrow0 + fr]);
                const size_t row = (size_t)(base + mrow0 + fr);
#pragma unroll
                for (int mt = 0; mt < 2; ++mt) { u16* yp = Y + row * 2048 + xcol + mt * 16 + fq * 4; const u32x2 pv = R.rY[mt];
                    u32x2 o; o[0] = pk2(bflo(pv[0]) + sc * yT[mt][0][0], bfhi(pv[0]) + sc * yT[mt][0][1]); o[1] = pk2(bflo(pv[1]) + sc * yT[mt][0][2], bfhi(pv[1]) + sc * yT[mt][0][3]);
                    asm volatile("global_store_dwordx2 %0, %1, off" :: "v"(yp), "v"(o) : "memory"); }
            }
            if (step + 2 < 34) prefetch_y(R, step + 2);
            { const float dl = __expf(a_last);
#pragma unroll
              for (int nt = 0; nt < 2; ++nt)
#pragma unroll
                  for (int j = 0; j < 4; ++j) accS[0][nt][j] *= dl; }
            { bf16x8 ga[4], gb[4][2];
              u16x4v tr[8];
              asm volatile("ds_read_b64_tr_b16 %0, %8\n\tds_read_b64_tr_b16 %1, %9\n\tds_read_b64_tr_b16 %2, %10\n\tds_read_b64_tr_b16 %3, %11\n\t"
                           "ds_read_b64_tr_b16 %4, %12\n\tds_read_b64_tr_b16 %5, %13\n\tds_read_b64_tr_b16 %6, %14\n\tds_read_b64_tr_b16 %7, %15\n\ts_waitcnt lgkmcnt(0)"
                           : "=&v"(tr[0]), "=&v"(tr[1]), "=&v"(tr[2]), "=&v"(tr[3]), "=&v"(tr[4]), "=&v"(tr[5]), "=&v"(tr[6]), "=&v"(tr[7])
                           : "v"(tra[0]), "v"(tra[1]), "v"(tra[2]), "v"(tra[3]), "v"(tra[4]), "v"(tra[5]), "v"(tra[6]), "v"(tra[7]) : "memory");
#pragma unroll
              for (int k = 0; k < 4; ++k) {
#pragma unroll
                  for (int e = 0; e < 4; ++e) { ga[k][e] = (short)tr[2 * k][e]; ga[k][4 + e] = (short)tr[2 * k + 1][e]; }
#pragma unroll
                  for (int nt = 0; nt < 2; ++nt) gb[k][nt] = *(const bf16x8*)(xwT + (nt * 16 + fr) * SS_LD + k * 32 + fq * 8); }
#pragma unroll
              for (int k = 0; k < 4; ++k)
#pragma unroll
                  for (int nt = 0; nt < 2; ++nt) accS[0][nt] = __builtin_amdgcn_mfma_f32_16x16x32_bf16(ga[k], gb[k][nt], accS[0][nt], 0, 0, 0); }
            lds_barrier();
        };
        prefetch(R0, 0); prefetch(R1, 1); prefetch_y(R0, 0); prefetch_y(R1, 1);
        for (int step = 0; step < 34; step += 2) { do_step(R0, step); do_step(R1, step + 1); }
        asm volatile("s_waitcnt vmcnt(0)" ::: "memory");
    }
}

__device__ void ssd_finish_phase(const Params& p) {
    u16* Y = (u16*)(p.ws + E_Y); const u16* Z = (const u16*)(p.ws + E_Z);
    const int lane = threadIdx.x & 63, wid = threadIdx.x >> 6;
    const int stride = gridDim.x * 8;
    for (int it0 = blockIdx.x * 8 + wid; it0 < RL * 4; it0 += 4 * stride) {
        u32x4v yw[4], zw[4]; size_t off[4]; bool ok[4];
#pragma unroll
        for (int u = 0; u < 4; ++u) { const int it = it0 + u * stride; ok[u] = it < RL * 4; off[u] = ok[u] ? (size_t)(it >> 2) * 2048 + (it & 3) * 512 + lane * 8 : 0;
            yw[u] = *(const u32x4v*)(Y + off[u]); zw[u] = *(const u32x4v*)(Z + off[u]); }
#pragma unroll
        for (int u = 0; u < 4; ++u) { const int it = it0 + u * stride;
            float v[8]; float ss = 0.f;
#pragma unroll
            for (int e2 = 0; e2 < 4; ++e2) { v[2 * e2] = bflo(yw[u][e2]) * siluf(bflo(zw[u][e2])); v[2 * e2 + 1] = bfhi(yw[u][e2]) * siluf(bfhi(zw[u][e2])); ss += v[2 * e2] * v[2 * e2] + v[2 * e2 + 1] * v[2 * e2 + 1]; }
            ss = wave_sum(ss);
            const float rs = rsqrtf(ss * (1.0f / 512.0f) + EPS);
            const float* gg = p.in[I_SSDNG] + (it & 3) * 512 + lane * 8; u32x4v o;
#pragma unroll
            for (int e2 = 0; e2 < 4; ++e2) o[e2] = pk2(v[2 * e2] * rs * gg[2 * e2], v[2 * e2 + 1] * rs * gg[2 * e2 + 1]);
            if (ok[u]) *(u32x4v*)(Y + off[u]) = o; }
    }
}

__global__ __launch_bounds__(512, 2) void mega(Params p) {
    extern __shared__ __attribute__((aligned(16))) unsigned char shm[];
    cg::grid_group grid = cg::this_grid();
    unsigned char* ws = p.ws;
    float* MOD = (float*)(ws + OFF_MOD); const float* MOD1 = MOD + 5 * NMOD * DM;
    u16* H = (u16*)(ws + OFF_H); float* XC = (float*)(ws + OFF_XC);
    const int bid = blockIdx.x, nb = gridDim.x;
    volatile LAS unsigned* xst = (volatile LAS unsigned*)(shm + LDS_XB);
    if (threadIdx.x < 2) xst[threadIdx.x] = 0u;
    __syncthreads();
    const XcdBarrier xb = xcd_barrier_post((unsigned*)(ws + OFF_BAR), xst);
    mod_gemv(shm, p);
    convert_weights_early(shm, p);
    if (p.ws == nullptr) grid.sync();
    xcd_barrier(xb);
    norm_mod_phase(p.in[I_X], p.in[I_CTX], p.in[I_NORMG], MOD, 0, 1, RT, 0, H);
    xcd_barrier(xb);
    { EpiBf16Plain E; E.O = (u16*)(ws + E_P0); E.ld = P0_LD; E.ncols = P0_LD; run_gemm(shm, H, (const u16*)(ws + A_AB_IN), RT, 2816, 1024, E); }
    xcd_barrier(xb);
    for (int it = bid; it < 4 * 68 * 4 + 4 * 34 * 4; it += nb) {
        if (it < 4 * 68 * 4) { const int h = it & 3, bc = it >> 2; gla_a_item(shm, p, bc / 68, bc % 68, h); }
        else { const int j = it - 4 * 68 * 4; const int gi = j & 3, bc = j >> 2; gmlp_item(shm, p, bc / 34, bc % 34, gi); }
    }
    xcd_barrier(xb);
    gla_scan_phase(p);
    xcd_barrier(xb);
    for (int it = bid; it < 4 * 68 * 4; it += nb) { const int h = it & 3, bc = it >> 2; gla_c_item(shm, p, bc / 68, bc % 68, h); }
    xcd_barrier(xb);
    { EpiRes E; E.src_lat = p.in[I_X]; E.src_ctx = p.in[I_CTX]; E.dst_lat = p.out; E.dst_ctx = XC; E.gate = MOD + 2 * DM; E.cm = 0; E.part = (float*)(ws + E_PART);
      run_gemm_split(shm, H, (const u16*)(ws + A_AB_OUT), 1024, 1024, E); }
    xcd_barrier(xb);
    norm_mod_phase(p.out, p.in[I_CTX], p.in[I_NORMG] + DM, MOD, 3, 4, RT, 0, H, (const float*)(ws + E_PART), 4, MOD + 4 * (NMOD * DM) + 2 * DM, XC);
    xcd_barrier(xb);
    { EpiSwiglu E; E.O = (u16*)(ws + E_ACT); run_gemm(shm, H, (const u16*)(ws + A_FF_IN0), RT, 5632, 1024, E); }
    xcd_barrier(xb);
    { EpiRes E; E.src_lat = p.out; E.src_ctx = XC; E.dst_lat = p.out; E.dst_ctx = XC; E.gate = MOD + 5 * DM; E.cm = 0; E.part = (float*)(ws + E_PART);
      run_gemm_split(shm, (const u16*)(ws + E_ACT), (const u16*)(ws + A_FF_OUT0), 1024, 2816, E); }
    xcd_barrier(xb);
    norm_mod_phase(p.out, XC, p.in[I_NORMG] + 2 * DM, MOD1, 0, 1, RT, 1, H, (const float*)(ws + E_PART), 11, MOD + 4 * (NMOD * DM) + 5 * DM, XC);
    xcd_barrier(xb);
    { EpiSsdIn E; E.XBC = (u16*)(ws + E_XBC); E.HALO = (u16*)(ws + A_HALO); E.DTRAW = (float*)(ws + A_DTRAW); run_gemm(shm, H, (const u16*)(ws + B_SSD_INA), RT, 3328, 1024, E); }
    xcd_barrier(xb);
    dt_phase(shm, p);
    conv_phase(p);
    xcd_barrier(xb);
    for (int it = bid; it < 4 * 32 * 4; it += nb) ssd_par_item(shm, p, it);
    xcd_barrier(xb);
    {
        unsigned* cnt = (unsigned*)(ws + OFF_BAR) + XCD_BAR_WORDS;
        volatile int* s_item_p = (volatile int*)(shm + LDS_XB + 8);
        if (nb == 256) {
            if (threadIdx.x == 0) { int item = -1;
                for (int k = 0; k < 8 && item < 0; ++k) { const unsigned y = (xb.x + k) & 7u; const unsigned r = xb_add(&cnt[y * 16], 1u); if (r < 32u) item = (int)(y * 32u + r); }
                *s_item_p = item; }
            __syncthreads();
            const int item = *s_item_p;
            if (item >= 0) { const int grp = item >> 4, idx = item & 15; ssd_item(shm, p, grp >> 2, (grp & 3) * 8 + (idx >> 1), idx & 1); }
        } else {
            for (int it = bid; it < 4 * 32 * 2; it += nb) { const int grp = it >> 4, idx = it & 15; ssd_item(shm, p, grp >> 2, (grp & 3) * 8 + (idx >> 1), idx & 1); }
        }
    }
    xcd_barrier(xb);
    { EpiBf16Plain E; E.O = (u16*)(ws + E_Z); E.ld = 2048; E.ncols = 2048; run_gemm(shm, H, (const u16*)(ws + B_WZ), RL, 2048, 1024, E); }
    convert_weights_late(shm, p);
    xcd_barrier(xb);
    ssd_finish_phase(p);
    xcd_barrier(xb);
    { EpiRes E; E.src_lat = p.out; E.src_ctx = XC; E.dst_lat = p.out; E.dst_ctx = XC; E.gate = MOD1 + 2 * DM; E.cm = 1; E.part = nullptr;
      run_gemm(shm, (const u16*)(ws + E_Y), (const u16*)(ws + A_SSD_OUT), RL, 1024, 2048, E); }
    xcd_barrier(xb);
    norm_mod_phase(p.out, XC, p.in[I_NORMG] + 3 * DM, MOD1, 3, 4, RL, 0, H);
    xcd_barrier(xb);
    { EpiSwiglu E; E.O = (u16*)(ws + E_ACT); run_gemm(shm, H, (const u16*)(ws + A_FF_IN1), RL, 5632, 1024, E); }
    xcd_barrier(xb);
    { EpiRes E; E.src_lat = p.out; E.src_ctx = XC; E.dst_lat = p.out; E.dst_ctx = XC; E.gate = MOD1 + 5 * DM; E.cm = 0; E.part = nullptr;
      run_gemm(shm, (const u16*)(ws + E_ACT), (const u16*)(ws + A_FF_OUT1), RL, 1024, 2816, E); }
    xcd_barrier(xb);
    final_norm_phase(p.out, p.in[I_FNG]);
}

extern "C" void kernel_launch(void* const* d_in, const int* in_sizes, int n_in, void* d_out, int out_size, void* d_ws, size_t ws_size, hipStream_t stream) {
    static int grid_blocks = 0;
    if (!grid_blocks) {
        int dev = 0, cus = 0, per_cu = 0;
        (void)hipGetDevice(&dev);
        (void)hipDeviceGetAttribute(&cus, hipDeviceAttributeMultiprocessorCount, dev);
        (void)hipFuncSetAttribute((const void*)mega, hipFuncAttributeMaxDynamicSharedMemorySize, LDS_BYTES);
        (void)hipOccupancyMaxActiveBlocksPerMultiprocessor(&per_cu, (const void*)mega, 512, LDS_BYTES);
        if (per_cu < 1) { fprintf(stderr, "occupancy query says %d blocks/CU\n", per_cu); per_cu = 1; }
        if (per_cu > 1) per_cu = 1;
        grid_blocks = cus * per_cu;
        if (ws_size < WS_END) fprintf(stderr, "workspace too small: %zu < %zu\n", ws_size, (size_t)WS_END);
    }
    Params p{};
    for (int i = 0; i < 26; ++i) p.in[i] = (const float*)d_in[i];
    p.out = (float*)d_out; p.ws = (unsigned char*)d_ws;
    (void)hipMemsetAsync((unsigned char*)d_ws + OFF_BAR, 0, (XCD_BAR_WORDS + 128) * sizeof(unsigned), stream);
    void* args[] = {&p};
    hipError_t e = hipLaunchCooperativeKernel((const void*)mega, dim3(grid_blocks), dim3(512), args, LDS_BYTES, stream);
    if (e != hipSuccess) fprintf(stderr, "cooperative launch failed: %s (grid %d)\n", hipGetErrorString(e), grid_blocks);
}
```

```cpp
#include <hip/hip_runtime.h>
#include <hip/hip_cooperative_groups.h>
#include <cstdio>
namespace cg = cooperative_groups;
namespace pg8 {
#define PG8_LAS __attribute__((address_space(3)))
typedef unsigned short bf16_t;
typedef short bf16x8 __attribute__((ext_vector_type(8)));
typedef float f32x4 __attribute__((ext_vector_type(4)));
typedef unsigned u32x4 __attribute__((ext_vector_type(4)));
constexpr int BM = 256, BK = 64, HALF = 128, HTB = HALF * BK * 2  , STAGE_BYTES = 8 * HTB, NXCD = 8, WGM = 8;

__host__ __device__ __forceinline__ int lds_byte(int r, int c) { const int st = (r >> 4) * 2 + (c >> 5), rr = r & 15, cc = c & 31, ob = rr * 64 + cc * 2; return st * 1024 + (ob ^ (((ob >> 9) & 1) << 5)); }
__host__ __device__ __forceinline__ void stage_rc(int b, int& R, int& C) { const int st = b / 1024, sb = b % 1024, swz = sb ^ (((sb >> 9) & 1) << 5); R = (st >> 1) * 16 + swz / 64; C = (st & 1) * 32 + (swz % 64) / 2; }
__host__ __device__ __forceinline__ int perm32(int rho) { const int n = rho >> 4, i = rho & 15; return 8 * (i >> 2) + 4 * n + (i & 3); }

struct Unit { int pm, pn, kt0, nkt; };
struct Gemm { const bf16_t* A; const bf16_t* Bt; int M, N, K; };

struct StaticOrder {
    int nM, nN, nwg, G, c, nkt_all;
    __host__ __device__ void init(int M, int N, int G_, int c_, int K_ = 0) { nM = M / BM; nN = N / BM; nwg = nM * nN; G = G_; c = c_; nkt_all = K_ / BK; }
    __host__ __device__ bool next(int i, Unit& u) const {
        const long L = (long)i * G + c; if (L >= nwg) return false;
        int wgid = (int)L; { const int q = nwg / NXCD, r = nwg % NXCD, xcd = wgid % NXCD, off = wgid / NXCD; wgid = (xcd < r ? xcd * (q + 1) : r * (q + 1) + (xcd - r) * q) + off; }
        const int nig = WGM * nN, gid = wgid / nig, fm = gid * WGM, gsz = (nM - fm) < WGM ? (nM - fm) : WGM;
        u.pm = fm + ((wgid % nig) % gsz); u.pn = (wgid % nig) / gsz; u.kt0 = 0; u.nkt = nkt_all; return true;
    }
    __device__ __forceinline__ void a_ready(const Unit&) const {}
    __device__ __forceinline__ void done(const Unit&) const {}
};
__device__ __forceinline__ unsigned cvt_pk_bf16(float lo, float hi) { unsigned r; asm volatile("v_cvt_pk_bf16_f32 %0, %1, %2" : "=v"(r) : "v"(lo), "v"(hi)); return r; }
template <class Epi, class Sched, bool STAMP = false>
__device__ __forceinline__ void gemm_phase(PG8_LAS unsigned char* lds, const Gemm g, const Sched& S, const Epi& E, unsigned long long* stamps) {
    int tid_ = threadIdx.x; asm volatile("" : "+v"(tid_)); const int tid = tid_, wid = __builtin_amdgcn_readfirstlane(tid >> 6), lane = tid & 63, wr = wid >> 2, wc = wid & 3, fr = lane & 15, fq = lane >> 4;
    const int K = g.K;
    int ts_lo = 0, ts_hi = 0, nts = 0; const unsigned long long rt_entry = STAMP ? (unsigned long long)wall_clock64() : 0ull;
#define PG8_STAMP() do { if (STAMP && wid == 0 && nts < 64) { const unsigned long long _c = (unsigned long long)clock64(); \
        ts_lo = (lane == nts) ? (int)(unsigned)_c : ts_lo; ts_hi = (lane == nts) ? (int)(unsigned)(_c >> 32) : ts_hi; ++nts; } } while (0)
    PG8_STAMP();
    unsigned voffA[2], voffB[2];
#pragma unroll
    for (int i = 0; i < 2; ++i) { int R, C; stage_rc(tid * 16 + i * 8192, R, C); const int Rb = Epi::PERM ? ((R & ~31) + perm32(R & 31)) : R;
        voffA[i] = (unsigned)(R * K + C) * 2u; voffB[i] = (unsigned)(Rb * K + C) * 2u; }
    const size_t kstep = (size_t)(BK * 2);
    const size_t hstep = (size_t)HALF * K * 2;
    const size_t tstep = 2 * hstep;
    const unsigned ldsw = (unsigned)wid * 1024u;
    const int aoff = lds_byte(wr * 64 + fr, fq * 8), boff = lds_byte(wc * 32 + fr, fq * 8);
#define PG8_SA(b, h) (((b) * 2 + (h)) * HTB)
#define PG8_SB(b, h) ((4 + (b) * 2 + (h)) * HTB)
#define PG8_STAGE(bufoff, gbase, voff) do { _Pragma("unroll") for (int _i = 0; _i < 2; ++_i) \
        __builtin_amdgcn_global_load_lds((const unsigned*)((const char*)(gbase) + (voff)[_i]), (PG8_LAS unsigned*)(lds + (bufoff) + ldsw + _i * 8192), 16, 0, 0); } while (0)
#define PG8_LDA(dst, b, h) do { _Pragma("unroll") for (int m = 0; m < 4; ++m) _Pragma("unroll") for (int k = 0; k < 2; ++k) dst[m][k] = *(const PG8_LAS bf16x8*)(lds + PG8_SA(b, h) + aoff + m * 2048 + k * 1024); } while (0)
#define PG8_LDB(dst, b, h) do { _Pragma("unroll") for (int n = 0; n < 2; ++n) _Pragma("unroll") for (int k = 0; k < 2; ++k) dst[n][k] = *(const PG8_LAS bf16x8*)(lds + PG8_SB(b, h) + boff + n * 2048 + k * 1024); } while (0)
#define PG8_MMA(ai, bj, At, Bt) do { __builtin_amdgcn_s_setprio(1); _Pragma("unroll") for (int m = 0; m < 4; ++m) _Pragma("unroll") for (int n = 0; n < 2; ++n) _Pragma("unroll") for (int k = 0; k < 2; ++k) \
        acc[ai][bj][m][n] = __builtin_amdgcn_mfma_f32_16x16x32_bf16(Bt[n][k], At[m][k], acc[ai][bj][m][n], 0, 0, 0); __builtin_amdgcn_s_setprio(0); } while (0)
#define PG8_WAIT_V(n) asm volatile("s_waitcnt vmcnt(" #n ")" ::: "memory")
#define PG8_WAIT_L(n) asm volatile("s_waitcnt lgkmcnt(" #n ")" ::: "memory")
#define PG8_BAR __builtin_amdgcn_s_barrier()
#define PG8_SCHED __builtin_amdgcn_sched_barrier(0)
    Unit cur, nxt; int ui = 0;
    if (!S.next(0, cur)) return;
    f32x4 acc[2][2][4][2];
#pragma unroll
    for (int a = 0; a < 2; ++a)
#pragma unroll
        for (int b = 0; b < 2; ++b)
#pragma unroll
            for (int m = 0; m < 4; ++m)
#pragma unroll
                for (int n = 0; n < 2; ++n) acc[a][b][m][n] = (f32x4){0.f, 0.f, 0.f, 0.f};
    bf16x8 At[4][2], B0[2][2], B1[2][2];
    const char* cA = (const char*)g.A + (size_t)cur.pm * tstep + (size_t)cur.kt0 * kstep; const char* cB = (const char*)g.Bt + (size_t)cur.pn * tstep + (size_t)cur.kt0 * kstep;
    S.a_ready(cur);
    PG8_STAGE(PG8_SB(0, 0), cB, voffB); PG8_STAGE(PG8_SA(0, 0), cA, voffA); PG8_STAGE(PG8_SB(0, 1), cB + hstep, voffB); PG8_STAGE(PG8_SA(0, 1), cA + hstep, voffA);
    if (wr == 1) PG8_BAR;
    PG8_WAIT_V(4); PG8_BAR;
    PG8_STAGE(PG8_SB(1, 0), cB + kstep, voffB); PG8_STAGE(PG8_SA(1, 0), cA + kstep, voffA); PG8_STAGE(PG8_SB(1, 1), cB + hstep + kstep, voffB);
    PG8_WAIT_V(6); PG8_BAR;
    PG8_STAMP();
    for (;;) {
        const bool has_next = S.next(ui + 1, nxt);
        const char* nA = has_next ? (const char*)g.A + (size_t)nxt.pm * tstep + (size_t)nxt.kt0 * kstep : cA; const char* nB = has_next ? (const char*)g.Bt + (size_t)nxt.pn * tstep + (size_t)nxt.kt0 * kstep : cB;
        const int nt = cur.nkt;
        for (int t = 0; t < nt; t += 2) {
            const bool last = (t == nt - 2);
            const char* a1 = cA + (size_t)(t + 1) * kstep;
            const char* a2 = last ? nA : cA + (size_t)(t + 2) * kstep; const char* b2 = last ? nB : cB + (size_t)(t + 2) * kstep;
            const char* a3 = a2 + kstep; const char* b3 = b2 + kstep;
            if (last && has_next) S.a_ready(nxt);
            PG8_LDB(B0, 0, 0); PG8_SCHED; PG8_LDA(At, 0, 0); PG8_STAGE(PG8_SA(1, 1), a1 + hstep, voffA);
            PG8_WAIT_L(8); PG8_BAR; PG8_WAIT_L(0); PG8_MMA(0, 0, At, B0); PG8_BAR; PG8_SCHED;
            PG8_LDB(B1, 0, 1); PG8_STAGE(PG8_SB(0, 0), b2, voffB);
            PG8_BAR; PG8_WAIT_L(0); PG8_MMA(0, 1, At, B1); PG8_BAR;
            PG8_LDA(At, 0, 1); PG8_STAGE(PG8_SA(0, 0), a2, voffA);
            PG8_BAR; PG8_WAIT_L(0); PG8_MMA(1, 0, At, B0); PG8_BAR; PG8_SCHED;
            PG8_STAGE(PG8_SB(0, 1), b2 + hstep, voffB);
            PG8_WAIT_V(6); PG8_BAR; PG8_MMA(1, 1, At, B1); PG8_BAR;
            PG8_LDB(B0, 1, 0); PG8_SCHED; PG8_LDA(At, 1, 0); PG8_STAGE(PG8_SA(0, 1), a2 + hstep, voffA);
            PG8_WAIT_L(8); PG8_BAR; PG8_WAIT_L(0); PG8_MMA(0, 0, At, B0); PG8_BAR; PG8_SCHED;
            PG8_LDB(B1, 1, 1); PG8_STAGE(PG8_SB(1, 0), b3, voffB);
            PG8_BAR; PG8_WAIT_L(0); PG8_MMA(0, 1, At, B1); PG8_BAR;
            PG8_LDA(At, 1, 1); PG8_STAGE(PG8_SA(1, 0), a3, voffA);
            PG8_BAR; PG8_WAIT_L(0); PG8_MMA(1, 0, At, B0); PG8_BAR; PG8_SCHED;
            PG8_STAGE(PG8_SB(1, 1), b3 + hstep, voffB);
            PG8_WAIT_V(6); PG8_BAR; PG8_MMA(1, 1, At, B1); PG8_BAR;
        }
        PG8_STAMP();
        if constexpr (!Epi::AFTER_DRAIN) { E(acc, cur, wr, wc, fr, fq); S.done(cur); }
        PG8_STAMP();
        if (!has_next) break;
#pragma unroll
        for (int a = 0; a < 2; ++a)
#pragma unroll
            for (int b = 0; b < 2; ++b)
#pragma unroll
                for (int m = 0; m < 4; ++m)
#pragma unroll
                    for (int n = 0; n < 2; ++n) acc[a][b][m][n] = (f32x4){0.f, 0.f, 0.f, 0.f};
        cur = nxt; cA = nA; cB = nB; ++ui;
    }
    PG8_WAIT_V(0);
    if (wr == 0) PG8_BAR;
    PG8_BAR;
    if constexpr (Epi::AFTER_DRAIN) { E.fused(acc, cur, wr, wc, fr, fq, lds, wid, lane); S.done(cur); }
    PG8_STAMP();
    if (STAMP && wid == 0) { stamps[lane] = lane < nts ? (((unsigned long long)(unsigned)ts_hi << 32) | (unsigned)ts_lo) : 0ull;
        if (lane == 62) stamps[62] = rt_entry; if (lane == 63) stamps[63] = (unsigned long long)wall_clock64(); }
#undef PG8_STAMP
#undef PG8_SA
#undef PG8_SB
#undef PG8_STAGE
#undef PG8_LDA
#undef PG8_LDB
#undef PG8_MMA
#undef PG8_WAIT_V
#undef PG8_WAIT_L
#undef PG8_BAR
#undef PG8_SCHED
}
}

#define XB_TMO      128
#define XB_XCNT(j)  (256  + 64 * (j))
#define XB_XSUB(j)  (1280 + 64 * (j))
#define XB_XGEN(j)  (2304 + 64 * (j))
#define XB_TOP      3328
#define XB_TOPGEN   3392
#define XCD_BAR_WORDS 3456
#define XB_SPIN_CAP (1u << 18)
#define LAS __attribute__((address_space(3)))

__device__ __forceinline__ unsigned xb_ld(unsigned* p)              { return __hip_atomic_load(p, __ATOMIC_RELAXED, __HIP_MEMORY_SCOPE_AGENT); }
__device__ __forceinline__ unsigned xb_add(unsigned* p, unsigned v) { return __hip_atomic_fetch_add(p, v, __ATOMIC_RELAXED, __HIP_MEMORY_SCOPE_AGENT); }
__device__ __forceinline__ unsigned xb_xcc_id() { return (unsigned)__builtin_amdgcn_s_getreg((3 << 11) | 20) & 0xFu; }
#define XB_SPIN(cond, bar) do { unsigned _sp = 0; while (cond) { __builtin_amdgcn_s_sleep(1); \
    if ((++_sp & 255u) == 0u) { if (xb_ld(&(bar)[XB_TMO])) break; if (_sp > XB_SPIN_CAP) { atomicAdd(&(bar)[XB_TMO], 1u); break; } } } } while (0)

struct XcdBarrier {
    unsigned* bar; unsigned x;
    volatile LAS unsigned* st;
};

__device__ __forceinline__ XcdBarrier xcd_barrier_post(unsigned* bar, volatile LAS unsigned* st) {
    XcdBarrier b; b.bar = bar; b.x = xb_xcc_id(); b.st = st;
    if (threadIdx.x == 0) (void)xb_add(&bar[XB_XCNT(b.x)], 1u);
    return b;
}
__device__ __forceinline__ void xcd_barrier_complete(unsigned* bar, unsigned x, unsigned& nloc, unsigned& nx) {
    const unsigned G = gridDim.x * gridDim.y * gridDim.z;
    unsigned sum, cnt, mine, sp = 0u;
    for (;;) {
        sum = 0u; cnt = 0u; mine = 0u;
#pragma unroll
        for (unsigned j = 0; j < 16; ++j) { const unsigned c = xb_ld(&bar[XB_XCNT(j)]); sum += c; cnt += (c > 0u) ? 1u : 0u; mine = (j == x) ? c : mine; }
        if (sum == G) break;
        __builtin_amdgcn_s_sleep(1);
        if ((++sp & 255u) == 0u) { if (xb_ld(&bar[XB_TMO])) break; if (sp > XB_SPIN_CAP) { atomicAdd(&bar[XB_TMO], 1u); break; } }
    }
    nloc = mine > 0u ? mine : 1u; nx = cnt > 0u ? cnt : 1u;
}

__device__ __attribute__((noinline)) void xcd_barrier_impl(unsigned* bar_, unsigned x_, volatile LAS unsigned* st_) {
    XcdBarrier b; b.bar = bar_; b.x = x_; b.st = st_;
    asm volatile("s_waitcnt vmcnt(0)" ::: "memory");
    __syncthreads();
    if (threadIdx.x == 0) {
        unsigned* bar = b.bar;
        __builtin_amdgcn_s_waitcnt(0);
        unsigned nloc = b.st[0], nx = b.st[1];
        if (nloc == 0u) { xcd_barrier_complete(bar, b.x, nloc, nx); b.st[0] = nloc; b.st[1] = nx; }
        const unsigned old = xb_add(&bar[XB_XSUB(b.x)], 1u);
        const unsigned gen = old / nloc;
        if (old + 1u == (gen + 1u) * nloc) {
            __builtin_amdgcn_fence(__ATOMIC_RELEASE, "agent");
            asm volatile("s_waitcnt vmcnt(0)" ::: "memory");
            const unsigned og = xb_add(&bar[XB_TOP], 1u);
            const unsigned tg = og / nx;
            if (og + 1u == (tg + 1u) * nx) xb_add(&bar[XB_TOPGEN], 1u);
            else XB_SPIN(xb_ld(&bar[XB_TOPGEN]) == tg, bar);
            __builtin_amdgcn_fence(__ATOMIC_ACQUIRE, "agent");
            xb_add(&bar[XB_XGEN(b.x)], 1u);
            asm volatile("s_waitcnt vmcnt(0)" ::: "memory");
        } else {
            XB_SPIN(xb_ld(&bar[XB_XGEN(b.x)]) == gen, bar);
            __builtin_amdgcn_fence(__ATOMIC_ACQUIRE, "agent");
            asm volatile("s_waitcnt vmcnt(0)" ::: "memory");
        }
    }
    __syncthreads();
}

__device__ __forceinline__ void xcd_barrier(const XcdBarrier& b) { xcd_barrier_impl(b.bar, b.x, b.st); }

typedef unsigned short u16;
using pg8::bf16x8; using pg8::f32x4;
typedef unsigned u32x2 __attribute__((ext_vector_type(2)));
typedef unsigned u32x4v __attribute__((ext_vector_type(4)));

constexpr int DM = 1024, NB = 4, SEQ = 4096, CTXL = 256, RL = NB * SEQ, RC = NB * CTXL, RT = RL + RC;
constexpr int DFF = 2816, NMOD = 6;
constexpr int P0_LD = 2592;
constexpr int P0_K = 0, P0_V = 256, P0_LR = 768, P0_Q = 800, P0_R = 1056, P0_U = 1568, P0_G = 2080;
constexpr int XBC_LD = 3072;
constexpr float EPS = 1e-6f;

constexpr size_t OFF_MOD = 0;
constexpr size_t OFF_A = 262144;
constexpr size_t A_AB_IN = OFF_A, A_AB_OUT = A_AB_IN + (size_t)2816 * 1024 * 2, A_FF_IN0 = A_AB_OUT + (size_t)1024 * 1024 * 2, A_FF_OUT0 = A_FF_IN0 + (size_t)5632 * 1024 * 2;
constexpr size_t A_END = A_FF_OUT0 + (size_t)1024 * 2816 * 2;
constexpr size_t A_DTRAW = OFF_A, A_HALO = A_DTRAW + (size_t)RT * 64 * 4;
constexpr size_t A_SSD_OUT = OFF_A, A_FF_IN1 = A_SSD_OUT + (size_t)1024 * 2048 * 2, A_FF_OUT1 = A_FF_IN1 + (size_t)5632 * 1024 * 2;
constexpr size_t OFF_B = A_END;
constexpr size_t B_SSD_INA = OFF_B, B_WZ = B_SSD_INA + (size_t)3328 * 1024 * 2, B_END = B_WZ + (size_t)2048 * 1024 * 2;
constexpr size_t OFF_XC = B_END;
constexpr size_t OFF_H = OFF_XC + (size_t)RC * DM * 4;
constexpr size_t OFF_DSC = OFF_H + (size_t)RT * DM * 2;
constexpr size_t OFF_DEC = OFF_DSC + (size_t)4 * 2 * 4 * 4 * 8192 * 4;
constexpr size_t OFF_E = OFF_DEC + (size_t)4 * 2 * 4 * 68 * 64 * 4;
constexpr size_t E_P0 = OFF_E, E_ACT = OFF_E, E_XBC = OFF_E, E_Z = OFF_E;
constexpr size_t E_Y = OFF_E + (size_t)RT * XBC_LD * 2;
constexpr size_t T_DT = E_Y + (size_t)RL * 2048 * 2, T_ACUM = T_DT + (size_t)RT * 64 * 4;
constexpr size_t WS_END = T_ACUM + (size_t)RT * 64 * 4;
constexpr size_t E_PART = OFF_E + (size_t)100 * 1024 * 1024;
constexpr size_t A_CB = OFF_A;
static_assert(A_HALO + (size_t)272 * 4 * 3072 * 2 <= A_END && A_FF_OUT1 + (size_t)1024 * 2816 * 2 <= A_END && A_CB + (size_t)512 * 16384 * 2 <= A_END, "region A overflow");
static_assert(WS_END <= (size_t)256 * 1024 * 1024, "workspace over 256 MiB");

constexpr int LDS_BYTES = 144 * 1024;
constexpr int LDS_XB = LDS_BYTES - 16;
constexpr size_t OFF_BAR = 245760;

struct Params { const float* in[26]; float* out; unsigned char* ws; };
enum { I_X = 0, I_C, I_CTX, I_CCTX, I_MODW, I_MODB, I_NORMG, I_FFWIN, I_FFWOUT, I_ABWIN, I_ABGW, I_ABGB, I_ABGNG, I_ABVNG, I_ABSW, I_ABSB, I_ABWOUT,
       I_SSDWIN, I_SSDCW, I_SSDCB, I_SSDDTB, I_SSDALOG, I_SSDD, I_SSDNG, I_SSDWOUT, I_FNG };

__device__ __forceinline__ u16 f2bf(float f) { return __builtin_bit_cast(u16, (__bf16)f); }
__device__ __forceinline__ float bf2f(unsigned b) { return __uint_as_float(b << 16); }
typedef float f32x2v __attribute__((ext_vector_type(2)));
typedef __bf16 bf16x2v __attribute__((ext_vector_type(2)));
__device__ __forceinline__ unsigned pk2(float lo, float hi) { const f32x2v v = {lo, hi}; return __builtin_bit_cast(unsigned, __builtin_convertvector(v, bf16x2v)); }
__device__ __forceinline__ float bflo(unsigned w) { return __uint_as_float(w << 16); }
__device__ __forceinline__ float bfhi(unsigned w) { return __uint_as_float(w & 0xFFFF0000u); }
__device__ __forceinline__ float siluf(float x) { return x * __builtin_amdgcn_rcpf(1.0f + __expf(-x)); }
__device__ __forceinline__ float geluf(float x) { const float y = 0.7978845608028654f * (x + 0.044715f * x * x * x); const float th = 1.0f - 2.0f * __builtin_amdgcn_rcpf(1.0f + __expf(2.0f * y)); return 0.5f * x * (1.0f + th); }
__device__ __forceinline__ float softplusf(float x) { return fmaxf(x, 0.f) + log1pf(__expf(-fabsf(x))); }
__device__ __forceinline__ float logsigmoidf(float x) { return fminf(x, 0.f) - __logf(1.0f + __expf(-fabsf(x))); }
__device__ __forceinline__ float wave_sum(float v) {
#pragma unroll
    for (int o = 32; o > 0; o >>= 1) v += __shfl_xor(v, o, 64);
    return v;
}

template <int MT, int NT>
__device__ __forceinline__ void wave_mma(f32x4 (&acc)[MT][NT], const u16* A, int lda, const u16* B, int ldb, int ksteps) {
    const int lane = threadIdx.x & 63, fr = lane & 15, fq = lane >> 4;
    const u16* ap = A + fr * lda + fq * 8; const u16* bp = B + fr * ldb + fq * 8;
    for (int k = 0; k < ksteps; ++k) {
        bf16x8 a[MT], b[NT];
#pragma unroll
        for (int i = 0; i < MT; ++i) a[i] = *(const bf16x8*)(ap + i * 16 * lda + k * 32);
#pragma unroll
        for (int i = 0; i < NT; ++i) b[i] = *(const bf16x8*)(bp + i * 16 * ldb + k * 32);
#pragma unroll
        for (int i = 0; i < MT; ++i)
#pragma unroll
            for (int j = 0; j < NT; ++j) acc[i][j] = __builtin_amdgcn_mfma_f32_16x16x32_bf16(a[i], b[j], acc[i][j], 0, 0, 0);
    }
}
template <int MT, int NT> __device__ __forceinline__ void zero_acc(f32x4 (&acc)[MT][NT]) {
#pragma unroll
    for (int i = 0; i < MT; ++i)
#pragma unroll
        for (int j = 0; j < NT; ++j) acc[i][j] = (f32x4){0.f, 0.f, 0.f, 0.f};
}

__device__ __forceinline__ u32x4v pack8(const f32x4& a, const f32x4& b) { u32x4v r; r[0] = pk2(a[0], a[1]); r[1] = pk2(a[2], a[3]); r[2] = pk2(b[0], b[1]); r[3] = pk2(b[2], b[3]); return r; }

struct EpiBf16Plain {
    static constexpr bool PERM = true, AFTER_DRAIN = false;
    u16* O; int ld; int ncols;
    __device__ __forceinline__ void operator()(const f32x4 (&acc)[2][2][4][2], const pg8::Unit& u, int wr, int wc, int fr, int fq) const {
        const int row0 = u.pm * 256 + wr * 64 + fr, col0 = u.pn * 256 + wc * 32 + 8 * fq;
#pragma unroll
        for (int ai = 0; ai < 2; ++ai)
#pragma unroll
            for (int m = 0; m < 4; ++m) { const int row = row0 + ai * 128 + m * 16;
#pragma unroll
                for (int bj = 0; bj < 2; ++bj) { const int c = col0 + bj * 128; if (c < ncols) *(u32x4v*)(O + (size_t)row * ld + c) = pack8(acc[ai][bj][m][0], acc[ai][bj][m][1]); } }
    }
};
struct EpiSwiglu {
    static constexpr bool PERM = true, AFTER_DRAIN = false;
    u16* O;
    __device__ __forceinline__ void operator()(const f32x4 (&acc)[2][2][4][2], const pg8::Unit& u, int wr, int wc, int fr, int fq) const {
        const int row0 = u.pm * 256 + wr * 64 + fr, j0 = u.pn * 128 + wc * 32 + 8 * fq;
#pragma unroll
        for (int ai = 0; ai < 2; ++ai)
#pragma unroll
            for (int m = 0; m < 4; ++m) { const int row = row0 + ai * 128 + m * 16; f32x4 o0, o1;
#pragma unroll
                for (int i = 0; i < 4; ++i) { o0[i] = siluf(acc[ai][0][m][0][i]) * acc[ai][1][m][0][i]; o1[i] = siluf(acc[ai][0][m][1][i]) * acc[ai][1][m][1][i]; }
                *(u32x4v*)(O + (size_t)row * DFF + j0) = pack8(o0, o1); }
    }
};
struct EpiSsdIn {
    static constexpr bool PERM = true, AFTER_DRAIN = false;
    u16* XBC; u16* HALO; float* DTRAW;
    __device__ __forceinline__ void operator()(const f32x4 (&acc)[2][2][4][2], const pg8::Unit& u, int wr, int wc, int fr, int fq) const {
        const int row0 = u.pm * 256 + wr * 64 + fr, col0 = u.pn * 256 + wc * 32 + 8 * fq;
#pragma unroll
        for (int ai = 0; ai < 2; ++ai)
#pragma unroll
            for (int m = 0; m < 4; ++m) { const int row = row0 + ai * 128 + m * 16; const int rr = row & 63; const int slot = rr < 2 ? rr : (rr >= 62 ? rr - 60 : -1);
#pragma unroll
                for (int bj = 0; bj < 2; ++bj) { const int c = col0 + bj * 128;
                    if (c < 3072) { const u32x4v v = pack8(acc[ai][bj][m][0], acc[ai][bj][m][1]); *(u32x4v*)(XBC + (size_t)row * XBC_LD + c) = v;
                        if (slot >= 0) *(u32x4v*)(HALO + ((size_t)(row >> 6) * 4 + slot) * XBC_LD + c) = v; }
                    else if (c < 3136) { float* d = DTRAW + (size_t)row * 64 + (c - 3072); *(f32x4*)d = acc[ai][bj][m][0]; *(f32x4*)(d + 4) = acc[ai][bj][m][1]; } } }
    }
};
struct EpiRes {
    static constexpr bool PERM = false, AFTER_DRAIN = false;
    const float* src_lat; const float* src_ctx; float* dst_lat; float* dst_ctx; const float* gate; int cm; float* part;
    __device__ __forceinline__ void operator()(const f32x4 (&acc)[2][2][4][2], const pg8::Unit& u, int wr, int wc, int fr, int fq) const {
        const int row0 = u.pm * 256 + wr * 64 + fr, col0 = u.pn * 256 + wc * 32 + 4 * fq;
#pragma unroll
        for (int ai = 0; ai < 2; ++ai)
#pragma unroll
            for (int m = 0; m < 4; ++m) { const int row = row0 + ai * 128 + m * 16; const float* s; float* d; int mi;
                if (row < RL) { const int xr = cm ? ((row & ~4095) | ((row & 63) << 6) | ((row >> 6) & 63)) : row; s = src_lat + (size_t)xr * DM; d = dst_lat + (size_t)xr * DM; mi = row >> 12; }
                else { s = src_ctx + (size_t)(row - RL) * DM; d = dst_ctx + (size_t)(row - RL) * DM; mi = 4; }
                const float* gt = gate + mi * (NMOD * DM);
                if (part != nullptr && row >= RL) { float* pd = part + ((size_t)(u.kt0 >> 2) * RC + (row - RL)) * DM;
#pragma unroll
                    for (int bj = 0; bj < 2; ++bj)
#pragma unroll
                        for (int n = 0; n < 2; ++n) { const int c = col0 + bj * 128 + n * 16; *(f32x4*)(pd + c) = acc[ai][bj][m][n]; }
                    continue; }
#pragma unroll
                for (int bj = 0; bj < 2; ++bj)
#pragma unroll
                    for (int n = 0; n < 2; ++n) { const int c = col0 + bj * 128 + n * 16; const f32x4 g4 = *(const f32x4*)(gt + c), x4 = *(const f32x4*)(s + c);
                        *(f32x4*)(d + c) = x4 + g4 * acc[ai][bj][m][n]; } }
    }
};

template <class Epi> __device__ __forceinline__ void run_gemm(unsigned char* shm, const u16* A, const u16* Bt, int M, int N, int K, const Epi& E) {
    pg8::Gemm g; g.A = A; g.Bt = Bt; g.M = M; g.N = N; g.K = K;
    pg8::StaticOrder S; S.init(M, N, (int)gridDim.x, (int)blockIdx.x, K);
    pg8::gemm_phase<Epi, pg8::StaticOrder, false>((PG8_LAS unsigned char*)shm, g, S, E, nullptr);
}

struct SplitOrder {
    pg8::StaticOrder lat; int nlat, nsl, nctx, G, c, nN;
    __device__ void init(int N, int K, int G_, int c_) { lat.init(RL, N, G_, c_, K); nlat = lat.nwg; nN = N / 256; nsl = (K / 64) / 4; nctx = (RC / 256) * nN * nsl; G = G_; c = c_; }
    __device__ bool next(int i, pg8::Unit& u) const {
        const long L = (long)i * G + c; if (L < nlat) return lat.next(i, u);
        const int j = (int)(L - nlat); if (j >= nctx) return false;
        const int sl = j % nsl, tile = j / nsl; u.pm = RL / 256 + tile / nN; u.pn = tile % nN; u.kt0 = sl * 4; u.nkt = 4; return true; }
    __device__ __forceinline__ void a_ready(const pg8::Unit&) const {}
    __device__ __forceinline__ void done(const pg8::Unit&) const {}
};
template <class Epi> __device__ __forceinline__ void run_gemm_split(unsigned char* shm, const u16* A, const u16* Bt, int N, int K, const Epi& E) {
    pg8::Gemm g; g.A = A; g.Bt = Bt; g.M = RT; g.N = N; g.K = K;
    SplitOrder S; S.init(N, K, (int)gridDim.x, (int)blockIdx.x);
    pg8::gemm_phase<Epi, SplitOrder, false>((PG8_LAS unsigned char*)shm, g, S, E, nullptr);
}

__device__ __forceinline__ int wcol(int r, int N, int mode) {
    if (mode == 0) return r < N ? r : -1;
    if (mode == 1) { const int q = r >> 8, s = (r >> 7) & 1, i = r & 127; return s * DFF + 128 * q + i; }
    if (mode == 2) return r + 3136;
    return r < 3136 ? r : -1;
}
__device__ __forceinline__ void convert_tile(unsigned char* shm, const float* src, u16* dst, int K, int N, int mode, int ti) {
    u16* tile = (u16*)shm;
    const int t = threadIdx.x, rl = t & 63, k0 = t >> 6, r2 = t >> 3, kk = (t & 7) * 8;
    const int nkt = K >> 7, rb = (ti / nkt) << 6, kb = (ti % nkt) << 7;
    const int col = wcol(rb + rl, N, mode);
    const float* sp = src + (size_t)(kb + k0) * N + (col >= 0 ? col : 0);
    float v[16];
#pragma unroll
    for (int i = 0; i < 16; ++i) v[i] = sp[(size_t)(8 * i) * N];
#pragma unroll
    for (int i = 0; i < 16; ++i) tile[rl * 136 + k0 + 8 * i] = f2bf(col >= 0 ? v[i] : 0.f);
    __syncthreads();
    *(u32x4v*)(dst + (size_t)(rb + r2) * K + kb + kk) = *(const u32x4v*)(tile + r2 * 136 + kk);
    *(u32x4v*)(dst + (size_t)(rb + r2) * K + kb + 64 + kk) = *(const u32x4v*)(tile + r2 * 136 + 64 + kk);
    __syncthreads();
}
constexpr int wtiles(int NR, int K) { return (NR / 64) * (K / 128); }
__device__ void convert_weights_early(unsigned char* shm, const Params& p) {
    unsigned char* ws = p.ws;
    constexpr int T0 = wtiles(5632, 1024), T1 = wtiles(1024, 2816), T2 = wtiles(3328, 1024), T3 = wtiles(2816, 1024), T4 = wtiles(2048, 1024), T5 = wtiles(1024, 1024);
    for (int gi = blockIdx.x; gi < T0 + T1 + T2 + T3 + T4 + T5; gi += gridDim.x) {
        int ti = gi;
        if (ti < T0) { convert_tile(shm, p.in[I_FFWIN], (u16*)(ws + A_FF_IN0), 1024, 5632, 1, ti); continue; } ti -= T0;
        if (ti < T1) { convert_tile(shm, p.in[I_FFWOUT], (u16*)(ws + A_FF_OUT0), 2816, 1024, 0, ti); continue; } ti -= T1;
        if (ti < T2) { convert_tile(shm, p.in[I_SSDWIN], (u16*)(ws + B_SSD_INA), 1024, 5184, 3, ti); continue; } ti -= T2;
        if (ti < T3) { convert_tile(shm, p.in[I_ABWIN], (u16*)(ws + A_AB_IN), 1024, 2592, 0, ti); continue; } ti -= T3;
        if (ti < T4) { convert_tile(shm, p.in[I_SSDWIN], (u16*)(ws + B_WZ), 1024, 5184, 2, ti); continue; } ti -= T4;
        convert_tile(shm, p.in[I_ABWOUT], (u16*)(ws + A_AB_OUT), 1024, 1024, 0, ti);
    }
}
__device__ void convert_weights_late(unsigned char* shm, const Params& p) {
    unsigned char* ws = p.ws;
    constexpr int T0 = wtiles(5632, 1024), T1 = wtiles(1024, 2816), T2 = wtiles(1024, 2048);
    for (int gi = blockIdx.x; gi < T0 + T1 + T2; gi += gridDim.x) {
        int ti = gi;
        if (ti < T0) { convert_tile(shm, p.in[I_FFWIN] + (size_t)1024 * 5632, (u16*)(ws + A_FF_IN1), 1024, 5632, 1, ti); continue; } ti -= T0;
        if (ti < T1) { convert_tile(shm, p.in[I_FFWOUT] + (size_t)2816 * 1024, (u16*)(ws + A_FF_OUT1), 2816, 1024, 0, ti); continue; } ti -= T1;
        convert_tile(shm, p.in[I_SSDWOUT], (u16*)(ws + A_SSD_OUT), 2048, 1024, 0, ti);
    }
}
__device__ void mod_gemv(unsigned char* shm, const Params& p) {
    float* sc = (float*)shm;
    float* red = sc + 5 * 1024;
    const int t = threadIdx.x;
    for (int i = t; i < 5 * 1024; i += 512) { const float v = i < 4096 ? p.in[I_C][i] : p.in[I_CCTX][i - 4096]; sc[i] = siluf(v); }
    __syncthreads();
    float* MOD = (float*)(p.ws + OFF_MOD);
    const int n = t & 31, kc = t >> 5;
    for (int job = blockIdx.x; job < 2 * 192; job += gridDim.x) {
        const int l = job / 192, nb = (job % 192) * 32;
        const float* W = p.in[I_MODW] + (size_t)l * DM * (NMOD * DM) + nb + n;
        float a[5] = {0.f, 0.f, 0.f, 0.f, 0.f};
#pragma unroll 16
        for (int i = 0; i < 64; ++i) { const int k = kc + 16 * i; const float w = W[(size_t)k * (NMOD * DM)];
#pragma unroll
            for (int m = 0; m < 5; ++m) a[m] += sc[m * 1024 + k] * w; }
#pragma unroll
        for (int m = 0; m < 5; ++m) red[(kc * 5 + m) * 32 + n] = a[m];
        __syncthreads();
        if (t < 160) { const int m = t >> 5; float s = 0.f;
#pragma unroll
            for (int q = 0; q < 16; ++q) s += red[(q * 5 + m) * 32 + n];
            MOD[((size_t)l * 5 + m) * (NMOD * DM) + nb + n] = s + p.in[I_MODB][(size_t)l * (NMOD * DM) + nb + n]; }
        __syncthreads();
    }
}

__device__ void norm_mod_phase(const float* lat, const float* ctx, const float* ng, const float* modl  , int ishift, int iscale, int nrows, int cm, u16* H, const float* part = nullptr, int nsl = 0, const float* pgate = nullptr, float* xc_out = nullptr) {
    const int lane = threadIdx.x & 63, wid = threadIdx.x >> 6;
    for (int row = blockIdx.x * 8 + wid; row < nrows; row += gridDim.x * 8) {
        const float* s = row < RL ? lat + (size_t)row * DM : ctx + (size_t)(row - RL) * DM;
        const int mi = row < RL ? (row >> 12) : 4;
        f32x4 v[4], pg[4], psh[4], psc[4]; float ss = 0.f;
        const float* sh = modl + mi * (NMOD * DM) + ishift * DM; const float* scp = modl + mi * (NMOD * DM) + iscale * DM;
#pragma unroll
        for (int i = 0; i < 4; ++i) v[i] = *(const f32x4*)(s + i * 256 + lane * 4);
#pragma unroll
        for (int i = 0; i < 4; ++i) { const int c = i * 256 + lane * 4; pg[i] = *(const f32x4*)(ng + c); psh[i] = *(const f32x4*)(sh + c); psc[i] = *(const f32x4*)(scp + c); }
#pragma unroll
        for (int i = 0; i < 4; ++i) ss += v[i][0] * v[i][0] + v[i][1] * v[i][1] + v[i][2] * v[i][2] + v[i][3] * v[i][3];
        if (part != nullptr && row >= RL) {
            ss = 0.f;
#pragma unroll
            for (int i = 0; i < 4; ++i) { const int c = i * 256 + lane * 4; f32x4 a = {0.f, 0.f, 0.f, 0.f};
                for (int sl = 0; sl < nsl; ++sl) a += *(const f32x4*)(part + ((size_t)sl * RC + (row - RL)) * DM + c);
                v[i] += *(const f32x4*)(pgate + c) * a; *(f32x4*)(xc_out + (size_t)(row - RL) * DM + c) = v[i];
                ss += v[i][0] * v[i][0] + v[i][1] * v[i][1] + v[i][2] * v[i][2] + v[i][3] * v[i][3]; } }
        ss = wave_sum(ss);
        const float rs = rsqrtf(ss * (1.0f / DM) + EPS);
        const int dr = (cm && row < RL) ? ((row & ~4095) | ((row & 63) << 6) | ((row >> 6) & 63)) : row;
#pragma unroll
        for (int i = 0; i < 4; ++i) { const int c = i * 256 + lane * 4; const f32x4 g4 = pg[i], sh4 = psh[i], sc4 = psc[i];
            float o[4];
#pragma unroll
            for (int e = 0; e < 4; ++e) o[e] = (v[i][e] * rs * g4[e]) * (1.0f + sc4[e]) + sh4[e];
            u32x2 w; w[0] = pk2(o[0], o[1]); w[1] = pk2(o[2], o[3]); *(u32x2*)(H + (size_t)dr * DM + c) = w; }
    }
}
__device__ void final_norm_phase(float* X, const float* g) {
    const int lane = threadIdx.x & 63, wid = threadIdx.x >> 6;
    for (int row = blockIdx.x * 8 + wid; row < RL; row += gridDim.x * 8) {
        float* s = X + (size_t)row * DM; f32x4 v[4]; float ss = 0.f;
#pragma unroll
        for (int i = 0; i < 4; ++i) { v[i] = *(const f32x4*)(s + i * 256 + lane * 4); ss += v[i][0] * v[i][0] + v[i][1] * v[i][1] + v[i][2] * v[i][2] + v[i][3] * v[i][3]; }
        ss = wave_sum(ss);
        const float rs = rsqrtf(ss * (1.0f / DM) + EPS);
#pragma unroll
        for (int i = 0; i < 4; ++i) { const int c = i * 256 + lane * 4; const f32x4 g4 = *(const f32x4*)(g + c); f32x4 o;
#pragma unroll
            for (int e = 0; e < 4; ++e) o[e] = (v[i][e] * rs) * g4[e];
            *(f32x4*)(s + c) = o; }
    }
}

__device__ __forceinline__ int gla_rowbase(int b, int c) { return c < 4 ? RL + b * CTXL + c * 64 : b * SEQ + (c - 4) * 64; }
__device__ __forceinline__ float* gla_ds_ptr(const Params& p, int b, int d, int h, int c) {
    return c < 4 ? (float*)(p.ws + OFF_DSC) + ((size_t)((b * 2 + d) * 4 + h) * 4 + c) * 8192 : p.out + ((size_t)((b * 2 + d) * 4 + h) * 64 + (c - 4)) * 8192;
}
constexpr int GL_BC = 0;
constexpr int GL_LR = GL_BC + 2 * 64 * 65 * 4;
constexpr int GL_GW = GL_LR + 64 * 32 * 4;
constexpr int GL_X0 = GL_GW + 2 * 16 * 64 * 4;
constexpr int GL_LD = 72;

struct GlaGw { float gw[16]; float gb; int h; };
__device__ __forceinline__ void gla_gates(unsigned char* shm, const Params& p, int rowbase, int h, GlaGw& G) {
    const u16* P0 = (const u16*)(p.ws + E_P0);
    float* BC = (float*)(shm + GL_BC); float* LR = (float*)(shm + GL_LR); float* QS = (float*)(shm + GL_GW);
    const int t = threadIdx.x;
    const int kk = t & 63, lq = (t >> 6) & 3, d = t >> 8;
    if (G.h != h) { G.h = h;
#pragma unroll
        for (int j = 0; j < 16; ++j) G.gw[j] = p.in[I_ABGW][(size_t)(d * 16 + j) * 256 + h * 64 + kk];
        G.gb = p.in[I_ABGB][d * 256 + h * 64 + kk]; }
    float gw[16];
#pragma unroll
    for (int j = 0; j < 16; ++j) gw[j] = G.gw[j];
    const float gb = G.gb;
    if (t < 256) { const int row = t >> 2, part = t & 3; const u32x4v w = *(const u32x4v*)(P0 + (size_t)(rowbase + row) * P0_LD + P0_LR + part * 8);
        f32x4 lo, hi; lo[0] = bflo(w[0]); lo[1] = bfhi(w[0]); lo[2] = bflo(w[1]); lo[3] = bfhi(w[1]); hi[0] = bflo(w[2]); hi[1] = bfhi(w[2]); hi[2] = bflo(w[3]); hi[3] = bfhi(w[3]);
        *(f32x4*)(LR + row * 32 + part * 8) = lo; *(f32x4*)(LR + row * 32 + part * 8 + 4) = hi; }
    __syncthreads();
    float la[16];
#pragma unroll
    for (int i = 0; i < 16; ++i) { const int l = lq * 16 + i; const float* lr = LR + l * 32 + d * 16; float pre = gb;
#pragma unroll
        for (int j4 = 0; j4 < 4; ++j4) { const f32x4 v = *(const f32x4*)(lr + j4 * 4); pre += v[0] * gw[j4 * 4] + v[1] * gw[j4 * 4 + 1] + v[2] * gw[j4 * 4 + 2] + v[3] * gw[j4 * 4 + 3]; }
        la[i] = logsigmoidf(pre) * (1.0f / 16.0f); }
    if (d == 0) {
#pragma unroll
        for (int i = 1; i < 16; ++i) la[i] += la[i - 1];
        QS[(d * 4 + lq) * 64 + kk] = la[15];
    } else {
#pragma unroll
        for (int i = 14; i >= 0; --i) la[i] += la[i + 1];
        QS[(d * 4 + lq) * 64 + kk] = la[0];
    }
    __syncthreads();
    float off = 0.f;
    if (d == 0) { for (int q = 0; q < lq; ++q) off += QS[(0 * 4 + q) * 64 + kk]; }
    else { for (int q = 3; q > lq; --q) off += QS[(1 * 4 + q) * 64 + kk]; }
#pragma unroll
    for (int i = 0; i < 16; ++i) BC[(d * 64 + lq * 16 + i) * 65 + kk] = la[i] + off;
    __syncthreads();
}
__device__ __forceinline__ void gla_load_v(u32x4v& w0, u32x4v& w1, const u16* P0, int rowbase, int h) {
    const int t = threadIdx.x, l = t & 63, vg = t >> 6;
    const u16* src = P0 + (size_t)(rowbase + l) * P0_LD + P0_V + h * 128 + vg * 16;
    w0 = *(const u32x4v*)src; w1 = *(const u32x4v*)(src + 8);
}
__device__ __forceinline__ void gla_stage_vT(u16* vT, const u32x4v& w0, const u32x4v& w1) {
    const int t = threadIdx.x, l = t & 63, vg = t >> 6;
#pragma unroll
    for (int e = 0; e < 4; ++e) { vT[(vg * 16 + 2 * e) * GL_LD + l] = (u16)(w0[e] & 0xFFFF); vT[(vg * 16 + 2 * e + 1) * GL_LD + l] = (u16)(w0[e] >> 16);
        vT[(vg * 16 + 8 + 2 * e) * GL_LD + l] = (u16)(w1[e] & 0xFFFF); vT[(vg * 16 + 8 + 2 * e + 1) * GL_LD + l] = (u16)(w1[e] >> 16); }
}

__device__ __forceinline__ void gla_a_item(unsigned char* shm, const Params& p, int b, int c, int h, GlaGw& G) {
    const u16* P0 = (const u16*)(p.ws + E_P0);
    const int rowbase = gla_rowbase(b, c), t = threadIdx.x, lane = t & 63, w = t >> 6;
    const u32x4v kw = *(const u32x4v*)(P0 + (size_t)(rowbase + (t & 63)) * P0_LD + P0_K + h * 64 + (t >> 6) * 8);
    u32x4v vw0, vw1; gla_load_v(vw0, vw1, P0, rowbase, h);
    gla_gates(shm, p, rowbase, h, G);
    const float* BC = (const float*)(shm + GL_BC);
    u16* kwT = (u16*)(shm + GL_X0);
    u16* vT = kwT + 2 * 64 * GL_LD;
    { const int l = t & 63, kg = t >> 6;
#pragma unroll
      for (int e = 0; e < 8; ++e) { const int k = kg * 8 + e; const float kv = (e & 1) ? bfhi(kw[e >> 1]) : bflo(kw[e >> 1]);
          const float w0 = __expf(BC[63 * 65 + k] - BC[l * 65 + k]), w1 = __expf(BC[(64 + 0) * 65 + k] - BC[(64 + l) * 65 + k]);
          kwT[k * GL_LD + l] = f2bf(kv * w0); kwT[(64 + k) * GL_LD + l] = f2bf(kv * w1); } }
    gla_stage_vT(vT, vw0, vw1);
    __syncthreads();
    { const int d = w >> 2, kb = w & 3; f32x4 acc[1][8]; zero_acc(acc);
      wave_mma<1, 8>(acc, kwT + (d * 64 + kb * 16) * GL_LD, GL_LD, vT, GL_LD, 2);
      float* DS = gla_ds_ptr(p, b, d, h, c);
#pragma unroll
      for (int nt = 0; nt < 8; ++nt) { const int v = nt * 16 + (lane & 15), k0 = kb * 16 + (lane >> 4) * 4; *(f32x4*)(DS + v * 64 + k0) = acc[0][nt]; } }
    if (t < 128) { const int d = t >> 6, kk = t & 63; const float bl = d == 0 ? BC[63 * 65 + kk] : BC[64 * 65 + kk];
        ((float*)(p.ws + OFF_DEC))[((size_t)((b * 2 + d) * 4 + h) * 68 + c) * 64 + kk] = __expf(bl); }
    __syncthreads();
}

__device__ void gmlp_item(unsigned char* shm, const Params& p, int b, int cc, int gi) {
    const u16* P0 = (const u16*)(p.ws + E_P0); u16* MG = (u16*)(p.ws + OFF_H);
    const int rowbase = cc < 2 ? RL + b * CTXL + cc * 128 : b * SEQ + (cc - 2) * 128;
    const int t = threadIdx.x, lane = t & 63, w = t >> 6;
    float* st = (float*)shm;
    u16* vnT = (u16*)(shm + 1024);
    u16* Ws = vnT + 128 * 136;
    { const int row = t >> 2, part = t & 3; const u16* src = P0 + (size_t)(rowbase + row) * P0_LD + P0_G + part * 128; float s = 0.f, ss = 0.f;
#pragma unroll 4
      for (int i = 0; i < 16; ++i) { const u32x4v wv = *(const u32x4v*)(src + i * 8);
#pragma unroll
          for (int e = 0; e < 4; ++e) { const float a = geluf(bflo(wv[e])), c2 = geluf(bfhi(wv[e])); s += a + c2; ss += a * a + c2 * c2; } }
      s += __shfl_xor(s, 1, 64); ss += __shfl_xor(ss, 1, 64); s += __shfl_xor(s, 2, 64); ss += __shfl_xor(ss, 2, 64);
      if (part == 0) { const float mu = s * (1.0f / 512.0f); const float var = fmaxf(ss * (1.0f / 512.0f) - mu * mu, 0.f); st[row * 2] = mu; st[row * 2 + 1] = rsqrtf(var + EPS); } }
    { const float* SW = p.in[I_ABSW] + (size_t)gi * 128 * 128;
#pragma unroll
      for (int ps = 0; ps < 8; ++ps) { const int idx = ps * 2048 + t * 4, tt = idx >> 7, s0 = idx & 127; const f32x4 v = *(const f32x4*)(SW + idx);
          u32x2 o; o[0] = pk2(v[0], v[1]); o[1] = pk2(v[2], v[3]); *(u32x2*)(Ws + tt * 136 + s0) = o; } }
    __syncthreads();
    { const int s = t & 127, cg4 = t >> 7; const u16* src = P0 + (size_t)(rowbase + s) * P0_LD + P0_G + gi * 128 + cg4 * 32; const float mu = st[s * 2], rstd = st[s * 2 + 1];
      const float* vg = p.in[I_ABVNG] + gi * 128 + cg4 * 32;
#pragma unroll
      for (int i = 0; i < 4; ++i) { const u32x4v wv = *(const u32x4v*)(src + i * 8);
#pragma unroll
          for (int e = 0; e < 8; ++e) { const float x = (e & 1) ? bfhi(wv[e >> 1]) : bflo(wv[e >> 1]); const int cl = i * 8 + e;
              vnT[(cg4 * 32 + cl) * 136 + s] = f2bf((geluf(x) - mu) * rstd * vg[cl]); } } }
    __syncthreads();
    { f32x4 acc[1][8]; zero_acc(acc);
      wave_mma<1, 8>(acc, vnT + (w * 16) * 136, 136, Ws, 136, 4);
      const int c0 = w * 16 + (lane >> 4) * 4;
#pragma unroll
      for (int nt = 0; nt < 8; ++nt) { const int tt = nt * 16 + (lane & 15); const float sb = p.in[I_ABSB][gi * 128 + tt];
          const u32x2 uw = *(const u32x2*)(P0 + (size_t)(rowbase + tt) * P0_LD + P0_U + gi * 128 + c0);
          const float o0 = geluf(bflo(uw[0])) * (acc[0][nt][0] + sb), o1 = geluf(bfhi(uw[0])) * (acc[0][nt][1] + sb), o2 = geluf(bflo(uw[1])) * (acc[0][nt][2] + sb), o3 = geluf(bfhi(uw[1])) * (acc[0][nt][3] + sb);
          u32x2 o; o[0] = pk2(o0, o1); o[1] = pk2(o2, o3); *(u32x2*)(MG + (size_t)(rowbase + tt) * DM + 512 + gi * 128 + c0) = o; } }
    __syncthreads();
}

__device__ void gla_scan_phase(const Params& p) {
    const float* DEC = (const float*)(p.ws + OFF_DEC);
    for (int g0 = blockIdx.x * 512 + threadIdx.x; g0 < 4 * 2 * 4 * 8192 / 2; g0 += gridDim.x * 512) {
        int e[2], bb[2], dd[2], hh[2]; const float* dec[2]; float s[2] = {0.f, 0.f};
#pragma unroll
        for (int q = 0; q < 2; ++q) { const int gidx = g0 + q * (4 * 2 * 4 * 8192 / 2); e[q] = gidx & 8191; const int bdh = gidx >> 13; hh[q] = bdh & 3; dd[q] = (bdh >> 2) & 1; bb[q] = bdh >> 3; dec[q] = DEC + (size_t)bdh * 68 * 64 + (e[q] & 63); }
        for (int i0 = 0; i0 < 68; i0 += 17) {
            float* ptr[2][17]; float ds[2][17], dc[2][17];
#pragma unroll
            for (int u = 0; u < 17; ++u)
#pragma unroll
                for (int q = 0; q < 2; ++q) { const int i = i0 + u; const int c = dd[q] == 0 ? i : (i < 4 ? 3 - i : 71 - i); ptr[q][u] = gla_ds_ptr(p, bb[q], dd[q], hh[q], c) + e[q]; ds[q][u] = *ptr[q][u]; dc[q][u] = dec[q][c * 64]; }
#pragma unroll
            for (int u = 0; u < 17; ++u)
#pragma unroll
                for (int q = 0; q < 2; ++q) { *ptr[q][u] = s[q]; s[q] = dc[q][u] * s[q] + ds[q][u]; }
        }
    }
}

__device__ __forceinline__ void gla_c_item(unsigned char* shm, const Params& p, int b, int c, int h, GlaGw& G) {
    const u16* P0 = (const u16*)(p.ws + E_P0); u16* MG = (u16*)(p.ws + OFF_H);
    const int rowbase = gla_rowbase(b, c), t = threadIdx.x, lane = t & 63, w = t >> 6;
    const u16* rp_ = P0 + (size_t)(rowbase + (t & 63)) * P0_LD + h * 64 + (t >> 6) * 8;
    const u32x4v qw = *(const u32x4v*)(rp_ + P0_Q), kw = *(const u32x4v*)(rp_ + P0_K);
    u32x4v vw0, vw1; gla_load_v(vw0, vw1, P0, rowbase, h);
    f32x4 spa[4], spb[4];
#pragma unroll
    for (int ps = 0; ps < 4; ++ps) { const int idx = ps * 4096 + t * 8; const float* src = gla_ds_ptr(p, b, idx >> 13, h, c) + (idx & 8191); spa[ps] = *(const f32x4*)src; spb[ps] = *(const f32x4*)(src + 4); }
    const u16* rrp = P0 + (size_t)(rowbase + (t >> 3)) * P0_LD + P0_R + h * 128 + (t & 7) * 16;
    const u32x4v r0 = *(const u32x4v*)rrp, r1 = *(const u32x4v*)(rrp + 8);
    gla_gates(shm, p, rowbase, h, G);
    const float* BC = (const float*)(shm + GL_BC);
    u16* qd = (u16*)(shm + GL_X0);
    u16* kd = qd + 2 * 64 * GL_LD;
    u16* vT = kd + 2 * 64 * GL_LD;
    u16* SpT = vT + 128 * GL_LD;
    u16* SC = (u16*)(shm + GL_BC);
    float* O = (float*)SpT;
    { const int l = t & 63, kg = t >> 6;
#pragma unroll
      for (int d = 0; d < 2; ++d) { u32x4v qo, ko;
#pragma unroll
          for (int e2 = 0; e2 < 4; ++e2) { const float e0 = BC[(d * 64 + l) * 65 + kg * 8 + 2 * e2], e1 = BC[(d * 64 + l) * 65 + kg * 8 + 2 * e2 + 1];
              qo[e2] = pk2(bflo(qw[e2]) * 0.125f * __expf(e0), bfhi(qw[e2]) * 0.125f * __expf(e1));
              ko[e2] = pk2(bflo(kw[e2]) * __expf(-e0), bfhi(kw[e2]) * __expf(-e1)); }
          *(u32x4v*)(qd + (d * 64 + l) * GL_LD + kg * 8) = qo; *(u32x4v*)(kd + (d * 64 + l) * GL_LD + kg * 8) = ko; } }
    gla_stage_vT(vT, vw0, vw1);
#pragma unroll
    for (int ps = 0; ps < 4; ++ps) { const int idx = ps * 4096 + t * 8, d = idx >> 13, rem = idx & 8191, v = rem >> 6, k0 = rem & 63;
        *(u32x4v*)(SpT + (d * 128 + v) * GL_LD + k0) = pack8(spa[ps], spb[ps]); }
    __syncthreads();
    { const int d = w >> 2, lb = w & 3; f32x4 acc[1][4]; zero_acc(acc);
      wave_mma<1, 4>(acc, qd + (d * 64 + lb * 16) * GL_LD, GL_LD, kd + d * 64 * GL_LD, GL_LD, 2);
      __syncthreads();
#pragma unroll
      for (int nt = 0; nt < 4; ++nt)
#pragma unroll
          for (int j = 0; j < 4; ++j) { const int l = lb * 16 + (lane >> 4) * 4 + j, s = nt * 16 + (lane & 15); const bool keep = d == 0 ? (s <= l) : (s >= l);
              SC[(d * 64 + l) * GL_LD + s] = f2bf(keep ? acc[0][nt][j] : 0.f); } }
    __syncthreads();
    f32x4 oacc[1][4]; zero_acc(oacc);
    const int lb = w & 3, vh = w >> 2;
#pragma unroll
    for (int d = 0; d < 2; ++d) {
        wave_mma<1, 4>(oacc, qd + (d * 64 + lb * 16) * GL_LD, GL_LD, SpT + (d * 128 + vh * 64) * GL_LD, GL_LD, 2);
        wave_mma<1, 4>(oacc, SC + (d * 64 + lb * 16) * GL_LD, GL_LD, vT + (vh * 64) * GL_LD, GL_LD, 2);
    }
    __syncthreads();
#pragma unroll
    for (int nt = 0; nt < 4; ++nt)
#pragma unroll
        for (int j = 0; j < 4; ++j) { const int l = lb * 16 + (lane >> 4) * 4 + j, v = vh * 64 + nt * 16 + (lane & 15); O[l * 132 + v] = oacc[0][nt][j]; }
    __syncthreads();
    { const int l = t >> 3, part = t & 7; float o[16]; float ss = 0.f;
#pragma unroll
      for (int i = 0; i < 4; ++i) { const f32x4 v4 = *(const f32x4*)(O + l * 132 + part * 16 + i * 4);
#pragma unroll
          for (int e = 0; e < 4; ++e) { o[i * 4 + e] = v4[e]; ss += v4[e] * v4[e]; } }
      ss += __shfl_xor(ss, 1, 64); ss += __shfl_xor(ss, 2, 64); ss += __shfl_xor(ss, 4, 64);
      const float rs = rsqrtf(ss * (1.0f / 128.0f) + EPS);
      const float* gg = p.in[I_ABGNG] + h * 128 + part * 16; u32x4v o0, o1;
#pragma unroll
      for (int e2 = 0; e2 < 4; ++e2) {
          o0[e2] = pk2(o[2 * e2] * rs * gg[2 * e2] * siluf(bflo(r0[e2])), o[2 * e2 + 1] * rs * gg[2 * e2 + 1] * siluf(bfhi(r0[e2])));
          o1[e2] = pk2(o[8 + 2 * e2] * rs * gg[8 + 2 * e2] * siluf(bflo(r1[e2])), o[8 + 2 * e2 + 1] * rs * gg[8 + 2 * e2 + 1] * siluf(bfhi(r1[e2]))); }
      u16* dst = MG + (size_t)(rowbase + l) * DM + h * 128 + part * 16; *(u32x4v*)dst = o0; *(u32x4v*)(dst + 8) = o1; }
    __syncthreads();
}

__device__ void conv_phase(const Params& p) {
    u16* XBC = (u16*)(p.ws + E_XBC); const u16* HALO = (const u16*)(p.ws + A_HALO);
    const int t = threadIdx.x, cg = t & 127, q = __builtin_amdgcn_readfirstlane(t >> 7);
    for (int it = blockIdx.x; it < (RT / 64) * 3; it += gridDim.x) {
        const int rb = it / 3, cp = (it % 3) * 1024, c0 = cp + cg * 8;
        const bool first = rb < 256 ? ((rb & 63) == 0) : (((rb - 256) & 3) == 0);
        const bool last = rb < 256 ? ((rb & 63) == 63) : (((rb - 256) & 3) == 3);
        const bool z0 = (q == 0) && first, z1 = (q == 3) && last;
        u16* rowq = XBC + ((size_t)rb * 64 + 16 * q) * XBC_LD + cp;
        const u16* pre = (q == 0) ? (z0 ? rowq : HALO + ((size_t)(rb - 1) * 4 + 2) * XBC_LD + cp) : rowq - 2 * XBC_LD;
        const u16* post = (q == 3) ? (z1 ? rowq : HALO + ((size_t)(rb + 1) * 4) * XBC_LD + cp) : rowq + 16 * XBC_LD;
        u32x4v win[20];
        win[0] = *(const u32x4v*)(pre + cg * 8); win[1] = *(const u32x4v*)(pre + XBC_LD + cg * 8);
#pragma unroll
        for (int i = 0; i < 16; ++i) win[2 + i] = *(const u32x4v*)(rowq + (size_t)i * XBC_LD + cg * 8);
        win[18] = *(const u32x4v*)(post + cg * 8); win[19] = *(const u32x4v*)(post + XBC_LD + cg * 8);
        const u32x4v zero = {0u, 0u, 0u, 0u};
        if (z0) { win[0] = zero; win[1] = zero; }
        if (z1) { win[18] = zero; win[19] = zero; }
        float wt[5][8], bias[8];
#pragma unroll
        for (int j = 0; j < 5; ++j) { const f32x4 a = *(const f32x4*)(p.in[I_SSDCW] + j * 3072 + c0), b2 = *(const f32x4*)(p.in[I_SSDCW] + j * 3072 + c0 + 4);
#pragma unroll
            for (int e = 0; e < 4; ++e) { wt[j][e] = a[e]; wt[j][4 + e] = b2[e]; } }
        { const f32x4 a = *(const f32x4*)(p.in[I_SSDCB] + c0), b2 = *(const f32x4*)(p.in[I_SSDCB] + c0 + 4);
#pragma unroll
          for (int e = 0; e < 4; ++e) { bias[e] = a[e]; bias[4 + e] = b2[e]; } }
        __syncthreads();
#pragma unroll
        for (int r = 0; r < 16; ++r) {
            float o[8];
#pragma unroll
            for (int e = 0; e < 8; ++e) o[e] = bias[e];
#pragma unroll
            for (int j = 0; j < 5; ++j)
#pragma unroll
                for (int e2 = 0; e2 < 4; ++e2) { o[2 * e2] += wt[j][2 * e2] * bflo(win[r + j][e2]); o[2 * e2 + 1] += wt[j][2 * e2 + 1] * bfhi(win[r + j][e2]); }
            u32x4v ov;
#pragma unroll
            for (int e2 = 0; e2 < 4; ++e2) ov[e2] = pk2(siluf(o[2 * e2]), siluf(o[2 * e2 + 1]));
            *(u32x4v*)(rowq + (size_t)r * XBC_LD + cg * 8) = ov;
        }
    }
}
__device__ void dt_phase(unsigned char* shm, const Params& p) {
    const float* DTRAW = (const float*)(p.ws + A_DTRAW); float* DT = (float*)(p.ws + T_DT); float* ACUM = (float*)(p.ws + T_ACUM);
    float* tile = (float*)shm;
    float* tdt = tile + 128 * 65;
    const int t = threadIdx.x, col = t & 63;
    const float bias = p.in[I_SSDDTB][col], a = -__expf(p.in[I_SSDALOG][col]);
    for (int ch = blockIdx.x; ch < RT / 128; ch += gridDim.x) {
        const size_t r0 = (size_t)ch * 128;
#pragma unroll
        for (int i = 0; i < 16; ++i) { const int m = i * 8 + (t >> 6); const float d = softplusf(DTRAW[(r0 + m) * 64 + col] + bias); tdt[m * 65 + col] = d; tile[m * 65 + col] = d * a; }
        __syncthreads();
        if (t < 64) { float run = 0.f;
            if (t < 32) { for (int m = 0; m < 128; ++m) { run += tile[m * 65 + t]; tile[m * 65 + t] = run; } }
            else { for (int m = 127; m >= 0; --m) { run += tile[m * 65 + t]; tile[m * 65 + t] = run; } } }
        __syncthreads();
        { const int m = t & 127, cq = t >> 7;
#pragma unroll
          for (int i = 0; i < 16; ++i) { const int c = cq * 16 + i; ACUM[(size_t)c * RT + r0 + m] = tile[m * 65 + c]; DT[(size_t)c * RT + r0 + m] = tdt[m * 65 + c]; } }
        __syncthreads();
    }
}
constexpr int SP_LD = 136;
constexpr int SP_C = 0;
constexpr int SP_B = SP_C + 128 * SP_LD * 2;
constexpr int SP_CB = SP_B + 128 * SP_LD * 2;
constexpr int SP_AC = SP_CB + 128 * SP_LD * 2;
constexpr int SP_DT = SP_AC + 16 * 128 * 4;
constexpr int SP_END = SP_DT + 16 * 128 * 4;
static_assert(SP_END <= LDS_XB, "SSD par LDS");
__device__ void ssd_par_item(unsigned char* shm, const Params& p, int item) {
    const u16* XBC = (const u16*)(p.ws + E_XBC); u16* Y = (u16*)(p.ws + E_Y);
    const float* DT = (const float*)(p.ws + T_DT); const float* ACUM = (const float*)(p.ws + T_ACUM);
    const int g = item & 3, base = (item >> 2) * 128;
    u16* Cs = (u16*)(shm + SP_C); u16* Ms = Cs; u16* Bs = (u16*)(shm + SP_B); u16* xT = Bs; u16* CBs = (u16*)(shm + SP_CB);
    float* acs = (float*)(shm + SP_AC); float* dts = (float*)(shm + SP_DT);
    const int t = threadIdx.x, lane = t & 63, w = t >> 6, fr = lane & 15, fq = lane >> 4;
#pragma unroll
    for (int i = 0; i < 4; ++i) { const int idx = i * 512 + t, m = idx >> 4, seg = idx & 15; const u16* rp = XBC + (size_t)(base + m) * XBC_LD + g * 128 + seg * 8;
        *(u32x4v*)(Cs + m * SP_LD + seg * 8) = *(const u32x4v*)(rp + 2560); *(u32x4v*)(Bs + m * SP_LD + seg * 8) = *(const u32x4v*)(rp + 2048); }
#pragma unroll
    for (int i = 0; i < 4; ++i) { const int idx = i * 512 + t, q = idx >> 7, m = idx & 127, hh = q >> 1, dir = q & 1; const size_t o = (size_t)(dir * 32 + g * 8 + hh) * RT + base + m;
        acs[idx] = ACUM[o]; dts[idx] = DT[o]; }
    __syncthreads();
    { f32x4 acc[1][8]; zero_acc(acc);
      wave_mma<1, 8>(acc, Bs + (w * 16) * SP_LD, SP_LD, Cs, SP_LD, 4);
#pragma unroll
      for (int nt = 0; nt < 8; ++nt) { u32x2 o; o[0] = pk2(acc[0][nt][0], acc[0][nt][1]); o[1] = pk2(acc[0][nt][2], acc[0][nt][3]); *(u32x2*)(CBs + (nt * 16 + fr) * SP_LD + w * 16 + fq * 4) = o; } }
    __syncthreads();
    const int seg = t & 15, mq = t >> 4, xs_ = t & 127, pseg = t >> 7, mrow0 = w * 16;
    u32x4v nx0, nx1;
    { const u16* xp = XBC + (size_t)(base + xs_) * XBC_LD + (g * 8) * 64 + pseg * 16; nx0 = *(const u32x4v*)xp; nx1 = *(const u32x4v*)(xp + 8); }
    for (int hh = 0; hh < 8; ++hh) {
        const int h = g * 8 + hh;
        const float* af = acs + (hh * 2) * 128; const float* ab = af + 128; const float* dtf = dts + (hh * 2) * 128; const float* dtb = dtf + 128;
        u32x2 xsv[4];
        { const size_t row = (size_t)(base + mrow0 + fr);
#pragma unroll
          for (int mt = 0; mt < 4; ++mt) xsv[mt] = *(const u32x2*)(XBC + row * XBC_LD + h * 64 + mt * 16 + fq * 4); }
        { const u32x4v x0 = nx0, x1 = nx1;
          if (hh < 7) { const u16* xp = XBC + (size_t)(base + xs_) * XBC_LD + (h + 1) * 64 + pseg * 16; nx0 = *(const u32x4v*)xp; nx1 = *(const u32x4v*)(xp + 8); }
#pragma unroll
          for (int e2 = 0; e2 < 4; ++e2) { xT[(pseg * 16 + 2 * e2) * SP_LD + xs_] = (u16)(x0[e2] & 0xFFFFu); xT[(pseg * 16 + 2 * e2 + 1) * SP_LD + xs_] = (u16)(x0[e2] >> 16);
              xT[(pseg * 16 + 8 + 2 * e2) * SP_LD + xs_] = (u16)(x1[e2] & 0xFFFFu); xT[(pseg * 16 + 8 + 2 * e2 + 1) * SP_LD + xs_] = (u16)(x1[e2] >> 16); } }
        { float afs[8], abs_[8], wf[8], wb[8];
#pragma unroll
          for (int q = 0; q < 2; ++q) { const f32x4 a4 = *(const f32x4*)(af + seg * 8 + 4 * q), b4 = *(const f32x4*)(ab + seg * 8 + 4 * q), c4 = *(const f32x4*)(dtf + seg * 8 + 4 * q), d4 = *(const f32x4*)(dtb + seg * 8 + 4 * q);
#pragma unroll
              for (int e = 0; e < 4; ++e) { afs[4 * q + e] = a4[e]; abs_[4 * q + e] = b4[e]; wf[4 * q + e] = c4[e]; wb[4 * q + e] = d4[e]; } }
#pragma unroll
          for (int i = 0; i < 4; ++i) { const int m = mq + 32 * i; const u32x4v cw = *(const u32x4v*)(CBs + m * SP_LD + seg * 8); const float amf = af[m], amb = ab[m]; float v[8];
#pragma unroll
              for (int e = 0; e < 8; ++e) { const int s2 = seg * 8 + e; const float cbv = (e & 1) ? bfhi(cw[e >> 1]) : bflo(cw[e >> 1]);
                  const float arg = s2 < m ? (amf - afs[e]) : (s2 > m ? (amb - abs_[e]) : 0.f); const float wgt = s2 < m ? wf[e] : (s2 > m ? wb[e] : wf[e] + wb[e]);
                  v[e] = cbv * __expf(arg) * wgt; }
              u32x4v mv; mv[0] = pk2(v[0], v[1]); mv[1] = pk2(v[2], v[3]); mv[2] = pk2(v[4], v[5]); mv[3] = pk2(v[6], v[7]);
              *(u32x4v*)(Ms + m * SP_LD + seg * 8) = mv; } }
        __syncthreads();
        f32x4 yT[4][1]; zero_acc(yT);
        wave_mma<4, 1>(yT, xT, SP_LD, Ms + mrow0 * SP_LD, SP_LD, 4);
        __syncthreads();
        { const float dsk = p.in[I_SSDD][h]; const size_t row = (size_t)(base + mrow0 + fr);
#pragma unroll
          for (int mt = 0; mt < 4; ++mt) { const int p0 = h * 64 + mt * 16 + fq * 4; const u32x2 xs = xsv[mt];
              u32x2 o; o[0] = pk2(yT[mt][0][0] + dsk * bflo(xs[0]), yT[mt][0][1] + dsk * bfhi(xs[0])); o[1] = pk2(yT[mt][0][2] + dsk * bflo(xs[1]), yT[mt][0][3] + dsk * bfhi(xs[1]));
              *(u32x2*)(Y + row * 2048 + p0) = o; } }
    }
}

constexpr int SS_LD = 136, SS_LB = 130;
constexpr int SS_C = 0;
constexpr int SS_B = SS_C + 128 * SS_LD * 2;
constexpr int SS_XW = SS_B + 128 * 256;
constexpr int SS_S = SS_XW + 32 * SS_LD * 2;
constexpr int SS_AC = SS_S + 32 * SS_LD * 2;
constexpr int SS_END = SS_AC + 512;
static_assert(SS_END <= LDS_XB, "SSD LDS");

__device__ __forceinline__ void lds_barrier() { asm volatile("s_waitcnt lgkmcnt(0)\n\ts_barrier" ::: "memory"); }
__device__ __forceinline__ unsigned ssd_off_b(unsigned row, unsigned ch) { return 256u * row + 16u * (ch ^ (((row & 3u) << 2) | ((row >> 2) & 3u))); }
__device__ __forceinline__ unsigned ssd_tr_addr(unsigned lane, unsigned c, unsigned ks, unsigned t) { const unsigned g = lane >> 4, q = (lane & 15u) >> 2, p = lane & 3u; return ssd_off_b(32u * ks + 8u * g + 4u * t + q, 2u * c + (p >> 1)) + 8u * (p & 1u); }
typedef unsigned short u16x4v __attribute__((ext_vector_type(4)));
struct SsdPre { u32x4v rC[4], rB[4], rX; u32x2 rY[2]; float rDt, rAcX, rAlast; };
__device__ __forceinline__ void ssd_item(unsigned char* shm, const Params& p, int b, int h, int ph) {
    const u16* XBC = (const u16*)(p.ws + E_XBC); u16* Y = (u16*)(p.ws + E_Y);
    const float* DT = (const float*)(p.ws + T_DT); const float* ACUM = (const float*)(p.ws + T_ACUM);
    u16* Cs = (u16*)(shm + SS_C); u16* Bs = (u16*)(shm + SS_B); u16* xwT = (u16*)(shm + SS_XW); u16* Sb = (u16*)(shm + SS_S);
    float* acs = (float*)(shm + SS_AC);
    const int t = threadIdx.x, lane = t & 63, w = t >> 6, g = h >> 3, fr = lane & 15, fq = lane >> 4;
    const int xcol = h * 64 + ph * 32, bcol = 2048 + g * 128, ccol = 2560 + g * 128;
    const int seg = t & 15, mq = t >> 4, xm = t & 127, xseg = t >> 7, mrow0 = w * 16;
    unsigned tra[8];
    { const unsigned bs_lds = (unsigned)(size_t)((__attribute__((address_space(3))) unsigned char*)(shm + SS_B));
#pragma unroll
      for (int k = 0; k < 4; ++k)
#pragma unroll
          for (int tq = 0; tq < 2; ++tq) tra[2 * k + tq] = bs_lds + ssd_tr_addr((unsigned)lane, (unsigned)w, (unsigned)k, (unsigned)tq); }
    for (int dir = 0; dir < 2; ++dir) {
        const float* dtc = DT + (size_t)(dir * 32 + h) * RT; const float* acc_ = ACUM + (size_t)(dir * 32 + h) * RT;
        f32x4 accS[1][2]; zero_acc(accS);
        SsdPre R0, R1;
        { const u32x4v z4 = {0u, 0u, 0u, 0u}; const u32x2 z2 = {0u, 0u};
#pragma unroll
          for (int i = 0; i < 4; ++i) { R0.rC[i] = z4; R1.rC[i] = z4; }
          R0.rY[0] = z2; R0.rY[1] = z2; R1.rY[0] = z2; R1.rY[1] = z2; }
        auto base_of = [&](int st) __attribute__((always_inline)) { return st < 2 ? RL + b * CTXL + (dir == 0 ? st : 1 - st) * 128 : b * SEQ + (dir == 0 ? st - 2 : 33 - st) * 128; };
        auto prefetch = [&](SsdPre& R, int st) __attribute__((always_inline)) {
            const int base_ = base_of(st); const bool ctx_ = st < 2;
#pragma unroll
            for (int i = 0; i < 4; ++i) { const int m = mq + 32 * i; const u16* rp = XBC + (size_t)(base_ + m) * XBC_LD + seg * 8; R.rB[i] = *(const u32x4v*)(rp + bcol); if (!ctx_) R.rC[i] = *(const u32x4v*)(rp + ccol); }
            R.rX = *(const u32x4v*)(XBC + (size_t)(base_ + xm) * XBC_LD + xcol + xseg * 8); R.rDt = dtc[base_ + xm]; R.rAcX = acc_[base_ + xm]; R.rAlast = acc_[base_ + (dir == 0 ? 127 : 0)];
        };
        auto prefetch_y = [&](SsdPre& R, int st) __attribute__((always_inline)) {
            if (st >= 2) { const int base_ = base_of(st);
#pragma unroll
                for (int mt = 0; mt < 2; ++mt) R.rY[mt] = *(const u32x2*)(Y + (size_t)(base_ + mrow0 + fr) * 2048 + xcol + mt * 16 + fq * 4); } };
        auto do_step = [&](SsdPre& R, int step) __attribute__((always_inline)) {
            const bool isctx = step < 2;
            const int base = base_of(step);
            const float a_last = __uint_as_float(__builtin_amdgcn_readfirstlane(__float_as_uint(R.rAlast)));
            const bool pf = step + 2 < 34; const int base2 = base_of(pf ? step + 2 : step);
            if (xseg == 0) acs[xm] = R.rAcX;
            const float wgt = R.rDt * __expf(a_last - R.rAcX);
            if (pf) { R.rDt = dtc[base2 + xm]; R.rAcX = acc_[base2 + xm]; R.rAlast = acc_[base2 + (dir == 0 ? 127 : 0)]; }
#pragma unroll
            for (int i = 0; i < 4; ++i) { const int m = mq + 32 * i; const u16* rp2 = XBC + (size_t)(base2 + m) * XBC_LD + seg * 8;
                *(u32x4v*)((unsigned char*)Bs + ssd_off_b((unsigned)m, (unsigned)seg)) = R.rB[i];
                if (pf) R.rB[i] = *(const u32x4v*)(rp2 + bcol);
                if (!isctx) *(u32x4v*)(Cs + m * SS_LD + seg * 8) = R.rC[i];
                if (pf) R.rC[i] = *(const u32x4v*)(rp2 + ccol); }
            {
#pragma unroll
              for (int e = 0; e < 8; ++e) { const float x = (e & 1) ? bfhi(R.rX[e >> 1]) : bflo(R.rX[e >> 1]); xwT[(xseg * 8 + e) * SS_LD + xm] = f2bf(x * wgt); }
              if (pf) R.rX = *(const u32x4v*)(XBC + (size_t)(base2 + xm) * XBC_LD + xcol + xseg * 8); }
            if (!isctx) {
#pragma unroll
                for (int nt = 0; nt < 2; ++nt) { u32x2 o; o[0] = pk2(accS[0][nt][0], accS[0][nt][1]); o[1] = pk2(accS[0][nt][2], accS[0][nt][3]); *(u32x2*)(Sb + (nt * 16 + fr) * SS_LD + mrow0 + fq * 4) = o; } }
            lds_barrier();
            if (!isctx) {
                f32x4 yT[2][1]; zero_acc(yT);
                { bf16x8 fa[4][2], fb[4];
#pragma unroll
                  for (int k = 0; k < 4; ++k) { fa[k][0] = *(const bf16x8*)(Sb + fr * SS_LD + k * 32 + fq * 8); fa[k][1] = *(const bf16x8*)(Sb + (16 + fr) * SS_LD + k * 32 + fq * 8);
                      fb[k] = *(const bf16x8*)(Cs + (mrow0 + fr) * SS_LD + k * 32 + fq * 8); }
#pragma unroll
                  for (int k = 0; k < 4; ++k) { yT[0][0] = __builtin_amdgcn_mfma_f32_16x16x32_bf16(fa[k][0], fb[k], yT[0][0], 0, 0, 0); yT[1][0] = __builtin_amdgcn_mfma_f32_16x16x32_bf16(fa[k][1], fb[k], yT[1][0], 0, 0, 0); } }
                const float sc = __expf(acs[mrow0 + fr]);
                const size_t row = (size_t)(base + mrow0 + fr);
#pragma unroll
                for (int mt = 0; mt < 2; ++mt) { u16* yp = Y + row * 2048 + xcol + mt * 16 + fq * 4; const u32x2 pv = R.rY[mt];
                    u32x2 o; o[0] = pk2(bflo(pv[0]) + sc * yT[mt][0][0], bfhi(pv[0]) + sc * yT[mt][0][1]); o[1] = pk2(bflo(pv[1]) + sc * yT[mt][0][2], bfhi(pv[1]) + sc * yT[mt][0][3]);
                    asm volatile("global_store_dwordx2 %0, %1, off" :: "v"(yp), "v"(o) : "memory"); }
            }
            if (step + 2 < 34) prefetch_y(R, step + 2);
            { const float dl = __expf(a_last);
#pragma unroll
              for (int nt = 0; nt < 2; ++nt)
#pragma unroll
                  for (int j = 0; j < 4; ++j) accS[0][nt][j] *= dl; }
            { bf16x8 ga[4], gb[4][2];
              u16x4v tr[8];
              asm volatile("ds_read_b64_tr_b16 %0, %8\n\tds_read_b64_tr_b16 %1, %9\n\tds_read_b64_tr_b16 %2, %10\n\tds_read_b64_tr_b16 %3, %11\n\t"
                           "ds_read_b64_tr_b16 %4, %12\n\tds_read_b64_tr_b16 %5, %13\n\tds_read_b64_tr_b16 %6, %14\n\tds_read_b64_tr_b16 %7, %15\n\ts_waitcnt lgkmcnt(0)"
                           : "=&v"(tr[0]), "=&v"(tr[1]), "=&v"(tr[2]), "=&v"(tr[3]), "=&v"(tr[4]), "=&v"(tr[5]), "=&v"(tr[6]), "=&v"(tr[7])
                           : "v"(tra[0]), "v"(tra[1]), "v"(tra[2]), "v"(tra[3]), "v"(tra[4]), "v"(tra[5]), "v"(tra[6]), "v"(tra[7]) : "memory");
#pragma unroll
              for (int k = 0; k < 4; ++k) {
#pragma unroll
                  for (int e = 0; e < 4; ++e) { ga[k][e] = (short)tr[2 * k][e]; ga[k][4 + e] = (short)tr[2 * k + 1][e]; }
#pragma unroll
                  for (int nt = 0; nt < 2; ++nt) gb[k][nt] = *(const bf16x8*)(xwT + (nt * 16 + fr) * SS_LD + k * 32 + fq * 8); }
#pragma unroll
              for (int k = 0; k < 4; ++k)
#pragma unroll
                  for (int nt = 0; nt < 2; ++nt) accS[0][nt] = __builtin_amdgcn_mfma_f32_16x16x32_bf16(ga[k], gb[k][nt], accS[0][nt], 0, 0, 0); }
            lds_barrier();
        };
        prefetch(R0, 0); prefetch(R1, 1); prefetch_y(R0, 0); prefetch_y(R1, 1);
        for (int step = 0; step < 34; step += 2) { do_step(R0, step); do_step(R1, step + 1); }
        asm volatile("s_waitcnt vmcnt(0)" ::: "memory");
    }
}

__device__ void ssd_finish_phase(const Params& p) {
    u16* Y = (u16*)(p.ws + E_Y); const u16* Z = (const u16*)(p.ws + E_Z);
    const int lane = threadIdx.x & 63, wid = threadIdx.x >> 6;
    const int stride = gridDim.x * 8;
    for (int it0 = blockIdx.x * 8 + wid; it0 < RL * 4; it0 += 4 * stride) {
        u32x4v yw[4], zw[4]; size_t off[4]; bool ok[4];
#pragma unroll
        for (int u = 0; u < 4; ++u) { const int it = it0 + u * stride; ok[u] = it < RL * 4; off[u] = ok[u] ? (size_t)(it >> 2) * 2048 + (it & 3) * 512 + lane * 8 : 0;
            yw[u] = *(const u32x4v*)(Y + off[u]); zw[u] = *(const u32x4v*)(Z + off[u]); }
#pragma unroll
        for (int u = 0; u < 4; ++u) { const int it = it0 + u * stride;
            float v[8]; float ss = 0.f;
#pragma unroll
            for (int e2 = 0; e2 < 4; ++e2) { v[2 * e2] = bflo(yw[u][e2]) * siluf(bflo(zw[u][e2])); v[2 * e2 + 1] = bfhi(yw[u][e2]) * siluf(bfhi(zw[u][e2])); ss += v[2 * e2] * v[2 * e2] + v[2 * e2 + 1] * v[2 * e2 + 1]; }
            ss = wave_sum(ss);
            const float rs = rsqrtf(ss * (1.0f / 512.0f) + EPS);
            const float* gg = p.in[I_SSDNG] + (it & 3) * 512 + lane * 8; u32x4v o;
#pragma unroll
            for (int e2 = 0; e2 < 4; ++e2) o[e2] = pk2(v[2 * e2] * rs * gg[2 * e2], v[2 * e2 + 1] * rs * gg[2 * e2 + 1]);
            if (ok[u]) *(u32x4v*)(Y + off[u]) = o; }
    }
}

__global__ __launch_bounds__(512, 2) void mega(Params p) {
    extern __shared__ __attribute__((aligned(16))) unsigned char shm[];
    cg::grid_group grid = cg::this_grid();
    unsigned char* ws = p.ws;
    float* MOD = (float*)(ws + OFF_MOD); const float* MOD1 = MOD + 5 * NMOD * DM;
    u16* H = (u16*)(ws + OFF_H); float* XC = (float*)(ws + OFF_XC);
    const int bid = blockIdx.x, nb = gridDim.x;
    volatile LAS unsigned* xst = (volatile LAS unsigned*)(shm + LDS_XB);
    if (threadIdx.x < 2) xst[threadIdx.x] = 0u;
    __syncthreads();
    const XcdBarrier xb = xcd_barrier_post((unsigned*)(ws + OFF_BAR), xst);
    mod_gemv(shm, p);
    convert_weights_early(shm, p);
    if (p.ws == nullptr) grid.sync();
    xcd_barrier(xb);
    norm_mod_phase(p.in[I_X], p.in[I_CTX], p.in[I_NORMG], MOD, 0, 1, RT, 0, H);
    xcd_barrier(xb);
    { EpiBf16Plain E; E.O = (u16*)(ws + E_P0); E.ld = P0_LD; E.ncols = P0_LD; run_gemm(shm, H, (const u16*)(ws + A_AB_IN), RT, 2816, 1024, E); }
    xcd_barrier(xb);
    { GlaGw G; G.h = -1;
    for (int it = bid; it < 4 * 68 * 4 + 4 * 34 * 4; it += nb) {
        if (it < 4 * 68 * 4) { const int h = it & 3, bc = it >> 2; gla_a_item(shm, p, bc / 68, bc % 68, h, G); }
        else { const int j = it - 4 * 68 * 4; const int gi = j & 3, bc = j >> 2; gmlp_item(shm, p, bc / 34, bc % 34, gi); }
    } }
    xcd_barrier(xb);
    gla_scan_phase(p);
    xcd_barrier(xb);
    { GlaGw G; G.h = -1; for (int it = bid; it < 4 * 68 * 4; it += nb) { const int h = it & 3, bc = it >> 2; gla_c_item(shm, p, bc / 68, bc % 68, h, G); } }
    xcd_barrier(xb);
    { EpiRes E; E.src_lat = p.in[I_X]; E.src_ctx = p.in[I_CTX]; E.dst_lat = p.out; E.dst_ctx = XC; E.gate = MOD + 2 * DM; E.cm = 0; E.part = (float*)(ws + E_PART);
      run_gemm_split(shm, H, (const u16*)(ws + A_AB_OUT), 1024, 1024, E); }
    xcd_barrier(xb);
    norm_mod_phase(p.out, p.in[I_CTX], p.in[I_NORMG] + DM, MOD, 3, 4, RT, 0, H, (const float*)(ws + E_PART), 4, MOD + 4 * (NMOD * DM) + 2 * DM, XC);
    xcd_barrier(xb);
    { EpiSwiglu E; E.O = (u16*)(ws + E_ACT); run_gemm(shm, H, (const u16*)(ws + A_FF_IN0), RT, 5632, 1024, E); }
    xcd_barrier(xb);
    { EpiRes E; E.src_lat = p.out; E.src_ctx = XC; E.dst_lat = p.out; E.dst_ctx = XC; E.gate = MOD + 5 * DM; E.cm = 0; E.part = (float*)(ws + E_PART);
      run_gemm_split(shm, (const u16*)(ws + E_ACT), (const u16*)(ws + A_FF_OUT0), 1024, 2816, E); }
    xcd_barrier(xb);
    norm_mod_phase(p.out, XC, p.in[I_NORMG] + 2 * DM, MOD1, 0, 1, RT, 1, H, (const float*)(ws + E_PART), 11, MOD + 4 * (NMOD * DM) + 5 * DM, XC);
    xcd_barrier(xb);
    { EpiSsdIn E; E.XBC = (u16*)(ws + E_XBC); E.HALO = (u16*)(ws + A_HALO); E.DTRAW = (float*)(ws + A_DTRAW); run_gemm(shm, H, (const u16*)(ws + B_SSD_INA), RT, 3328, 1024, E); }
    xcd_barrier(xb);
    dt_phase(shm, p);
    conv_phase(p);
    xcd_barrier(xb);
    for (int it = bid; it < 4 * 32 * 4; it += nb) ssd_par_item(shm, p, it);
    xcd_barrier(xb);
    {
        unsigned* cnt = (unsigned*)(ws + OFF_BAR) + XCD_BAR_WORDS;
        volatile int* s_item_p = (volatile int*)(shm + LDS_XB + 8);
        if (nb == 256) {
            if (threadIdx.x == 0) { int item = -1;
                for (int k = 0; k < 8 && item < 0; ++k) { const unsigned y = (xb.x + k) & 7u; const unsigned r = xb_add(&cnt[y * 16], 1u); if (r < 32u) item = (int)(y * 32u + r); }
                *s_item_p = item; }
            __syncthreads();
            const int item = *s_item_p;
            if (item >= 0) { const int grp = item >> 4, idx = item & 15; ssd_item(shm, p, grp >> 2, (grp & 3) * 8 + (idx >> 1), idx & 1); }
        } else {
            for (int it = bid; it < 4 * 32 * 2; it += nb) { const int grp = it >> 4, idx = it & 15; ssd_item(shm, p, grp >> 2, (grp & 3) * 8 + (idx >> 1), idx & 1); }
        }
    }
    xcd_barrier(xb);
    { EpiBf16Plain E; E.O = (u16*)(ws + E_Z); E.ld = 2048; E.ncols = 2048; run_gemm(shm, H, (const u16*)(ws + B_WZ), RL, 2048, 1024, E); }
    convert_weights_late(shm, p);
    xcd_barrier(xb);
    ssd_finish_phase(p);
    xcd_barrier(xb);
    { EpiRes E; E.src_lat = p.out; E.src_ctx = XC; E.dst_lat = p.out; E.dst_ctx = XC; E.gate = MOD1 + 2 * DM; E.cm = 1; E.part = nullptr;
      run_gemm(shm, (const u16*)(ws + E_Y), (const u16*)(ws + A_SSD_OUT), RL, 1024, 2048, E); }
    xcd_barrier(xb);
    norm_mod_phase(p.out, XC, p.in[I_NORMG] + 3 * DM, MOD1, 3, 4, RL, 0, H);
    xcd_barrier(xb);
    { EpiSwiglu E; E.O = (u16*)(ws + E_ACT); run_gemm(shm, H, (const u16*)(ws + A_FF_IN1), RL, 5632, 1024, E); }
    xcd_barrier(xb);
    { EpiRes E; E.src_lat = p.out; E.src_ctx = XC; E.dst_lat = p.out; E.dst_ctx = XC; E.gate = MOD1 + 5 * DM; E.cm = 0; E.part = nullptr;
      run_gemm(shm, (const u16*)(ws + E_ACT), (const u16*)(ws + A_FF_OUT1), RL, 1024, 2816, E); }
    xcd_barrier(xb);
    final_norm_phase(p.out, p.in[I_FNG]);
}

extern "C" void kernel_launch(void* const* d_in, const int* in_sizes, int n_in, void* d_out, int out_size, void* d_ws, size_t ws_size, hipStream_t stream) {
    static int grid_blocks = 0;
    if (!grid_blocks) {
        int dev = 0, cus = 0, per_cu = 0;
        (void)hipGetDevice(&dev);
        (void)hipDeviceGetAttribute(&cus, hipDeviceAttributeMultiprocessorCount, dev);
        (void)hipFuncSetAttribute((const void*)mega, hipFuncAttributeMaxDynamicSharedMemorySize, LDS_BYTES);
        (void)hipOccupancyMaxActiveBlocksPerMultiprocessor(&per_cu, (const void*)mega, 512, LDS_BYTES);
        if (per_cu < 1) { fprintf(stderr, "occupancy query says %d blocks/CU\n", per_cu); per_cu = 1; }
        if (per_cu > 1) per_cu = 1;
        grid_blocks = cus * per_cu;
        if (ws_size < WS_END) fprintf(stderr, "workspace too small: %zu < %zu\n", ws_size, (size_t)WS_END);
    }
    Params p{};
    for (int i = 0; i < 26; ++i) p.in[i] = (const float*)d_in[i];
    p.out = (float*)d_out; p.ws = (unsigned char*)d_ws;
    (void)hipMemsetAsync((unsigned char*)d_ws + OFF_BAR, 0, (XCD_BAR_WORDS + 128) * sizeof(unsigned), stream);
    void* args[] = {&p};
    hipError_t e = hipLaunchCooperativeKernel((const void*)mega, dim3(grid_blocks), dim3(512), args, LDS_BYTES, stream);
    if (e != hipSuccess) fprintf(stderr, "cooperative launch failed: %s (grid %d)\n", hipGetErrorString(e), grid_blocks);
}
```

```cpp
#include <hip/hip_runtime.h>
#include <hip/hip_cooperative_groups.h>
#include <cstdio>
namespace cg = cooperative_groups;
namespace pg8 {
#define PG8_LAS __attribute__((address_space(3)))
typedef unsigned short bf16_t;
typedef short bf16x8 __attribute__((ext_vector_type(8)));
typedef float f32x4 __attribute__((ext_vector_type(4)));
typedef unsigned u32x4 __attribute__((ext_vector_type(4)));
constexpr int BM = 256, BK = 64, HALF = 128, HTB = HALF * BK * 2  , STAGE_BYTES = 8 * HTB, NXCD = 8, WGM = 8;

__host__ __device__ __forceinline__ int lds_byte(int r, int c) { const int st = (r >> 4) * 2 + (c >> 5), rr = r & 15, cc = c & 31, ob = rr * 64 + cc * 2; return st * 1024 + (ob ^ (((ob >> 9) & 1) << 5)); }
__host__ __device__ __forceinline__ void stage_rc(int b, int& R, int& C) { const int st = b / 1024, sb = b % 1024, swz = sb ^ (((sb >> 9) & 1) << 5); R = (st >> 1) * 16 + swz / 64; C = (st & 1) * 32 + (swz % 64) / 2; }
__host__ __device__ __forceinline__ int perm32(int rho) { const int n = rho >> 4, i = rho & 15; return 8 * (i >> 2) + 4 * n + (i & 3); }

struct Unit { int pm, pn, kt0, nkt; };
struct Gemm { const bf16_t* A; const bf16_t* Bt; int M, N, K; };

struct StaticOrder {
    int nM, nN, nwg, G, c, nkt_all;
    __host__ __device__ void init(int M, int N, int G_, int c_, int K_ = 0) { nM = M / BM; nN = N / BM; nwg = nM * nN; G = G_; c = c_; nkt_all = K_ / BK; }
    __host__ __device__ bool next(int i, Unit& u) const {
        const long L = (long)i * G + c; if (L >= nwg) return false;
        int wgid = (int)L; { const int q = nwg / NXCD, r = nwg % NXCD, xcd = wgid % NXCD, off = wgid / NXCD; wgid = (xcd < r ? xcd * (q + 1) : r * (q + 1) + (xcd - r) * q) + off; }
        const int nig = WGM * nN, gid = wgid / nig, fm = gid * WGM, gsz = (nM - fm) < WGM ? (nM - fm) : WGM;
        u.pm = fm + ((wgid % nig) % gsz); u.pn = (wgid % nig) / gsz; u.kt0 = 0; u.nkt = nkt_all; return true;
    }
    __device__ __forceinline__ void a_ready(const Unit&) const {}
    __device__ __forceinline__ void done(const Unit&) const {}
};
__device__ __forceinline__ unsigned cvt_pk_bf16(float lo, float hi) { unsigned r; asm volatile("v_cvt_pk_bf16_f32 %0, %1, %2" : "=v"(r) : "v"(lo), "v"(hi)); return r; }
template <class Epi, class Sched, bool STAMP = false>
__device__ __forceinline__ void gemm_phase(PG8_LAS unsigned char* lds, const Gemm g, const Sched& S, const Epi& E, unsigned long long* stamps) {
    int tid_ = threadIdx.x; asm volatile("" : "+v"(tid_)); const int tid = tid_, wid = __builtin_amdgcn_readfirstlane(tid >> 6), lane = tid & 63, wr = wid >> 2, wc = wid & 3, fr = lane & 15, fq = lane >> 4;
    const int K = g.K;
    int ts_lo = 0, ts_hi = 0, nts = 0; const unsigned long long rt_entry = STAMP ? (unsigned long long)wall_clock64() : 0ull;
#define PG8_STAMP() do { if (STAMP && wid == 0 && nts < 64) { const unsigned long long _c = (unsigned long long)clock64(); \
        ts_lo = (lane == nts) ? (int)(unsigned)_c : ts_lo; ts_hi = (lane == nts) ? (int)(unsigned)(_c >> 32) : ts_hi; ++nts; } } while (0)
    PG8_STAMP();
    unsigned voffA[2], voffB[2];
#pragma unroll
    for (int i = 0; i < 2; ++i) { int R, C; stage_rc(tid * 16 + i * 8192, R, C); const int Rb = Epi::PERM ? ((R & ~31) + perm32(R & 31)) : R;
        voffA[i] = (unsigned)(R * K + C) * 2u; voffB[i] = (unsigned)(Rb * K + C) * 2u; }
    const size_t kstep = (size_t)(BK * 2);
    const size_t hstep = (size_t)HALF * K * 2;
    const size_t tstep = 2 * hstep;
    const unsigned ldsw = (unsigned)wid * 1024u;
    const int aoff = lds_byte(wr * 64 + fr, fq * 8), boff = lds_byte(wc * 32 + fr, fq * 8);
#define PG8_SA(b, h) (((b) * 2 + (h)) * HTB)
#define PG8_SB(b, h) ((4 + (b) * 2 + (h)) * HTB)
#define PG8_STAGE(bufoff, gbase, voff) do { _Pragma("unroll") for (int _i = 0; _i < 2; ++_i) \
        __builtin_amdgcn_global_load_lds((const unsigned*)((const char*)(gbase) + (voff)[_i]), (PG8_LAS unsigned*)(lds + (bufoff) + ldsw + _i * 8192), 16, 0, 0); } while (0)
#define PG8_LDA(dst, b, h) do { _Pragma("unroll") for (int m = 0; m < 4; ++m) _Pragma("unroll") for (int k = 0; k < 2; ++k) dst[m][k] = *(const PG8_LAS bf16x8*)(lds + PG8_SA(b, h) + aoff + m * 2048 + k * 1024); } while (0)
#define PG8_LDB(dst, b, h) do { _Pragma("unroll") for (int n = 0; n < 2; ++n) _Pragma("unroll") for (int k = 0; k < 2; ++k) dst[n][k] = *(const PG8_LAS bf16x8*)(lds + PG8_SB(b, h) + boff + n * 2048 + k * 1024); } while (0)
#define PG8_MMA(ai, bj, At, Bt) do { __builtin_amdgcn_s_setprio(1); _Pragma("unroll") for (int m = 0; m < 4; ++m) _Pragma("unroll") for (int n = 0; n < 2; ++n) _Pragma("unroll") for (int k = 0; k < 2; ++k) \
        acc[ai][bj][m][n] = __builtin_amdgcn_mfma_f32_16x16x32_bf16(Bt[n][k], At[m][k], acc[ai][bj][m][n], 0, 0, 0); __builtin_amdgcn_s_setprio(0); } while (0)
#define PG8_WAIT_V(n) asm volatile("s_waitcnt vmcnt(" #n ")" ::: "memory")
#define PG8_WAIT_L(n) asm volatile("s_waitcnt lgkmcnt(" #n ")" ::: "memory")
#define PG8_BAR __builtin_amdgcn_s_barrier()
#define PG8_SCHED __builtin_amdgcn_sched_barrier(0)
    Unit cur, nxt; int ui = 0;
    if (!S.next(0, cur)) return;
    f32x4 acc[2][2][4][2];
#pragma unroll
    for (int a = 0; a < 2; ++a)
#pragma unroll
        for (int b = 0; b < 2; ++b)
#pragma unroll
            for (int m = 0; m < 4; ++m)
#pragma unroll
                for (int n = 0; n < 2; ++n) acc[a][b][m][n] = (f32x4){0.f, 0.f, 0.f, 0.f};
    bf16x8 At[4][2], B0[2][2], B1[2][2];
    const char* cA = (const char*)g.A + (size_t)cur.pm * tstep + (size_t)cur.kt0 * kstep; const char* cB = (const char*)g.Bt + (size_t)cur.pn * tstep + (size_t)cur.kt0 * kstep;
    S.a_ready(cur);
    PG8_STAGE(PG8_SB(0, 0), cB, voffB); PG8_STAGE(PG8_SA(0, 0), cA, voffA); PG8_STAGE(PG8_SB(0, 1), cB + hstep, voffB); PG8_STAGE(PG8_SA(0, 1), cA + hstep, voffA);
    if (wr == 1) PG8_BAR;
    PG8_WAIT_V(4); PG8_BAR;
    PG8_STAGE(PG8_SB(1, 0), cB + kstep, voffB); PG8_STAGE(PG8_SA(1, 0), cA + kstep, voffA); PG8_STAGE(PG8_SB(1, 1), cB + hstep + kstep, voffB);
    PG8_WAIT_V(6); PG8_BAR;
    PG8_STAMP();
    for (;;) {
        const bool has_next = S.next(ui + 1, nxt);
        const char* nA = has_next ? (const char*)g.A + (size_t)nxt.pm * tstep + (size_t)nxt.kt0 * kstep : cA; const char* nB = has_next ? (const char*)g.Bt + (size_t)nxt.pn * tstep + (size_t)nxt.kt0 * kstep : cB;
        const int nt = cur.nkt;
        for (int t = 0; t < nt; t += 2) {
            const bool last = (t == nt - 2);
            const char* a1 = cA + (size_t)(t + 1) * kstep;
            const char* a2 = last ? nA : cA + (size_t)(t + 2) * kstep; const char* b2 = last ? nB : cB + (size_t)(t + 2) * kstep;
            const char* a3 = a2 + kstep; const char* b3 = b2 + kstep;
            if (last && has_next) S.a_ready(nxt);
            PG8_LDB(B0, 0, 0); PG8_SCHED; PG8_LDA(At, 0, 0); PG8_STAGE(PG8_SA(1, 1), a1 + hstep, voffA);
            PG8_WAIT_L(8); PG8_BAR; PG8_WAIT_L(0); PG8_MMA(0, 0, At, B0); PG8_BAR; PG8_SCHED;
            PG8_LDB(B1, 0, 1); PG8_STAGE(PG8_SB(0, 0), b2, voffB);
            PG8_BAR; PG8_WAIT_L(0); PG8_MMA(0, 1, At, B1); PG8_BAR;
            PG8_LDA(At, 0, 1); PG8_STAGE(PG8_SA(0, 0), a2, voffA);
            PG8_BAR; PG8_WAIT_L(0); PG8_MMA(1, 0, At, B0); PG8_BAR; PG8_SCHED;
            PG8_STAGE(PG8_SB(0, 1), b2 + hstep, voffB);
            PG8_WAIT_V(6); PG8_BAR; PG8_MMA(1, 1, At, B1); PG8_BAR;
            PG8_LDB(B0, 1, 0); PG8_SCHED; PG8_LDA(At, 1, 0); PG8_STAGE(PG8_SA(0, 1), a2 + hstep, voffA);
            PG8_WAIT_L(8); PG8_BAR; PG8_WAIT_L(0); PG8_MMA(0, 0, At, B0); PG8_BAR; PG8_SCHED;
            PG8_LDB(B1, 1, 1); PG8_STAGE(PG8_SB(1, 0), b3, voffB);
            PG8_BAR; PG8_WAIT_L(0); PG8_MMA(0, 1, At, B1); PG8_BAR;
            PG8_LDA(At, 1, 1); PG8_STAGE(PG8_SA(1, 0), a3, voffA);
            PG8_BAR; PG8_WAIT_L(0); PG8_MMA(1, 0, At, B0); PG8_BAR; PG8_SCHED;
            PG8_STAGE(PG8_SB(1, 1), b3 + hstep, voffB);
            PG8_WAIT_V(6); PG8_BAR; PG8_MMA(1, 1, At, B1); PG8_BAR;
        }
        PG8_STAMP();
        if constexpr (!Epi::AFTER_DRAIN) { E(acc, cur, wr, wc, fr, fq); S.done(cur); }
        PG8_STAMP();
        if (!has_next) break;
#pragma unroll
        for (int a = 0; a < 2; ++a)
#pragma unroll
            for (int b = 0; b < 2; ++b)
#pragma unroll
                for (int m = 0; m < 4; ++m)
#pragma unroll
                    for (int n = 0; n < 2; ++n) acc[a][b][m][n] = (f32x4){0.f, 0.f, 0.f, 0.f};
        cur = nxt; cA = nA; cB = nB; ++ui;
    }
    PG8_WAIT_V(0);
    if (wr == 0) PG8_BAR;
    PG8_BAR;
    if constexpr (Epi::AFTER_DRAIN) { E.fused(acc, cur, wr, wc, fr, fq, lds, wid, lane); S.done(cur); }
    PG8_STAMP();
    if (STAMP && wid == 0) { stamps[lane] = lane < nts ? (((unsigned long long)(unsigned)ts_hi << 32) | (unsigned)ts_lo) : 0ull;
        if (lane == 62) stamps[62] = rt_entry; if (lane == 63) stamps[63] = (unsigned long long)wall_clock64(); }
#undef PG8_STAMP
#undef PG8_SA
#undef PG8_SB
#undef PG8_STAGE
#undef PG8_LDA
#undef PG8_LDB
#undef PG8_MMA
#undef PG8_WAIT_V
#undef PG8_WAIT_L
#undef PG8_BAR
#undef PG8_SCHED
}
}

#define XB_TMO      128
#define XB_XCNT(j)  (256  + 64 * (j))
#define XB_XSUB(j)  (1280 + 64 * (j))
#define XB_XGEN(j)  (2304 + 64 * (j))
#define XB_TOP      3328
#define XB_TOPGEN   3392
#define XCD_BAR_WORDS 3456
#define XB_SPIN_CAP (1u << 18)
#define LAS __attribute__((address_space(3)))

__device__ __forceinline__ unsigned xb_ld(unsigned* p)              { return __hip_atomic_load(p, __ATOMIC_RELAXED, __HIP_MEMORY_SCOPE_AGENT); }
__device__ __forceinline__ unsigned xb_add(unsigned* p, unsigned v) { return __hip_atomic_fetch_add(p, v, __ATOMIC_RELAXED, __HIP_MEMORY_SCOPE_AGENT); }
__device__ __forceinline__ unsigned xb_xcc_id() { return (unsigned)__builtin_amdgcn_s_getreg((3 << 11) | 20) & 0xFu; }
#define XB_SPIN(cond, bar) do { unsigned _sp = 0; while (cond) { __builtin_amdgcn_s_sleep(1); \
    if ((++_sp & 255u) == 0u) { if (xb_ld(&(bar)[XB_TMO])) break; if (_sp > XB_SPIN_CAP) { atomicAdd(&(bar)[XB_TMO], 1u); break; } } } } while (0)

struct XcdBarrier {
    unsigned* bar; unsigned x;
    volatile LAS unsigned* st;
};

__device__ __forceinline__ XcdBarrier xcd_barrier_post(unsigned* bar, volatile LAS unsigned* st) {
    XcdBarrier b; b.bar = bar; b.x = xb_xcc_id(); b.st = st;
    if (threadIdx.x == 0) (void)xb_add(&bar[XB_XCNT(b.x)], 1u);
    return b;
}
__device__ __forceinline__ void xcd_barrier_complete(unsigned* bar, unsigned x, unsigned& nloc, unsigned& nx) {
    const unsigned G = gridDim.x * gridDim.y * gridDim.z;
    unsigned sum, cnt, mine, sp = 0u;
    for (;;) {
        sum = 0u; cnt = 0u; mine = 0u;
#pragma unroll
        for (unsigned j = 0; j < 16; ++j) { const unsigned c = xb_ld(&bar[XB_XCNT(j)]); sum += c; cnt += (c > 0u) ? 1u : 0u; mine = (j == x) ? c : mine; }
        if (sum == G) break;
        __builtin_amdgcn_s_sleep(1);
        if ((++sp & 255u) == 0u) { if (xb_ld(&bar[XB_TMO])) break; if (sp > XB_SPIN_CAP) { atomicAdd(&bar[XB_TMO], 1u); break; } }
    }
    nloc = mine > 0u ? mine : 1u; nx = cnt > 0u ? cnt : 1u;
}

__device__ __attribute__((noinline)) void xcd_barrier_impl(unsigned* bar_, unsigned x_, volatile LAS unsigned* st_) {
    XcdBarrier b; b.bar = bar_; b.x = x_; b.st = st_;
    asm volatile("s_waitcnt vmcnt(0)" ::: "memory");
    __syncthreads();
    if (threadIdx.x == 0) {
        unsigned* bar = b.bar;
        __builtin_amdgcn_s_waitcnt(0);
        unsigned nloc = b.st[0], nx = b.st[1];
        if (nloc == 0u) { xcd_barrier_complete(bar, b.x, nloc, nx); b.st[0] = nloc; b.st[1] = nx; }
        const unsigned old = xb_add(&bar[XB_XSUB(b.x)], 1u);
        const unsigned gen = old / nloc;
        if (old + 1u == (gen + 1u) * nloc) {
            __builtin_amdgcn_fence(__ATOMIC_RELEASE, "agent");
            asm volatile("s_waitcnt vmcnt(0)" ::: "memory");
            const unsigned og = xb_add(&bar[XB_TOP], 1u);
            const unsigned tg = og / nx;
            if (og + 1u == (tg + 1u) * nx) xb_add(&bar[XB_TOPGEN], 1u);
            else XB_SPIN(xb_ld(&bar[XB_TOPGEN]) == tg, bar);
            __builtin_amdgcn_fence(__ATOMIC_ACQUIRE, "agent");
            xb_add(&bar[XB_XGEN(b.x)], 1u);
            asm volatile("s_waitcnt vmcnt(0)" ::: "memory");
        } else {
            XB_SPIN(xb_ld(&bar[XB_XGEN(b.x)]) == gen, bar);
            __builtin_amdgcn_fence(__ATOMIC_ACQUIRE, "agent");
            asm volatile("s_waitcnt vmcnt(0)" ::: "memory");
        }
    }
    __syncthreads();
}

__device__ __forceinline__ void xcd_barrier(const XcdBarrier& b) { xcd_barrier_impl(b.bar, b.x, b.st); }

typedef unsigned short u16;
using pg8::bf16x8; using pg8::f32x4;
typedef unsigned u32x2 __attribute__((ext_vector_type(2)));
typedef unsigned u32x4v __attribute__((ext_vector_type(4)));

constexpr int DM = 1024, NB = 4, SEQ = 4096, CTXL = 256, RL = NB * SEQ, RC = NB * CTXL, RT = RL + RC;
constexpr int DFF = 2816, NMOD = 6;
constexpr int P0_LD = 2592;
constexpr int P0_K = 0, P0_V = 256, P0_LR = 768, P0_Q = 800, P0_R = 1056, P0_U = 1568, P0_G = 2080;
constexpr int XBC_LD = 3072;
constexpr float EPS = 1e-6f;

constexpr size_t OFF_MOD = 0;
constexpr size_t OFF_A = 262144;
constexpr size_t A_AB_IN = OFF_A, A_AB_OUT = A_AB_IN + (size_t)2816 * 1024 * 2, A_FF_IN0 = A_AB_OUT + (size_t)1024 * 1024 * 2, A_FF_OUT0 = A_FF_IN0 + (size_t)5632 * 1024 * 2;
constexpr size_t A_END = A_FF_OUT0 + (size_t)1024 * 2816 * 2;
constexpr size_t A_DTRAW = OFF_A, A_HALO = A_DTRAW + (size_t)RT * 64 * 4;
constexpr size_t A_SSD_OUT = OFF_A, A_FF_IN1 = A_SSD_OUT + (size_t)1024 * 2048 * 2, A_FF_OUT1 = A_FF_IN1 + (size_t)5632 * 1024 * 2;
constexpr size_t OFF_B = A_END;
constexpr size_t B_SSD_INA = OFF_B, B_WZ = B_SSD_INA + (size_t)3328 * 1024 * 2, B_END = B_WZ + (size_t)2048 * 1024 * 2;
constexpr size_t OFF_XC = B_END;
constexpr size_t OFF_H = OFF_XC + (size_t)RC * DM * 4;
constexpr size_t OFF_DSC = OFF_H + (size_t)RT * DM * 2;
constexpr size_t OFF_DEC = OFF_DSC + (size_t)4 * 2 * 4 * 4 * 8192 * 4;
constexpr size_t OFF_E = OFF_DEC + (size_t)4 * 2 * 4 * 68 * 64 * 4;
constexpr size_t E_P0 = OFF_E, E_ACT = OFF_E, E_XBC = OFF_E, E_Z = OFF_E;
constexpr size_t E_Y = OFF_E + (size_t)RT * XBC_LD * 2;
constexpr size_t T_DT = E_Y + (size_t)RL * 2048 * 2, T_ACUM = T_DT + (size_t)RT * 64 * 4;
constexpr size_t WS_END = T_ACUM + (size_t)RT * 64 * 4;
constexpr size_t E_PART = OFF_E + (size_t)100 * 1024 * 1024;
constexpr size_t A_CB = OFF_A;
static_assert(A_HALO + (size_t)272 * 4 * 3072 * 2 <= A_END && A_FF_OUT1 + (size_t)1024 * 2816 * 2 <= A_END && A_CB + (size_t)512 * 16384 * 2 <= A_END, "region A overflow");
static_assert(WS_END <= (size_t)256 * 1024 * 1024, "workspace over 256 MiB");

constexpr int LDS_BYTES = 144 * 1024;
constexpr int LDS_XB = LDS_BYTES - 16;
constexpr size_t OFF_BAR = 245760;

struct Params { const float* in[26]; float* out; unsigned char* ws; };
enum { I_X = 0, I_C, I_CTX, I_CCTX, I_MODW, I_MODB, I_NORMG, I_FFWIN, I_FFWOUT, I_ABWIN, I_ABGW, I_ABGB, I_ABGNG, I_ABVNG, I_ABSW, I_ABSB, I_ABWOUT,
       I_SSDWIN, I_SSDCW, I_SSDCB, I_SSDDTB, I_SSDALOG, I_SSDD, I_SSDNG, I_SSDWOUT, I_FNG };

__device__ __forceinline__ u16 f2bf(float f) { return __builtin_bit_cast(u16, (__bf16)f); }
__device__ __forceinline__ float bf2f(unsigned b) { return __uint_as_float(b << 16); }
typedef float f32x2v __attribute__((ext_vector_type(2)));
typedef __bf16 bf16x2v __attribute__((ext_vector_type(2)));
__device__ __forceinline__ unsigned pk2(float lo, float hi) { const f32x2v v = {lo, hi}; return __builtin_bit_cast(unsigned, __builtin_convertvector(v, bf16x2v)); }
__device__ __forceinline__ float bflo(unsigned w) { return __uint_as_float(w << 16); }
__device__ __forceinline__ float bfhi(unsigned w) { return __uint_as_float(w & 0xFFFF0000u); }
__device__ __forceinline__ float siluf(float x) { return x * __builtin_amdgcn_rcpf(1.0f + __expf(-x)); }
__device__ __forceinline__ float geluf(float x) { const float y = 0.7978845608028654f * (x + 0.044715f * x * x * x); const float th = 1.0f - 2.0f * __builtin_amdgcn_rcpf(1.0f + __expf(2.0f * y)); return 0.5f * x * (1.0f + th); }
__device__ __forceinline__ float softplusf(float x) { return fmaxf(x, 0.f) + log1pf(__expf(-fabsf(x))); }
__device__ __forceinline__ float logsigmoidf(float x) { return fminf(x, 0.f) - __logf(1.0f + __expf(-fabsf(x))); }
__device__ __forceinline__ float wave_sum(float v) {
#pragma unroll
    for (int o = 32; o > 0; o >>= 1) v += __shfl_xor(v, o, 64);
    return v;
}

template <int MT, int NT>
__device__ __forceinline__ void wave_mma(f32x4 (&acc)[MT][NT], const u16* A, int lda, const u16* B, int ldb, int ksteps) {
    const int lane = threadIdx.x & 63, fr = lane & 15, fq = lane >> 4;
    const u16* ap = A + fr * lda + fq * 8; const u16* bp = B + fr * ldb + fq * 8;
    for (int k = 0; k < ksteps; ++k) {
        bf16x8 a[MT], b[NT];
#pragma unroll
        for (int i = 0; i < MT; ++i) a[i] = *(const bf16x8*)(ap + i * 16 * lda + k * 32);
#pragma unroll
        for (int i = 0; i < NT; ++i) b[i] = *(const bf16x8*)(bp + i * 16 * ldb + k * 32);
#pragma unroll
        for (int i = 0; i < MT; ++i)
#pragma unroll
            for (int j = 0; j < NT; ++j) acc[i][j] = __builtin_amdgcn_mfma_f32_16x16x32_bf16(a[i], b[j], acc[i][j], 0, 0, 0);
    }
}
template <int MT, int NT> __device__ __forceinline__ void zero_acc(f32x4 (&acc)[MT][NT]) {
#pragma unroll
    for (int i = 0; i < MT; ++i)
#pragma unroll
        for (int j = 0; j < NT; ++j) acc[i][j] = (f32x4){0.f, 0.f, 0.f, 0.f};
}

__device__ __forceinline__ u32x4v pack8(const f32x4& a, const f32x4& b) { u32x4v r; r[0] = pk2(a[0], a[1]); r[1] = pk2(a[2], a[3]); r[2] = pk2(b[0], b[1]); r[3] = pk2(b[2], b[3]); return r; }

struct EpiBf16Plain {
    static constexpr bool PERM = true, AFTER_DRAIN = false;
    u16* O; int ld; int ncols;
    __device__ __forceinline__ void operator()(const f32x4 (&acc)[2][2][4][2], const pg8::Unit& u, int wr, int wc, int fr, int fq) const {
        const int row0 = u.pm * 256 + wr * 64 + fr, col0 = u.pn * 256 + wc * 32 + 8 * fq;
#pragma unroll
        for (int ai = 0; ai < 2; ++ai)
#pragma unroll
            for (int m = 0; m < 4; ++m) { const int row = row0 + ai * 128 + m * 16;
#pragma unroll
                for (int bj = 0; bj < 2; ++bj) { const int c = col0 + bj * 128; if (c < ncols) *(u32x4v*)(O + (size_t)row * ld + c) = pack8(acc[ai][bj][m][0], acc[ai][bj][m][1]); } }
    }
};
struct EpiSwiglu {
    static constexpr bool PERM = true, AFTER_DRAIN = false;
    u16* O;
    __device__ __forceinline__ void operator()(const f32x4 (&acc)[2][2][4][2], const pg8::Unit& u, int wr, int wc, int fr, int fq) const {
        const int row0 = u.pm * 256 + wr * 64 + fr, j0 = u.pn * 128 + wc * 32 + 8 * fq;
#pragma unroll
        for (int ai = 0; ai < 2; ++ai)
#pragma unroll
            for (int m = 0; m < 4; ++m) { const int row = row0 + ai * 128 + m * 16; f32x4 o0, o1;
#pragma unroll
                for (int i = 0; i < 4; ++i) { o0[i] = siluf(acc[ai][0][m][0][i]) * acc[ai][1][m][0][i]; o1[i] = siluf(acc[ai][0][m][1][i]) * acc[ai][1][m][1][i]; }
                *(u32x4v*)(O + (size_t)row * DFF + j0) = pack8(o0, o1); }
    }
};
struct EpiSsdIn {
    static constexpr bool PERM = true, AFTER_DRAIN = false;
    u16* XBC; u16* HALO; float* DTRAW;
    __device__ __forceinline__ void operator()(const f32x4 (&acc)[2][2][4][2], const pg8::Unit& u, int wr, int wc, int fr, int fq) const {
        const int row0 = u.pm * 256 + wr * 64 + fr, col0 = u.pn * 256 + wc * 32 + 8 * fq;
#pragma unroll
        for (int ai = 0; ai < 2; ++ai)
#pragma unroll
            for (int m = 0; m < 4; ++m) { const int row = row0 + ai * 128 + m * 16; const int rr = row & 63; const int slot = rr < 2 ? rr : (rr >= 62 ? rr - 60 : -1);
#pragma unroll
                for (int bj = 0; bj < 2; ++bj) { const int c = col0 + bj * 128;
                    if (c < 3072) { const u32x4v v = pack8(acc[ai][bj][m][0], acc[ai][bj][m][1]); *(u32x4v*)(XBC + (size_t)row * XBC_LD + c) = v;
                        if (slot >= 0) *(u32x4v*)(HALO + ((size_t)(row >> 6) * 4 + slot) * XBC_LD + c) = v; }
                    else if (c < 3136) { float* d = DTRAW + (size_t)row * 64 + (c - 3072); *(f32x4*)d = acc[ai][bj][m][0]; *(f32x4*)(d + 4) = acc[ai][bj][m][1]; } } }
    }
};
struct EpiRes {
    static constexpr bool PERM = false, AFTER_DRAIN = false;
    const float* src_lat; const float* src_ctx; float* dst_lat; float* dst_ctx; const float* gate; int cm; float* part;
    __device__ __forceinline__ void operator()(const f32x4 (&acc)[2][2][4][2], const pg8::Unit& u, int wr, int wc, int fr, int fq) const {
        const int row0 = u.pm * 256 + wr * 64 + fr, col0 = u.pn * 256 + wc * 32 + 4 * fq;
#pragma unroll
        for (int ai = 0; ai < 2; ++ai)
#pragma unroll
            for (int m = 0; m < 4; ++m) { const int row = row0 + ai * 128 + m * 16; const float* s; float* d; int mi;
                if (row < RL) { const int xr = cm ? ((row & ~4095) | ((row & 63) << 6) | ((row >> 6) & 63)) : row; s = src_lat + (size_t)xr * DM; d = dst_lat + (size_t)xr * DM; mi = row >> 12; }
                else { s = src_ctx + (size_t)(row - RL) * DM; d = dst_ctx + (size_t)(row - RL) * DM; mi = 4; }
                const float* gt = gate + mi * (NMOD * DM);
                if (part != nullptr && row >= RL) { float* pd = part + ((size_t)(u.kt0 >> 2) * RC + (row - RL)) * DM;
#pragma unroll
                    for (int bj = 0; bj < 2; ++bj)
#pragma unroll
                        for (int n = 0; n < 2; ++n) { const int c = col0 + bj * 128 + n * 16; *(f32x4*)(pd + c) = acc[ai][bj][m][n]; }
                    continue; }
#pragma unroll
                for (int bj = 0; bj < 2; ++bj)
#pragma unroll
                    for (int n = 0; n < 2; ++n) { const int c = col0 + bj * 128 + n * 16; const f32x4 g4 = *(const f32x4*)(gt + c), x4 = *(const f32x4*)(s + c);
                        *(f32x4*)(d + c) = x4 + g4 * acc[ai][bj][m][n]; } }
    }
};

template <class Epi> __device__ __forceinline__ void run_gemm(unsigned char* shm, const u16* A, const u16* Bt, int M, int N, int K, const Epi& E) {
    pg8::Gemm g; g.A = A; g.Bt = Bt; g.M = M; g.N = N; g.K = K;
    pg8::StaticOrder S; S.init(M, N, (int)gridDim.x, (int)blockIdx.x, K);
    pg8::gemm_phase<Epi, pg8::StaticOrder, false>((PG8_LAS unsigned char*)shm, g, S, E, nullptr);
}

struct SplitOrder {
    pg8::StaticOrder lat; int nlat, nsl, nctx, G, c, nN;
    __device__ void init(int N, int K, int G_, int c_) { lat.init(RL, N, G_, c_, K); nlat = lat.nwg; nN = N / 256; nsl = (K / 64) / 4; nctx = (RC / 256) * nN * nsl; G = G_; c = c_; }
    __device__ bool next(int i, pg8::Unit& u) const {
        const long L = (long)i * G + c; if (L < nlat) return lat.next(i, u);
        const int j = (int)(L - nlat); if (j >= nctx) return false;
        const int sl = j % nsl, tile = j / nsl; u.pm = RL / 256 + tile / nN; u.pn = tile % nN; u.kt0 = sl * 4; u.nkt = 4; return true; }
    __device__ __forceinline__ void a_ready(const pg8::Unit&) const {}
    __device__ __forceinline__ void done(const pg8::Unit&) const {}
};
template <class Epi> __device__ __forceinline__ void run_gemm_split(unsigned char* shm, const u16* A, const u16* Bt, int N, int K, const Epi& E) {
    pg8::Gemm g; g.A = A; g.Bt = Bt; g.M = RT; g.N = N; g.K = K;
    SplitOrder S; S.init(N, K, (int)gridDim.x, (int)blockIdx.x);
    pg8::gemm_phase<Epi, SplitOrder, false>((PG8_LAS unsigned char*)shm, g, S, E, nullptr);
}

__device__ __forceinline__ int wcol(int r, int N, int mode) {
    if (mode == 0) return r < N ? r : -1;
    if (mode == 1) { const int q = r >> 8, s = (r >> 7) & 1, i = r & 127; return s * DFF + 128 * q + i; }
    if (mode == 2) return r + 3136;
    return r < 3136 ? r : -1;
}
__device__ __forceinline__ void convert_tile(unsigned char* shm, const float* src, u16* dst, int K, int N, int mode, int ti) {
    u16* tile = (u16*)shm;
    const int t = threadIdx.x, rl = t & 63, k0 = t >> 6, r2 = t >> 3, kk = (t & 7) * 8;
    const int nkt = K >> 7, rb = (ti / nkt) << 6, kb = (ti % nkt) << 7;
    const int col = wcol(rb + rl, N, mode);
    const float* sp = src + (size_t)(kb + k0) * N + (col >= 0 ? col : 0);
    float v[16];
#pragma unroll
    for (int i = 0; i < 16; ++i) v[i] = sp[(size_t)(8 * i) * N];
#pragma unroll
    for (int i = 0; i < 16; ++i) tile[rl * 136 + k0 + 8 * i] = f2bf(col >= 0 ? v[i] : 0.f);
    __syncthreads();
    *(u32x4v*)(dst + (size_t)(rb + r2) * K + kb + kk) = *(const u32x4v*)(tile + r2 * 136 + kk);
    *(u32x4v*)(dst + (size_t)(rb + r2) * K + kb + 64 + kk) = *(const u32x4v*)(tile + r2 * 136 + 64 + kk);
    __syncthreads();
}
constexpr int wtiles(int NR, int K) { return (NR / 64) * (K / 128); }
__device__ void convert_weights_early(unsigned char* shm, const Params& p) {
    unsigned char* ws = p.ws;
    constexpr int T0 = wtiles(5632, 1024), T1 = wtiles(1024, 2816), T2 = wtiles(3328, 1024), T3 = wtiles(2816, 1024), T4 = wtiles(2048, 1024), T5 = wtiles(1024, 1024);
    for (int gi = blockIdx.x; gi < T0 + T1 + T2 + T3 + T4 + T5; gi += gridDim.x) {
        int ti = gi;
        if (ti < T0) { convert_tile(shm, p.in[I_FFWIN], (u16*)(ws + A_FF_IN0), 1024, 5632, 1, ti); continue; } ti -= T0;
        if (ti < T1) { convert_tile(shm, p.in[I_FFWOUT], (u16*)(ws + A_FF_OUT0), 2816, 1024, 0, ti); continue; } ti -= T1;
        if (ti < T2) { convert_tile(shm, p.in[I_SSDWIN], (u16*)(ws + B_SSD_INA), 1024, 5184, 3, ti); continue; } ti -= T2;
        if (ti < T3) { convert_tile(shm, p.in[I_ABWIN], (u16*)(ws + A_AB_IN), 1024, 2592, 0, ti); continue; } ti -= T3;
        if (ti < T4) { convert_tile(shm, p.in[I_SSDWIN], (u16*)(ws + B_WZ), 1024, 5184, 2, ti); continue; } ti -= T4;
        convert_tile(shm, p.in[I_ABWOUT], (u16*)(ws + A_AB_OUT), 1024, 1024, 0, ti);
    }
}
__device__ void convert_weights_late(unsigned char* shm, const Params& p) {
    unsigned char* ws = p.ws;
    constexpr int T0 = wtiles(5632, 1024), T1 = wtiles(1024, 2816), T2 = wtiles(1024, 2048);
    for (int gi = blockIdx.x; gi < T0 + T1 + T2; gi += gridDim.x) {
        int ti = gi;
        if (ti < T0) { convert_tile(shm, p.in[I_FFWIN] + (size_t)1024 * 5632, (u16*)(ws + A_FF_IN1), 1024, 5632, 1, ti); continue; } ti -= T0;
        if (ti < T1) { convert_tile(shm, p.in[I_FFWOUT] + (size_t)2816 * 1024, (u16*)(ws + A_FF_OUT1), 2816, 1024, 0, ti); continue; } ti -= T1;
        convert_tile(shm, p.in[I_SSDWOUT], (u16*)(ws + A_SSD_OUT), 2048, 1024, 0, ti);
    }
}
__device__ void mod_gemv(unsigned char* shm, const Params& p) {
    float* sc = (float*)shm;
    float* red = sc + 5 * 1024;
    const int t = threadIdx.x;
    for (int i = t; i < 5 * 1024; i += 512) { const float v = i < 4096 ? p.in[I_C][i] : p.in[I_CCTX][i - 4096]; sc[i] = siluf(v); }
    __syncthreads();
    float* MOD = (float*)(p.ws + OFF_MOD);
    const int n = t & 31, kc = t >> 5;
    for (int job = blockIdx.x; job < 2 * 192; job += gridDim.x) {
        const int l = job / 192, nb = (job % 192) * 32;
        const float* W = p.in[I_MODW] + (size_t)l * DM * (NMOD * DM) + nb + n;
        float a[5] = {0.f, 0.f, 0.f, 0.f, 0.f};
#pragma unroll 16
        for (int i = 0; i < 64; ++i) { const int k = kc + 16 * i; const float w = W[(size_t)k * (NMOD * DM)];
#pragma unroll
            for (int m = 0; m < 5; ++m) a[m] += sc[m * 1024 + k] * w; }
#pragma unroll
        for (int m = 0; m < 5; ++m) red[(kc * 5 + m) * 32 + n] = a[m];
        __syncthreads();
        if (t < 160) { const int m = t >> 5; float s = 0.f;
#pragma unroll
            for (int q = 0; q < 16; ++q) s += red[(q * 5 + m) * 32 + n];
            MOD[((size_t)l * 5 + m) * (NMOD * DM) + nb + n] = s + p.in[I_MODB][(size_t)l * (NMOD * DM) + nb + n]; }
        __syncthreads();
    }
}

__device__ void norm_mod_phase(const float* lat, const float* ctx, const float* ng, const float* modl  , int ishift, int iscale, int nrows, int cm, u16* H, const float* part = nullptr, int nsl = 0, const float* pgate = nullptr, float* xc_out = nullptr) {
    const int lane = threadIdx.x & 63, wid = threadIdx.x >> 6;
    for (int row = blockIdx.x * 8 + wid; row < nrows; row += gridDim.x * 8) {
        const float* s = row < RL ? lat + (size_t)row * DM : ctx + (size_t)(row - RL) * DM;
        const int mi = row < RL ? (row >> 12) : 4;
        f32x4 v[4], pg[4], psh[4], psc[4]; float ss = 0.f;
        const float* sh = modl + mi * (NMOD * DM) + ishift * DM; const float* scp = modl + mi * (NMOD * DM) + iscale * DM;
#pragma unroll
        for (int i = 0; i < 4; ++i) v[i] = *(const f32x4*)(s + i * 256 + lane * 4);
#pragma unroll
        for (int i = 0; i < 4; ++i) { const int c = i * 256 + lane * 4; pg[i] = *(const f32x4*)(ng + c); psh[i] = *(const f32x4*)(sh + c); psc[i] = *(const f32x4*)(scp + c); }
#pragma unroll
        for (int i = 0; i < 4; ++i) ss += v[i][0] * v[i][0] + v[i][1] * v[i][1] + v[i][2] * v[i][2] + v[i][3] * v[i][3];
        if (part != nullptr && row >= RL) {
            ss = 0.f;
#pragma unroll
            for (int i = 0; i < 4; ++i) { const int c = i * 256 + lane * 4; f32x4 a = {0.f, 0.f, 0.f, 0.f};
                for (int sl = 0; sl < nsl; ++sl) a += *(const f32x4*)(part + ((size_t)sl * RC + (row - RL)) * DM + c);
                v[i] += *(const f32x4*)(pgate + c) * a; *(f32x4*)(xc_out + (size_t)(row - RL) * DM + c) = v[i];
                ss += v[i][0] * v[i][0] + v[i][1] * v[i][1] + v[i][2] * v[i][2] + v[i][3] * v[i][3]; } }
        ss = wave_sum(ss);
        const float rs = rsqrtf(ss * (1.0f / DM) + EPS);
        const int dr = (cm && row < RL) ? ((row & ~4095) | ((row & 63) << 6) | ((row >> 6) & 63)) : row;
#pragma unroll
        for (int i = 0; i < 4; ++i) { const int c = i * 256 + lane * 4; const f32x4 g4 = pg[i], sh4 = psh[i], sc4 = psc[i];
            float o[4];
#pragma unroll
            for (int e = 0; e < 4; ++e) o[e] = (v[i][e] * rs * g4[e]) * (1.0f + sc4[e]) + sh4[e];
            u32x2 w; w[0] = pk2(o[0], o[1]); w[1] = pk2(o[2], o[3]); *(u32x2*)(H + (size_t)dr * DM + c) = w; }
    }
}
__device__ void final_norm_phase(float* X, const float* g) {
    const int lane = threadIdx.x & 63, wid = threadIdx.x >> 6;
    for (int row = blockIdx.x * 8 + wid; row < RL; row += gridDim.x * 8) {
        float* s = X + (size_t)row * DM; f32x4 v[4]; float ss = 0.f;
#pragma unroll
        for (int i = 0; i < 4; ++i) { v[i] = *(const f32x4*)(s + i * 256 + lane * 4); ss += v[i][0] * v[i][0] + v[i][1] * v[i][1] + v[i][2] * v[i][2] + v[i][3] * v[i][3]; }
        ss = wave_sum(ss);
        const float rs = rsqrtf(ss * (1.0f / DM) + EPS);
#pragma unroll
        for (int i = 0; i < 4; ++i) { const int c = i * 256 + lane * 4; const f32x4 g4 = *(const f32x4*)(g + c); f32x4 o;
#pragma unroll
            for (int e = 0; e < 4; ++e) o[e] = (v[i][e] * rs) * g4[e];
            *(f32x4*)(s + c) = o; }
    }
}

__device__ __forceinline__ int gla_rowbase(int b, int c) { return c < 4 ? RL + b * CTXL + c * 64 : b * SEQ + (c - 4) * 64; }
__device__ __forceinline__ float* gla_ds_ptr(const Params& p, int b, int d, int h, int c) {
    return c < 4 ? (float*)(p.ws + OFF_DSC) + ((size_t)((b * 2 + d) * 4 + h) * 4 + c) * 8192 : p.out + ((size_t)((b * 2 + d) * 4 + h) * 64 + (c - 4)) * 8192;
}
constexpr int GL_BC = 0;
constexpr int GL_LR = GL_BC + 2 * 64 * 65 * 4;
constexpr int GL_GW = GL_LR + 64 * 32 * 4;
constexpr int GL_X0 = GL_GW + 2 * 16 * 64 * 4;
constexpr int GL_LD = 72;

__device__ void gla_gates(unsigned char* shm, const Params& p, int rowbase, int h) {
    const u16* P0 = (const u16*)(p.ws + E_P0);
    float* BC = (float*)(shm + GL_BC); float* LR = (float*)(shm + GL_LR); float* QS = (float*)(shm + GL_GW);
    const int t = threadIdx.x;
    const int kk = t & 63, lq = (t >> 6) & 3, d = t >> 8;
    float gw[16];
#pragma unroll
    for (int j = 0; j < 16; ++j) gw[j] = p.in[I_ABGW][(size_t)(d * 16 + j) * 256 + h * 64 + kk];
    const float gb = p.in[I_ABGB][d * 256 + h * 64 + kk];
    if (t < 256) { const int row = t >> 2, part = t & 3; const u32x4v w = *(const u32x4v*)(P0 + (size_t)(rowbase + row) * P0_LD + P0_LR + part * 8);
        f32x4 lo, hi; lo[0] = bflo(w[0]); lo[1] = bfhi(w[0]); lo[2] = bflo(w[1]); lo[3] = bfhi(w[1]); hi[0] = bflo(w[2]); hi[1] = bfhi(w[2]); hi[2] = bflo(w[3]); hi[3] = bfhi(w[3]);
        *(f32x4*)(LR + row * 32 + part * 8) = lo; *(f32x4*)(LR + row * 32 + part * 8 + 4) = hi; }
    __syncthreads();
    float la[16];
#pragma unroll
    for (int i = 0; i < 16; ++i) { const int l = lq * 16 + i; const float* lr = LR + l * 32 + d * 16; float pre = gb;
#pragma unroll
        for (int j4 = 0; j4 < 4; ++j4) { const f32x4 v = *(const f32x4*)(lr + j4 * 4); pre += v[0] * gw[j4 * 4] + v[1] * gw[j4 * 4 + 1] + v[2] * gw[j4 * 4 + 2] + v[3] * gw[j4 * 4 + 3]; }
        la[i] = logsigmoidf(pre) * (1.0f / 16.0f); }
    if (d == 0) {
#pragma unroll
        for (int i = 1; i < 16; ++i) la[i] += la[i - 1];
        QS[(d * 4 + lq) * 64 + kk] = la[15];
    } else {
#pragma unroll
        for (int i = 14; i >= 0; --i) la[i] += la[i + 1];
        QS[(d * 4 + lq) * 64 + kk] = la[0];
    }
    __syncthreads();
    float off = 0.f;
    if (d == 0) { for (int q = 0; q < lq; ++q) off += QS[(0 * 4 + q) * 64 + kk]; }
    else { for (int q = 3; q > lq; --q) off += QS[(1 * 4 + q) * 64 + kk]; }
#pragma unroll
    for (int i = 0; i < 16; ++i) BC[(d * 64 + lq * 16 + i) * 65 + kk] = la[i] + off;
    __syncthreads();
}
__device__ __forceinline__ void gla_load_v(u32x4v& w0, u32x4v& w1, const u16* P0, int rowbase, int h) {
    const int t = threadIdx.x, l = t & 63, vg = t >> 6;
    const u16* src = P0 + (size_t)(rowbase + l) * P0_LD + P0_V + h * 128 + vg * 16;
    w0 = *(const u32x4v*)src; w1 = *(const u32x4v*)(src + 8);
}
__device__ __forceinline__ void gla_stage_vT(u16* vT, const u32x4v& w0, const u32x4v& w1) {
    const int t = threadIdx.x, l = t & 63, vg = t >> 6;
#pragma unroll
    for (int e = 0; e < 4; ++e) { vT[(vg * 16 + 2 * e) * GL_LD + l] = (u16)(w0[e] & 0xFFFF); vT[(vg * 16 + 2 * e + 1) * GL_LD + l] = (u16)(w0[e] >> 16);
        vT[(vg * 16 + 8 + 2 * e) * GL_LD + l] = (u16)(w1[e] & 0xFFFF); vT[(vg * 16 + 8 + 2 * e + 1) * GL_LD + l] = (u16)(w1[e] >> 16); }
}

__device__ void gla_a_item(unsigned char* shm, const Params& p, int b, int c, int h) {
    const u16* P0 = (const u16*)(p.ws + E_P0);
    const int rowbase = gla_rowbase(b, c), t = threadIdx.x, lane = t & 63, w = t >> 6;
    const u32x4v kw = *(const u32x4v*)(P0 + (size_t)(rowbase + (t & 63)) * P0_LD + P0_K + h * 64 + (t >> 6) * 8);
    u32x4v vw0, vw1; gla_load_v(vw0, vw1, P0, rowbase, h);
    gla_gates(shm, p, rowbase, h);
    const float* BC = (const float*)(shm + GL_BC);
    u16* kwT = (u16*)(shm + GL_X0);
    u16* vT = kwT + 2 * 64 * GL_LD;
    { const int l = t & 63, kg = t >> 6;
#pragma unroll
      for (int e = 0; e < 8; ++e) { const int k = kg * 8 + e; const float kv = (e & 1) ? bfhi(kw[e >> 1]) : bflo(kw[e >> 1]);
          const float w0 = __expf(BC[63 * 65 + k] - BC[l * 65 + k]), w1 = __expf(BC[(64 + 0) * 65 + k] - BC[(64 + l) * 65 + k]);
          kwT[k * GL_LD + l] = f2bf(kv * w0); kwT[(64 + k) * GL_LD + l] = f2bf(kv * w1); } }
    gla_stage_vT(vT, vw0, vw1);
    __syncthreads();
    { const int d = w >> 2, kb = w & 3; f32x4 acc[1][8]; zero_acc(acc);
      wave_mma<1, 8>(acc, kwT + (d * 64 + kb * 16) * GL_LD, GL_LD, vT, GL_LD, 2);
      float* DS = gla_ds_ptr(p, b, d, h, c);
#pragma unroll
      for (int nt = 0; nt < 8; ++nt) { const int v = nt * 16 + (lane & 15), k0 = kb * 16 + (lane >> 4) * 4; *(f32x4*)(DS + v * 64 + k0) = acc[0][nt]; } }
    if (t < 128) { const int d = t >> 6, kk = t & 63; const float bl = d == 0 ? BC[63 * 65 + kk] : BC[64 * 65 + kk];
        ((float*)(p.ws + OFF_DEC))[((size_t)((b * 2 + d) * 4 + h) * 68 + c) * 64 + kk] = __expf(bl); }
    __syncthreads();
}

__device__ void gmlp_item(unsigned char* shm, const Params& p, int b, int cc, int gi) {
    const u16* P0 = (const u16*)(p.ws + E_P0); u16* MG = (u16*)(p.ws + OFF_H);
    const int rowbase = cc < 2 ? RL + b * CTXL + cc * 128 : b * SEQ + (cc - 2) * 128;
    const int t = threadIdx.x, lane = t & 63, w = t >> 6;
    float* st = (float*)shm;
    u16* vnT = (u16*)(shm + 1024);
    u16* Ws = vnT + 128 * 136;
    { const int row = t >> 2, part = t & 3; const u16* src = P0 + (size_t)(rowbase + row) * P0_LD + P0_G + part * 128; float s = 0.f, ss = 0.f;
#pragma unroll 4
      for (int i = 0; i < 16; ++i) { const u32x4v wv = *(const u32x4v*)(src + i * 8);
#pragma unroll
          for (int e = 0; e < 4; ++e) { const float a = geluf(bflo(wv[e])), c2 = geluf(bfhi(wv[e])); s += a + c2; ss += a * a + c2 * c2; } }
      s += __shfl_xor(s, 1, 64); ss += __shfl_xor(ss, 1, 64); s += __shfl_xor(s, 2, 64); ss += __shfl_xor(ss, 2, 64);
      if (part == 0) { const float mu = s * (1.0f / 512.0f); const float var = fmaxf(ss * (1.0f / 512.0f) - mu * mu, 0.f); st[row * 2] = mu; st[row * 2 + 1] = rsqrtf(var + EPS); } }
    { const float* SW = p.in[I_ABSW] + (size_t)gi * 128 * 128;
#pragma unroll
      for (int ps = 0; ps < 8; ++ps) { const int idx = ps * 2048 + t * 4, tt = idx >> 7, s0 = idx & 127; const f32x4 v = *(const f32x4*)(SW + idx);
          u32x2 o; o[0] = pk2(v[0], v[1]); o[1] = pk2(v[2], v[3]); *(u32x2*)(Ws + tt * 136 + s0) = o; } }
    __syncthreads();
    { const int s = t & 127, cg4 = t >> 7; const u16* src = P0 + (size_t)(rowbase + s) * P0_LD + P0_G + gi * 128 + cg4 * 32; const float mu = st[s * 2], rstd = st[s * 2 + 1];
      const float* vg = p.in[I_ABVNG] + gi * 128 + cg4 * 32;
#pragma unroll
      for (int i = 0; i < 4; ++i) { const u32x4v wv = *(const u32x4v*)(src + i * 8);
#pragma unroll
          for (int e = 0; e < 8; ++e) { const float x = (e & 1) ? bfhi(wv[e >> 1]) : bflo(wv[e >> 1]); const int cl = i * 8 + e;
              vnT[(cg4 * 32 + cl) * 136 + s] = f2bf((geluf(x) - mu) * rstd * vg[cl]); } } }
    __syncthreads();
    { f32x4 acc[1][8]; zero_acc(acc);
      wave_mma<1, 8>(acc, vnT + (w * 16) * 136, 136, Ws, 136, 4);
      const int c0 = w * 16 + (lane >> 4) * 4;
#pragma unroll
      for (int nt = 0; nt < 8; ++nt) { const int tt = nt * 16 + (lane & 15); const float sb = p.in[I_ABSB][gi * 128 + tt];
          const u32x2 uw = *(const u32x2*)(P0 + (size_t)(rowbase + tt) * P0_LD + P0_U + gi * 128 + c0);
          const float o0 = geluf(bflo(uw[0])) * (acc[0][nt][0] + sb), o1 = geluf(bfhi(uw[0])) * (acc[0][nt][1] + sb), o2 = geluf(bflo(uw[1])) * (acc[0][nt][2] + sb), o3 = geluf(bfhi(uw[1])) * (acc[0][nt][3] + sb);
          u32x2 o; o[0] = pk2(o0, o1); o[1] = pk2(o2, o3); *(u32x2*)(MG + (size_t)(rowbase + tt) * DM + 512 + gi * 128 + c0) = o; } }
    __syncthreads();
}

__device__ void gla_scan_phase(const Params& p) {
    const float* DEC = (const float*)(p.ws + OFF_DEC);
    for (int g0 = blockIdx.x * 512 + threadIdx.x; g0 < 4 * 2 * 4 * 8192 / 2; g0 += gridDim.x * 512) {
        int e[2], bb[2], dd[2], hh[2]; const float* dec[2]; float s[2] = {0.f, 0.f};
#pragma unroll
        for (int q = 0; q < 2; ++q) { const int gidx = g0 + q * (4 * 2 * 4 * 8192 / 2); e[q] = gidx & 8191; const int bdh = gidx >> 13; hh[q] = bdh & 3; dd[q] = (bdh >> 2) & 1; bb[q] = bdh >> 3; dec[q] = DEC + (size_t)bdh * 68 * 64 + (e[q] & 63); }
        for (int i0 = 0; i0 < 68; i0 += 17) {
            float* ptr[2][17]; float ds[2][17], dc[2][17];
#pragma unroll
            for (int u = 0; u < 17; ++u)
#pragma unroll
                for (int q = 0; q < 2; ++q) { const int i = i0 + u; const int c = dd[q] == 0 ? i : (i < 4 ? 3 - i : 71 - i); ptr[q][u] = gla_ds_ptr(p, bb[q], dd[q], hh[q], c) + e[q]; ds[q][u] = *ptr[q][u]; dc[q][u] = dec[q][c * 64]; }
#pragma unroll
            for (int u = 0; u < 17; ++u)
#pragma unroll
                for (int q = 0; q < 2; ++q) { *ptr[q][u] = s[q]; s[q] = dc[q][u] * s[q] + ds[q][u]; }
        }
    }
}

__device__ void gla_c_item(unsigned char* shm, const Params& p, int b, int c, int h) {
    const u16* P0 = (const u16*)(p.ws + E_P0); u16* MG = (u16*)(p.ws + OFF_H);
    const int rowbase = gla_rowbase(b, c), t = threadIdx.x, lane = t & 63, w = t >> 6;
    const u16* rp_ = P0 + (size_t)(rowbase + (t & 63)) * P0_LD + h * 64 + (t >> 6) * 8;
    const u32x4v qw = *(const u32x4v*)(rp_ + P0_Q), kw = *(const u32x4v*)(rp_ + P0_K);
    u32x4v vw0, vw1; gla_load_v(vw0, vw1, P0, rowbase, h);
    f32x4 spa[4], spb[4];
#pragma unroll
    for (int ps = 0; ps < 4; ++ps) { const int idx = ps * 4096 + t * 8; const float* src = gla_ds_ptr(p, b, idx >> 13, h, c) + (idx & 8191); spa[ps] = *(const f32x4*)src; spb[ps] = *(const f32x4*)(src + 4); }
    const u16* rrp = P0 + (size_t)(rowbase + (t >> 3)) * P0_LD + P0_R + h * 128 + (t & 7) * 16;
    const u32x4v r0 = *(const u32x4v*)rrp, r1 = *(const u32x4v*)(rrp + 8);
    gla_gates(shm, p, rowbase, h);
    const float* BC = (const float*)(shm + GL_BC);
    u16* qd = (u16*)(shm + GL_X0);
    u16* kd = qd + 2 * 64 * GL_LD;
    u16* vT = kd + 2 * 64 * GL_LD;
    u16* SpT = vT + 128 * GL_LD;
    u16* SC = (u16*)(shm + GL_BC);
    float* O = (float*)SpT;
    { const int l = t & 63, kg = t >> 6;
#pragma unroll
      for (int d = 0; d < 2; ++d) { u32x4v qo, ko;
#pragma unroll
          for (int e2 = 0; e2 < 4; ++e2) { const float e0 = BC[(d * 64 + l) * 65 + kg * 8 + 2 * e2], e1 = BC[(d * 64 + l) * 65 + kg * 8 + 2 * e2 + 1];
              qo[e2] = pk2(bflo(qw[e2]) * 0.125f * __expf(e0), bfhi(qw[e2]) * 0.125f * __expf(e1));
              ko[e2] = pk2(bflo(kw[e2]) * __expf(-e0), bfhi(kw[e2]) * __expf(-e1)); }
          *(u32x4v*)(qd + (d * 64 + l) * GL_LD + kg * 8) = qo; *(u32x4v*)(kd + (d * 64 + l) * GL_LD + kg * 8) = ko; } }
    gla_stage_vT(vT, vw0, vw1);
#pragma unroll
    for (int ps = 0; ps < 4; ++ps) { const int idx = ps * 4096 + t * 8, d = idx >> 13, rem = idx & 8191, v = rem >> 6, k0 = rem & 63;
        *(u32x4v*)(SpT + (d * 128 + v) * GL_LD + k0) = pack8(spa[ps], spb[ps]); }
    __syncthreads();
    { const int d = w >> 2, lb = w & 3; f32x4 acc[1][4]; zero_acc(acc);
      wave_mma<1, 4>(acc, qd + (d * 64 + lb * 16) * GL_LD, GL_LD, kd + d * 64 * GL_LD, GL_LD, 2);
      __syncthreads();
#pragma unroll
      for (int nt = 0; nt < 4; ++nt)
#pragma unroll
          for (int j = 0; j < 4; ++j) { const int l = lb * 16 + (lane >> 4) * 4 + j, s = nt * 16 + (lane & 15); const bool keep = d == 0 ? (s <= l) : (s >= l);
              SC[(d * 64 + l) * GL_LD + s] = f2bf(keep ? acc[0][nt][j] : 0.f); } }
    __syncthreads();
    f32x4 oacc[1][4]; zero_acc(oacc);
    const int lb = w & 3, vh = w >> 2;
#pragma unroll
    for (int d = 0; d < 2; ++d) {
        wave_mma<1, 4>(oacc, qd + (d * 64 + lb * 16) * GL_LD, GL_LD, SpT + (d * 128 + vh * 64) * GL_LD, GL_LD, 2);
        wave_mma<1, 4>(oacc, SC + (d * 64 + lb * 16) * GL_LD, GL_LD, vT + (vh * 64) * GL_LD, GL_LD, 2);
    }
    __syncthreads();
#pragma unroll
    for (int nt = 0; nt < 4; ++nt)
#pragma unroll
        for (int j = 0; j < 4; ++j) { const int l = lb * 16 + (lane >> 4) * 4 + j, v = vh * 64 + nt * 16 + (lane & 15); O[l * 132 + v] = oacc[0][nt][j]; }
    __syncthreads();
    { const int l = t >> 3, part = t & 7; float o[16]; float ss = 0.f;
#pragma unroll
      for (int i = 0; i < 4; ++i) { const f32x4 v4 = *(const f32x4*)(O + l * 132 + part * 16 + i * 4);
#pragma unroll
          for (int e = 0; e < 4; ++e) { o[i * 4 + e] = v4[e]; ss += v4[e] * v4[e]; } }
      ss += __shfl_xor(ss, 1, 64); ss += __shfl_xor(ss, 2, 64); ss += __shfl_xor(ss, 4, 64);
      const float rs = rsqrtf(ss * (1.0f / 128.0f) + EPS);
      const float* gg = p.in[I_ABGNG] + h * 128 + part * 16; u32x4v o0, o1;
#pragma unroll
      for (int e2 = 0; e2 < 4; ++e2) {
          o0[e2] = pk2(o[2 * e2] * rs * gg[2 * e2] * siluf(bflo(r0[e2])), o[2 * e2 + 1] * rs * gg[2 * e2 + 1] * siluf(bfhi(r0[e2])));
          o1[e2] = pk2(o[8 + 2 * e2] * rs * gg[8 + 2 * e2] * siluf(bflo(r1[e2])), o[8 + 2 * e2 + 1] * rs * gg[8 + 2 * e2 + 1] * siluf(bfhi(r1[e2]))); }
      u16* dst = MG + (size_t)(rowbase + l) * DM + h * 128 + part * 16; *(u32x4v*)dst = o0; *(u32x4v*)(dst + 8) = o1; }
    __syncthreads();
}

__device__ void conv_phase(const Params& p) {
    u16* XBC = (u16*)(p.ws + E_XBC); const u16* HALO = (const u16*)(p.ws + A_HALO);
    const int t = threadIdx.x, cg = t & 127, q = __builtin_amdgcn_readfirstlane(t >> 7);
    for (int it = blockIdx.x; it < (RT / 64) * 3; it += gridDim.x) {
        const int rb = it / 3, cp = (it % 3) * 1024, c0 = cp + cg * 8;
        const bool first = rb < 256 ? ((rb & 63) == 0) : (((rb - 256) & 3) == 0);
        const bool last = rb < 256 ? ((rb & 63) == 63) : (((rb - 256) & 3) == 3);
        const bool z0 = (q == 0) && first, z1 = (q == 3) && last;
        u16* rowq = XBC + ((size_t)rb * 64 + 16 * q) * XBC_LD + cp;
        const u16* pre = (q == 0) ? (z0 ? rowq : HALO + ((size_t)(rb - 1) * 4 + 2) * XBC_LD + cp) : rowq - 2 * XBC_LD;
        const u16* post = (q == 3) ? (z1 ? rowq : HALO + ((size_t)(rb + 1) * 4) * XBC_LD + cp) : rowq + 16 * XBC_LD;
        u32x4v win[20];
        win[0] = *(const u32x4v*)(pre + cg * 8); win[1] = *(const u32x4v*)(pre + XBC_LD + cg * 8);
#pragma unroll
        for (int i = 0; i < 16; ++i) win[2 + i] = *(const u32x4v*)(rowq + (size_t)i * XBC_LD + cg * 8);
        win[18] = *(const u32x4v*)(post + cg * 8); win[19] = *(const u32x4v*)(post + XBC_LD + cg * 8);
        const u32x4v zero = {0u, 0u, 0u, 0u};
        if (z0) { win[0] = zero; win[1] = zero; }
        if (z1) { win[18] = zero; win[19] = zero; }
        float wt[5][8], bias[8];
#pragma unroll
        for (int j = 0; j < 5; ++j) { const f32x4 a = *(const f32x4*)(p.in[I_SSDCW] + j * 3072 + c0), b2 = *(const f32x4*)(p.in[I_SSDCW] + j * 3072 + c0 + 4);
#pragma unroll
            for (int e = 0; e < 4; ++e) { wt[j][e] = a[e]; wt[j][4 + e] = b2[e]; } }
        { const f32x4 a = *(const f32x4*)(p.in[I_SSDCB] + c0), b2 = *(const f32x4*)(p.in[I_SSDCB] + c0 + 4);
#pragma unroll
          for (int e = 0; e < 4; ++e) { bias[e] = a[e]; bias[4 + e] = b2[e]; } }
        __syncthreads();
#pragma unroll
        for (int r = 0; r < 16; ++r) {
            float o[8];
#pragma unroll
            for (int e = 0; e < 8; ++e) o[e] = bias[e];
#pragma unroll
            for (int j = 0; j < 5; ++j)
#pragma unroll
                for (int e2 = 0; e2 < 4; ++e2) { o[2 * e2] += wt[j][2 * e2] * bflo(win[r + j][e2]); o[2 * e2 + 1] += wt[j][2 * e2 + 1] * bfhi(win[r + j][e2]); }
            u32x4v ov;
#pragma unroll
            for (int e2 = 0; e2 < 4; ++e2) ov[e2] = pk2(siluf(o[2 * e2]), siluf(o[2 * e2 + 1]));
            *(u32x4v*)(rowq + (size_t)r * XBC_LD + cg * 8) = ov;
        }
    }
}
__device__ void dt_phase(unsigned char* shm, const Params& p) {
    const float* DTRAW = (const float*)(p.ws + A_DTRAW); float* DT = (float*)(p.ws + T_DT); float* ACUM = (float*)(p.ws + T_ACUM);
    float* tile = (float*)shm;
    float* tdt = tile + 128 * 65;
    const int t = threadIdx.x, col = t & 63;
    const float bias = p.in[I_SSDDTB][col], a = -__expf(p.in[I_SSDALOG][col]);
    for (int ch = blockIdx.x; ch < RT / 128; ch += gridDim.x) {
        const size_t r0 = (size_t)ch * 128;
#pragma unroll
        for (int i = 0; i < 16; ++i) { const int m = i * 8 + (t >> 6); const float d = softplusf(DTRAW[(r0 + m) * 64 + col] + bias); tdt[m * 65 + col] = d; tile[m * 65 + col] = d * a; }
        __syncthreads();
        if (t < 64) { float run = 0.f;
            if (t < 32) { for (int m = 0; m < 128; ++m) { run += tile[m * 65 + t]; tile[m * 65 + t] = run; } }
            else { for (int m = 127; m >= 0; --m) { run += tile[m * 65 + t]; tile[m * 65 + t] = run; } } }
        __syncthreads();
        { const int m = t & 127, cq = t >> 7;
#pragma unroll
          for (int i = 0; i < 16; ++i) { const int c = cq * 16 + i; ACUM[(size_t)c * RT + r0 + m] = tile[m * 65 + c]; DT[(size_t)c * RT + r0 + m] = tdt[m * 65 + c]; } }
        __syncthreads();
    }
}
constexpr int SP_LD = 136;
constexpr int SP_C = 0;
constexpr int SP_B = SP_C + 128 * SP_LD * 2;
constexpr int SP_CB = SP_B + 128 * SP_LD * 2;
constexpr int SP_AC = SP_CB + 128 * SP_LD * 2;
constexpr int SP_DT = SP_AC + 16 * 128 * 4;
constexpr int SP_END = SP_DT + 16 * 128 * 4;
static_assert(SP_END <= LDS_XB, "SSD par LDS");
__device__ void ssd_par_item(unsigned char* shm, const Params& p, int item) {
    const u16* XBC = (const u16*)(p.ws + E_XBC); u16* Y = (u16*)(p.ws + E_Y);
    const float* DT = (const float*)(p.ws + T_DT); const float* ACUM = (const float*)(p.ws + T_ACUM);
    const int g = item & 3, base = (item >> 2) * 128;
    u16* Cs = (u16*)(shm + SP_C); u16* Ms = Cs; u16* Bs = (u16*)(shm + SP_B); u16* xT = Bs; u16* CBs = (u16*)(shm + SP_CB);
    float* acs = (float*)(shm + SP_AC); float* dts = (float*)(shm + SP_DT);
    const int t = threadIdx.x, lane = t & 63, w = t >> 6, fr = lane & 15, fq = lane >> 4;
#pragma unroll
    for (int i = 0; i < 4; ++i) { const int idx = i * 512 + t, m = idx >> 4, seg = idx & 15; const u16* rp = XBC + (size_t)(base + m) * XBC_LD + g * 128 + seg * 8;
        *(u32x4v*)(Cs + m * SP_LD + seg * 8) = *(const u32x4v*)(rp + 2560); *(u32x4v*)(Bs + m * SP_LD + seg * 8) = *(const u32x4v*)(rp + 2048); }
#pragma unroll
    for (int i = 0; i < 4; ++i) { const int idx = i * 512 + t, q = idx >> 7, m = idx & 127, hh = q >> 1, dir = q & 1; const size_t o = (size_t)(dir * 32 + g * 8 + hh) * RT + base + m;
        acs[idx] = ACUM[o]; dts[idx] = DT[o]; }
    __syncthreads();
    { f32x4 acc[1][8]; zero_acc(acc);
      wave_mma<1, 8>(acc, Bs + (w * 16) * SP_LD, SP_LD, Cs, SP_LD, 4);
#pragma unroll
      for (int nt = 0; nt < 8; ++nt) { u32x2 o; o[0] = pk2(acc[0][nt][0], acc[0][nt][1]); o[1] = pk2(acc[0][nt][2], acc[0][nt][3]); *(u32x2*)(CBs + (nt * 16 + fr) * SP_LD + w * 16 + fq * 4) = o; } }
    __syncthreads();
    const int seg = t & 15, mq = t >> 4, xs_ = t & 127, pseg = t >> 7, mrow0 = w * 16;
    u32x4v nx0, nx1;
    { const u16* xp = XBC + (size_t)(base + xs_) * XBC_LD + (g * 8) * 64 + pseg * 16; nx0 = *(const u32x4v*)xp; nx1 = *(const u32x4v*)(xp + 8); }
    for (int hh = 0; hh < 8; ++hh) {
        const int h = g * 8 + hh;
        const float* af = acs + (hh * 2) * 128; const float* ab = af + 128; const float* dtf = dts + (hh * 2) * 128; const float* dtb = dtf + 128;
        u32x2 xsv[4];
        { const size_t row = (size_t)(base + mrow0 + fr);
#pragma unroll
          for (int mt = 0; mt < 4; ++mt) xsv[mt] = *(const u32x2*)(XBC + row * XBC_LD + h * 64 + mt * 16 + fq * 4); }
        { const u32x4v x0 = nx0, x1 = nx1;
          if (hh < 7) { const u16* xp = XBC + (size_t)(base + xs_) * XBC_LD + (h + 1) * 64 + pseg * 16; nx0 = *(const u32x4v*)xp; nx1 = *(const u32x4v*)(xp + 8); }
#pragma unroll
          for (int e2 = 0; e2 < 4; ++e2) { xT[(pseg * 16 + 2 * e2) * SP_LD + xs_] = (u16)(x0[e2] & 0xFFFFu); xT[(pseg * 16 + 2 * e2 + 1) * SP_LD + xs_] = (u16)(x0[e2] >> 16);
              xT[(pseg * 16 + 8 + 2 * e2) * SP_LD + xs_] = (u16)(x1[e2] & 0xFFFFu); xT[(pseg * 16 + 8 + 2 * e2 + 1) * SP_LD + xs_] = (u16)(x1[e2] >> 16); } }
        { float afs[8], abs_[8], wf[8], wb[8];
#pragma unroll
          for (int q = 0; q < 2; ++q) { const f32x4 a4 = *(const f32x4*)(af + seg * 8 + 4 * q), b4 = *(const f32x4*)(ab + seg * 8 + 4 * q), c4 = *(const f32x4*)(dtf + seg * 8 + 4 * q), d4 = *(const f32x4*)(dtb + seg * 8 + 4 * q);
#pragma unroll
              for (int e = 0; e < 4; ++e) { afs[4 * q + e] = a4[e]; abs_[4 * q + e] = b4[e]; wf[4 * q + e] = c4[e]; wb[4 * q + e] = d4[e]; } }
#pragma unroll
          for (int i = 0; i < 4; ++i) { const int m = mq + 32 * i; const u32x4v cw = *(const u32x4v*)(CBs + m * SP_LD + seg * 8); const float amf = af[m], amb = ab[m]; float v[8];
#pragma unroll
              for (int e = 0; e < 8; ++e) { const int s2 = seg * 8 + e; const float cbv = (e & 1) ? bfhi(cw[e >> 1]) : bflo(cw[e >> 1]);
                  const float arg = s2 < m ? (amf - afs[e]) : (s2 > m ? (amb - abs_[e]) : 0.f); const float wgt = s2 < m ? wf[e] : (s2 > m ? wb[e] : wf[e] + wb[e]);
                  v[e] = cbv * __expf(arg) * wgt; }
              u32x4v mv; mv[0] = pk2(v[0], v[1]); mv[1] = pk2(v[2], v[3]); mv[2] = pk2(v[4], v[5]); mv[3] = pk2(v[6], v[7]);
              *(u32x4v*)(Ms + m * SP_LD + seg * 8) = mv; } }
        __syncthreads();
        f32x4 yT[4][1]; zero_acc(yT);
        wave_mma<4, 1>(yT, xT, SP_LD, Ms + mrow0 * SP_LD, SP_LD, 4);
        __syncthreads();
        { const float dsk = p.in[I_SSDD][h]; const size_t row = (size_t)(base + mrow0 + fr);
#pragma unroll
          for (int mt = 0; mt < 4; ++mt) { const int p0 = h * 64 + mt * 16 + fq * 4; const u32x2 xs = xsv[mt];
              u32x2 o; o[0] = pk2(yT[mt][0][0] + dsk * bflo(xs[0]), yT[mt][0][1] + dsk * bfhi(xs[0])); o[1] = pk2(yT[mt][0][2] + dsk * bflo(xs[1]), yT[mt][0][3] + dsk * bfhi(xs[1]));
              *(u32x2*)(Y + row * 2048 + p0) = o; } }
    }
}

constexpr int SS_LD = 136, SS_LB = 130;
constexpr int SS_C = 0;
constexpr int SS_B = SS_C + 128 * SS_LD * 2;
constexpr int SS_XW = SS_B + 128 * 256;
constexpr int SS_S = SS_XW + 32 * SS_LD * 2;
constexpr int SS_AC = SS_S + 32 * SS_LD * 2;
constexpr int SS_END = SS_AC + 512;
static_assert(SS_END <= LDS_XB, "SSD LDS");

__device__ __forceinline__ void lds_barrier() { asm volatile("s_waitcnt lgkmcnt(0)\n\ts_barrier" ::: "memory"); }
__device__ __forceinline__ unsigned ssd_off_b(unsigned row, unsigned ch) { return 256u * row + 16u * (ch ^ (((row & 3u) << 2) | ((row >> 2) & 3u))); }
__device__ __forceinline__ unsigned ssd_tr_addr(unsigned lane, unsigned c, unsigned ks, unsigned t) { const unsigned g = lane >> 4, q = (lane & 15u) >> 2, p = lane & 3u; return ssd_off_b(32u * ks + 8u * g + 4u * t + q, 2u * c + (p >> 1)) + 8u * (p & 1u); }
typedef unsigned short u16x4v __attribute__((ext_vector_type(4)));
struct SsdPre { u32x4v rC[4], rB[4], rX; u32x2 rY[2]; float rDt, rAcX, rAlast; };
__device__ __forceinline__ void ssd_item(unsigned char* shm, const Params& p, int b, int h, int ph) {
    const u16* XBC = (const u16*)(p.ws + E_XBC); u16* Y = (u16*)(p.ws + E_Y);
    const float* DT = (const float*)(p.ws + T_DT); const float* ACUM = (const float*)(p.ws + T_ACUM);
    u16* Cs = (u16*)(shm + SS_C); u16* Bs = (u16*)(shm + SS_B); u16* xwT = (u16*)(shm + SS_XW); u16* Sb = (u16*)(shm + SS_S);
    float* acs = (float*)(shm + SS_AC);
    const int t = threadIdx.x, lane = t & 63, w = t >> 6, g = h >> 3, fr = lane & 15, fq = lane >> 4;
    const int xcol = h * 64 + ph * 32, bcol = 2048 + g * 128, ccol = 2560 + g * 128;
    const int seg = t & 15, mq = t >> 4, xm = t & 127, xseg = t >> 7, mrow0 = w * 16;
    unsigned tra[8];
    { const unsigned bs_lds = (unsigned)(size_t)((__attribute__((address_space(3))) unsigned char*)(shm + SS_B));
#pragma unroll
      for (int k = 0; k < 4; ++k)
#pragma unroll
          for (int tq = 0; tq < 2; ++tq) tra[2 * k + tq] = bs_lds + ssd_tr_addr((unsigned)lane, (unsigned)w, (unsigned)k, (unsigned)tq); }
    for (int dir = 0; dir < 2; ++dir) {
        const float* dtc = DT + (size_t)(dir * 32 + h) * RT; const float* acc_ = ACUM + (size_t)(dir * 32 + h) * RT;
        f32x4 accS[1][2]; zero_acc(accS);
        SsdPre R0, R1;
        { const u32x4v z4 = {0u, 0u, 0u, 0u}; const u32x2 z2 = {0u, 0u};
#pragma unroll
          for (int i = 0; i < 4; ++i) { R0.rC[i] = z4; R1.rC[i] = z4; }
          R0.rY[0] = z2; R0.rY[1] = z2; R1.rY[0] = z2; R1.rY[1] = z2; }
        auto base_of = [&](int st) __attribute__((always_inline)) { return st < 2 ? RL + b * CTXL + (dir == 0 ? st : 1 - st) * 128 : b * SEQ + (dir == 0 ? st - 2 : 33 - st) * 128; };
        auto prefetch = [&](SsdPre& R, int st) __attribute__((always_inline)) {
            const int base_ = base_of(st); const bool ctx_ = st < 2;
#pragma unroll
            for (int i = 0; i < 4; ++i) { const int m = mq + 32 * i; const u16* rp = XBC + (size_t)(base_ + m) * XBC_LD + seg * 8; R.rB[i] = *(const u32x4v*)(rp + bcol); if (!ctx_) R.rC[i] = *(const u32x4v*)(rp + ccol); }
            R.rX = *(const u32x4v*)(XBC + (size_t)(base_ + xm) * XBC_LD + xcol + xseg * 8); R.rDt = dtc[base_ + xm]; R.rAcX = acc_[base_ + xm]; R.rAlast = acc_[base_ + (dir == 0 ? 127 : 0)];
        };
        auto prefetch_y = [&](SsdPre& R, int st) __attribute__((always_inline)) {
            if (st >= 2) { const int base_ = base_of(st);
#pragma unroll
                for (int mt = 0; mt < 2; ++mt) R.rY[mt] = *(const u32x2*)(Y + (size_t)(base_ + mrow0 + fr) * 2048 + xcol + mt * 16 + fq * 4); } };
        auto do_step = [&](SsdPre& R, int step) __attribute__((always_inline)) {
            const bool isctx = step < 2;
            const int base = base_of(step);
            const float a_last = __uint_as_float(__builtin_amdgcn_readfirstlane(__float_as_uint(R.rAlast)));
            const bool pf = step + 2 < 34; const int base2 = base_of(pf ? step + 2 : step);
            if (xseg == 0) acs[xm] = R.rAcX;
            const float wgt = R.rDt * __expf(a_last - R.rAcX);
            if (pf) { R.rDt = dtc[base2 + xm]; R.rAcX = acc_[base2 + xm]; R.rAlast = acc_[base2 + (dir == 0 ? 127 : 0)]; }
#pragma unroll
            for (int i = 0; i < 4; ++i) { const int m = mq + 32 * i; const u16* rp2 = XBC + (size_t)(base2 + m) * XBC_LD + seg * 8;
                *(u32x4v*)((unsigned char*)Bs + ssd_off_b((unsigned)m, (unsigned)seg)) = R.rB[i];
                if (pf) R.rB[i] = *(const u32x4v*)(rp2 + bcol);
                if (!isctx) *(u32x4v*)(Cs + m * SS_LD + seg * 8) = R.rC[i];
                if (pf) R.rC[i] = *(const u32x4v*)(rp2 + ccol); }
            {
#pragma unroll
              for (int e = 0; e < 8; ++e) { const float x = (e & 1) ? bfhi(R.rX[e >> 1]) : bflo(R.rX[e >> 1]); xwT[(xseg * 8 + e) * SS_LD + xm] = f2bf(x * wgt); }
              if (pf) R.rX = *(const u32x4v*)(XBC + (size_t)(base2 + xm) * XBC_LD + xcol + xseg * 8); }
            if (!isctx) {
#pragma unroll
                for (int nt = 0; nt < 2; ++nt) { u32x2 o; o[0] = pk2(accS[0][nt][0], accS[0][nt][1]); o[1] = pk2(accS[0][nt][2], accS[0][nt][3]); *(u32x2*)(Sb + (nt * 16 + fr) * SS_LD + mrow0 + fq * 4) = o; } }
            lds_barrier();
            if (!isctx) {
                f32x4 yT[2][1]; zero_acc(yT);
                { bf16x8 fa[4][2], fb[4];
#pragma unroll
                  for (int k = 0; k < 4; ++k) { fa[k][0] = *(const bf16x8*)(Sb + fr * SS_LD + k * 32 + fq * 8); fa[k][1] = *(const bf16x8*)(Sb + (16 + fr) * SS_LD + k * 32 + fq * 8);
                      fb[k] = *(const bf16x8*)(Cs + (mrow0 + fr) * SS_LD + k * 32 + fq * 8); }
#pragma unroll
                  for (int k = 0; k < 4; ++k) { yT[0][0] = __builtin_amdgcn_mfma_f32_16x16x32_bf16(fa[k][0], fb[k], yT[0][0], 0, 0, 0); yT[1][0] = __builtin_amdgcn_mfma_f32_16x16x32_bf16(fa[k][1], fb[k], yT[1][0], 0, 0, 0); } }
                const float sc = __expf(acs[mrow0 + fr]);
                const size_t row = (size_t)(base + mrow0 + fr);
#pragma unroll
                for (int mt = 0; mt < 2; ++mt) { u16* yp = Y + row * 2048 + xcol + mt * 16 + fq * 4; const u32x2 pv = R.rY[mt];
                    u32x2 o; o[0] = pk2(bflo(pv[0]) + sc * yT[mt][0][0], bfhi(pv[0]) + sc * yT[mt][0][1]); o[1] = pk2(bflo(pv[1]) + sc * yT[mt][0][2], bfhi(pv[1]) + sc * yT[mt][0][3]);
                    asm volatile("global_store_dwordx2 %0, %1, off" :: "v"(yp), "v"(o) : "memory"); }
            }
            if (step + 2 < 34) prefetch_y(R, step + 2);
            { const float dl = __expf(a_last);
#pragma unroll
              for (int nt = 0; nt < 2; ++nt)
#pragma unroll
                  for (int j = 0; j < 4; ++j) accS[0][nt][j] *= dl; }
            { bf16x8 ga[4], gb[4][2];
              u16x4v tr[8];
              asm volatile("ds_read_b64_tr_b16 %0, %8\n\tds_read_b64_tr_b16 %1, %9\n\tds_read_b64_tr_b16 %2, %10\n\tds_read_b64_tr_b16 %3, %11\n\t"
                           "ds_read_b64_tr_b16 %4, %12\n\tds_read_b64_tr_b16 %5, %13\n\tds_read_b64_tr_b16 %6, %14\n\tds_read_b64_tr_b16 %7, %15\n\ts_waitcnt lgkmcnt(0)"
                           : "=&v"(tr[0]), "=&v"(tr[1]), "=&v"(tr[2]), "=&v"(tr[3]), "=&v"(tr[4]), "=&v"(tr[5]), "=&v"(tr[6]), "=&v"(tr[7])
                           : "v"(tra[0]), "v"(tra[1]), "v"(tra[2]), "v"(tra[3]), "v"(tra[4]), "v"(tra[5]), "v"(tra[6]), "v"(tra[7]) : "memory");
#pragma unroll
              for (int k = 0; k < 4; ++k) {
#pragma unroll
                  for (int e = 0; e < 4; ++e) { ga[k][e] = (short)tr[2 * k][e]; ga[k][4 + e] = (short)tr[2 * k + 1][e]; }
#pragma unroll
                  for (int nt = 0; nt < 2; ++nt) gb[k][nt] = *(const bf16x8*)(xwT + (nt * 16 + fr) * SS_LD + k * 32 + fq * 8); }
#pragma unroll
              for (int k = 0; k < 4; ++k)
#pragma unroll
                  for (int nt = 0; nt < 2; ++nt) accS[0][nt] = __builtin_amdgcn_mfma_f32_16x16x32_bf16(ga[k], gb[k][nt], accS[0][nt], 0, 0, 0); }
            lds_barrier();
        };
        prefetch(R0, 0); prefetch(R1, 1); prefetch_y(R0, 0); prefetch_y(R1, 1);
        for (int step = 0; step < 34; step += 2) { do_step(R0, step); do_step(R1, step + 1); }
        asm volatile("s_waitcnt vmcnt(0)" ::: "memory");
    }
}

__device__ void ssd_finish_phase(const Params& p) {
    u16* Y = (u16*)(p.ws + E_Y); const u16* Z = (const u16*)(p.ws + E_Z);
    const int lane = threadIdx.x & 63, wid = threadIdx.x >> 6;
    const int stride = gridDim.x * 8;
    for (int it0 = blockIdx.x * 8 + wid; it0 < RL * 4; it0 += 4 * stride) {
        u32x4v yw[4], zw[4]; size_t off[4]; bool ok[4];
#pragma unroll
        for (int u = 0; u < 4; ++u) { const int it = it0 + u * stride; ok[u] = it < RL * 4; off[u] = ok[u] ? (size_t)(it >> 2) * 2048 + (it & 3) * 512 + lane * 8 : 0;
            yw[u] = *(const u32x4v*)(Y + off[u]); zw[u] = *(const u32x4v*)(Z + off[u]); }
#pragma unroll
        for (int u = 0; u < 4; ++u) { const int it = it0 + u * stride;
            float v[8]; float ss = 0.f;
#pragma unroll
            for (int e2 = 0; e2 < 4; ++e2) { v[2 * e2] = bflo(yw[u][e2]) * siluf(bflo(zw[u][e2])); v[2 * e2 + 1] = bfhi(yw[u][e2]) * siluf(bfhi(zw[u][e2])); ss += v[2 * e2] * v[2 * e2] + v[2 * e2 + 1] * v[2 * e2 + 1]; }
            ss = wave_sum(ss);
            const float rs = rsqrtf(ss * (1.0f / 512.0f) + EPS);
            const float* gg = p.in[I_SSDNG] + (it & 3) * 512 + lane * 8; u32x4v o;
#pragma unroll
            for (int e2 = 0; e2 < 4; ++e2) o[e2] = pk2(v[2 * e2] * rs * gg[2 * e2], v[2 * e2 + 1] * rs * gg[2 * e2 + 1]);
            if (ok[u]) *(u32x4v*)(Y + off[u]) = o; }
    }
}

__global__ __launch_bounds__(512, 2) void mega(Params p) {
    extern __shared__ __attribute__((aligned(16))) unsigned char shm[];
    cg::grid_group grid = cg::this_grid();
    unsigned char* ws = p.ws;
    float* MOD = (float*)(ws + OFF_MOD); const float* MOD1 = MOD + 5 * NMOD * DM;
    u16* H = (u16*)(ws + OFF_H); float* XC = (float*)(ws + OFF_XC);
    const int bid = blockIdx.x, nb = gridDim.x;
    volatile LAS unsigned* xst = (volatile LAS unsigned*)(shm + LDS_XB);
    if (threadIdx.x < 2) xst[threadIdx.x] = 0u;
    __syncthreads();
    const XcdBarrier xb = xcd_barrier_post((unsigned*)(ws + OFF_BAR), xst);
    mod_gemv(shm, p);
    convert_weights_early(shm, p);
    if (p.ws == nullptr) grid.sync();
    xcd_barrier(xb);
    norm_mod_phase(p.in[I_X], p.in[I_CTX], p.in[I_NORMG], MOD, 0, 1, RT, 0, H);
    xcd_barrier(xb);
    { EpiBf16Plain E; E.O = (u16*)(ws + E_P0); E.ld = P0_LD; E.ncols = P0_LD; run_gemm(shm, H, (const u16*)(ws + A_AB_IN), RT, 2816, 1024, E); }
    xcd_barrier(xb);
    for (int it = bid; it < 4 * 68 * 4; it += nb) { const int h = it & 3, bc = it >> 2; gla_a_item(shm, p, bc / 68, bc % 68, h); }
    xcd_barrier(xb);
    gla_scan_phase(p);
    xcd_barrier(xb);
    for (int it = bid; it < 4 * 68 * 4; it += nb) { const int h = it & 3, bc = it >> 2; gla_c_item(shm, p, bc / 68, bc % 68, h); }
    {
        const int nlo = (4 * 68 * 4) % nb, first = nb > nlo ? nlo : 0, nw = nb - first;
        if (bid >= first) for (int j = bid - first; j < 4 * 34 * 4; j += nw) { const int gi = j & 3, bc = j >> 2; gmlp_item(shm, p, bc / 34, bc % 34, gi); }
    }
    xcd_barrier(xb);
    { EpiRes E; E.src_lat = p.in[I_X]; E.src_ctx = p.in[I_CTX]; E.dst_lat = p.out; E.dst_ctx = XC; E.gate = MOD + 2 * DM; E.cm = 0; E.part = (float*)(ws + E_PART);
      run_gemm_split(shm, H, (const u16*)(ws + A_AB_OUT), 1024, 1024, E); }
    xcd_barrier(xb);
    norm_mod_phase(p.out, p.in[I_CTX], p.in[I_NORMG] + DM, MOD, 3, 4, RT, 0, H, (const float*)(ws + E_PART), 4, MOD + 4 * (NMOD * DM) + 2 * DM, XC);
    xcd_barrier(xb);
    { EpiSwiglu E; E.O = (u16*)(ws + E_ACT); run_gemm(shm, H, (const u16*)(ws + A_FF_IN0), RT, 5632, 1024, E); }
    xcd_barrier(xb);
    { EpiRes E; E.src_lat = p.out; E.src_ctx = XC; E.dst_lat = p.out; E.dst_ctx = XC; E.gate = MOD + 5 * DM; E.cm = 0; E.part = (float*)(ws + E_PART);
      run_gemm_split(shm, (const u16*)(ws + E_ACT), (const u16*)(ws + A_FF_OUT0), 1024, 2816, E); }
    xcd_barrier(xb);
    norm_mod_phase(p.out, XC, p.in[I_NORMG] + 2 * DM, MOD1, 0, 1, RT, 1, H, (const float*)(ws + E_PART), 11, MOD + 4 * (NMOD * DM) + 5 * DM, XC);
    xcd_barrier(xb);
    { EpiSsdIn E; E.XBC = (u16*)(ws + E_XBC); E.HALO = (u16*)(ws + A_HALO); E.DTRAW = (float*)(ws + A_DTRAW); run_gemm(shm, H, (const u16*)(ws + B_SSD_INA), RT, 3328, 1024, E); }
    xcd_barrier(xb);
    dt_phase(shm, p);
    conv_phase(p);
    xcd_barrier(xb);
    for (int it = bid; it < 4 * 32 * 4; it += nb) ssd_par_item(shm, p, it);
    xcd_barrier(xb);
    {
        unsigned* cnt = (unsigned*)(ws + OFF_BAR) + XCD_BAR_WORDS;
        volatile int* s_item_p = (volatile int*)(shm + LDS_XB + 8);
        if (nb == 256) {
            if (threadIdx.x == 0) { int item = -1;
                for (int k = 0; k < 8 && item < 0; ++k) { const unsigned y = (xb.x + k) & 7u; const unsigned r = xb_add(&cnt[y * 16], 1u); if (r < 32u) item = (int)(y * 32u + r); }
                *s_item_p = item; }
            __syncthreads();
            const int item = *s_item_p;
            if (item >= 0) { const int grp = item >> 4, idx = item & 15; ssd_item(shm, p, grp >> 2, (grp & 3) * 8 + (idx >> 1), idx & 1); }
        } else {
            for (int it = bid; it < 4 * 32 * 2; it += nb) { const int grp = it >> 4, idx = it & 15; ssd_item(shm, p, grp >> 2, (grp & 3) * 8 + (idx >> 1), idx & 1); }
        }
    }
    xcd_barrier(xb);
    { EpiBf16Plain E; E.O = (u16*)(ws + E_Z); E.ld = 2048; E.ncols = 2048; run_gemm(shm, H, (const u16*)(ws + B_WZ), RL, 2048, 1024, E); }
    convert_weights_late(shm, p);
    xcd_barrier(xb);
    ssd_finish_phase(p);
    xcd_barrier(xb);
    { EpiRes E; E.src_lat = p.out; E.src_ctx = XC; E.dst_lat = p.out; E.dst_ctx = XC; E.gate = MOD1 + 2 * DM; E.cm = 1; E.part = nullptr;
      run_gemm(shm, (const u16*)(ws + E_Y), (const u16*)(ws + A_SSD_OUT), RL, 1024, 2048, E); }
    xcd_barrier(xb);
    norm_mod_phase(p.out, XC, p.in[I_NORMG] + 3 * DM, MOD1, 3, 4, RL, 0, H);
    xcd_barrier(xb);
    { EpiSwiglu E; E.O = (u16*)(ws + E_ACT); run_gemm(shm, H, (const u16*)(ws + A_FF_IN1), RL, 5632, 1024, E); }
    xcd_barrier(xb);
    { EpiRes E; E.src_lat = p.out; E.src_ctx = XC; E.dst_lat = p.out; E.dst_ctx = XC; E.gate = MOD1 + 5 * DM; E.cm = 0; E.part = nullptr;
      run_gemm(shm, (const u16*)(ws + E_ACT), (const u16*)(ws + A_FF_OUT1), RL, 1024, 2816, E); }
    xcd_barrier(xb);
    final_norm_phase(p.out, p.in[I_FNG]);
}

extern "C" void kernel_launch(void* const* d_in, const int* in_sizes, int n_in, void* d_out, int out_size, void* d_ws, size_t ws_size, hipStream_t stream) {
    static int grid_blocks = 0;
    if (!grid_blocks) {
        int dev = 0, cus = 0, per_cu = 0;
        (void)hipGetDevice(&dev);
        (void)hipDeviceGetAttribute(&cus, hipDeviceAttributeMultiprocessorCount, dev);
        (void)hipFuncSetAttribute((const void*)mega, hipFuncAttributeMaxDynamicSharedMemorySize, LDS_BYTES);
        (void)hipOccupancyMaxActiveBlocksPerMultiprocessor(&per_cu, (const void*)mega, 512, LDS_BYTES);
        if (per_cu < 1) { fprintf(stderr, "occupancy query says %d blocks/CU\n", per_cu); per_cu = 1; }
        if (per_cu > 1) per_cu = 1;
        grid_blocks = cus * per_cu;
        if (ws_size < WS_END) fprintf(stderr, "workspace too small: %zu < %zu\n", ws_size, (size_t)WS_END);
    }
    Params p{};
    for (int i = 0; i < 26; ++i) p.in[i] = (const float*)d_in[i];
    p.out = (float*)d_out; p.ws = (unsigned char*)d_ws;
    (void)hipMemsetAsync((unsigned char*)d_ws + OFF_BAR, 0, (XCD_BAR_WORDS + 128) * sizeof(unsigned), stream);
    void* args[] = {&p};
    hipError_t e = hipLaunchCooperativeKernel((const void*)mega, dim3(grid_blocks), dim3(512), args, LDS_BYTES, stream);
    if (e != hipSuccess) fprintf(stderr, "cooperative launch failed: %s (grid %d)\n", hipGetErrorString(e), grid_blocks);
}
```
